# Optimizing an MI355X kernel written in HIP

```python
import jax, jax.numpy as jnp
from jax import lax
import numpy as np

D_MODEL = 1024
BATCH = 4
SEQ = 8192
DEPTH = 2

D_MIX = D_MODEL
D_FOURIER = D_MIX // 2
D_SSM = D_MIX - D_FOURIER
FOURIER_HEADS = 8
FOURIER_HEAD_DIM = D_FOURIER // FOURIER_HEADS
SSM_GROUP = 16
SSM_GROUPS = D_SSM // SSM_GROUP
SSM_STATE = 64
N_DIR = 2
D_FF = 4 * D_MODEL
DT_MIN = 1e-3
DT_MAX = 1e-1
EPS = 1e-6

kernel_name = "hybrid_fnet_s5_sandwich_encoder"


def rms_norm(x, g):
    x32 = x.astype(jnp.float32)
    y = x32 * lax.rsqrt(jnp.mean(x32 * x32, axis=-1, keepdims=True) + EPS)
    return (y * g.astype(jnp.float32)).astype(x.dtype)


def fourier_mixer(u, w_f):
    b, l, _ = u.shape
    uh = u.astype(jnp.float32).reshape(b, l, FOURIER_HEADS, FOURIER_HEAD_DIM)
    f = jnp.fft.fft(jnp.fft.fft(uh, axis=3, norm="ortho"), axis=1, norm="ortho").real
    y = jnp.einsum("blhc,hcd->blhd", f, w_f.astype(jnp.float32))
    return y.reshape(b, l, D_FOURIER).astype(u.dtype)


def _combine(left, right):
    a_l, b_l = left
    a_r, b_r = right
    return a_r * a_l, a_r * b_l + b_r


def s5_direction(u, lam_re, lam_im, log_dt, b_re, b_im, c_re, c_im, reverse):
    f32 = jnp.float32
    lam = lax.complex(lam_re.astype(f32), lam_im.astype(f32))
    dt = jnp.exp(log_dt.astype(f32))[:, None]
    lam_bar = jnp.exp(lam * dt)
    b_bar = ((lam_bar - 1.0) / lam)[..., None] * lax.complex(b_re.astype(f32), b_im.astype(f32))
    bu = jnp.einsum("blgh,gph->blgp", u, b_bar)
    a = jnp.broadcast_to(lam_bar, bu.shape)
    _, s = lax.associative_scan(_combine, (a, bu), axis=1, reverse=reverse)
    c = lax.complex(c_re.astype(f32), c_im.astype(f32))
    return jnp.einsum("blgp,ghp->blgh", s, c).real


def ssm_mixer(u, lam_re, lam_im, log_dt, b_re, b_im, c_re, c_im, d_skip, w_glu, b_glu):
    bsz, l, _ = u.shape
    u32 = u.astype(jnp.float32).reshape(bsz, l, SSM_GROUPS, SSM_GROUP)
    y = d_skip.astype(jnp.float32) * u32
    for k in range(N_DIR):
        y = y + s5_direction(u32, lam_re[k], lam_im[k], log_dt[k], b_re[k], b_im[k],
                             c_re[k], c_im[k], reverse=(k == 1))
    y = y.reshape(bsz, l, D_SSM)
    g = jax.nn.gelu(y)
    out = g * jax.nn.sigmoid(g @ w_glu.astype(jnp.float32) + b_glu.astype(jnp.float32))
    return out.astype(u.dtype)


def setup_inputs(seed: int = 0) -> dict:
    key = jax.random.key(seed)
    ks = jax.random.split(key, 24)
    f32 = jnp.float32
    nrm = lambda k, s, scale: (jax.random.normal(k, s, f32) * scale)
    gain = lambda k, s: 1.0 + 0.02 * jax.random.normal(k, s, f32)
    G, H, P = SSM_GROUPS, SSM_GROUP, SSM_STATE
    x = jax.random.normal(ks[0], (BATCH, SEQ, D_MODEL), f32)
    w_in = nrm(ks[1], (DEPTH, D_MODEL, D_MIX), D_MODEL ** -0.5)
    w_out = nrm(ks[2], (DEPTH, D_MIX, D_MODEL), D_MIX ** -0.5)
    pre_mix_g = gain(ks[3], (DEPTH, D_MODEL))
    post_mix_g = gain(ks[4], (DEPTH, D_MODEL))
    pre_mlp_g = gain(ks[5], (DEPTH, D_MODEL))
    post_mlp_g = gain(ks[6], (DEPTH, D_MODEL))
    fourier_out_g = gain(ks[7], (DEPTH, D_FOURIER))
    ssm_out_g = gain(ks[8], (DEPTH, D_SSM))
    w_fourier = nrm(ks[9], (DEPTH, FOURIER_HEADS, FOURIER_HEAD_DIM, FOURIER_HEAD_DIM),
                    FOURIER_HEAD_DIM ** -0.5)
    lam_re = -0.5 + 0.01 * jax.random.normal(ks[10], (DEPTH, N_DIR, G, P), f32)
    lam_im = (jnp.arange(P, dtype=f32) * np.pi)[None, None, None, :] + \
        0.01 * jax.random.normal(ks[11], (DEPTH, N_DIR, G, P), f32)
    log_dt = jax.random.uniform(ks[12], (DEPTH, N_DIR, G), f32,
                                minval=np.log(DT_MIN), maxval=np.log(DT_MAX))
    b_re = nrm(ks[13], (DEPTH, N_DIR, G, P, H), (2.0 * H) ** -0.5)
    b_im = nrm(ks[14], (DEPTH, N_DIR, G, P, H), (2.0 * H) ** -0.5)
    c_re = nrm(ks[15], (DEPTH, N_DIR, G, H, P), 0.5 ** 0.5)
    c_im = nrm(ks[16], (DEPTH, N_DIR, G, H, P), 0.5 ** 0.5)
    d_skip = nrm(ks[17], (DEPTH, G, H), 1.0)
    w_glu = nrm(ks[18], (DEPTH, D_SSM, D_SSM), D_SSM ** -0.5)
    b_glu = nrm(ks[19], (DEPTH, D_SSM), 0.01)
    w_ff1 = nrm(ks[20], (DEPTH, D_MODEL, D_FF), D_MODEL ** -0.5)
    w_ff2 = nrm(ks[21], (DEPTH, D_FF, D_MODEL), D_FF ** -0.5)
    return {"x": x, "w_in": w_in, "w_out": w_out, "pre_mix_g": pre_mix_g,
            "post_mix_g": post_mix_g, "pre_mlp_g": pre_mlp_g, "post_mlp_g": post_mlp_g,
            "fourier_out_g": fourier_out_g, "ssm_out_g": ssm_out_g, "w_fourier": w_fourier,
            "lam_re": lam_re, "lam_im": lam_im, "log_dt": log_dt, "b_re": b_re, "b_im": b_im,
            "c_re": c_re, "c_im": c_im, "d_skip": d_skip, "w_glu": w_glu, "b_glu": b_glu,
            "w_ff1": w_ff1, "w_ff2": w_ff2}


def reference(x, w_in, w_out, pre_mix_g, post_mix_g, pre_mlp_g, post_mlp_g,
              fourier_out_g, ssm_out_g, w_fourier, lam_re, lam_im, log_dt,
              b_re, b_im, c_re, c_im, d_skip, w_glu, b_glu, w_ff1, w_ff2):
    for i in range(DEPTH):
        h = rms_norm(x, pre_mix_g[i])
        z = h @ w_in[i]
        zf = z[..., :D_FOURIER]
        zs = z[..., D_FOURIER:]
        yf = rms_norm(fourier_mixer(zf, w_fourier[i]), fourier_out_g[i])
        ys = rms_norm(ssm_mixer(zs, lam_re[i], lam_im[i], log_dt[i], b_re[i], b_im[i],
                                c_re[i], c_im[i], d_skip[i], w_glu[i], b_glu[i]),
                      ssm_out_g[i])
        m = jnp.concatenate([yf, ys], axis=-1) @ w_out[i]
        x = x + rms_norm(m, post_mix_g[i])
        h = rms_norm(x, pre_mlp_g[i])
        f = jnp.square(jax.nn.relu(h @ w_ff1[i])) @ w_ff2[i]
        x = x + rms_norm(f, post_mlp_g[i])
    return x
```

```cpp
#include <hip/hip_runtime.h>
#include <hip/hip_cooperative_groups.h>
#include <cstdio>
namespace cg = cooperative_groups;

#define LAS __attribute__((address_space(3)))
typedef unsigned short bf16;
typedef short bf16x8 __attribute__((ext_vector_type(8)));
typedef float f32x4 __attribute__((ext_vector_type(4)));
typedef float f32x2 __attribute__((ext_vector_type(2)));
typedef unsigned u32x4 __attribute__((ext_vector_type(4)));
typedef unsigned u32x2 __attribute__((ext_vector_type(2)));

constexpr int NB = 4, SEQ = 8192, DM = 1024, MT = NB * SEQ, DFO = 512, NHEAD = 8, SG = 32, SP = 64, DFF = 4096, NIN = 1536;
constexpr float EPS = 1e-6f;
constexpr int LDS_BYTES = 147456;
constexpr size_t MiB = 1u << 20;
constexpr size_t OFF_RA = 384 * 1024, OFF_RB = 512 * 1024;
constexpr size_t OFF_E3 = 1 * MiB, OFF_D1 = 2 * MiB, OFF_TM = 6 * MiB, OFF_MST = 22 * MiB, OFF_W = 30 * MiB;
constexpr size_t W_IN = 0, W_OUT = 3 * MiB, W_1 = 5 * MiB, W_2 = 13 * MiB, W_GLU = 21 * MiB, W_LAYER = 22 * MiB;
constexpr size_t OFF_XB = 76 * MiB, OFF_MF = 140 * MiB, OFF_G = 140 * MiB, OFF_H = 204 * MiB;
constexpr size_t OFF_PQ = 204 * MiB, OFF_AO = 204 * MiB, OFF_UB = 268 * MiB, OFF_T = 332 * MiB, OFF_SLOC = 396 * MiB, OFF_SSS = 460 * MiB, OFF_SSM = 461 * MiB, OFF_SSF = 463 * MiB, WS_END = 465 * MiB;

struct Params {
    const float *x, *w_in, *w_out, *pre_mix_g, *post_mix_g, *pre_mlp_g, *post_mlp_g, *fourier_out_g, *ssm_out_g, *w_fourier,
        *lam_re, *lam_im, *log_dt, *b_re, *b_im, *c_re, *c_im, *d_skip, *w_glu, *b_glu, *w_ff1, *w_ff2;
    float* out; unsigned char* ws;
    int ph_lo, ph_hi;
};

__device__ __forceinline__ unsigned f2bf(float f) { unsigned u = __builtin_bit_cast(unsigned, f); return (u + 0x7fffu + ((u >> 16) & 1u)) >> 16; }
__device__ __forceinline__ unsigned pk2(float lo, float hi) { return f2bf(lo) | (f2bf(hi) << 16); }
__device__ __forceinline__ float bflo(unsigned w) { return __builtin_bit_cast(float, w << 16); }
__device__ __forceinline__ float bfhi(unsigned w) { return __builtin_bit_cast(float, w & 0xffff0000u); }
__device__ __forceinline__ float wave_sum(float v) {
#pragma unroll
    for (int o = 1; o < 64; o <<= 1) v += __shfl_xor(v, o);
    return v;
}
__device__ __forceinline__ float gelu_t(float x) { const float u = 0.7978845608f * (x + 0.044715f * x * x * x); return x / (1.0f + __expf(-2.0f * u)); }
__device__ __forceinline__ float sigm(float v) { return 1.0f / (1.0f + __expf(-v)); }

namespace pg8 {
#define PG8_LAS __attribute__((address_space(3)))
typedef unsigned short bf16_t;
constexpr int BM = 256, BK = 64, HALF = 128, HTB = HALF * BK * 2, STAGE_BYTES = 8 * HTB, NXCD = 8, WGM = 8;
__host__ __device__ __forceinline__ int lds_byte(int r, int c) { const int st = (r >> 4) * 2 + (c >> 5), rr = r & 15, cc = c & 31, ob = rr * 64 + cc * 2; return st * 1024 + (ob ^ (((ob >> 9) & 1) << 5)); }
__host__ __device__ __forceinline__ void stage_rc(int b, int& R, int& C) { const int st = b / 1024, sb = b % 1024, swz = sb ^ (((sb >> 9) & 1) << 5); R = (st >> 1) * 16 + swz / 64; C = (st & 1) * 32 + (swz % 64) / 2; }
__host__ __device__ __forceinline__ int perm32(int rho) { const int n = rho >> 4, i = rho & 15; return 8 * (i >> 2) + 4 * n + (i & 3); }

struct Unit { int pm, pn, z; };
struct Gemm { const bf16_t* A; const bf16_t* Bt; int M, N, K, lda, ldb; size_t sA, sB; int nZ; };

struct Order {
    int nM, nN, nwg, nZ, G, c;
    __device__ void init(int M, int N, int nZ_, int G_, int c_) { nM = M / BM; nN = N / BM; nwg = nM * nN; nZ = nZ_; G = G_; c = c_; }
    __device__ bool next(int i, Unit& u) const {
        const long L = (long)i * G + c; if (L >= (long)nwg * nZ) return false;
        u.z = (int)(L / nwg);
        int wgid = (int)(L % nwg); { const int q = nwg / NXCD, r = nwg % NXCD, xcd = wgid % NXCD, off = wgid / NXCD; wgid = (xcd < r ? xcd * (q + 1) : r * (q + 1) + (xcd - r) * q) + off; }
        const int nig = WGM * nN, gid = wgid / nig, fm = gid * WGM, gsz = (nM - fm) < WGM ? (nM - fm) : WGM;
        u.pm = fm + ((wgid % nig) % gsz); u.pn = (wgid % nig) / gsz; return true;
    }
};

template <class Epi>
__device__ __forceinline__ void gemm_phase(PG8_LAS unsigned char* lds, const Gemm g, const Order& S, const Epi& E) {
    int tid = threadIdx.x; asm volatile("" : "+v"(tid));
    const int wid = __builtin_amdgcn_readfirstlane(tid >> 6), lane = tid & 63, wr = wid >> 2, wc = wid & 3, fr = lane & 15, fq = lane >> 4;
    const int K = g.K, nt = K / BK;
    unsigned voffA[2], voffB[2];
#pragma unroll
    for (int i = 0; i < 2; ++i) { int R, C; stage_rc(tid * 16 + i * 8192, R, C); const int Rb = Epi::PERM ? ((R & ~31) + perm32(R & 31)) : R;
        voffA[i] = (unsigned)(R * g.lda + C) * 2u; voffB[i] = (unsigned)(Rb * g.ldb + C) * 2u; }
    const size_t kstep = (size_t)(BK * 2);
    const size_t hA = (size_t)HALF * g.lda * 2, hB = (size_t)HALF * g.ldb * 2;
    const size_t tA = 2 * hA, tB = 2 * hB;
    const unsigned ldsw = (unsigned)wid * 1024u;
    const int aoff = lds_byte(wr * 64 + fr, fq * 8), boff = lds_byte(wc * 32 + fr, fq * 8);
#define PG8_SA(b, h) (((b) * 2 + (h)) * HTB)
#define PG8_SB(b, h) ((4 + (b) * 2 + (h)) * HTB)
#define PG8_STAGE(bufoff, gbase, voff) do { _Pragma("unroll") for (int _i = 0; _i < 2; ++_i) \
        __builtin_amdgcn_global_load_lds((const unsigned*)((const char*)(gbase) + (voff)[_i]), (PG8_LAS unsigned*)(lds + (bufoff) + ldsw + _i * 8192), 16, 0, 0); } while (0)
#define PG8_LDA(dst, b, h) do { _Pragma("unroll") for (int m = 0; m < 4; ++m) _Pragma("unroll") for (int k = 0; k < 2; ++k) dst[m][k] = *(const PG8_LAS bf16x8*)(lds + PG8_SA(b, h) + aoff + m * 2048 + k * 1024); } while (0)
#define PG8_LDB(dst, b, h) do { _Pragma("unroll") for (int n = 0; n < 2; ++n) _Pragma("unroll") for (int k = 0; k < 2; ++k) dst[n][k] = *(const PG8_LAS bf16x8*)(lds + PG8_SB(b, h) + boff + n * 2048 + k * 1024); } while (0)
#define PG8_MMA(ai, bj, At, Bt) do { __builtin_amdgcn_s_setprio(1); _Pragma("unroll") for (int m = 0; m < 4; ++m) _Pragma("unroll") for (int n = 0; n < 2; ++n) _Pragma("unroll") for (int k = 0; k < 2; ++k) \
        acc[ai][bj][m][n] = __builtin_amdgcn_mfma_f32_16x16x32_bf16(Bt[n][k], At[m][k], acc[ai][bj][m][n], 0, 0, 0); __builtin_amdgcn_s_setprio(0); } while (0)
#define PG8_WAIT_V(n) asm volatile("s_waitcnt vmcnt(" #n ")" ::: "memory")
#define PG8_WAIT_L(n) asm volatile("s_waitcnt lgkmcnt(" #n ")" ::: "memory")
#define PG8_BAR __builtin_amdgcn_s_barrier()
#define PG8_SCHED __builtin_amdgcn_sched_barrier(0)
    Unit cur, nxt; int ui = 0;
    if (!S.next(0, cur)) return;
    f32x4 acc[2][2][4][2];
#pragma unroll
    for (int a = 0; a < 2; ++a)
#pragma unroll
        for (int b = 0; b < 2; ++b)
#pragma unroll
            for (int m = 0; m < 4; ++m)
#pragma unroll
                for (int n = 0; n < 2; ++n) acc[a][b][m][n] = (f32x4){0.f, 0.f, 0.f, 0.f};
    bf16x8 At[4][2], B0[2][2], B1[2][2];
    const char* cA = (const char*)g.A + ((size_t)cur.z * g.sA) * 2 + (size_t)cur.pm * tA; const char* cB = (const char*)g.Bt + ((size_t)cur.z * g.sB) * 2 + (size_t)cur.pn * tB;
    PG8_STAGE(PG8_SB(0, 0), cB, voffB); PG8_STAGE(PG8_SA(0, 0), cA, voffA); PG8_STAGE(PG8_SB(0, 1), cB + hB, voffB); PG8_STAGE(PG8_SA(0, 1), cA + hA, voffA);
    if (wr == 1) PG8_BAR;
    PG8_WAIT_V(4); PG8_BAR;
    PG8_STAGE(PG8_SB(1, 0), cB + kstep, voffB); PG8_STAGE(PG8_SA(1, 0), cA + kstep, voffA); PG8_STAGE(PG8_SB(1, 1), cB + hB + kstep, voffB);
    PG8_WAIT_V(6); PG8_BAR;
    for (;;) {
        const bool has_next = S.next(ui + 1, nxt);
        const char* nA = has_next ? (const char*)g.A + ((size_t)nxt.z * g.sA) * 2 + (size_t)nxt.pm * tA : cA; const char* nB = has_next ? (const char*)g.Bt + ((size_t)nxt.z * g.sB) * 2 + (size_t)nxt.pn * tB : cB;
        for (int t = 0; t < nt; t += 2) {
            const bool last = (t == nt - 2);
            const char* a1 = cA + (size_t)(t + 1) * kstep;
            const char* a2 = last ? nA : cA + (size_t)(t + 2) * kstep; const char* b2 = last ? nB : cB + (size_t)(t + 2) * kstep;
            const char* a3 = a2 + kstep; const char* b3 = b2 + kstep;
            PG8_LDB(B0, 0, 0); PG8_SCHED; PG8_LDA(At, 0, 0); PG8_STAGE(PG8_SA(1, 1), a1 + hA, voffA);
            PG8_WAIT_L(8); PG8_BAR; PG8_WAIT_L(0); PG8_MMA(0, 0, At, B0); PG8_BAR; PG8_SCHED;
            PG8_LDB(B1, 0, 1); PG8_STAGE(PG8_SB(0, 0), b2, voffB);
            PG8_BAR; PG8_WAIT_L(0); PG8_MMA(0, 1, At, B1); PG8_BAR;
            PG8_LDA(At, 0, 1); PG8_STAGE(PG8_SA(0, 0), a2, voffA);
            PG8_BAR; PG8_WAIT_L(0); PG8_MMA(1, 0, At, B0); PG8_BAR; PG8_SCHED;
            PG8_STAGE(PG8_SB(0, 1), b2 + hB, voffB);
            PG8_WAIT_V(6); PG8_BAR; PG8_MMA(1, 1, At, B1); PG8_BAR;
            PG8_LDB(B0, 1, 0); PG8_SCHED; PG8_LDA(At, 1, 0); PG8_STAGE(PG8_SA(0, 1), a2 + hA, voffA);
            PG8_WAIT_L(8); PG8_BAR; PG8_WAIT_L(0); PG8_MMA(0, 0, At, B0); PG8_BAR; PG8_SCHED;
            PG8_LDB(B1, 1, 1); PG8_STAGE(PG8_SB(1, 0), b3, voffB);
            PG8_BAR; PG8_WAIT_L(0); PG8_MMA(0, 1, At, B1); PG8_BAR;
            PG8_LDA(At, 1, 1); PG8_STAGE(PG8_SA(1, 0), a3, voffA);
            PG8_BAR; PG8_WAIT_L(0); PG8_MMA(1, 0, At, B0); PG8_BAR; PG8_SCHED;
            PG8_STAGE(PG8_SB(1, 1), b3 + hB, voffB);
            PG8_WAIT_V(6); PG8_BAR; PG8_MMA(1, 1, At, B1); PG8_BAR;
        }
        E(acc, cur, wr, wc, fr, fq);
        if (!has_next) break;
#pragma unroll
        for (int a = 0; a < 2; ++a)
#pragma unroll
            for (int b = 0; b < 2; ++b)
#pragma unroll
                for (int m = 0; m < 4; ++m)
#pragma unroll
                    for (int n = 0; n < 2; ++n) acc[a][b][m][n] = (f32x4){0.f, 0.f, 0.f, 0.f};
        cur = nxt; cA = nA; cB = nB; ++ui;
    }
    PG8_WAIT_V(0);
    if (wr == 0) PG8_BAR;
    PG8_BAR;
#undef PG8_SA
#undef PG8_SB
#undef PG8_STAGE
#undef PG8_LDA
#undef PG8_LDB
#undef PG8_MMA
#undef PG8_WAIT_V
#undef PG8_WAIT_L
#undef PG8_BAR
#undef PG8_SCHED
}
}

typedef const f32x4 (&AccRef)[2][2][4][2];
__device__ __forceinline__ u32x4 pack8(f32x4 a, f32x4 b) { u32x4 w; w.x = pk2(a[0], a[1]); w.y = pk2(a[2], a[3]); w.z = pk2(b[0], b[1]); w.w = pk2(b[2], b[3]); return w; }

struct EpiIn {
    static constexpr bool PERM = true;
    bf16* PQ; bf16* UB; const float* r;
    __device__ __forceinline__ void operator()(AccRef acc, const pg8::Unit& u, int wr, int wc, int fr, int fq) const {
#pragma unroll
        for (int ai = 0; ai < 2; ++ai)
#pragma unroll
            for (int m = 0; m < 4; ++m) {
                const int row = u.pm * 256 + ai * 128 + wr * 64 + m * 16 + fr; const float rs = r[row];
#pragma unroll
                for (int bj = 0; bj < 2; ++bj) {
                    const int col0 = u.pn * 256 + bj * 128 + wc * 32 + 8 * fq;
                    const u32x4 w = pack8(acc[ai][bj][m][0] * rs, acc[ai][bj][m][1] * rs);
                    if (col0 < 1024) *(u32x4*)(PQ + (size_t)row * 1024 + col0) = w;
                    else { const int c2 = col0 - 1024, gg = c2 >> 4, h0 = c2 & 15; *(u32x4*)(UB + ((size_t)(gg * 2048 + (row >> 4)) * 512 + (row & 15) * 16 + h0)) = w; }
                }
            }
    }
};
struct EpiSloc {
    static constexpr bool PERM = false;
    float* S;
    __device__ __forceinline__ void operator()(AccRef acc, const pg8::Unit& u, int wr, int wc, int fr, int fq) const {
#pragma unroll
        for (int ai = 0; ai < 2; ++ai)
#pragma unroll
            for (int m = 0; m < 4; ++m) {
                const int row = u.pm * 256 + ai * 128 + wr * 64 + m * 16 + fr;
                float* rp = S + ((size_t)u.z * 2048 + row) * 256 + wc * 32 + 4 * fq;
#pragma unroll
                for (int bj = 0; bj < 2; ++bj)
#pragma unroll
                    for (int n = 0; n < 2; ++n) *(f32x4*)(rp + bj * 128 + n * 16) = acc[ai][bj][m][n];
            }
    }
};
struct EpiSsmOut {
    static constexpr bool PERM = true;
    bf16* G;
    __device__ __forceinline__ void operator()(AccRef acc, const pg8::Unit& u, int wr, int wc, int fr, int fq) const {
#pragma unroll
        for (int ai = 0; ai < 2; ++ai)
#pragma unroll
            for (int m = 0; m < 4; ++m) {
                const int row = u.pm * 256 + ai * 128 + wr * 64 + m * 16 + fr;
#pragma unroll
                for (int bj = 0; bj < 2; ++bj) {
                    const int col0 = bj * 128 + wc * 32 + 8 * fq, t = col0 >> 4, i0 = col0 & 15;
                    f32x4 a = acc[ai][bj][m][0], b = acc[ai][bj][m][1];
#pragma unroll
                    for (int j = 0; j < 4; ++j) { a[j] = gelu_t(a[j]); b[j] = gelu_t(b[j]); }
                    *(u32x4*)(G + ((size_t)row * 16 + t) * 512 + u.z * 16 + i0) = pack8(a, b);
                }
            }
    }
};
struct EpiGlu {
    static constexpr bool PERM = true;
    const bf16* G; const float* bias; bf16* AO; float* ss;
    __device__ __forceinline__ void operator()(AccRef acc, const pg8::Unit& u, int wr, int wc, int fr, int fq) const {
#pragma unroll
        for (int ai = 0; ai < 2; ++ai)
#pragma unroll
            for (int m = 0; m < 4; ++m) {
                const int row = u.pm * 256 + ai * 128 + wr * 64 + m * 16 + fr; float s2 = 0.f;
#pragma unroll
                for (int bj = 0; bj < 2; ++bj) {
                    const int col0 = u.pn * 256 + bj * 128 + wc * 32 + 8 * fq;
                    const u32x4 gv = *(const u32x4*)(G + (size_t)row * 512 + col0);
                    const f32x4 b0 = *(const f32x4*)(bias + col0), b1 = *(const f32x4*)(bias + col0 + 4);
                    f32x4 a = acc[ai][bj][m][0] + b0, b = acc[ai][bj][m][1] + b1;
                    a[0] = bflo(gv.x) * sigm(a[0]); a[1] = bfhi(gv.x) * sigm(a[1]); a[2] = bflo(gv.y) * sigm(a[2]); a[3] = bfhi(gv.y) * sigm(a[3]);
                    b[0] = bflo(gv.z) * sigm(b[0]); b[1] = bfhi(gv.z) * sigm(b[1]); b[2] = bflo(gv.w) * sigm(b[2]); b[3] = bfhi(gv.w) * sigm(b[3]);
#pragma unroll
                    for (int j = 0; j < 4; ++j) s2 += a[j] * a[j] + b[j] * b[j];
                    *(u32x4*)(AO + (size_t)row * 1024 + 512 + col0) = pack8(a, b);
                }
                s2 += __shfl_xor(s2, 16); s2 += __shfl_xor(s2, 32);
                if (fq == 0) ss[row * 8 + u.pn * 4 + wc] = s2;
            }
    }
};
struct EpiOutSS {
    static constexpr bool PERM = true;
    bf16* O; float* ss;
    __device__ __forceinline__ void operator()(AccRef acc, const pg8::Unit& u, int wr, int wc, int fr, int fq) const {
#pragma unroll
        for (int ai = 0; ai < 2; ++ai)
#pragma unroll
            for (int m = 0; m < 4; ++m) {
                const int row = u.pm * 256 + ai * 128 + wr * 64 + m * 16 + fr; float s2 = 0.f;
#pragma unroll
                for (int bj = 0; bj < 2; ++bj) {
                    const int col0 = u.pn * 256 + bj * 128 + wc * 32 + 8 * fq;
                    const f32x4 a = acc[ai][bj][m][0], b = acc[ai][bj][m][1];
#pragma unroll
                    for (int j = 0; j < 4; ++j) s2 += a[j] * a[j] + b[j] * b[j];
                    *(u32x4*)(O + (size_t)row * 1024 + col0) = pack8(a, b);
                }
                s2 += __shfl_xor(s2, 16); s2 += __shfl_xor(s2, 32);
                if (fq == 0) ss[row * 16 + u.pn * 4 + wc] = s2;
            }
    }
};
struct EpiFF1 {
    static constexpr bool PERM = true;
    bf16* H; const float* r;
    __device__ __forceinline__ void operator()(AccRef acc, const pg8::Unit& u, int wr, int wc, int fr, int fq) const {
#pragma unroll
        for (int ai = 0; ai < 2; ++ai)
#pragma unroll
            for (int m = 0; m < 4; ++m) {
                const int row = u.pm * 256 + ai * 128 + wr * 64 + m * 16 + fr; const float rs = r[row];
#pragma unroll
                for (int bj = 0; bj < 2; ++bj) {
                    const int col0 = u.pn * 256 + bj * 128 + wc * 32 + 8 * fq;
                    f32x4 a = acc[ai][bj][m][0] * rs, b = acc[ai][bj][m][1] * rs;
#pragma unroll
                    for (int j = 0; j < 4; ++j) { a[j] = fmaxf(a[j], 0.f); a[j] *= a[j]; b[j] = fmaxf(b[j], 0.f); b[j] *= b[j]; }
                    *(u32x4*)(H + (size_t)row * 4096 + col0) = pack8(a, b);
                }
            }
    }
};

__device__ __forceinline__ void transpose_item(const float* W, int ldw, bf16* WT, int ldt, const float* sc_lo, const float* sc_hi, int split,
                                               LAS float* scr, int item, int nblk, int lane) {
    const int kb = item / nblk, nb = item % nblk, k0 = 64 * kb, n0 = 32 * nb;
#pragma unroll 8
    for (int i = 0; i < 32; ++i) { const int kk = 2 * i + (lane >> 5), k = k0 + kk;
        float s = 1.f; if (sc_lo) s = (k < split) ? sc_lo[k] : sc_hi[k - split];
        scr[kk * 33 + (lane & 31)] = W[(size_t)k * ldw + n0 + (lane & 31)] * s; }
    asm volatile("s_waitcnt lgkmcnt(0)" ::: "memory");
    const int c = lane & 7;
#pragma unroll
    for (int j = 0; j < 4; ++j) { const int n = (lane >> 3) + 8 * j; const LAS float* s = scr + (8 * c) * 33 + n;
        u32x4 o; o.x = pk2(s[0 * 33], s[1 * 33]); o.y = pk2(s[2 * 33], s[3 * 33]); o.z = pk2(s[4 * 33], s[5 * 33]); o.w = pk2(s[6 * 33], s[7 * 33]);
        *(u32x4*)(WT + (size_t)(n0 + n) * ldt + k0 + 8 * c) = o; }
    asm volatile("s_waitcnt lgkmcnt(0)" ::: "memory");
}

__device__ __forceinline__ void fold_item(const Params& p, int item, LAS unsigned char* lds) {
    int tid = threadIdx.x; asm volatile("" : "+v"(tid)); const int ly = item >> 7, h = (item >> 4) & 7, kb = item & 15, k0 = kb * 64;
    LAS float* Wt = (LAS float*)lds;
    LAS float* Wf = Wt + 64 * 65;
    LAS float* TC = Wf + 64 * 65;
    LAS float* TS = TC + 64 * 65;
    LAS float* cs = TS + 64 * 65;
    __syncthreads();
    const float* win = p.w_in + (size_t)ly * 1024 * 1024; const float* wf = p.w_fourier + ((size_t)ly * 8 + h) * 4096; const float* g = p.pre_mix_g + ly * 1024;
    for (int i = tid; i < 4096; i += 512) { const int k = i >> 6, c = i & 63; Wt[k * 65 + c] = win[(size_t)(k0 + k) * 1024 + 64 * h + c] * g[k0 + k]; Wf[k * 65 + c] = wf[i]; }
    if (tid < 64) { float s, c; sincospif((float)tid / 32.0f, &s, &c); cs[tid] = c; cs[64 + tid] = s; }
    __syncthreads();
#pragma nounroll
    for (int i = tid; i < 4096; i += 512) { const int k = i >> 6, d = i & 63; float ac = 0.f, as = 0.f;
#pragma unroll 4
        for (int c = 0; c < 64; ++c) { const float w = Wt[k * 65 + c]; const int ph = (c * d) & 63; ac += w * cs[ph]; as += w * cs[64 + ph]; }
        TC[k * 65 + d] = ac; TS[k * 65 + d] = as; }
    __syncthreads();
    const float scale = 1.0f / 724.0773439350247f;
    bf16* WT = (bf16*)(p.ws + OFF_W + (size_t)ly * W_LAYER + W_IN);
    { const int k = tid & 63, eg = tid >> 6;
#pragma nounroll
      for (int j = 0; j < 8; ++j) { const int e = eg * 8 + j; float ap = 0.f, aq = 0.f;
#pragma unroll 4
          for (int d = 0; d < 64; ++d) { const float w = Wf[d * 65 + e]; ap += TC[k * 65 + d] * w; aq += TS[k * 65 + d] * w; }
          WT[(size_t)(64 * h + e) * 1024 + k0 + k] = (bf16)f2bf(ap * scale);
          WT[(size_t)(512 + 64 * h + e) * 1024 + k0 + k] = (bf16)f2bf(-aq * scale); } }
}

__device__ __forceinline__ void ssm_mat_item(const Params& p, int item, LAS unsigned char* lds) {
    int tid = threadIdx.x; asm volatile("" : "+v"(tid)); const int ly = item >> 5, g = item & 31;
    LAS float* pwr = (LAS float*)lds;
    LAS float* pwi = pwr + 2 * 17 * 64;
    LAS float* bbr = pwi + 2 * 17 * 64;
    LAS float* bbi = bbr + 2 * 64 * 16;
    LAS float* ccr = bbi + 2 * 64 * 16;
    LAS float* cci = ccr + 2 * 16 * 64;
    LAS float* Gt = cci + 2 * 16 * 64;
    __syncthreads();
    if (tid < 128) { const int k = tid >> 6, pp = tid & 63; const int idx = (ly * 2 + k) * 32 + g;
        const float dt = expf(p.log_dt[idx]); const float lr = p.lam_re[idx * 64 + pp], li = p.lam_im[idx * 64 + pp];
        for (int tau = 0; tau <= 16; ++tau) { const float e = expf(lr * dt * tau); float s, c; sincosf(li * dt * tau, &s, &c); pwr[(k * 17 + tau) * 64 + pp] = e * c; pwi[(k * 17 + tau) * 64 + pp] = e * s; }
        const float lbr = pwr[(k * 17 + 1) * 64 + pp] - 1.0f, lbi = pwi[(k * 17 + 1) * 64 + pp];
        const float den = 1.0f / (lr * lr + li * li); const float cr = (lbr * lr + lbi * li) * den, ci = (lbi * lr - lbr * li) * den;
        for (int h = 0; h < 16; ++h) { const float br = p.b_re[((size_t)idx * 64 + pp) * 16 + h], bi = p.b_im[((size_t)idx * 64 + pp) * 16 + h];
            bbr[(k * 64 + pp) * 16 + h] = cr * br - ci * bi; bbi[(k * 64 + pp) * 16 + h] = cr * bi + ci * br; } }
    for (int i = tid; i < 2048; i += 512) { const int k = i >> 10, r = i & 1023; const int idx = (ly * 2 + k) * 32 + g; ccr[i] = p.c_re[(size_t)idx * 1024 + r]; cci[i] = p.c_im[(size_t)idx * 1024 + r]; }
    __syncthreads();
    for (int o = tid; o < 8192; o += 512) { const int k = o >> 12, tau = (o >> 8) & 15, i = (o >> 4) & 15, h = o & 15; float a = 0.f;
        for (int pp = 0; pp < 64; ++pp) { const float c_r = ccr[(k * 16 + i) * 64 + pp], c_i = cci[(k * 16 + i) * 64 + pp], l_r = pwr[(k * 17 + tau) * 64 + pp], l_i = pwi[(k * 17 + tau) * 64 + pp];
            const float xr = c_r * l_r - c_i * l_i, xi = c_r * l_i + c_i * l_r; a += xr * bbr[(k * 64 + pp) * 16 + h] - xi * bbi[(k * 64 + pp) * 16 + h]; }
        Gt[o] = a; }
    __syncthreads();
    bf16* TM = (bf16*)(p.ws + OFF_TM) + (size_t)item * 256 * 512; bf16* MS = (bf16*)(p.ws + OFF_MST) + (size_t)item * 256 * 256;
    const float* dsk = p.d_skip + (ly * 32 + g) * 16;
    for (int o = tid; o < 256 * 512; o += 512) { const int r = o >> 9, col = o & 511, t = r >> 4, i = r & 15; float v;
        if (col < 256) { const int j = col >> 4, h = col & 15; v = 0.f;
            if (j <= t) v += Gt[((0 * 16 + (t - j)) * 16 + i) * 16 + h];
            if (j >= t) v += Gt[((1 * 16 + (j - t)) * 16 + i) * 16 + h];
            if (j == t && h == i) v += dsk[i]; }
        else { const int k = (col - 256) >> 7, q = (col - 256) & 127, pp = q >> 1, part = q & 1; const int tau = k == 0 ? (t + 1) : (16 - t);
            const float c_r = ccr[(k * 16 + i) * 64 + pp], c_i = cci[(k * 16 + i) * 64 + pp], l_r = pwr[(k * 17 + tau) * 64 + pp], l_i = pwi[(k * 17 + tau) * 64 + pp];
            v = part == 0 ? (c_r * l_r - c_i * l_i) : -(c_r * l_i + c_i * l_r); }
        TM[o] = (bf16)f2bf(v); }
    for (int o = tid; o < 256 * 256; o += 512) { const int r = o >> 8, col = o & 255, k = r >> 7, q = r & 127, pp = q >> 1, part = q & 1, j = col >> 4, h = col & 15;
        const int tau = k == 0 ? (15 - j) : j;
        const float l_r = pwr[(k * 17 + tau) * 64 + pp], l_i = pwi[(k * 17 + tau) * 64 + pp], b_r = bbr[(k * 64 + pp) * 16 + h], b_i = bbi[(k * 64 + pp) * 16 + h];
        const float v = part == 0 ? (l_r * b_r - l_i * b_i) : (l_r * b_i + l_i * b_r);
        MS[o] = (bf16)f2bf(v); }
}

__device__ __forceinline__ void p0_prologue(const Params& p, LAS unsigned char* lds, int G, int bid) {
    int tid = threadIdx.x; asm volatile("" : "+v"(tid));
    const int lane = tid & 63, wave = __builtin_amdgcn_readfirstlane(tid >> 6);
    for (int it = bid; it < 256 + 64; it += G) { if (it < 256) fold_item(p, it, lds); else ssm_mat_item(p, it - 256, lds); }
    __syncthreads();
    {
        LAS float* scr = (LAS float*)(lds + wave * 8448);
        const int gw = bid * 8 + wave, NGW = G * 8;
        constexpr int I_IN = 16 * 16, I_OUT = 16 * 32, I_1 = 16 * 128, I_2 = 64 * 32, I_G = 8 * 16, I_L = I_IN + I_OUT + I_1 + I_2 + I_G;
        for (int it = gw; it < 2 * I_L; it += NGW) {
            const int ly = it / I_L; int r = it % I_L; unsigned char* wb = p.ws + OFF_W + (size_t)ly * W_LAYER;
            if (r < I_IN) { transpose_item(p.w_in + (size_t)ly * 1024 * 1024 + 512, 1024, (bf16*)(wb + W_IN) + (size_t)1024 * 1024, 1024, p.pre_mix_g + ly * 1024, nullptr, 1 << 30, scr, r, 16, lane); continue; } r -= I_IN;
            if (r < I_OUT) { transpose_item(p.w_out + (size_t)ly * 1024 * 1024, 1024, (bf16*)(wb + W_OUT), 1024, p.fourier_out_g + ly * 512, p.ssm_out_g + ly * 512, 512, scr, r, 32, lane); continue; } r -= I_OUT;
            if (r < I_1) { transpose_item(p.w_ff1 + (size_t)ly * 1024 * 4096, 4096, (bf16*)(wb + W_1), 1024, p.pre_mlp_g + ly * 1024, nullptr, 1 << 30, scr, r, 128, lane); continue; } r -= I_1;
            if (r < I_2) { transpose_item(p.w_ff2 + (size_t)ly * 4096 * 1024, 1024, (bf16*)(wb + W_2), 4096, nullptr, nullptr, 0, scr, r, 32, lane); continue; } r -= I_2;
            transpose_item(p.w_glu + (size_t)ly * 512 * 512, 512, (bf16*)(wb + W_GLU), 512, nullptr, nullptr, 0, scr, r, 16, lane);
        }
        bf16* XB = (bf16*)(p.ws + OFF_XB); float* rA = (float*)(p.ws + OFF_RA);
        for (int row = gw; row < MT; row += NGW) {
            const f32x4* xr = (const f32x4*)(p.x + (size_t)row * 1024) + lane; float s2 = 0.f;
            u32x2* o = (u32x2*)(XB + (size_t)row * 1024) + lane;
#pragma unroll
            for (int j = 0; j < 4; ++j) { const f32x4 v = xr[64 * j]; s2 += v[0] * v[0] + v[1] * v[1] + v[2] * v[2] + v[3] * v[3]; u32x2 w; w.x = pk2(v[0], v[1]); w.y = pk2(v[2], v[3]); o[64 * j] = w; }
            s2 = wave_sum(s2);
            if (lane == 0) rA[row] = rsqrtf(s2 * (1.0f / 1024.0f) + EPS);
        }
    }
    {
        bf16* D1 = (bf16*)(p.ws + OFF_D1); bf16* E3 = (bf16*)(p.ws + OFF_E3);
        const int gt = bid * 512 + tid, NT = G * 512;
        for (int idx = gt; idx < 64 * 2 * 128 * 128; idx += NT) { const int n2 = idx >> 15, sel = (idx >> 14) & 1, k1 = (idx >> 7) & 127, n1 = idx & 127;
            const int ph = (k1 * (64 * n1 + n2)) & 8191; float s, c; sincospif((float)ph * (1.0f / 4096.0f), &s, &c); D1[idx] = (bf16)f2bf(sel ? s : c); }
        for (int idx = gt; idx < 64 * 128; idx += NT) { const int k2 = idx >> 7, col = idx & 127, part = col >> 6, n2 = col & 63;
            const int ph = (n2 * k2) & 63; float s, c; sincospif((float)ph * (1.0f / 32.0f), &s, &c); E3[idx] = (bf16)f2bf(part ? s : c); }
    }
}

__device__ __forceinline__ bf16x8 negbf(bf16x8 v) { u32x4 t = __builtin_bit_cast(u32x4, v); t = t ^ 0x80008000u; return __builtin_bit_cast(bf16x8, t); }
__device__ __forceinline__ bf16x8 gather8(const LAS unsigned short* X, int pitch) {
    u32x4 t;
    t.x = (unsigned)X[0] | ((unsigned)X[pitch] << 16); t.y = (unsigned)X[2 * pitch] | ((unsigned)X[3 * pitch] << 16);
    t.z = (unsigned)X[4 * pitch] | ((unsigned)X[5 * pitch] << 16); t.w = (unsigned)X[6 * pitch] | ((unsigned)X[7 * pitch] << 16);
    return __builtin_bit_cast(bf16x8, t);
}
__device__ __forceinline__ void fft1_phase(const bf16* PQ, const bf16* D1, bf16* T, LAS unsigned char* lds, int G, int bid) {
    int tid = threadIdx.x; asm volatile("" : "+v"(tid));
    const int lane = tid & 63, wave = __builtin_amdgcn_readfirstlane(tid >> 6), wm = wave & 3, wn = wave >> 2, fr = lane & 15, fq = lane >> 4;
    const LAS unsigned short* X = (const LAS unsigned short*)lds;
    for (int pr = bid; pr < 256; pr += G) {
        const int n2 = pr & 63, cb = pr >> 6;
        const bf16* Cb = D1 + (size_t)n2 * 2 * 128 * 128; const bf16* Sb = Cb + 128 * 128;
        for (int b = 0; b < NB; ++b) {
            __syncthreads();
#pragma unroll
            for (int j = 0; j < 8; ++j) { const int q = tid + 512 * j, row = q >> 4, cc = q & 15, part = row >> 7, n1 = row & 127;
                const u32x4 v = *(const u32x4*)(PQ + ((size_t)(b * SEQ + 64 * n1 + n2)) * 1024 + part * 512 + cb * 128 + 8 * cc);
                LAS unsigned* d = (LAS unsigned*)(lds + row * 260 + cc * 16); d[0] = v.x; d[1] = v.y; d[2] = v.z; d[3] = v.w; }
            __syncthreads();
            f32x4 Ar[2][4], Ai[2][4];
#pragma unroll
            for (int mb = 0; mb < 2; ++mb)
#pragma unroll
                for (int nb = 0; nb < 4; ++nb) { Ar[mb][nb] = (f32x4){0.f, 0.f, 0.f, 0.f}; Ai[mb][nb] = (f32x4){0.f, 0.f, 0.f, 0.f}; }
#pragma nounroll
            for (int ks = 0; ks < 8; ++ks) {
                bf16x8 Bf[4];
#pragma unroll
                for (int nb = 0; nb < 4; ++nb) Bf[nb] = gather8(X + (32 * ks + 8 * fq) * 130 + 64 * wn + 16 * nb + fr, 130);
                bf16x8 Cf[2], Sf[2];
#pragma unroll
                for (int mb = 0; mb < 2; ++mb) { const int off = (32 * wm + 16 * mb + fr) * 128 + 32 * (ks & 3) + 8 * fq; Cf[mb] = *(const bf16x8*)(Cb + off); Sf[mb] = *(const bf16x8*)(Sb + off); }
#pragma unroll
                for (int mb = 0; mb < 2; ++mb)
#pragma unroll
                    for (int nb = 0; nb < 4; ++nb) {
                        if (ks < 4) { Ar[mb][nb] = __builtin_amdgcn_mfma_f32_16x16x32_bf16(Bf[nb], Cf[mb], Ar[mb][nb], 0, 0, 0);
                                      Ai[mb][nb] = __builtin_amdgcn_mfma_f32_16x16x32_bf16(Bf[nb], negbf(Sf[mb]), Ai[mb][nb], 0, 0, 0); }
                        else        { Ar[mb][nb] = __builtin_amdgcn_mfma_f32_16x16x32_bf16(Bf[nb], Sf[mb], Ar[mb][nb], 0, 0, 0);
                                      Ai[mb][nb] = __builtin_amdgcn_mfma_f32_16x16x32_bf16(Bf[nb], Cf[mb], Ai[mb][nb], 0, 0, 0); }
                    }
            }
#pragma unroll
            for (int mb = 0; mb < 2; ++mb)
#pragma unroll
                for (int nb = 0; nb < 4; ++nb) { const int k1 = 32 * wm + 16 * mb + fr, c = cb * 128 + 64 * wn + 16 * nb + 4 * fq;
                    u32x2 w; w.x = pk2(Ar[mb][nb][0], Ar[mb][nb][1]); w.y = pk2(Ar[mb][nb][2], Ar[mb][nb][3]);
                    *(u32x2*)(T + ((((size_t)(b * 128 + k1) * 2 + 0) * 64 + n2) * 512 + c)) = w;
                    w.x = pk2(Ai[mb][nb][0], Ai[mb][nb][1]); w.y = pk2(Ai[mb][nb][2], Ai[mb][nb][3]);
                    *(u32x2*)(T + ((((size_t)(b * 128 + k1) * 2 + 1) * 64 + n2) * 512 + c)) = w; }
        }
    }
    __syncthreads();
}

__device__ __forceinline__ void fft3_phase(const bf16* T, const bf16* E3, bf16* AO, LAS unsigned char* lds, int G, int bid) {
    int tid = threadIdx.x; asm volatile("" : "+v"(tid));
    const int lane = tid & 63, wave = __builtin_amdgcn_readfirstlane(tid >> 6), fr = lane & 15, fq = lane >> 4;
    const LAS unsigned short* X = (const LAS unsigned short*)lds;
    LAS float* red = (LAS float*)(lds + 128 * 1028);
    for (int unit = bid; unit < 512; unit += G) {
        const int b = unit >> 7, k1 = unit & 127;
        __syncthreads();
        const bf16* src = T + (size_t)unit * 65536;
#pragma unroll
        for (int j = 0; j < 16; ++j) { const int q = tid + 512 * j, row = q >> 6, cc = q & 63;
            const u32x4 v = *(const u32x4*)(src + row * 512 + cc * 8);
            LAS unsigned* d = (LAS unsigned*)(lds + row * 1028 + cc * 16); d[0] = v.x; d[1] = v.y; d[2] = v.z; d[3] = v.w; }
        __syncthreads();
        f32x4 acc[4][4];
#pragma unroll
        for (int mb = 0; mb < 4; ++mb)
#pragma unroll
            for (int nb = 0; nb < 4; ++nb) acc[mb][nb] = (f32x4){0.f, 0.f, 0.f, 0.f};
#pragma nounroll
        for (int ks = 0; ks < 4; ++ks) {
            bf16x8 Bf[4];
#pragma unroll
            for (int nb = 0; nb < 4; ++nb) Bf[nb] = gather8(X + (32 * ks + 8 * fq) * 514 + 64 * wave + 16 * nb + fr, 514);
            bf16x8 Ef[4];
#pragma unroll
            for (int mb = 0; mb < 4; ++mb) Ef[mb] = *(const bf16x8*)(E3 + (16 * mb + fr) * 128 + 32 * ks + 8 * fq);
#pragma unroll
            for (int mb = 0; mb < 4; ++mb)
#pragma unroll
                for (int nb = 0; nb < 4; ++nb) acc[mb][nb] = __builtin_amdgcn_mfma_f32_16x16x32_bf16(Bf[nb], Ef[mb], acc[mb][nb], 0, 0, 0);
        }
#pragma unroll
        for (int mb = 0; mb < 4; ++mb) { float s = 0.f;
#pragma unroll
            for (int nb = 0; nb < 4; ++nb)
#pragma unroll
                for (int j = 0; j < 4; ++j) s += acc[mb][nb][j] * acc[mb][nb][j];
            s += __shfl_xor(s, 16); s += __shfl_xor(s, 32);
            if (fq == 0) red[wave * 64 + 16 * mb + fr] = s; }
        __syncthreads();
#pragma unroll
        for (int mb = 0; mb < 4; ++mb) { float tot = 0.f;
#pragma unroll
            for (int w = 0; w < 8; ++w) tot += red[w * 64 + 16 * mb + fr];
            const float rinv = rsqrtf(tot * (1.0f / 512.0f) + EPS);
            const size_t token = (size_t)b * SEQ + k1 + 128 * (16 * mb + fr);
#pragma unroll
            for (int nb = 0; nb < 4; ++nb) { u32x2 w; w.x = pk2(acc[mb][nb][0] * rinv, acc[mb][nb][1] * rinv); w.y = pk2(acc[mb][nb][2] * rinv, acc[mb][nb][3] * rinv);
                *(u32x2*)(AO + token * 1024 + 64 * wave + 16 * nb + 4 * fq) = w; } }
    }
    __syncthreads();
}

__device__ __forceinline__ void carry_phase(const Params& p, int ly, const float* Sloc, bf16* UB, int G, int bid) {
    int tid = threadIdx.x; asm volatile("" : "+v"(tid));
    const int lane = tid & 63, wave = __builtin_amdgcn_readfirstlane(tid >> 6);
    if (wave != 0) return;
    for (int w = bid; w < 256; w += G) {
        const int dir = w & 1, g = (w >> 1) & 31, b = w >> 6, pp = lane; const int idx = (ly * 2 + dir) * 32 + g;
        const float dt = expf(p.log_dt[idx]); const float lr = p.lam_re[idx * 64 + pp] * dt * 16.0f, li = p.lam_im[idx * 64 + pp] * dt * 16.0f;
        const float e = expf(lr); float sn, cs; sincosf(li, &sn, &cs); const float l_r = e * cs, l_i = e * sn;
        float cr = 0.f, ci = 0.f;
        const float* src = Sloc + ((size_t)(g * 2048 + b * 512)) * 256 + dir * 128 + 2 * pp;
        bf16* dst = UB + ((size_t)(g * 2048 + b * 512)) * 512 + 256 + dir * 128 + 2 * pp;
        for (int s0 = 0; s0 < 512; s0 += 8) {
            f32x2 v[8];
#pragma unroll
            for (int j = 0; j < 8; ++j) { const int ss = dir == 0 ? (s0 + j) : (511 - s0 - j); v[j] = *(const f32x2*)(src + (size_t)ss * 256); }
#pragma unroll
            for (int j = 0; j < 8; ++j) { const int ss = dir == 0 ? (s0 + j) : (511 - s0 - j);
                *(unsigned*)(dst + (size_t)ss * 512) = pk2(cr, ci);
                const float nr = l_r * cr - l_i * ci + v[j][0], ni = l_r * ci + l_i * cr + v[j][1]; cr = nr; ci = ni; }
        }
    }
}

__device__ __forceinline__ void norm_phase(const float* xin, float* xout, const bf16* MF, const float* ss, const float* gain, bf16* XB, float* rnext, bool last, int G, int bid) {
    int tid = threadIdx.x; asm volatile("" : "+v"(tid));
    const int lane = tid & 63, wave = __builtin_amdgcn_readfirstlane(tid >> 6);
    const int gw = bid * 8 + wave, NGW = G * 8;
    for (int row = gw; row < MT; row += NGW) {
        float tot = 0.f;
#pragma unroll
        for (int k = 0; k < 16; ++k) tot += ss[row * 16 + k];
        const float rinv = rsqrtf(tot * (1.0f / 1024.0f) + EPS); float s2 = 0.f;
        const f32x4* xr = (const f32x4*)(xin + (size_t)row * 1024) + lane; f32x4* xo = (f32x4*)(xout + (size_t)row * 1024) + lane;
        const u32x2* mr = (const u32x2*)(MF + (size_t)row * 1024) + lane; u32x2* bo = (u32x2*)(XB + (size_t)row * 1024) + lane; const f32x4* gr = (const f32x4*)gain + lane;
#pragma unroll
        for (int j = 0; j < 4; ++j) { f32x4 v = xr[64 * j]; const u32x2 mm = mr[64 * j]; const f32x4 gg = gr[64 * j];
            v[0] += bflo(mm.x) * rinv * gg[0]; v[1] += bfhi(mm.x) * rinv * gg[1]; v[2] += bflo(mm.y) * rinv * gg[2]; v[3] += bfhi(mm.y) * rinv * gg[3];
            s2 += v[0] * v[0] + v[1] * v[1] + v[2] * v[2] + v[3] * v[3]; xo[64 * j] = v;
            if (!last) { u32x2 w; w.x = pk2(v[0], v[1]); w.y = pk2(v[2], v[3]); bo[64 * j] = w; } }
        s2 = wave_sum(s2);
        if (lane == 0) rnext[row] = rsqrtf(s2 * (1.0f / 1024.0f) + EPS);
    }
}
__device__ __forceinline__ void rescale_phase(bf16* AO, const float* ss, int G, int bid) {
    int tid = threadIdx.x; asm volatile("" : "+v"(tid));
    const int lane = tid & 63, wave = __builtin_amdgcn_readfirstlane(tid >> 6);
    const int gw = bid * 8 + wave, NGW = G * 8;
    for (int row = gw; row < MT; row += NGW) {
        float tot = 0.f;
#pragma unroll
        for (int k = 0; k < 8; ++k) tot += ss[row * 8 + k];
        const float rinv = rsqrtf(tot * (1.0f / 512.0f) + EPS);
        u32x4* ptr = (u32x4*)(AO + (size_t)row * 1024 + 512) + lane; u32x4 v = *ptr;
        v.x = pk2(bflo(v.x) * rinv, bfhi(v.x) * rinv); v.y = pk2(bflo(v.y) * rinv, bfhi(v.y) * rinv); v.z = pk2(bflo(v.z) * rinv, bfhi(v.z) * rinv); v.w = pk2(bflo(v.w) * rinv, bfhi(v.w) * rinv);
        *ptr = v;
    }
}

constexpr int PH_PER_LAYER = 11, N_PHASES = 1 + 2 * PH_PER_LAYER;
__global__ void __launch_bounds__(512) hybrid_fwd(Params p) {
    extern __shared__ __attribute__((aligned(16))) unsigned char lds_raw[];
    LAS unsigned char* lds = (LAS unsigned char*)lds_raw;
    cg::grid_group grid = cg::this_grid();
    const int Gk = gridDim.x, bk = blockIdx.x;
    unsigned char* ws = p.ws;
    float* sss = (float*)(ws + OFF_SSS); float* ssm = (float*)(ws + OFF_SSM); float* ssf = (float*)(ws + OFF_SSF); float* rA = (float*)(ws + OFF_RA); float* rB = (float*)(ws + OFF_RB);
    bf16* XB = (bf16*)(ws + OFF_XB); bf16* MF = (bf16*)(ws + OFF_MF); bf16* GB = (bf16*)(ws + OFF_G); bf16* HB = (bf16*)(ws + OFF_H);
    bf16* PQ = (bf16*)(ws + OFF_PQ); bf16* AO = (bf16*)(ws + OFF_AO); bf16* UB = (bf16*)(ws + OFF_UB); bf16* TB = (bf16*)(ws + OFF_T); float* SL = (float*)(ws + OFF_SLOC);

#pragma nounroll
    for (int ph = p.ph_lo; ph < p.ph_hi; ++ph) {
        int G = Gk, bid = bk; asm volatile("" : "+s"(G), "+s"(bid));
        if (ph == 0) { p0_prologue(p, lds, G, bid); }
        else {
            const int ly = (ph - 1) / PH_PER_LAYER, sp = (ph - 1) % PH_PER_LAYER;
            unsigned char* wb = ws + OFF_W + (size_t)ly * W_LAYER;
            pg8::Order S;
            switch (sp) {
            case 0: {
                pg8::Gemm g{XB, (const bf16*)(wb + W_IN), MT, NIN, 1024, 1024, 1024, 0, 0, 1}; S.init(MT, NIN, 1, G, bid);
                EpiIn E{PQ, UB, rA}; pg8::gemm_phase<EpiIn>(lds, g, S, E); } break;
            case 1: {
                fft1_phase(PQ, (const bf16*)(ws + OFF_D1), TB, lds, G, bid);
                pg8::Gemm g{UB, (const bf16*)(ws + OFF_MST) + (size_t)ly * 32 * 256 * 256, 2048, 256, 256, 512, 256, (size_t)2048 * 512, (size_t)256 * 256, 32}; S.init(2048, 256, 32, G, bid);
                EpiSloc E{SL}; pg8::gemm_phase<EpiSloc>(lds, g, S, E); } break;
            case 2: {
                carry_phase(p, ly, SL, UB, G, bid);
                fft3_phase(TB, (const bf16*)(ws + OFF_E3), AO, lds, G, bid); } break;
            case 3: {
                pg8::Gemm g{UB, (const bf16*)(ws + OFF_TM) + (size_t)ly * 32 * 256 * 512, 2048, 256, 512, 512, 512, (size_t)2048 * 512, (size_t)256 * 512, 32}; S.init(2048, 256, 32, G, bid);
                EpiSsmOut E{GB}; pg8::gemm_phase<EpiSsmOut>(lds, g, S, E); } break;
            case 4: {
                pg8::Gemm g{GB, (const bf16*)(wb + W_GLU), MT, 512, 512, 512, 512, 0, 0, 1}; S.init(MT, 512, 1, G, bid);
                EpiGlu E{GB, p.b_glu + ly * 512, AO, sss}; pg8::gemm_phase<EpiGlu>(lds, g, S, E); } break;
            case 5: rescale_phase(AO, sss, G, bid); break;
            case 6: {
                pg8::Gemm g{AO, (const bf16*)(wb + W_OUT), MT, 1024, 1024, 1024, 1024, 0, 0, 1}; S.init(MT, 1024, 1, G, bid);
                EpiOutSS E{MF, ssm}; pg8::gemm_phase<EpiOutSS>(lds, g, S, E); } break;
            case 7: norm_phase(ly == 0 ? p.x : p.out, p.out, MF, ssm, p.post_mix_g + ly * 1024, XB, rB, false, G, bid); break;
            case 8: {
                pg8::Gemm g{XB, (const bf16*)(wb + W_1), MT, DFF, 1024, 1024, 1024, 0, 0, 1}; S.init(MT, DFF, 1, G, bid);
                EpiFF1 E{HB, rB}; pg8::gemm_phase<EpiFF1>(lds, g, S, E); } break;
            case 9: {
                pg8::Gemm g{HB, (const bf16*)(wb + W_2), MT, 1024, DFF, DFF, DFF, 0, 0, 1}; S.init(MT, 1024, 1, G, bid);
                EpiOutSS E{MF, ssf}; pg8::gemm_phase<EpiOutSS>(lds, g, S, E); } break;
            case 10: norm_phase(p.out, p.out, MF, ssf, p.post_mlp_g + ly * 1024, XB, rA, ly == 1, G, bid); break;
            }
        }
        if (ph + 1 < p.ph_hi) {
            asm volatile("s_waitcnt vmcnt(0) lgkmcnt(0)" ::: "memory");
            __syncthreads();
            if (threadIdx.x < 64) asm volatile("buffer_wbl2 sc1\n\ts_waitcnt vmcnt(0)" ::: "memory");
            __syncthreads();
            grid.sync();
            asm volatile("buffer_inv sc1\n\ts_waitcnt vmcnt(0)" ::: "memory");
            __syncthreads();
        }
    }
}

extern "C" void kernel_launch(void* const* d_in, const int* in_sizes, int n_in, void* d_out, int out_size, void* d_ws, size_t ws_size, hipStream_t stream) {
    static int grid = 0;
    if (grid == 0) {
        if (n_in != 22 || ws_size < WS_END) { fprintf(stderr, "kernel_launch: unexpected n_in %d or ws_size %zu (< %zu)\n", n_in, ws_size, (size_t)WS_END); grid = -1; return; }
        int dev = 0, cus = 0, per_cu = 0;
        hipGetDevice(&dev); hipDeviceGetAttribute(&cus, hipDeviceAttributeMultiprocessorCount, dev);
        if (hipFuncSetAttribute((const void*)hybrid_fwd, hipFuncAttributeMaxDynamicSharedMemorySize, LDS_BYTES) != hipSuccess) { fprintf(stderr, "kernel_launch: hipFuncSetAttribute failed\n"); grid = -1; return; }
        if (hipOccupancyMaxActiveBlocksPerMultiprocessor(&per_cu, (const void*)hybrid_fwd, 512, LDS_BYTES) != hipSuccess || per_cu < 1) { fprintf(stderr, "kernel_launch: occupancy query says %d blocks per CU\n", per_cu); per_cu = 1; }
        (void)hipGetLastError();
        grid = cus;
    }
    if (grid < 0) return;
    Params p{};
    const float** f = (const float**)&p;
    for (int i = 0; i < 22; ++i) f[i] = (const float*)d_in[i];
    p.out = (float*)d_out; p.ws = (unsigned char*)d_ws; p.ph_lo = 0; p.ph_hi = N_PHASES;
    void* args[] = {&p};
    hipError_t e = hipLaunchCooperativeKernel((const void*)hybrid_fwd, dim3(grid), dim3(512), args, LDS_BYTES, stream);
    if (e != hipSuccess) fprintf(stderr, "kernel_launch: cooperative launch failed: %s (grid %d)\n", hipGetErrorString(e), grid);
}
```

```cpp
#include <hip/hip_runtime.h>
#include <hip/hip_cooperative_groups.h>
#include <cstdio>
namespace cg = cooperative_groups;

#define LAS __attribute__((address_space(3)))
typedef unsigned short bf16;
typedef short bf16x8 __attribute__((ext_vector_type(8)));
typedef float f32x4 __attribute__((ext_vector_type(4)));
typedef float f32x2 __attribute__((ext_vector_type(2)));
typedef unsigned u32x4 __attribute__((ext_vector_type(4)));
typedef unsigned u32x2 __attribute__((ext_vector_type(2)));

constexpr int NB = 4, SEQ = 8192, DM = 1024, MT = NB * SEQ, DFO = 512, NHEAD = 8, SG = 32, SP = 64, DFF = 4096, NIN = 1536;
constexpr float EPS = 1e-6f;
constexpr int LDS_BYTES = 147456;
constexpr size_t MiB = 1u << 20;
constexpr size_t OFF_RA = 384 * 1024, OFF_RB = 512 * 1024, OFF_BAR = 640 * 1024, BAR_BYTES = 16384;
constexpr size_t OFF_E3 = 1 * MiB, OFF_D1 = 2 * MiB, OFF_TM = 6 * MiB, OFF_MST = 22 * MiB, OFF_W = 30 * MiB;
constexpr size_t W_IN = 0, W_OUT = 3 * MiB, W_1 = 5 * MiB, W_2 = 13 * MiB, W_GLU = 21 * MiB, W_LAYER = 22 * MiB;
constexpr size_t OFF_XB = 76 * MiB, OFF_MF = 140 * MiB, OFF_G = 140 * MiB, OFF_H = 204 * MiB;
constexpr size_t OFF_PQ = 204 * MiB, OFF_AO = 204 * MiB, OFF_UB = 268 * MiB, OFF_T = 332 * MiB, OFF_SLOC = 396 * MiB, OFF_SSS = 460 * MiB, OFF_SSM = 461 * MiB, OFF_SSF = 463 * MiB, WS_END = 465 * MiB;

struct Params {
    const float *x, *w_in, *w_out, *pre_mix_g, *post_mix_g, *pre_mlp_g, *post_mlp_g, *fourier_out_g, *ssm_out_g, *w_fourier,
        *lam_re, *lam_im, *log_dt, *b_re, *b_im, *c_re, *c_im, *d_skip, *w_glu, *b_glu, *w_ff1, *w_ff2;
    float* out; unsigned char* ws;
    int ph_lo, ph_hi;
};

__device__ __forceinline__ unsigned f2bf(float f) { unsigned u = __builtin_bit_cast(unsigned, f); return (u + 0x7fffu + ((u >> 16) & 1u)) >> 16; }
__device__ __forceinline__ unsigned pk2(float lo, float hi) { return f2bf(lo) | (f2bf(hi) << 16); }
__device__ __forceinline__ float bflo(unsigned w) { return __builtin_bit_cast(float, w << 16); }
__device__ __forceinline__ float bfhi(unsigned w) { return __builtin_bit_cast(float, w & 0xffff0000u); }
__device__ __forceinline__ float wave_sum(float v) {
#pragma unroll
    for (int o = 1; o < 64; o <<= 1) v += __shfl_xor(v, o);
    return v;
}
__device__ __forceinline__ float gelu_t(float x) { const float u = 0.7978845608f * (x + 0.044715f * x * x * x); return x / (1.0f + __expf(-2.0f * u)); }
__device__ __forceinline__ float sigm(float v) { return 1.0f / (1.0f + __expf(-v)); }

namespace pg8 {
#define PG8_LAS __attribute__((address_space(3)))
typedef unsigned short bf16_t;
constexpr int BM = 256, BK = 64, HALF = 128, HTB = HALF * BK * 2, STAGE_BYTES = 8 * HTB, NXCD = 8, WGM = 8;
__host__ __device__ __forceinline__ int lds_byte(int r, int c) { const int st = (r >> 4) * 2 + (c >> 5), rr = r & 15, cc = c & 31, ob = rr * 64 + cc * 2; return st * 1024 + (ob ^ (((ob >> 9) & 1) << 5)); }
__host__ __device__ __forceinline__ void stage_rc(int b, int& R, int& C) { const int st = b / 1024, sb = b % 1024, swz = sb ^ (((sb >> 9) & 1) << 5); R = (st >> 1) * 16 + swz / 64; C = (st & 1) * 32 + (swz % 64) / 2; }
__host__ __device__ __forceinline__ int perm32(int rho) { const int n = rho >> 4, i = rho & 15; return 8 * (i >> 2) + 4 * n + (i & 3); }

struct Unit { int pm, pn, z; };
struct Gemm { const bf16_t* A; const bf16_t* Bt; int M, N, K, lda, ldb; size_t sA, sB; int nZ; };

struct Order {
    int nM, nN, nwg, nZ, G, c;
    __device__ void init(int M, int N, int nZ_, int G_, int c_) { nM = M / BM; nN = N / BM; nwg = nM * nN; nZ = nZ_; G = G_; c = c_; }
    __device__ bool next(int i, Unit& u) const {
        const long L = (long)i * G + c; if (L >= (long)nwg * nZ) return false;
        u.z = (int)(L / nwg);
        int wgid = (int)(L % nwg); { const int q = nwg / NXCD, r = nwg % NXCD, xcd = wgid % NXCD, off = wgid / NXCD; wgid = (xcd < r ? xcd * (q + 1) : r * (q + 1) + (xcd - r) * q) + off; }
        const int nig = WGM * nN, gid = wgid / nig, fm = gid * WGM, gsz = (nM - fm) < WGM ? (nM - fm) : WGM;
        u.pm = fm + ((wgid % nig) % gsz); u.pn = (wgid % nig) / gsz; return true;
    }
};

template <class Epi>
__device__ __forceinline__ void gemm_phase(PG8_LAS unsigned char* lds, const Gemm g, const Order& S, const Epi& E) {
    int tid = threadIdx.x; asm volatile("" : "+v"(tid));
    const int wid = __builtin_amdgcn_readfirstlane(tid >> 6), lane = tid & 63, wr = wid >> 2, wc = wid & 3, fr = lane & 15, fq = lane >> 4;
    const int K = g.K, nt = K / BK;
    unsigned voffA[2], voffB[2];
#pragma unroll
    for (int i = 0; i < 2; ++i) { int R, C; stage_rc(tid * 16 + i * 8192, R, C); const int Rb = Epi::PERM ? ((R & ~31) + perm32(R & 31)) : R;
        voffA[i] = (unsigned)(R * g.lda + C) * 2u; voffB[i] = (unsigned)(Rb * g.ldb + C) * 2u; }
    const size_t kstep = (size_t)(BK * 2);
    const size_t hA = (size_t)HALF * g.lda * 2, hB = (size_t)HALF * g.ldb * 2;
    const size_t tA = 2 * hA, tB = 2 * hB;
    const unsigned ldsw = (unsigned)wid * 1024u;
    const int aoff = lds_byte(wr * 64 + fr, fq * 8), boff = lds_byte(wc * 32 + fr, fq * 8);
#define PG8_SA(b, h) (((b) * 2 + (h)) * HTB)
#define PG8_SB(b, h) ((4 + (b) * 2 + (h)) * HTB)
#define PG8_STAGE(bufoff, gbase, voff) do { _Pragma("unroll") for (int _i = 0; _i < 2; ++_i) \
        __builtin_amdgcn_global_load_lds((const unsigned*)((const char*)(gbase) + (voff)[_i]), (PG8_LAS unsigned*)(lds + (bufoff) + ldsw + _i * 8192), 16, 0, 0); } while (0)
#define PG8_LDA(dst, b, h) do { _Pragma("unroll") for (int m = 0; m < 4; ++m) _Pragma("unroll") for (int k = 0; k < 2; ++k) dst[m][k] = *(const PG8_LAS bf16x8*)(lds + PG8_SA(b, h) + aoff + m * 2048 + k * 1024); } while (0)
#define PG8_LDB(dst, b, h) do { _Pragma("unroll") for (int n = 0; n < 2; ++n) _Pragma("unroll") for (int k = 0; k < 2; ++k) dst[n][k] = *(const PG8_LAS bf16x8*)(lds + PG8_SB(b, h) + boff + n * 2048 + k * 1024); } while (0)
#define PG8_MMA(ai, bj, At, Bt) do { __builtin_amdgcn_s_setprio(1); _Pragma("unroll") for (int m = 0; m < 4; ++m) _Pragma("unroll") for (int n = 0; n < 2; ++n) _Pragma("unroll") for (int k = 0; k < 2; ++k) \
        acc[ai][bj][m][n] = __builtin_amdgcn_mfma_f32_16x16x32_bf16(Bt[n][k], At[m][k], acc[ai][bj][m][n], 0, 0, 0); __builtin_amdgcn_s_setprio(0); } while (0)
#define PG8_WAIT_V(n) asm volatile("s_waitcnt vmcnt(" #n ")" ::: "memory")
#define PG8_WAIT_L(n) asm volatile("s_waitcnt lgkmcnt(" #n ")" ::: "memory")
#define PG8_BAR __builtin_amdgcn_s_barrier()
#define PG8_SCHED __builtin_amdgcn_sched_barrier(0)
    Unit cur, nxt; int ui = 0;
    if (!S.next(0, cur)) return;
    f32x4 acc[2][2][4][2];
#pragma unroll
    for (int a = 0; a < 2; ++a)
#pragma unroll
        for (int b = 0; b < 2; ++b)
#pragma unroll
            for (int m = 0; m < 4; ++m)
#pragma unroll
                for (int n = 0; n < 2; ++n) acc[a][b][m][n] = (f32x4){0.f, 0.f, 0.f, 0.f};
    bf16x8 At[4][2], B0[2][2], B1[2][2];
    const char* cA = (const char*)g.A + ((size_t)cur.z * g.sA) * 2 + (size_t)cur.pm * tA; const char* cB = (const char*)g.Bt + ((size_t)cur.z * g.sB) * 2 + (size_t)cur.pn * tB;
    PG8_STAGE(PG8_SB(0, 0), cB, voffB); PG8_STAGE(PG8_SA(0, 0), cA, voffA); PG8_STAGE(PG8_SB(0, 1), cB + hB, voffB); PG8_STAGE(PG8_SA(0, 1), cA + hA, voffA);
    if (wr == 1) PG8_BAR;
    PG8_WAIT_V(4); PG8_BAR;
    PG8_STAGE(PG8_SB(1, 0), cB + kstep, voffB); PG8_STAGE(PG8_SA(1, 0), cA + kstep, voffA); PG8_STAGE(PG8_SB(1, 1), cB + hB + kstep, voffB);
    PG8_WAIT_V(6); PG8_BAR;
    for (;;) {
        const bool has_next = S.next(ui + 1, nxt);
        const char* nA = has_next ? (const char*)g.A + ((size_t)nxt.z * g.sA) * 2 + (size_t)nxt.pm * tA : cA; const char* nB = has_next ? (const char*)g.Bt + ((size_t)nxt.z * g.sB) * 2 + (size_t)nxt.pn * tB : cB;
        for (int t = 0; t < nt; t += 2) {
            const bool last = (t == nt - 2);
            const char* a1 = cA + (size_t)(t + 1) * kstep;
            const char* a2 = last ? nA : cA + (size_t)(t + 2) * kstep; const char* b2 = last ? nB : cB + (size_t)(t + 2) * kstep;
            const char* a3 = a2 + kstep; const char* b3 = b2 + kstep;
            PG8_LDB(B0, 0, 0); PG8_SCHED; PG8_LDA(At, 0, 0); PG8_STAGE(PG8_SA(1, 1), a1 + hA, voffA);
            PG8_WAIT_L(8); PG8_BAR; PG8_WAIT_L(0); PG8_MMA(0, 0, At, B0); PG8_BAR; PG8_SCHED;
            PG8_LDB(B1, 0, 1); PG8_STAGE(PG8_SB(0, 0), b2, voffB);
            PG8_BAR; PG8_WAIT_L(0); PG8_MMA(0, 1, At, B1); PG8_BAR;
            PG8_LDA(At, 0, 1); PG8_STAGE(PG8_SA(0, 0), a2, voffA);
            PG8_BAR; PG8_WAIT_L(0); PG8_MMA(1, 0, At, B0); PG8_BAR; PG8_SCHED;
            PG8_STAGE(PG8_SB(0, 1), b2 + hB, voffB);
            PG8_WAIT_V(6); PG8_BAR; PG8_MMA(1, 1, At, B1); PG8_BAR;
            PG8_LDB(B0, 1, 0); PG8_SCHED; PG8_LDA(At, 1, 0); PG8_STAGE(PG8_SA(0, 1), a2 + hA, voffA);
            PG8_WAIT_L(8); PG8_BAR; PG8_WAIT_L(0); PG8_MMA(0, 0, At, B0); PG8_BAR; PG8_SCHED;
            PG8_LDB(B1, 1, 1); PG8_STAGE(PG8_SB(1, 0), b3, voffB);
            PG8_BAR; PG8_WAIT_L(0); PG8_MMA(0, 1, At, B1); PG8_BAR;
            PG8_LDA(At, 1, 1); PG8_STAGE(PG8_SA(1, 0), a3, voffA);
            PG8_BAR; PG8_WAIT_L(0); PG8_MMA(1, 0, At, B0); PG8_BAR; PG8_SCHED;
            PG8_STAGE(PG8_SB(1, 1), b3 + hB, voffB);
            PG8_WAIT_V(6); PG8_BAR; PG8_MMA(1, 1, At, B1); PG8_BAR;
        }
        E(acc, cur, wr, wc, fr, fq);
        if (!has_next) break;
#pragma unroll
        for (int a = 0; a < 2; ++a)
#pragma unroll
            for (int b = 0; b < 2; ++b)
#pragma unroll
                for (int m = 0; m < 4; ++m)
#pragma unroll
                    for (int n = 0; n < 2; ++n) acc[a][b][m][n] = (f32x4){0.f, 0.f, 0.f, 0.f};
        cur = nxt; cA = nA; cB = nB; ++ui;
    }
    PG8_WAIT_V(0);
    if (wr == 0) PG8_BAR;
    PG8_BAR;
#undef PG8_SA
#undef PG8_SB
#undef PG8_STAGE
#undef PG8_LDA
#undef PG8_LDB
#undef PG8_MMA
#undef PG8_WAIT_V
#undef PG8_WAIT_L
#undef PG8_BAR
#undef PG8_SCHED
}
}

typedef const f32x4 (&AccRef)[2][2][4][2];
__device__ __forceinline__ u32x4 pack8(f32x4 a, f32x4 b) { u32x4 w; w.x = pk2(a[0], a[1]); w.y = pk2(a[2], a[3]); w.z = pk2(b[0], b[1]); w.w = pk2(b[2], b[3]); return w; }

struct EpiIn {
    static constexpr bool PERM = true;
    bf16* PQ; bf16* UB; const float* r;
    __device__ __forceinline__ void operator()(AccRef acc, const pg8::Unit& u, int wr, int wc, int fr, int fq) const {
#pragma unroll
        for (int ai = 0; ai < 2; ++ai)
#pragma unroll
            for (int m = 0; m < 4; ++m) {
                const int row = u.pm * 256 + ai * 128 + wr * 64 + m * 16 + fr; const float rs = r[row];
#pragma unroll
                for (int bj = 0; bj < 2; ++bj) {
                    const int col0 = u.pn * 256 + bj * 128 + wc * 32 + 8 * fq;
                    const u32x4 w = pack8(acc[ai][bj][m][0] * rs, acc[ai][bj][m][1] * rs);
                    if (col0 < 1024) *(u32x4*)(PQ + (size_t)row * 1024 + col0) = w;
                    else { const int c2 = col0 - 1024, gg = c2 >> 4, h0 = c2 & 15; *(u32x4*)(UB + ((size_t)(gg * 2048 + (row >> 4)) * 512 + (row & 15) * 16 + h0)) = w; }
                }
            }
    }
};
struct EpiSloc {
    static constexpr bool PERM = false;
    float* S;
    __device__ __forceinline__ void operator()(AccRef acc, const pg8::Unit& u, int wr, int wc, int fr, int fq) const {
#pragma unroll
        for (int ai = 0; ai < 2; ++ai)
#pragma unroll
            for (int m = 0; m < 4; ++m) {
                const int row = u.pm * 256 + ai * 128 + wr * 64 + m * 16 + fr;
                float* rp = S + ((size_t)u.z * 2048 + row) * 256 + wc * 32 + 4 * fq;
#pragma unroll
                for (int bj = 0; bj < 2; ++bj)
#pragma unroll
                    for (int n = 0; n < 2; ++n) *(f32x4*)(rp + bj * 128 + n * 16) = acc[ai][bj][m][n];
            }
    }
};
struct EpiSsmOut {
    static constexpr bool PERM = true;
    bf16* G;
    __device__ __forceinline__ void operator()(AccRef acc, const pg8::Unit& u, int wr, int wc, int fr, int fq) const {
#pragma unroll
        for (int ai = 0; ai < 2; ++ai)
#pragma unroll
            for (int m = 0; m < 4; ++m) {
                const int row = u.pm * 256 + ai * 128 + wr * 64 + m * 16 + fr;
#pragma unroll
                for (int bj = 0; bj < 2; ++bj) {
                    const int col0 = bj * 128 + wc * 32 + 8 * fq, t = col0 >> 4, i0 = col0 & 15;
                    f32x4 a = acc[ai][bj][m][0], b = acc[ai][bj][m][1];
#pragma unroll
                    for (int j = 0; j < 4; ++j) { a[j] = gelu_t(a[j]); b[j] = gelu_t(b[j]); }
                    *(u32x4*)(G + ((size_t)row * 16 + t) * 512 + u.z * 16 + i0) = pack8(a, b);
                }
            }
    }
};
struct EpiGlu {
    static constexpr bool PERM = true;
    const bf16* G; const float* bias; bf16* AO; float* ss;
    __device__ __forceinline__ void operator()(AccRef acc, const pg8::Unit& u, int wr, int wc, int fr, int fq) const {
#pragma unroll
        for (int ai = 0; ai < 2; ++ai)
#pragma unroll
            for (int m = 0; m < 4; ++m) {
                const int row = u.pm * 256 + ai * 128 + wr * 64 + m * 16 + fr; float s2 = 0.f;
#pragma unroll
                for (int bj = 0; bj < 2; ++bj) {
                    const int col0 = u.pn * 256 + bj * 128 + wc * 32 + 8 * fq;
                    const u32x4 gv = *(const u32x4*)(G + (size_t)row * 512 + col0);
                    const f32x4 b0 = *(const f32x4*)(bias + col0), b1 = *(const f32x4*)(bias + col0 + 4);
                    f32x4 a = acc[ai][bj][m][0] + b0, b = acc[ai][bj][m][1] + b1;
                    a[0] = bflo(gv.x) * sigm(a[0]); a[1] = bfhi(gv.x) * sigm(a[1]); a[2] = bflo(gv.y) * sigm(a[2]); a[3] = bfhi(gv.y) * sigm(a[3]);
                    b[0] = bflo(gv.z) * sigm(b[0]); b[1] = bfhi(gv.z) * sigm(b[1]); b[2] = bflo(gv.w) * sigm(b[2]); b[3] = bfhi(gv.w) * sigm(b[3]);
#pragma unroll
                    for (int j = 0; j < 4; ++j) s2 += a[j] * a[j] + b[j] * b[j];
                    *(u32x4*)(AO + (size_t)row * 1024 + 512 + col0) = pack8(a, b);
                }
                s2 += __shfl_xor(s2, 16); s2 += __shfl_xor(s2, 32);
                if (fq == 0) ss[row * 8 + u.pn * 4 + wc] = s2;
            }
    }
};
struct EpiOutSS {
    static constexpr bool PERM = true;
    bf16* O; float* ss;
    __device__ __forceinline__ void operator()(AccRef acc, const pg8::Unit& u, int wr, int wc, int fr, int fq) const {
#pragma unroll
        for (int ai = 0; ai < 2; ++ai)
#pragma unroll
            for (int m = 0; m < 4; ++m) {
                const int row = u.pm * 256 + ai * 128 + wr * 64 + m * 16 + fr; float s2 = 0.f;
#pragma unroll
                for (int bj = 0; bj < 2; ++bj) {
                    const int col0 = u.pn * 256 + bj * 128 + wc * 32 + 8 * fq;
                    const f32x4 a = acc[ai][bj][m][0], b = acc[ai][bj][m][1];
#pragma unroll
                    for (int j = 0; j < 4; ++j) s2 += a[j] * a[j] + b[j] * b[j];
                    *(u32x4*)(O + (size_t)row * 1024 + col0) = pack8(a, b);
                }
                s2 += __shfl_xor(s2, 16); s2 += __shfl_xor(s2, 32);
                if (fq == 0) ss[row * 16 + u.pn * 4 + wc] = s2;
            }
    }
};
struct EpiFF1 {
    static constexpr bool PERM = true;
    bf16* H; const float* r;
    __device__ __forceinline__ void operator()(AccRef acc, const pg8::Unit& u, int wr, int wc, int fr, int fq) const {
#pragma unroll
        for (int ai = 0; ai < 2; ++ai)
#pragma unroll
            for (int m = 0; m < 4; ++m) {
                const int row = u.pm * 256 + ai * 128 + wr * 64 + m * 16 + fr; const float rs = r[row];
#pragma unroll
                for (int bj = 0; bj < 2; ++bj) {
                    const int col0 = u.pn * 256 + bj * 128 + wc * 32 + 8 * fq;
                    f32x4 a = acc[ai][bj][m][0] * rs, b = acc[ai][bj][m][1] * rs;
#pragma unroll
                    for (int j = 0; j < 4; ++j) { a[j] = fmaxf(a[j], 0.f); a[j] *= a[j]; b[j] = fmaxf(b[j], 0.f); b[j] *= b[j]; }
                    *(u32x4*)(H + (size_t)row * 4096 + col0) = pack8(a, b);
                }
            }
    }
};

__device__ __forceinline__ void transpose_item(const float* W, int ldw, bf16* WT, int ldt, const float* sc_lo, const float* sc_hi, int split,
                                               LAS float* scr, int item, int nblk, int lane) {
    const int kb = item / nblk, nb = item % nblk, k0 = 64 * kb, n0 = 32 * nb;
#pragma unroll 8
    for (int i = 0; i < 32; ++i) { const int kk = 2 * i + (lane >> 5), k = k0 + kk;
        float s = 1.f; if (sc_lo) s = (k < split) ? sc_lo[k] : sc_hi[k - split];
        scr[kk * 33 + (lane & 31)] = W[(size_t)k * ldw + n0 + (lane & 31)] * s; }
    asm volatile("s_waitcnt lgkmcnt(0)" ::: "memory");
    const int c = lane & 7;
#pragma unroll
    for (int j = 0; j < 4; ++j) { const int n = (lane >> 3) + 8 * j; const LAS float* s = scr + (8 * c) * 33 + n;
        u32x4 o; o.x = pk2(s[0 * 33], s[1 * 33]); o.y = pk2(s[2 * 33], s[3 * 33]); o.z = pk2(s[4 * 33], s[5 * 33]); o.w = pk2(s[6 * 33], s[7 * 33]);
        *(u32x4*)(WT + (size_t)(n0 + n) * ldt + k0 + 8 * c) = o; }
    asm volatile("s_waitcnt lgkmcnt(0)" ::: "memory");
}

__device__ __forceinline__ void fold_item(const Params& p, int item, LAS unsigned char* lds) {
    int tid = threadIdx.x; asm volatile("" : "+v"(tid)); const int ly = item >> 7, h = (item >> 4) & 7, kb = item & 15, k0 = kb * 64;
    LAS float* Wt = (LAS float*)lds;
    LAS float* Wf = Wt + 64 * 65;
    LAS float* TC = Wf + 64 * 65;
    LAS float* TS = TC + 64 * 65;
    LAS float* cs = TS + 64 * 65;
    __syncthreads();
    const float* win = p.w_in + (size_t)ly * 1024 * 1024; const float* wf = p.w_fourier + ((size_t)ly * 8 + h) * 4096; const float* g = p.pre_mix_g + ly * 1024;
    for (int i = tid; i < 4096; i += 512) { const int k = i >> 6, c = i & 63; Wt[k * 65 + c] = win[(size_t)(k0 + k) * 1024 + 64 * h + c] * g[k0 + k]; Wf[k * 65 + c] = wf[i]; }
    if (tid < 64) { float s, c; sincospif((float)tid / 32.0f, &s, &c); cs[tid] = c; cs[64 + tid] = s; }
    __syncthreads();
#pragma nounroll
    for (int i = tid; i < 4096; i += 512) { const int k = i >> 6, d = i & 63; float ac = 0.f, as = 0.f;
#pragma unroll 4
        for (int c = 0; c < 64; ++c) { const float w = Wt[k * 65 + c]; const int ph = (c * d) & 63; ac += w * cs[ph]; as += w * cs[64 + ph]; }
        TC[k * 65 + d] = ac; TS[k * 65 + d] = as; }
    __syncthreads();
    const float scale = 1.0f / 724.0773439350247f;
    bf16* WT = (bf16*)(p.ws + OFF_W + (size_t)ly * W_LAYER + W_IN);
    { const int k = tid & 63, eg = tid >> 6;
#pragma nounroll
      for (int j = 0; j < 8; ++j) { const int e = eg * 8 + j; float ap = 0.f, aq = 0.f;
#pragma unroll 4
          for (int d = 0; d < 64; ++d) { const float w = Wf[d * 65 + e]; ap += TC[k * 65 + d] * w; aq += TS[k * 65 + d] * w; }
          WT[(size_t)(64 * h + e) * 1024 + k0 + k] = (bf16)f2bf(ap * scale);
          WT[(size_t)(512 + 64 * h + e) * 1024 + k0 + k] = (bf16)f2bf(-aq * scale); } }
}

__device__ __forceinline__ void ssm_mat_item(const Params& p, int item, LAS unsigned char* lds) {
    int tid = threadIdx.x; asm volatile("" : "+v"(tid)); const int ly = item >> 5, g = item & 31;
    LAS float* pwr = (LAS float*)lds;
    LAS float* pwi = pwr + 2 * 17 * 64;
    LAS float* bbr = pwi + 2 * 17 * 64;
    LAS float* bbi = bbr + 2 * 64 * 16;
    LAS float* ccr = bbi + 2 * 64 * 16;
    LAS float* cci = ccr + 2 * 16 * 64;
    LAS float* Gt = cci + 2 * 16 * 64;
    __syncthreads();
    if (tid < 128) { const int k = tid >> 6, pp = tid & 63; const int idx = (ly * 2 + k) * 32 + g;
        const float dt = expf(p.log_dt[idx]); const float lr = p.lam_re[idx * 64 + pp], li = p.lam_im[idx * 64 + pp];
        for (int tau = 0; tau <= 16; ++tau) { const float e = expf(lr * dt * tau); float s, c; sincosf(li * dt * tau, &s, &c); pwr[(k * 17 + tau) * 64 + pp] = e * c; pwi[(k * 17 + tau) * 64 + pp] = e * s; }
        const float lbr = pwr[(k * 17 + 1) * 64 + pp] - 1.0f, lbi = pwi[(k * 17 + 1) * 64 + pp];
        const float den = 1.0f / (lr * lr + li * li); const float cr = (lbr * lr + lbi * li) * den, ci = (lbi * lr - lbr * li) * den;
        for (int h = 0; h < 16; ++h) { const float br = p.b_re[((size_t)idx * 64 + pp) * 16 + h], bi = p.b_im[((size_t)idx * 64 + pp) * 16 + h];
            bbr[(k * 64 + pp) * 16 + h] = cr * br - ci * bi; bbi[(k * 64 + pp) * 16 + h] = cr * bi + ci * br; } }
    for (int i = tid; i < 2048; i += 512) { const int k = i >> 10, r = i & 1023; const int idx = (ly * 2 + k) * 32 + g; ccr[i] = p.c_re[(size_t)idx * 1024 + r]; cci[i] = p.c_im[(size_t)idx * 1024 + r]; }
    __syncthreads();
    for (int o = tid; o < 8192; o += 512) { const int k = o >> 12, tau = (o >> 8) & 15, i = (o >> 4) & 15, h = o & 15; float a = 0.f;
        for (int pp = 0; pp < 64; ++pp) { const float c_r = ccr[(k * 16 + i) * 64 + pp], c_i = cci[(k * 16 + i) * 64 + pp], l_r = pwr[(k * 17 + tau) * 64 + pp], l_i = pwi[(k * 17 + tau) * 64 + pp];
            const float xr = c_r * l_r - c_i * l_i, xi = c_r * l_i + c_i * l_r; a += xr * bbr[(k * 64 + pp) * 16 + h] - xi * bbi[(k * 64 + pp) * 16 + h]; }
        Gt[o] = a; }
    __syncthreads();
    bf16* TM = (bf16*)(p.ws + OFF_TM) + (size_t)item * 256 * 512; bf16* MS = (bf16*)(p.ws + OFF_MST) + (size_t)item * 256 * 256;
    const float* dsk = p.d_skip + (ly * 32 + g) * 16;
    for (int o = tid; o < 256 * 512; o += 512) { const int r = o >> 9, col = o & 511, t = r >> 4, i = r & 15; float v;
        if (col < 256) { const int j = col >> 4, h = col & 15; v = 0.f;
            if (j <= t) v += Gt[((0 * 16 + (t - j)) * 16 + i) * 16 + h];
            if (j >= t) v += Gt[((1 * 16 + (j - t)) * 16 + i) * 16 + h];
            if (j == t && h == i) v += dsk[i]; }
        else { const int k = (col - 256) >> 7, q = (col - 256) & 127, pp = q >> 1, part = q & 1; const int tau = k == 0 ? (t + 1) : (16 - t);
            const float c_r = ccr[(k * 16 + i) * 64 + pp], c_i = cci[(k * 16 + i) * 64 + pp], l_r = pwr[(k * 17 + tau) * 64 + pp], l_i = pwi[(k * 17 + tau) * 64 + pp];
            v = part == 0 ? (c_r * l_r - c_i * l_i) : -(c_r * l_i + c_i * l_r); }
        TM[o] = (bf16)f2bf(v); }
    for (int o = tid; o < 256 * 256; o += 512) { const int r = o >> 8, col = o & 255, k = r >> 7, q = r & 127, pp = q >> 1, part = q & 1, j = col >> 4, h = col & 15;
        const int tau = k == 0 ? (15 - j) : j;
        const float l_r = pwr[(k * 17 + tau) * 64 + pp], l_i = pwi[(k * 17 + tau) * 64 + pp], b_r = bbr[(k * 64 + pp) * 16 + h], b_i = bbi[(k * 64 + pp) * 16 + h];
        const float v = part == 0 ? (l_r * b_r - l_i * b_i) : (l_r * b_i + l_i * b_r);
        MS[o] = (bf16)f2bf(v); }
}

__device__ __forceinline__ void p0_prologue(const Params& p, LAS unsigned char* lds, int G, int bid) {
    int tid = threadIdx.x; asm volatile("" : "+v"(tid));
    const int lane = tid & 63, wave = __builtin_amdgcn_readfirstlane(tid >> 6);
    for (int it = bid; it < 256 + 64; it += G) { if (it < 256) fold_item(p, it, lds); else ssm_mat_item(p, it - 256, lds); }
    __syncthreads();
    {
        LAS float* scr = (LAS float*)(lds + wave * 8448);
        const int gw = bid * 8 + wave, NGW = G * 8;
        constexpr int I_IN = 16 * 16, I_OUT = 16 * 32, I_1 = 16 * 128, I_2 = 64 * 32, I_G = 8 * 16, I_L = I_IN + I_OUT + I_1 + I_2 + I_G;
        for (int it = gw; it < 2 * I_L; it += NGW) {
            const int ly = it / I_L; int r = it % I_L; unsigned char* wb = p.ws + OFF_W + (size_t)ly * W_LAYER;
            if (r < I_IN) { transpose_item(p.w_in + (size_t)ly * 1024 * 1024 + 512, 1024, (bf16*)(wb + W_IN) + (size_t)1024 * 1024, 1024, p.pre_mix_g + ly * 1024, nullptr, 1 << 30, scr, r, 16, lane); continue; } r -= I_IN;
            if (r < I_OUT) { transpose_item(p.w_out + (size_t)ly * 1024 * 1024, 1024, (bf16*)(wb + W_OUT), 1024, p.fourier_out_g + ly * 512, p.ssm_out_g + ly * 512, 512, scr, r, 32, lane); continue; } r -= I_OUT;
            if (r < I_1) { transpose_item(p.w_ff1 + (size_t)ly * 1024 * 4096, 4096, (bf16*)(wb + W_1), 1024, p.pre_mlp_g + ly * 1024, nullptr, 1 << 30, scr, r, 128, lane); continue; } r -= I_1;
            if (r < I_2) { transpose_item(p.w_ff2 + (size_t)ly * 4096 * 1024, 1024, (bf16*)(wb + W_2), 4096, nullptr, nullptr, 0, scr, r, 32, lane); continue; } r -= I_2;
            transpose_item(p.w_glu + (size_t)ly * 512 * 512, 512, (bf16*)(wb + W_GLU), 512, nullptr, nullptr, 0, scr, r, 16, lane);
        }
        bf16* XB = (bf16*)(p.ws + OFF_XB); float* rA = (float*)(p.ws + OFF_RA);
        for (int row = gw; row < MT; row += NGW) {
            const f32x4* xr = (const f32x4*)(p.x + (size_t)row * 1024) + lane; float s2 = 0.f;
            u32x2* o = (u32x2*)(XB + (size_t)row * 1024) + lane;
#pragma unroll
            for (int j = 0; j < 4; ++j) { const f32x4 v = xr[64 * j]; s2 += v[0] * v[0] + v[1] * v[1] + v[2] * v[2] + v[3] * v[3]; u32x2 w; w.x = pk2(v[0], v[1]); w.y = pk2(v[2], v[3]); o[64 * j] = w; }
            s2 = wave_sum(s2);
            if (lane == 0) rA[row] = rsqrtf(s2 * (1.0f / 1024.0f) + EPS);
        }
    }
    {
        bf16* D1 = (bf16*)(p.ws + OFF_D1); bf16* E3 = (bf16*)(p.ws + OFF_E3);
        const int gt = bid * 512 + tid, NT = G * 512;
        for (int idx = gt; idx < 64 * 2 * 128 * 128; idx += NT) { const int n2 = idx >> 15, sel = (idx >> 14) & 1, k1 = (idx >> 7) & 127, n1 = idx & 127;
            const int ph = (k1 * (64 * n1 + n2)) & 8191; float s, c; sincospif((float)ph * (1.0f / 4096.0f), &s, &c); D1[idx] = (bf16)f2bf(sel ? s : c); }
        for (int idx = gt; idx < 64 * 128; idx += NT) { const int k2 = idx >> 7, col = idx & 127, part = col >> 6, n2 = col & 63;
            const int ph = (n2 * k2) & 63; float s, c; sincospif((float)ph * (1.0f / 32.0f), &s, &c); E3[idx] = (bf16)f2bf(part ? s : c); }
    }
}

__device__ __forceinline__ bf16x8 negbf(bf16x8 v) { u32x4 t = __builtin_bit_cast(u32x4, v); t = t ^ 0x80008000u; return __builtin_bit_cast(bf16x8, t); }
__device__ __forceinline__ bf16x8 gather8(const LAS unsigned short* X, int pitch) {
    u32x4 t;
    t.x = (unsigned)X[0] | ((unsigned)X[pitch] << 16); t.y = (unsigned)X[2 * pitch] | ((unsigned)X[3 * pitch] << 16);
    t.z = (unsigned)X[4 * pitch] | ((unsigned)X[5 * pitch] << 16); t.w = (unsigned)X[6 * pitch] | ((unsigned)X[7 * pitch] << 16);
    return __builtin_bit_cast(bf16x8, t);
}
__device__ __forceinline__ void fft1_phase(const bf16* PQ, const bf16* D1, bf16* T, LAS unsigned char* lds, int G, int bid) {
    int tid = threadIdx.x; asm volatile("" : "+v"(tid));
    const int lane = tid & 63, wave = __builtin_amdgcn_readfirstlane(tid >> 6), wm = wave & 3, wn = wave >> 2, fr = lane & 15, fq = lane >> 4;
    const LAS unsigned short* X = (const LAS unsigned short*)lds;
    for (int pr = bid; pr < 256; pr += G) {
        const int n2 = pr & 63, cb = pr >> 6;
        const bf16* Cb = D1 + (size_t)n2 * 2 * 128 * 128; const bf16* Sb = Cb + 128 * 128;
        for (int b = 0; b < NB; ++b) {
            __syncthreads();
#pragma unroll
            for (int j = 0; j < 8; ++j) { const int q = tid + 512 * j, row = q >> 4, cc = q & 15, part = row >> 7, n1 = row & 127;
                const u32x4 v = *(const u32x4*)(PQ + ((size_t)(b * SEQ + 64 * n1 + n2)) * 1024 + part * 512 + cb * 128 + 8 * cc);
                LAS unsigned* d = (LAS unsigned*)(lds + row * 260 + cc * 16); d[0] = v.x; d[1] = v.y; d[2] = v.z; d[3] = v.w; }
            __syncthreads();
            f32x4 Ar[2][4], Ai[2][4];
#pragma unroll
            for (int mb = 0; mb < 2; ++mb)
#pragma unroll
                for (int nb = 0; nb < 4; ++nb) { Ar[mb][nb] = (f32x4){0.f, 0.f, 0.f, 0.f}; Ai[mb][nb] = (f32x4){0.f, 0.f, 0.f, 0.f}; }
#pragma nounroll
            for (int ks = 0; ks < 8; ++ks) {
                bf16x8 Bf[4];
#pragma unroll
                for (int nb = 0; nb < 4; ++nb) Bf[nb] = gather8(X + (32 * ks + 8 * fq) * 130 + 64 * wn + 16 * nb + fr, 130);
                bf16x8 Cf[2], Sf[2];
#pragma unroll
                for (int mb = 0; mb < 2; ++mb) { const int off = (32 * wm + 16 * mb + fr) * 128 + 32 * (ks & 3) + 8 * fq; Cf[mb] = *(const bf16x8*)(Cb + off); Sf[mb] = *(const bf16x8*)(Sb + off); }
#pragma unroll
                for (int mb = 0; mb < 2; ++mb)
#pragma unroll
                    for (int nb = 0; nb < 4; ++nb) {
                        if (ks < 4) { Ar[mb][nb] = __builtin_amdgcn_mfma_f32_16x16x32_bf16(Bf[nb], Cf[mb], Ar[mb][nb], 0, 0, 0);
                                      Ai[mb][nb] = __builtin_amdgcn_mfma_f32_16x16x32_bf16(Bf[nb], negbf(Sf[mb]), Ai[mb][nb], 0, 0, 0); }
                        else        { Ar[mb][nb] = __builtin_amdgcn_mfma_f32_16x16x32_bf16(Bf[nb], Sf[mb], Ar[mb][nb], 0, 0, 0);
                                      Ai[mb][nb] = __builtin_amdgcn_mfma_f32_16x16x32_bf16(Bf[nb], Cf[mb], Ai[mb][nb], 0, 0, 0); }
                    }
            }
#pragma unroll
            for (int mb = 0; mb < 2; ++mb)
#pragma unroll
                for (int nb = 0; nb < 4; ++nb) { const int k1 = 32 * wm + 16 * mb + fr, c = cb * 128 + 64 * wn + 16 * nb + 4 * fq;
                    u32x2 w; w.x = pk2(Ar[mb][nb][0], Ar[mb][nb][1]); w.y = pk2(Ar[mb][nb][2], Ar[mb][nb][3]);
                    *(u32x2*)(T + ((((size_t)(b * 128 + k1) * 2 + 0) * 64 + n2) * 512 + c)) = w;
                    w.x = pk2(Ai[mb][nb][0], Ai[mb][nb][1]); w.y = pk2(Ai[mb][nb][2], Ai[mb][nb][3]);
                    *(u32x2*)(T + ((((size_t)(b * 128 + k1) * 2 + 1) * 64 + n2) * 512 + c)) = w; }
        }
    }
    __syncthreads();
}

__device__ __forceinline__ void fft3_phase(const bf16* T, const bf16* E3, bf16* AO, LAS unsigned char* lds, int G, int bid) {
    int tid = threadIdx.x; asm volatile("" : "+v"(tid));
    const int lane = tid & 63, wave = __builtin_amdgcn_readfirstlane(tid >> 6), fr = lane & 15, fq = lane >> 4;
    const LAS unsigned short* X = (const LAS unsigned short*)lds;
    LAS float* red = (LAS float*)(lds + 128 * 1028);
    for (int unit = bid; unit < 512; unit += G) {
        const int b = unit >> 7, k1 = unit & 127;
        __syncthreads();
        const bf16* src = T + (size_t)unit * 65536;
#pragma unroll
        for (int j = 0; j < 16; ++j) { const int q = tid + 512 * j, row = q >> 6, cc = q & 63;
            const u32x4 v = *(const u32x4*)(src + row * 512 + cc * 8);
            LAS unsigned* d = (LAS unsigned*)(lds + row * 1028 + cc * 16); d[0] = v.x; d[1] = v.y; d[2] = v.z; d[3] = v.w; }
        __syncthreads();
        f32x4 acc[4][4];
#pragma unroll
        for (int mb = 0; mb < 4; ++mb)
#pragma unroll
            for (int nb = 0; nb < 4; ++nb) acc[mb][nb] = (f32x4){0.f, 0.f, 0.f, 0.f};
#pragma nounroll
        for (int ks = 0; ks < 4; ++ks) {
            bf16x8 Bf[4];
#pragma unroll
            for (int nb = 0; nb < 4; ++nb) Bf[nb] = gather8(X + (32 * ks + 8 * fq) * 514 + 64 * wave + 16 * nb + fr, 514);
            bf16x8 Ef[4];
#pragma unroll
            for (int mb = 0; mb < 4; ++mb) Ef[mb] = *(const bf16x8*)(E3 + (16 * mb + fr) * 128 + 32 * ks + 8 * fq);
#pragma unroll
            for (int mb = 0; mb < 4; ++mb)
#pragma unroll
                for (int nb = 0; nb < 4; ++nb) acc[mb][nb] = __builtin_amdgcn_mfma_f32_16x16x32_bf16(Bf[nb], Ef[mb], acc[mb][nb], 0, 0, 0);
        }
#pragma unroll
        for (int mb = 0; mb < 4; ++mb) { float s = 0.f;
#pragma unroll
            for (int nb = 0; nb < 4; ++nb)
#pragma unroll
                for (int j = 0; j < 4; ++j) s += acc[mb][nb][j] * acc[mb][nb][j];
            s += __shfl_xor(s, 16); s += __shfl_xor(s, 32);
            if (fq == 0) red[wave * 64 + 16 * mb + fr] = s; }
        __syncthreads();
#pragma unroll
        for (int mb = 0; mb < 4; ++mb) { float tot = 0.f;
#pragma unroll
            for (int w = 0; w < 8; ++w) tot += red[w * 64 + 16 * mb + fr];
            const float rinv = rsqrtf(tot * (1.0f / 512.0f) + EPS);
            const size_t token = (size_t)b * SEQ + k1 + 128 * (16 * mb + fr);
#pragma unroll
            for (int nb = 0; nb < 4; ++nb) { u32x2 w; w.x = pk2(acc[mb][nb][0] * rinv, acc[mb][nb][1] * rinv); w.y = pk2(acc[mb][nb][2] * rinv, acc[mb][nb][3] * rinv);
                *(u32x2*)(AO + token * 1024 + 64 * wave + 16 * nb + 4 * fq) = w; } }
    }
    __syncthreads();
}

__device__ __forceinline__ void carry_phase(const Params& p, int ly, const float* Sloc, bf16* UB, int G, int bid) {
    int tid = threadIdx.x; asm volatile("" : "+v"(tid));
    const int lane = tid & 63, wave = __builtin_amdgcn_readfirstlane(tid >> 6);
    if (wave != 0) return;
    for (int w = bid; w < 256; w += G) {
        const int dir = w & 1, g = (w >> 1) & 31, b = w >> 6, pp = lane; const int idx = (ly * 2 + dir) * 32 + g;
        const float dt = expf(p.log_dt[idx]); const float lr = p.lam_re[idx * 64 + pp] * dt * 16.0f, li = p.lam_im[idx * 64 + pp] * dt * 16.0f;
        const float e = expf(lr); float sn, cs; sincosf(li, &sn, &cs); const float l_r = e * cs, l_i = e * sn;
        float cr = 0.f, ci = 0.f;
        const float* src = Sloc + ((size_t)(g * 2048 + b * 512)) * 256 + dir * 128 + 2 * pp;
        bf16* dst = UB + ((size_t)(g * 2048 + b * 512)) * 512 + 256 + dir * 128 + 2 * pp;
        for (int s0 = 0; s0 < 512; s0 += 8) {
            f32x2 v[8];
#pragma unroll
            for (int j = 0; j < 8; ++j) { const int ss = dir == 0 ? (s0 + j) : (511 - s0 - j); v[j] = *(const f32x2*)(src + (size_t)ss * 256); }
#pragma unroll
            for (int j = 0; j < 8; ++j) { const int ss = dir == 0 ? (s0 + j) : (511 - s0 - j);
                *(unsigned*)(dst + (size_t)ss * 512) = pk2(cr, ci);
                const float nr = l_r * cr - l_i * ci + v[j][0], ni = l_r * ci + l_i * cr + v[j][1]; cr = nr; ci = ni; }
        }
    }
}

__device__ __forceinline__ void norm_phase(const float* xin, float* xout, const bf16* MF, const float* ss, const float* gain, bf16* XB, float* rnext, bool last, int G, int bid) {
    int tid = threadIdx.x; asm volatile("" : "+v"(tid));
    const int lane = tid & 63, wave = __builtin_amdgcn_readfirstlane(tid >> 6);
    const int gw = bid * 8 + wave, NGW = G * 8;
    for (int row = gw; row < MT; row += NGW) {
        float tot = 0.f;
#pragma unroll
        for (int k = 0; k < 16; ++k) tot += ss[row * 16 + k];
        const float rinv = rsqrtf(tot * (1.0f / 1024.0f) + EPS); float s2 = 0.f;
        const f32x4* xr = (const f32x4*)(xin + (size_t)row * 1024) + lane; f32x4* xo = (f32x4*)(xout + (size_t)row * 1024) + lane;
        const u32x2* mr = (const u32x2*)(MF + (size_t)row * 1024) + lane; u32x2* bo = (u32x2*)(XB + (size_t)row * 1024) + lane; const f32x4* gr = (const f32x4*)gain + lane;
#pragma unroll
        for (int j = 0; j < 4; ++j) { f32x4 v = xr[64 * j]; const u32x2 mm = mr[64 * j]; const f32x4 gg = gr[64 * j];
            v[0] += bflo(mm.x) * rinv * gg[0]; v[1] += bfhi(mm.x) * rinv * gg[1]; v[2] += bflo(mm.y) * rinv * gg[2]; v[3] += bfhi(mm.y) * rinv * gg[3];
            s2 += v[0] * v[0] + v[1] * v[1] + v[2] * v[2] + v[3] * v[3]; xo[64 * j] = v;
            if (!last) { u32x2 w; w.x = pk2(v[0], v[1]); w.y = pk2(v[2], v[3]); bo[64 * j] = w; } }
        s2 = wave_sum(s2);
        if (lane == 0) rnext[row] = rsqrtf(s2 * (1.0f / 1024.0f) + EPS);
    }
}
__device__ __forceinline__ void rescale_phase(bf16* AO, const float* ss, int G, int bid) {
    int tid = threadIdx.x; asm volatile("" : "+v"(tid));
    const int lane = tid & 63, wave = __builtin_amdgcn_readfirstlane(tid >> 6);
    const int gw = bid * 8 + wave, NGW = G * 8;
    for (int row = gw; row < MT; row += NGW) {
        float tot = 0.f;
#pragma unroll
        for (int k = 0; k < 8; ++k) tot += ss[row * 8 + k];
        const float rinv = rsqrtf(tot * (1.0f / 512.0f) + EPS);
        u32x4* ptr = (u32x4*)(AO + (size_t)row * 1024 + 512) + lane; u32x4 v = *ptr;
        v.x = pk2(bflo(v.x) * rinv, bfhi(v.x) * rinv); v.y = pk2(bflo(v.y) * rinv, bfhi(v.y) * rinv); v.z = pk2(bflo(v.z) * rinv, bfhi(v.z) * rinv); v.w = pk2(bflo(v.w) * rinv, bfhi(v.w) * rinv);
        *ptr = v;
    }
}


#define XB_TMO      128
#define XB_XCNT(j)  (256  + 64 * (j))
#define XB_XSUB(j)  (1280 + 64 * (j))
#define XB_XGEN(j)  (2304 + 64 * (j))
#define XB_TOP      3328
#define XB_TOPGEN   3392
#define XCD_BAR_WORDS 3456
#define XB_SPIN_CAP (1u << 18)
__device__ __forceinline__ unsigned xb_ld(unsigned* p)              { return __hip_atomic_load(p, __ATOMIC_RELAXED, __HIP_MEMORY_SCOPE_AGENT); }
__device__ __forceinline__ unsigned xb_add(unsigned* p, unsigned v) { return __hip_atomic_fetch_add(p, v, __ATOMIC_RELAXED, __HIP_MEMORY_SCOPE_AGENT); }
__device__ __forceinline__ unsigned xb_xcc_id() { return (unsigned)__builtin_amdgcn_s_getreg((3 << 11) | 20) & 0xFu; }
#define XB_SPIN(cond, bar) do { unsigned _sp = 0; while (cond) { __builtin_amdgcn_s_sleep(1); \
    if ((++_sp & 255u) == 0u) { if (xb_ld(&(bar)[XB_TMO])) break; if (_sp > XB_SPIN_CAP) { atomicAdd(&(bar)[XB_TMO], 1u); break; } } } } while (0)
struct XcdBarrier { unsigned* bar; unsigned x; volatile LAS unsigned* st; };
__device__ __forceinline__ XcdBarrier xcd_barrier_post(unsigned* bar, volatile LAS unsigned* st) {
    XcdBarrier b; b.bar = bar; b.x = xb_xcc_id(); b.st = st;
    if (threadIdx.x == 0) (void)xb_add(&bar[XB_XCNT(b.x)], 1u);
    return b;
}
__device__ __forceinline__ void xcd_barrier_complete(unsigned* bar, unsigned x, unsigned& nloc, unsigned& nx) {
    const unsigned G = gridDim.x * gridDim.y * gridDim.z;
    unsigned sum, cnt, mine, sp = 0u;
    for (;;) {
        sum = 0u; cnt = 0u; mine = 0u;
#pragma unroll
        for (unsigned j = 0; j < 16; ++j) { const unsigned c = xb_ld(&bar[XB_XCNT(j)]); sum += c; cnt += (c > 0u) ? 1u : 0u; mine = (j == x) ? c : mine; }
        if (sum == G) break;
        __builtin_amdgcn_s_sleep(1);
        if ((++sp & 255u) == 0u) { if (xb_ld(&bar[XB_TMO])) break; if (sp > XB_SPIN_CAP) { atomicAdd(&bar[XB_TMO], 1u); break; } }
    }
    nloc = mine > 0u ? mine : 1u; nx = cnt > 0u ? cnt : 1u;
}
__device__ __forceinline__ void xcd_barrier(const XcdBarrier& b) {
    asm volatile("s_waitcnt vmcnt(0)" ::: "memory");
    __syncthreads();
    if (threadIdx.x == 0) {
        unsigned* bar = b.bar;
        __builtin_amdgcn_s_waitcnt(0);
        unsigned nloc = b.st[0], nx = b.st[1];
        if (nloc == 0u) { xcd_barrier_complete(bar, b.x, nloc, nx); b.st[0] = nloc; b.st[1] = nx; }
        const unsigned old = xb_add(&bar[XB_XSUB(b.x)], 1u);
        const unsigned gen = old / nloc;
        if (old + 1u == (gen + 1u) * nloc) {
            __builtin_amdgcn_fence(__ATOMIC_RELEASE, "agent");
            asm volatile("s_waitcnt vmcnt(0)" ::: "memory");
            const unsigned og = xb_add(&bar[XB_TOP], 1u);
            const unsigned tg = og / nx;
            if (og + 1u == (tg + 1u) * nx) xb_add(&bar[XB_TOPGEN], 1u);
            else XB_SPIN(xb_ld(&bar[XB_TOPGEN]) == tg, bar);
            __builtin_amdgcn_fence(__ATOMIC_ACQUIRE, "agent");
            xb_add(&bar[XB_XGEN(b.x)], 1u);
            asm volatile("s_waitcnt vmcnt(0)" ::: "memory");
        } else {
            XB_SPIN(xb_ld(&bar[XB_XGEN(b.x)]) == gen, bar);
            __builtin_amdgcn_fence(__ATOMIC_ACQUIRE, "agent");
            asm volatile("s_waitcnt vmcnt(0)" ::: "memory");
        }
    }
    __syncthreads();
}

#ifndef REP_P0
#define REP_P0 1
#endif
#ifndef REP_SYNC
#define REP_SYNC 1
#endif
#ifndef REP_MASK_V
#define REP_MASK_V 0u
#endif
constexpr unsigned REP_MASK = REP_MASK_V;
constexpr int PH_PER_LAYER = 11, N_PHASES = 1 + 2 * PH_PER_LAYER;
__global__ void __launch_bounds__(512) hybrid_fwd(Params p) {
    extern __shared__ __attribute__((aligned(16))) unsigned char lds_raw[];
    LAS unsigned char* lds = (LAS unsigned char*)lds_raw;
    cg::grid_group grid = cg::this_grid();
    volatile LAS unsigned* xst = (volatile LAS unsigned*)(lds + LDS_BYTES - 16);
    if (threadIdx.x < 4) xst[threadIdx.x] = 0u;
    __syncthreads();
    const XcdBarrier xbar = xcd_barrier_post((unsigned*)(p.ws + OFF_BAR), xst);
    if (p.ph_hi > 1000) grid.sync();
    const int Gk = gridDim.x, bk = blockIdx.x;
    unsigned char* ws = p.ws;
    float* sss = (float*)(ws + OFF_SSS); float* ssm = (float*)(ws + OFF_SSM); float* ssf = (float*)(ws + OFF_SSF); float* rA = (float*)(ws + OFF_RA); float* rB = (float*)(ws + OFF_RB);
    bf16* XB = (bf16*)(ws + OFF_XB); bf16* MF = (bf16*)(ws + OFF_MF); bf16* GB = (bf16*)(ws + OFF_G); bf16* HB = (bf16*)(ws + OFF_H);
    bf16* PQ = (bf16*)(ws + OFF_PQ); bf16* AO = (bf16*)(ws + OFF_AO); bf16* UB = (bf16*)(ws + OFF_UB); bf16* TB = (bf16*)(ws + OFF_T); float* SL = (float*)(ws + OFF_SLOC);

#pragma nounroll
    for (int ph = p.ph_lo; ph < p.ph_hi; ++ph) {
        int G = Gk, bid = bk; asm volatile("" : "+s"(G), "+s"(bid));
        if (ph == 0) { for (int rep = 0; rep < REP_P0; ++rep) p0_prologue(p, lds, G, bid); }
        else {
            const int ly = (ph - 1) / PH_PER_LAYER, sp = (ph - 1) % PH_PER_LAYER;
            unsigned char* wb = ws + OFF_W + (size_t)ly * W_LAYER;
            pg8::Order S;
            const int nrep = ((REP_MASK >> sp) & 1u) ? 2 : 1;
            for (int rep = 0; rep < nrep; ++rep)
            switch (sp) {
            case 0: {
                pg8::Gemm g{XB, (const bf16*)(wb + W_IN), MT, NIN, 1024, 1024, 1024, 0, 0, 1}; S.init(MT, NIN, 1, G, bid);
                EpiIn E{PQ, UB, rA}; pg8::gemm_phase<EpiIn>(lds, g, S, E); } break;
            case 1: {
                fft1_phase(PQ, (const bf16*)(ws + OFF_D1), TB, lds, G, bid);
                pg8::Gemm g{UB, (const bf16*)(ws + OFF_MST) + (size_t)ly * 32 * 256 * 256, 2048, 256, 256, 512, 256, (size_t)2048 * 512, (size_t)256 * 256, 32}; S.init(2048, 256, 32, G, bid);
                EpiSloc E{SL}; pg8::gemm_phase<EpiSloc>(lds, g, S, E); } break;
            case 2: {
                carry_phase(p, ly, SL, UB, G, bid);
                fft3_phase(TB, (const bf16*)(ws + OFF_E3), AO, lds, G, bid); } break;
            case 3: {
                pg8::Gemm g{UB, (const bf16*)(ws + OFF_TM) + (size_t)ly * 32 * 256 * 512, 2048, 256, 512, 512, 512, (size_t)2048 * 512, (size_t)256 * 512, 32}; S.init(2048, 256, 32, G, bid);
                EpiSsmOut E{GB}; pg8::gemm_phase<EpiSsmOut>(lds, g, S, E); } break;
            case 4: {
                pg8::Gemm g{GB, (const bf16*)(wb + W_GLU), MT, 512, 512, 512, 512, 0, 0, 1}; S.init(MT, 512, 1, G, bid);
                EpiGlu E{GB, p.b_glu + ly * 512, AO, sss}; pg8::gemm_phase<EpiGlu>(lds, g, S, E); } break;
            case 5: rescale_phase(AO, sss, G, bid); break;
            case 6: {
                pg8::Gemm g{AO, (const bf16*)(wb + W_OUT), MT, 1024, 1024, 1024, 1024, 0, 0, 1}; S.init(MT, 1024, 1, G, bid);
                EpiOutSS E{MF, ssm}; pg8::gemm_phase<EpiOutSS>(lds, g, S, E); } break;
            case 7: norm_phase(ly == 0 ? p.x : p.out, p.out, MF, ssm, p.post_mix_g + ly * 1024, XB, rB, false, G, bid); break;
            case 8: {
                pg8::Gemm g{XB, (const bf16*)(wb + W_1), MT, DFF, 1024, 1024, 1024, 0, 0, 1}; S.init(MT, DFF, 1, G, bid);
                EpiFF1 E{HB, rB}; pg8::gemm_phase<EpiFF1>(lds, g, S, E); } break;
            case 9: {
                pg8::Gemm g{HB, (const bf16*)(wb + W_2), MT, 1024, DFF, DFF, DFF, 0, 0, 1}; S.init(MT, 1024, 1, G, bid);
                EpiOutSS E{MF, ssf}; pg8::gemm_phase<EpiOutSS>(lds, g, S, E); } break;
            case 10: norm_phase(p.out, p.out, MF, ssf, p.post_mlp_g + ly * 1024, XB, rA, ly == 1, G, bid); break;
            }
        }
        if (ph + 1 < p.ph_hi) for (int rep = 0; rep < REP_SYNC; ++rep) xcd_barrier(xbar);
    }
}

extern "C" void kernel_launch(void* const* d_in, const int* in_sizes, int n_in, void* d_out, int out_size, void* d_ws, size_t ws_size, hipStream_t stream) {
    static int grid = 0;
    if (grid == 0) {
        if (n_in != 22 || ws_size < WS_END) { fprintf(stderr, "kernel_launch: unexpected n_in %d or ws_size %zu (< %zu)\n", n_in, ws_size, (size_t)WS_END); grid = -1; return; }
        int dev = 0, cus = 0, per_cu = 0;
        hipGetDevice(&dev); hipDeviceGetAttribute(&cus, hipDeviceAttributeMultiprocessorCount, dev);
        if (hipFuncSetAttribute((const void*)hybrid_fwd, hipFuncAttributeMaxDynamicSharedMemorySize, LDS_BYTES) != hipSuccess) { fprintf(stderr, "kernel_launch: hipFuncSetAttribute failed\n"); grid = -1; return; }
        if (hipOccupancyMaxActiveBlocksPerMultiprocessor(&per_cu, (const void*)hybrid_fwd, 512, LDS_BYTES) != hipSuccess || per_cu < 1) { fprintf(stderr, "kernel_launch: occupancy query says %d blocks per CU\n", per_cu); per_cu = 1; }
        (void)hipGetLastError();
        grid = cus;
    }
    if (grid < 0) return;
    if (hipMemsetAsync((char*)d_ws + OFF_BAR, 0, BAR_BYTES, stream) != hipSuccess) { fprintf(stderr, "kernel_launch: memset of the barrier words failed\n"); return; }
    Params p{};
    const float** f = (const float**)&p;
    for (int i = 0; i < 22; ++i) f[i] = (const float*)d_in[i];
    p.out = (float*)d_out; p.ws = (unsigned char*)d_ws; p.ph_lo = 0; p.ph_hi = N_PHASES;
    void* args[] = {&p};
    hipError_t e = hipLaunchCooperativeKernel((const void*)hybrid_fwd, dim3(grid), dim3(512), args, LDS_BYTES, stream);
    if (e != hipSuccess) fprintf(stderr, "kernel_launch: cooperative launch failed: %s (grid %d)\n", hipGetErrorString(e), grid);
}
```

```cpp
#include <hip/hip_runtime.h>
#include <hip/hip_cooperative_groups.h>
#include <cstdio>
namespace cg = cooperative_groups;

#define P0_REP_A 1
#define P0_REP_B 1
#define P0_REP_C 1
#define LAS __attribute__((address_space(3)))
typedef unsigned short bf16;
typedef short bf16x8 __attribute__((ext_vector_type(8)));
typedef float f32x4 __attribute__((ext_vector_type(4)));
typedef float f32x2 __attribute__((ext_vector_type(2)));
typedef unsigned u32x4 __attribute__((ext_vector_type(4)));
typedef unsigned u32x2 __attribute__((ext_vector_type(2)));

constexpr int NB = 4, SEQ = 8192, DM = 1024, MT = NB * SEQ, DFO = 512, NHEAD = 8, SG = 32, SP = 64, DFF = 4096, NIN = 1536;
constexpr float EPS = 1e-6f;
constexpr int LDS_BYTES = 147456;
constexpr size_t MiB = 1u << 20;
constexpr size_t OFF_RA = 384 * 1024, OFF_RB = 512 * 1024, OFF_BAR = 640 * 1024, BAR_BYTES = 16384;
constexpr size_t OFF_E3 = 1 * MiB, OFF_D1 = 2 * MiB, OFF_TM = 6 * MiB, OFF_MST = 22 * MiB, OFF_W = 30 * MiB;
constexpr size_t W_IN = 0, W_OUT = 3 * MiB, W_1 = 5 * MiB, W_2 = 13 * MiB, W_GLU = 21 * MiB, W_LAYER = 22 * MiB;
constexpr size_t OFF_XB = 76 * MiB, OFF_MF = 140 * MiB, OFF_G = 140 * MiB, OFF_H = 204 * MiB;
constexpr size_t OFF_PQ = 204 * MiB, OFF_AO = 204 * MiB, OFF_UB = 268 * MiB, OFF_T = 332 * MiB, OFF_SLOC = 396 * MiB, OFF_SSS = 460 * MiB, OFF_SSM = 461 * MiB, OFF_SSF = 463 * MiB, WS_END = 465 * MiB;

struct Params {
    const float *x, *w_in, *w_out, *pre_mix_g, *post_mix_g, *pre_mlp_g, *post_mlp_g, *fourier_out_g, *ssm_out_g, *w_fourier,
        *lam_re, *lam_im, *log_dt, *b_re, *b_im, *c_re, *c_im, *d_skip, *w_glu, *b_glu, *w_ff1, *w_ff2;
    float* out; unsigned char* ws;
    int ph_lo, ph_hi;
};

__device__ __forceinline__ unsigned f2bf(float f) { unsigned u = __builtin_bit_cast(unsigned, f); return (u + 0x7fffu + ((u >> 16) & 1u)) >> 16; }
__device__ __forceinline__ unsigned pk2(float lo, float hi) { return f2bf(lo) | (f2bf(hi) << 16); }
__device__ __forceinline__ float bflo(unsigned w) { return __builtin_bit_cast(float, w << 16); }
__device__ __forceinline__ float bfhi(unsigned w) { return __builtin_bit_cast(float, w & 0xffff0000u); }
__device__ __forceinline__ float wave_sum(float v) {
#pragma unroll
    for (int o = 1; o < 64; o <<= 1) v += __shfl_xor(v, o);
    return v;
}
__device__ __forceinline__ float gelu_t(float x) { const float u = 0.7978845608f * (x + 0.044715f * x * x * x); return x / (1.0f + __expf(-2.0f * u)); }
__device__ __forceinline__ float sigm(float v) { return 1.0f / (1.0f + __expf(-v)); }

namespace pg8 {
#define PG8_LAS __attribute__((address_space(3)))
typedef unsigned short bf16_t;
constexpr int BM = 256, BK = 64, HALF = 128, HTB = HALF * BK * 2, STAGE_BYTES = 8 * HTB, NXCD = 8, WGM = 8;
__host__ __device__ __forceinline__ int lds_byte(int r, int c) { const int st = (r >> 4) * 2 + (c >> 5), rr = r & 15, cc = c & 31, ob = rr * 64 + cc * 2; return st * 1024 + (ob ^ (((ob >> 9) & 1) << 5)); }
__host__ __device__ __forceinline__ void stage_rc(int b, int& R, int& C) { const int st = b / 1024, sb = b % 1024, swz = sb ^ (((sb >> 9) & 1) << 5); R = (st >> 1) * 16 + swz / 64; C = (st & 1) * 32 + (swz % 64) / 2; }
__host__ __device__ __forceinline__ int perm32(int rho) { const int n = rho >> 4, i = rho & 15; return 8 * (i >> 2) + 4 * n + (i & 3); }

struct Unit { int pm, pn, z; };
struct Gemm { const bf16_t* A; const bf16_t* Bt; int M, N, K, lda, ldb; size_t sA, sB; int nZ; };

struct Order {
    int nM, nN, nwg, nZ, G, c;
    __device__ void init(int M, int N, int nZ_, int G_, int c_) { nM = M / BM; nN = N / BM; nwg = nM * nN; nZ = nZ_; G = G_; c = c_; }
    __device__ bool next(int i, Unit& u) const {
        const long L = (long)i * G + c; if (L >= (long)nwg * nZ) return false;
        u.z = (int)(L / nwg);
        int wgid = (int)(L % nwg); { const int q = nwg / NXCD, r = nwg % NXCD, xcd = wgid % NXCD, off = wgid / NXCD; wgid = (xcd < r ? xcd * (q + 1) : r * (q + 1) + (xcd - r) * q) + off; }
        const int nig = WGM * nN, gid = wgid / nig, fm = gid * WGM, gsz = (nM - fm) < WGM ? (nM - fm) : WGM;
        u.pm = fm + ((wgid % nig) % gsz); u.pn = (wgid % nig) / gsz; return true;
    }
};

template <class Epi>
__device__ __forceinline__ void gemm_phase(PG8_LAS unsigned char* lds, const Gemm g, const Order& S, const Epi& E) {
    int tid = threadIdx.x; asm volatile("" : "+v"(tid));
    const int wid = __builtin_amdgcn_readfirstlane(tid >> 6), lane = tid & 63, wr = wid >> 2, wc = wid & 3, fr = lane & 15, fq = lane >> 4;
    const int K = g.K, nt = K / BK;
    unsigned voffA[2], voffB[2];
#pragma unroll
    for (int i = 0; i < 2; ++i) { int R, C; stage_rc(tid * 16 + i * 8192, R, C); const int Rb = Epi::PERM ? ((R & ~31) + perm32(R & 31)) : R;
        voffA[i] = (unsigned)(R * g.lda + C) * 2u; voffB[i] = (unsigned)(Rb * g.ldb + C) * 2u; }
    const size_t kstep = (size_t)(BK * 2);
    const size_t hA = (size_t)HALF * g.lda * 2, hB = (size_t)HALF * g.ldb * 2;
    const size_t tA = 2 * hA, tB = 2 * hB;
    const unsigned ldsw = (unsigned)wid * 1024u;
    const int aoff = lds_byte(wr * 64 + fr, fq * 8), boff = lds_byte(wc * 32 + fr, fq * 8);
#define PG8_SA(b, h) (((b) * 2 + (h)) * HTB)
#define PG8_SB(b, h) ((4 + (b) * 2 + (h)) * HTB)
#define PG8_STAGE(bufoff, gbase, voff) do { _Pragma("unroll") for (int _i = 0; _i < 2; ++_i) \
        __builtin_amdgcn_global_load_lds((const unsigned*)((const char*)(gbase) + (voff)[_i]), (PG8_LAS unsigned*)(lds + (bufoff) + ldsw + _i * 8192), 16, 0, 0); } while (0)
#define PG8_LDA(dst, b, h) do { _Pragma("unroll") for (int m = 0; m < 4; ++m) _Pragma("unroll") for (int k = 0; k < 2; ++k) dst[m][k] = *(const PG8_LAS bf16x8*)(lds + PG8_SA(b, h) + aoff + m * 2048 + k * 1024); } while (0)
#define PG8_LDB(dst, b, h) do { _Pragma("unroll") for (int n = 0; n < 2; ++n) _Pragma("unroll") for (int k = 0; k < 2; ++k) dst[n][k] = *(const PG8_LAS bf16x8*)(lds + PG8_SB(b, h) + boff + n * 2048 + k * 1024); } while (0)
#define PG8_MMA(ai, bj, At, Bt) do { __builtin_amdgcn_s_setprio(1); _Pragma("unroll") for (int m = 0; m < 4; ++m) _Pragma("unroll") for (int n = 0; n < 2; ++n) _Pragma("unroll") for (int k = 0; k < 2; ++k) \
        acc[ai][bj][m][n] = __builtin_amdgcn_mfma_f32_16x16x32_bf16(Bt[n][k], At[m][k], acc[ai][bj][m][n], 0, 0, 0); __builtin_amdgcn_s_setprio(0); } while (0)
#define PG8_WAIT_V(n) asm volatile("s_waitcnt vmcnt(" #n ")" ::: "memory")
#define PG8_WAIT_L(n) asm volatile("s_waitcnt lgkmcnt(" #n ")" ::: "memory")
#define PG8_BAR __builtin_amdgcn_s_barrier()
#define PG8_SCHED __builtin_amdgcn_sched_barrier(0)
    Unit cur, nxt; int ui = 0;
    if (!S.next(0, cur)) return;
    f32x4 acc[2][2][4][2];
#pragma unroll
    for (int a = 0; a < 2; ++a)
#pragma unroll
        for (int b = 0; b < 2; ++b)
#pragma unroll
            for (int m = 0; m < 4; ++m)
#pragma unroll
                for (int n = 0; n < 2; ++n) acc[a][b][m][n] = (f32x4){0.f, 0.f, 0.f, 0.f};
    bf16x8 At[4][2], B0[2][2], B1[2][2];
    const char* cA = (const char*)g.A + ((size_t)cur.z * g.sA) * 2 + (size_t)cur.pm * tA; const char* cB = (const char*)g.Bt + ((size_t)cur.z * g.sB) * 2 + (size_t)cur.pn * tB;
    PG8_STAGE(PG8_SB(0, 0), cB, voffB); PG8_STAGE(PG8_SA(0, 0), cA, voffA); PG8_STAGE(PG8_SB(0, 1), cB + hB, voffB); PG8_STAGE(PG8_SA(0, 1), cA + hA, voffA);
    if (wr == 1) PG8_BAR;
    PG8_WAIT_V(4); PG8_BAR;
    PG8_STAGE(PG8_SB(1, 0), cB + kstep, voffB); PG8_STAGE(PG8_SA(1, 0), cA + kstep, voffA); PG8_STAGE(PG8_SB(1, 1), cB + hB + kstep, voffB);
    PG8_WAIT_V(6); PG8_BAR;
    for (;;) {
        const bool has_next = S.next(ui + 1, nxt);
        const char* nA = has_next ? (const char*)g.A + ((size_t)nxt.z * g.sA) * 2 + (size_t)nxt.pm * tA : cA; const char* nB = has_next ? (const char*)g.Bt + ((size_t)nxt.z * g.sB) * 2 + (size_t)nxt.pn * tB : cB;
        for (int t = 0; t < nt; t += 2) {
            const bool last = (t == nt - 2);
            const char* a1 = cA + (size_t)(t + 1) * kstep;
            const char* a2 = last ? nA : cA + (size_t)(t + 2) * kstep; const char* b2 = last ? nB : cB + (size_t)(t + 2) * kstep;
            const char* a3 = a2 + kstep; const char* b3 = b2 + kstep;
            PG8_LDB(B0, 0, 0); PG8_SCHED; PG8_LDA(At, 0, 0); PG8_STAGE(PG8_SA(1, 1), a1 + hA, voffA);
            PG8_WAIT_L(8); PG8_BAR; PG8_WAIT_L(0); PG8_MMA(0, 0, At, B0); PG8_BAR; PG8_SCHED;
            PG8_LDB(B1, 0, 1); PG8_STAGE(PG8_SB(0, 0), b2, voffB);
            PG8_BAR; PG8_WAIT_L(0); PG8_MMA(0, 1, At, B1); PG8_BAR;
            PG8_LDA(At, 0, 1); PG8_STAGE(PG8_SA(0, 0), a2, voffA);
            PG8_BAR; PG8_WAIT_L(0); PG8_MMA(1, 0, At, B0); PG8_BAR; PG8_SCHED;
            PG8_STAGE(PG8_SB(0, 1), b2 + hB, voffB);
            PG8_WAIT_V(6); PG8_BAR; PG8_MMA(1, 1, At, B1); PG8_BAR;
            PG8_LDB(B0, 1, 0); PG8_SCHED; PG8_LDA(At, 1, 0); PG8_STAGE(PG8_SA(0, 1), a2 + hA, voffA);
            PG8_WAIT_L(8); PG8_BAR; PG8_WAIT_L(0); PG8_MMA(0, 0, At, B0); PG8_BAR; PG8_SCHED;
            PG8_LDB(B1, 1, 1); PG8_STAGE(PG8_SB(1, 0), b3, voffB);
            PG8_BAR; PG8_WAIT_L(0); PG8_MMA(0, 1, At, B1); PG8_BAR;
            PG8_LDA(At, 1, 1); PG8_STAGE(PG8_SA(1, 0), a3, voffA);
            PG8_BAR; PG8_WAIT_L(0); PG8_MMA(1, 0, At, B0); PG8_BAR; PG8_SCHED;
            PG8_STAGE(PG8_SB(1, 1), b3 + hB, voffB);
            PG8_WAIT_V(6); PG8_BAR; PG8_MMA(1, 1, At, B1); PG8_BAR;
        }
        E(acc, cur, wr, wc, fr, fq);
        if (!has_next) break;
#pragma unroll
        for (int a = 0; a < 2; ++a)
#pragma unroll
            for (int b = 0; b < 2; ++b)
#pragma unroll
                for (int m = 0; m < 4; ++m)
#pragma unroll
                    for (int n = 0; n < 2; ++n) acc[a][b][m][n] = (f32x4){0.f, 0.f, 0.f, 0.f};
        cur = nxt; cA = nA; cB = nB; ++ui;
    }
    PG8_WAIT_V(0);
    if (wr == 0) PG8_BAR;
    PG8_BAR;
#undef PG8_SA
#undef PG8_SB
#undef PG8_STAGE
#undef PG8_LDA
#undef PG8_LDB
#undef PG8_MMA
#undef PG8_WAIT_V
#undef PG8_WAIT_L
#undef PG8_BAR
#undef PG8_SCHED
}
}

typedef const f32x4 (&AccRef)[2][2][4][2];
__device__ __forceinline__ u32x4 pack8(f32x4 a, f32x4 b) { u32x4 w; w.x = pk2(a[0], a[1]); w.y = pk2(a[2], a[3]); w.z = pk2(b[0], b[1]); w.w = pk2(b[2], b[3]); return w; }

struct EpiIn {
    static constexpr bool PERM = true;
    bf16* PQ; bf16* UB; const float* r;
    __device__ __forceinline__ void operator()(AccRef acc, const pg8::Unit& u, int wr, int wc, int fr, int fq) const {
#pragma unroll
        for (int ai = 0; ai < 2; ++ai)
#pragma unroll
            for (int m = 0; m < 4; ++m) {
                const int row = u.pm * 256 + ai * 128 + wr * 64 + m * 16 + fr; const float rs = r[row];
#pragma unroll
                for (int bj = 0; bj < 2; ++bj) {
                    const int col0 = u.pn * 256 + bj * 128 + wc * 32 + 8 * fq;
                    const u32x4 w = pack8(acc[ai][bj][m][0] * rs, acc[ai][bj][m][1] * rs);
                    if (col0 < 1024) *(u32x4*)(PQ + (size_t)row * 1024 + col0) = w;
                    else { const int c2 = col0 - 1024, gg = c2 >> 4, h0 = c2 & 15; *(u32x4*)(UB + ((size_t)(gg * 2048 + (row >> 4)) * 512 + (row & 15) * 16 + h0)) = w; }
                }
            }
    }
};
struct EpiSloc {
    static constexpr bool PERM = false;
    float* S;
    __device__ __forceinline__ void operator()(AccRef acc, const pg8::Unit& u, int wr, int wc, int fr, int fq) const {
#pragma unroll
        for (int ai = 0; ai < 2; ++ai)
#pragma unroll
            for (int m = 0; m < 4; ++m) {
                const int row = u.pm * 256 + ai * 128 + wr * 64 + m * 16 + fr;
                float* rp = S + ((size_t)u.z * 2048 + row) * 256 + wc * 32 + 4 * fq;
#pragma unroll
                for (int bj = 0; bj < 2; ++bj)
#pragma unroll
                    for (int n = 0; n < 2; ++n) *(f32x4*)(rp + bj * 128 + n * 16) = acc[ai][bj][m][n];
            }
    }
};
struct EpiSsmOut {
    static constexpr bool PERM = true;
    bf16* G;
    __device__ __forceinline__ void operator()(AccRef acc, const pg8::Unit& u, int wr, int wc, int fr, int fq) const {
#pragma unroll
        for (int ai = 0; ai < 2; ++ai)
#pragma unroll
            for (int m = 0; m < 4; ++m) {
                const int row = u.pm * 256 + ai * 128 + wr * 64 + m * 16 + fr;
#pragma unroll
                for (int bj = 0; bj < 2; ++bj) {
                    const int col0 = bj * 128 + wc * 32 + 8 * fq, t = col0 >> 4, i0 = col0 & 15;
                    f32x4 a = acc[ai][bj][m][0], b = acc[ai][bj][m][1];
#pragma unroll
                    for (int j = 0; j < 4; ++j) { a[j] = gelu_t(a[j]); b[j] = gelu_t(b[j]); }
                    *(u32x4*)(G + ((size_t)row * 16 + t) * 512 + u.z * 16 + i0) = pack8(a, b);
                }
            }
    }
};
struct EpiGlu {
    static constexpr bool PERM = true;
    const bf16* G; const float* bias; bf16* AO; float* ss;
    __device__ __forceinline__ void operator()(AccRef acc, const pg8::Unit& u, int wr, int wc, int fr, int fq) const {
#pragma unroll
        for (int ai = 0; ai < 2; ++ai)
#pragma unroll
            for (int m = 0; m < 4; ++m) {
                const int row = u.pm * 256 + ai * 128 + wr * 64 + m * 16 + fr; float s2 = 0.f;
#pragma unroll
                for (int bj = 0; bj < 2; ++bj) {
                    const int col0 = u.pn * 256 + bj * 128 + wc * 32 + 8 * fq;
                    const u32x4 gv = *(const u32x4*)(G + (size_t)row * 512 + col0);
                    const f32x4 b0 = *(const f32x4*)(bias + col0), b1 = *(const f32x4*)(bias + col0 + 4);
                    f32x4 a = acc[ai][bj][m][0] + b0, b = acc[ai][bj][m][1] + b1;
                    a[0] = bflo(gv.x) * sigm(a[0]); a[1] = bfhi(gv.x) * sigm(a[1]); a[2] = bflo(gv.y) * sigm(a[2]); a[3] = bfhi(gv.y) * sigm(a[3]);
                    b[0] = bflo(gv.z) * sigm(b[0]); b[1] = bfhi(gv.z) * sigm(b[1]); b[2] = bflo(gv.w) * sigm(b[2]); b[3] = bfhi(gv.w) * sigm(b[3]);
#pragma unroll
                    for (int j = 0; j < 4; ++j) s2 += a[j] * a[j] + b[j] * b[j];
                    *(u32x4*)(AO + (size_t)row * 1024 + 512 + col0) = pack8(a, b);
                }
                s2 += __shfl_xor(s2, 16); s2 += __shfl_xor(s2, 32);
                if (fq == 0) ss[row * 8 + u.pn * 4 + wc] = s2;
            }
    }
};
struct EpiOutSS {
    static constexpr bool PERM = true;
    bf16* O; float* ss;
    __device__ __forceinline__ void operator()(AccRef acc, const pg8::Unit& u, int wr, int wc, int fr, int fq) const {
#pragma unroll
        for (int ai = 0; ai < 2; ++ai)
#pragma unroll
            for (int m = 0; m < 4; ++m) {
                const int row = u.pm * 256 + ai * 128 + wr * 64 + m * 16 + fr; float s2 = 0.f;
#pragma unroll
                for (int bj = 0; bj < 2; ++bj) {
                    const int col0 = u.pn * 256 + bj * 128 + wc * 32 + 8 * fq;
                    const f32x4 a = acc[ai][bj][m][0], b = acc[ai][bj][m][1];
#pragma unroll
                    for (int j = 0; j < 4; ++j) s2 += a[j] * a[j] + b[j] * b[j];
                    *(u32x4*)(O + (size_t)row * 1024 + col0) = pack8(a, b);
                }
                s2 += __shfl_xor(s2, 16); s2 += __shfl_xor(s2, 32);
                if (fq == 0) ss[row * 16 + u.pn * 4 + wc] = s2;
            }
    }
};
struct EpiFF1 {
    static constexpr bool PERM = true;
    bf16* H; const float* r;
    __device__ __forceinline__ void operator()(AccRef acc, const pg8::Unit& u, int wr, int wc, int fr, int fq) const {
#pragma unroll
        for (int ai = 0; ai < 2; ++ai)
#pragma unroll
            for (int m = 0; m < 4; ++m) {
                const int row = u.pm * 256 + ai * 128 + wr * 64 + m * 16 + fr; const float rs = r[row];
#pragma unroll
                for (int bj = 0; bj < 2; ++bj) {
                    const int col0 = u.pn * 256 + bj * 128 + wc * 32 + 8 * fq;
                    f32x4 a = acc[ai][bj][m][0] * rs, b = acc[ai][bj][m][1] * rs;
#pragma unroll
                    for (int j = 0; j < 4; ++j) { a[j] = fmaxf(a[j], 0.f); a[j] *= a[j]; b[j] = fmaxf(b[j], 0.f); b[j] *= b[j]; }
                    *(u32x4*)(H + (size_t)row * 4096 + col0) = pack8(a, b);
                }
            }
    }
};

__device__ __forceinline__ void transpose_item(const float* W, int ldw, bf16* WT, int ldt, const float* sc_lo, const float* sc_hi, int split,
                                               LAS float* scr, int item, int nblk, int lane) {
    const int kb = item / nblk, nb = item % nblk, k0 = 64 * kb, n0 = 32 * nb;
#pragma unroll 16
    for (int i = 0; i < 32; ++i) { const int kk = 2 * i + (lane >> 5), k = k0 + kk;
        float s = 1.f; if (sc_lo) s = (k < split) ? sc_lo[k] : sc_hi[k - split];
        scr[kk * 33 + (lane & 31)] = W[(size_t)k * ldw + n0 + (lane & 31)] * s; }
    asm volatile("s_waitcnt lgkmcnt(0)" ::: "memory");
    const int c = lane & 7;
#pragma unroll
    for (int j = 0; j < 4; ++j) { const int n = (lane >> 3) + 8 * j; const LAS float* s = scr + (8 * c) * 33 + n;
        u32x4 o; o.x = pk2(s[0 * 33], s[1 * 33]); o.y = pk2(s[2 * 33], s[3 * 33]); o.z = pk2(s[4 * 33], s[5 * 33]); o.w = pk2(s[6 * 33], s[7 * 33]);
        *(u32x4*)(WT + (size_t)(n0 + n) * ldt + k0 + 8 * c) = o; }
    asm volatile("s_waitcnt lgkmcnt(0)" ::: "memory");
}

__device__ __forceinline__ void fold_item(const Params& p, int item, LAS unsigned char* lds) {
    int tid = threadIdx.x; asm volatile("" : "+v"(tid)); const int ly = item >> 7, h = (item >> 4) & 7, kb = item & 15, k0 = kb * 64;
    LAS float* Wt = (LAS float*)lds;
    LAS float* Wf = Wt + 64 * 65;
    LAS float* TC = Wf + 64 * 65;
    LAS float* TS = TC + 64 * 65;
    LAS float* cs = TS + 64 * 65;
    __syncthreads();
    const float* win = p.w_in + (size_t)ly * 1024 * 1024; const float* wf = p.w_fourier + ((size_t)ly * 8 + h) * 4096; const float* g = p.pre_mix_g + ly * 1024;
    for (int i = tid; i < 4096; i += 512) { const int k = i >> 6, c = i & 63; Wt[k * 65 + c] = win[(size_t)(k0 + k) * 1024 + 64 * h + c] * g[k0 + k]; Wf[k * 65 + c] = wf[i]; }
    if (tid < 64) { float s, c; sincospif((float)tid / 32.0f, &s, &c); cs[tid] = c; cs[64 + tid] = s; }
    __syncthreads();
#pragma nounroll
    for (int i = tid; i < 4096; i += 512) { const int k = i >> 6, d = i & 63; float ac = 0.f, as = 0.f;
#pragma unroll 4
        for (int c = 0; c < 64; ++c) { const float w = Wt[k * 65 + c]; const int ph = (c * d) & 63; ac += w * cs[ph]; as += w * cs[64 + ph]; }
        TC[k * 65 + d] = ac; TS[k * 65 + d] = as; }
    __syncthreads();
    const float scale = 1.0f / 724.0773439350247f;
    bf16* WT = (bf16*)(p.ws + OFF_W + (size_t)ly * W_LAYER + W_IN);
    { const int k = tid & 63, eg = tid >> 6;
#pragma nounroll
      for (int j = 0; j < 8; ++j) { const int e = eg * 8 + j; float ap = 0.f, aq = 0.f;
#pragma unroll 4
          for (int d = 0; d < 64; ++d) { const float w = Wf[d * 65 + e]; ap += TC[k * 65 + d] * w; aq += TS[k * 65 + d] * w; }
          WT[(size_t)(64 * h + e) * 1024 + k0 + k] = (bf16)f2bf(ap * scale);
          WT[(size_t)(512 + 64 * h + e) * 1024 + k0 + k] = (bf16)f2bf(-aq * scale); } }
}

__device__ __forceinline__ void ssm_mat_item(const Params& p, int item, LAS unsigned char* lds) {
    int tid = threadIdx.x; asm volatile("" : "+v"(tid)); const int ly = item >> 7, g = (item >> 2) & 31, qt = item & 3;
    LAS float* pwr = (LAS float*)lds;
    LAS float* pwi = pwr + 2 * 17 * 64;
    LAS float* bbr = pwi + 2 * 17 * 64;
    LAS float* bbi = bbr + 2 * 64 * 16;
    LAS float* ccr = bbi + 2 * 64 * 16;
    LAS float* cci = ccr + 2 * 16 * 64;
    LAS float* Gt = cci + 2 * 16 * 64;
    __syncthreads();
    if (tid < 128) { const int k = tid >> 6, pp = tid & 63; const int idx = (ly * 2 + k) * 32 + g;
        const float dt = expf(p.log_dt[idx]); const float lr = p.lam_re[idx * 64 + pp], li = p.lam_im[idx * 64 + pp];
        for (int tau = 0; tau <= 16; ++tau) { const float e = expf(lr * dt * tau); float s, c; sincosf(li * dt * tau, &s, &c); pwr[(k * 17 + tau) * 64 + pp] = e * c; pwi[(k * 17 + tau) * 64 + pp] = e * s; }
        const float lbr = pwr[(k * 17 + 1) * 64 + pp] - 1.0f, lbi = pwi[(k * 17 + 1) * 64 + pp];
        const float den = 1.0f / (lr * lr + li * li); const float cr = (lbr * lr + lbi * li) * den, ci = (lbi * lr - lbr * li) * den;
        for (int h = 0; h < 16; ++h) { const float br = p.b_re[((size_t)idx * 64 + pp) * 16 + h], bi = p.b_im[((size_t)idx * 64 + pp) * 16 + h];
            bbr[(k * 64 + pp) * 16 + h] = cr * br - ci * bi; bbi[(k * 64 + pp) * 16 + h] = cr * bi + ci * br; } }
    for (int i = tid; i < 2048; i += 512) { const int k = i >> 10, r = i & 1023; const int idx = (ly * 2 + k) * 32 + g; ccr[i] = p.c_re[(size_t)idx * 1024 + r]; cci[i] = p.c_im[(size_t)idx * 1024 + r]; }
    __syncthreads();
    { const int k = tid >> 8, i = (tid >> 4) & 15, h = tid & 15; float a[16];
#pragma unroll
      for (int tau = 0; tau < 16; ++tau) a[tau] = 0.f;
#pragma nounroll
      for (int pp = 0; pp < 64; ++pp) { const float c_r = ccr[(k * 16 + i) * 64 + pp], c_i = cci[(k * 16 + i) * 64 + pp], b_r = bbr[(k * 64 + pp) * 16 + h], b_i = bbi[(k * 64 + pp) * 16 + h];
          const float xr = c_r * b_r - c_i * b_i, xi = c_r * b_i + c_i * b_r;
#pragma unroll
          for (int tau = 0; tau < 16; ++tau) a[tau] += xr * pwr[(k * 17 + tau) * 64 + pp] - xi * pwi[(k * 17 + tau) * 64 + pp]; }
#pragma unroll
      for (int tau = 0; tau < 16; ++tau) Gt[((k * 16 + tau) * 16 + i) * 16 + h] = a[tau]; }
    __syncthreads();
    bf16* TM = (bf16*)(p.ws + OFF_TM) + (size_t)(ly * 32 + g) * 256 * 512; bf16* MS = (bf16*)(p.ws + OFF_MST) + (size_t)(ly * 32 + g) * 256 * 256;
    const float* dsk = p.d_skip + (ly * 32 + g) * 16;
    for (int o = qt * 64 * 512 + tid; o < (qt + 1) * 64 * 512; o += 512) { const int r = o >> 9, col = o & 511, t = r >> 4, i = r & 15; float v;
        if (col < 256) { const int j = col >> 4, h = col & 15; v = 0.f;
            if (j <= t) v += Gt[((0 * 16 + (t - j)) * 16 + i) * 16 + h];
            if (j >= t) v += Gt[((1 * 16 + (j - t)) * 16 + i) * 16 + h];
            if (j == t && h == i) v += dsk[i]; }
        else { const int k = (col - 256) >> 7, q = (col - 256) & 127, pp = q >> 1, part = q & 1; const int tau = k == 0 ? (t + 1) : (16 - t);
            const float c_r = ccr[(k * 16 + i) * 64 + pp], c_i = cci[(k * 16 + i) * 64 + pp], l_r = pwr[(k * 17 + tau) * 64 + pp], l_i = pwi[(k * 17 + tau) * 64 + pp];
            v = part == 0 ? (c_r * l_r - c_i * l_i) : -(c_r * l_i + c_i * l_r); }
        TM[o] = (bf16)f2bf(v); }
    for (int o = qt * 64 * 256 + tid; o < (qt + 1) * 64 * 256; o += 512) { const int r = o >> 8, col = o & 255, k = r >> 7, q = r & 127, pp = q >> 1, part = q & 1, j = col >> 4, h = col & 15;
        const int tau = k == 0 ? (15 - j) : j;
        const float l_r = pwr[(k * 17 + tau) * 64 + pp], l_i = pwi[(k * 17 + tau) * 64 + pp], b_r = bbr[(k * 64 + pp) * 16 + h], b_i = bbi[(k * 64 + pp) * 16 + h];
        const float v = part == 0 ? (l_r * b_r - l_i * b_i) : (l_r * b_i + l_i * b_r);
        MS[o] = (bf16)f2bf(v); }
}

__device__ __forceinline__ void p0_prologue(const Params& p, LAS unsigned char* lds, int G, int bid) {
    int tid = threadIdx.x; asm volatile("" : "+v"(tid));
    const int lane = tid & 63, wave = __builtin_amdgcn_readfirstlane(tid >> 6);
    for (int rp = 0; rp < P0_REP_A; ++rp)
    for (int it = bid; it < 512; it += G) { if (it < 256) fold_item(p, it, lds); else ssm_mat_item(p, it - 256, lds); }
    __syncthreads();
    {
        LAS float* scr = (LAS float*)(lds + wave * 8448);
        const int gw = bid * 8 + wave, NGW = G * 8;
        constexpr int I_IN = 16 * 16, I_OUT = 16 * 32, I_1 = 16 * 128, I_2 = 64 * 32, I_G = 8 * 16, I_L = I_IN + I_OUT + I_1 + I_2 + I_G;
        for (int rp = 0; rp < P0_REP_B; ++rp)
        for (int it = gw; it < 2 * I_L; it += NGW) {
            const int ly = it / I_L; int r = it % I_L; unsigned char* wb = p.ws + OFF_W + (size_t)ly * W_LAYER;
            if (r < I_IN) { transpose_item(p.w_in + (size_t)ly * 1024 * 1024 + 512, 1024, (bf16*)(wb + W_IN) + (size_t)1024 * 1024, 1024, p.pre_mix_g + ly * 1024, nullptr, 1 << 30, scr, r, 16, lane); continue; } r -= I_IN;
            if (r < I_OUT) { transpose_item(p.w_out + (size_t)ly * 1024 * 1024, 1024, (bf16*)(wb + W_OUT), 1024, p.fourier_out_g + ly * 512, p.ssm_out_g + ly * 512, 512, scr, r, 32, lane); continue; } r -= I_OUT;
            if (r < I_1) { transpose_item(p.w_ff1 + (size_t)ly * 1024 * 4096, 4096, (bf16*)(wb + W_1), 1024, p.pre_mlp_g + ly * 1024, nullptr, 1 << 30, scr, r, 128, lane); continue; } r -= I_1;
            if (r < I_2) { transpose_item(p.w_ff2 + (size_t)ly * 4096 * 1024, 1024, (bf16*)(wb + W_2), 4096, nullptr, nullptr, 0, scr, r, 32, lane); continue; } r -= I_2;
            transpose_item(p.w_glu + (size_t)ly * 512 * 512, 512, (bf16*)(wb + W_GLU), 512, nullptr, nullptr, 0, scr, r, 16, lane);
        }
        bf16* XB = (bf16*)(p.ws + OFF_XB); float* rA = (float*)(p.ws + OFF_RA);
        for (int rp = 0; rp < P0_REP_C; ++rp)
        for (int row0 = gw; row0 < MT; row0 += 4 * NGW) {
            f32x4 v[4][4];
#pragma unroll
            for (int rr = 0; rr < 4; ++rr) { const f32x4* xr = (const f32x4*)(p.x + (size_t)(row0 + rr * NGW) * 1024) + lane;
#pragma unroll
                for (int j = 0; j < 4; ++j) v[rr][j] = xr[64 * j]; }
#pragma unroll
            for (int rr = 0; rr < 4; ++rr) { const int row = row0 + rr * NGW; float s2 = 0.f;
                u32x2* o = (u32x2*)(XB + (size_t)row * 1024) + lane;
#pragma unroll
                for (int j = 0; j < 4; ++j) { const f32x4 t = v[rr][j]; s2 += t[0] * t[0] + t[1] * t[1] + t[2] * t[2] + t[3] * t[3]; u32x2 w; w.x = pk2(t[0], t[1]); w.y = pk2(t[2], t[3]); o[64 * j] = w; }
                s2 = wave_sum(s2);
                if (lane == 0) rA[row] = rsqrtf(s2 * (1.0f / 1024.0f) + EPS); }
        }
    }
    {
        bf16* D1 = (bf16*)(p.ws + OFF_D1); bf16* E3 = (bf16*)(p.ws + OFF_E3);
        const int gt = bid * 512 + tid, NT = G * 512;
        for (int idx = gt; idx < 64 * 2 * 128 * 128; idx += NT) { const int n2 = idx >> 15, sel = (idx >> 14) & 1, k1 = (idx >> 7) & 127, n1 = idx & 127;
            const int ph = (k1 * (64 * n1 + n2)) & 8191; float s, c; sincospif((float)ph * (1.0f / 4096.0f), &s, &c); D1[idx] = (bf16)f2bf(sel ? s : c); }
        for (int idx = gt; idx < 64 * 128; idx += NT) { const int k2 = idx >> 7, col = idx & 127, part = col >> 6, n2 = col & 63;
            const int ph = (n2 * k2) & 63; float s, c; sincospif((float)ph * (1.0f / 32.0f), &s, &c); E3[idx] = (bf16)f2bf(part ? s : c); }
    }
}

typedef short v4s16 __attribute__((ext_vector_type(4)));
__device__ __forceinline__ bf16x8 negbf(bf16x8 v) { u32x4 t = __builtin_bit_cast(u32x4, v); t = t ^ 0x80008000u; return __builtin_bit_cast(bf16x8, t); }
__device__ __forceinline__ bf16x8 tr_frag(const LAS unsigned char* a, int hs) {
    const v4s16 lo = __builtin_amdgcn_ds_read_tr16_b64_v4i16((LAS v4s16*)a), hi = __builtin_amdgcn_ds_read_tr16_b64_v4i16((LAS v4s16*)(a + hs));
    return __builtin_shufflevector(lo, hi, 0, 1, 2, 3, 4, 5, 6, 7);
}
constexpr int F1_P = 264, F1_CS = 256 * F1_P;
__device__ __forceinline__ void fft1_phase(const bf16* PQ, const bf16* D1, bf16* T, LAS unsigned char* lds, int G, int bid) {
    int tid = threadIdx.x; asm volatile("" : "+v"(tid));
    const int lane = tid & 63, wave = __builtin_amdgcn_readfirstlane(tid >> 6), wm = wave & 3, wn = wave >> 2, fr = lane & 15, fq = lane >> 4, tq = fr >> 2, tp = fr & 3;
    for (int pr = bid; pr < 256; pr += G) {
        const int n2 = pr & 63, cb = pr >> 6;
        __syncthreads();
        {
            const bf16* src = D1 + (size_t)n2 * 2 * 128 * 128;
#pragma unroll
            for (int j = 0; j < 8; ++j) { const int q = tid + 512 * j, sel = q >> 11, row = (q >> 4) & 127, cc = q & 15;
                *(LAS u32x4*)(lds + F1_CS + sel * 34816 + row * 272 + cc * 16) = *(const u32x4*)(src + sel * 16384 + row * 128 + 8 * cc); }
        }
        for (int b = 0; b < NB; ++b) {
            __syncthreads();
#pragma unroll
            for (int j = 0; j < 8; ++j) { const int q = tid + 512 * j, row = q >> 4, cc = q & 15, part = row >> 7, n1 = row & 127;
                const u32x4 v = *(const u32x4*)(PQ + ((size_t)(b * SEQ + 64 * n1 + n2)) * 1024 + part * 512 + cb * 128 + 8 * cc);
                LAS u32x2* d = (LAS u32x2*)(lds + row * F1_P + cc * 16); d[0] = (u32x2){v.x, v.y}; d[1] = (u32x2){v.z, v.w}; }
            __syncthreads();
            f32x4 Ar[2][4], Ai[2][4];
#pragma unroll
            for (int mb = 0; mb < 2; ++mb)
#pragma unroll
                for (int nb = 0; nb < 4; ++nb) { Ar[mb][nb] = (f32x4){0.f, 0.f, 0.f, 0.f}; Ai[mb][nb] = (f32x4){0.f, 0.f, 0.f, 0.f}; }
#pragma nounroll
            for (int ks = 0; ks < 8; ++ks) {
                bf16x8 Bf[4];
#pragma unroll
                for (int nb = 0; nb < 4; ++nb) Bf[nb] = tr_frag(lds + (32 * ks + 8 * fq + tq) * F1_P + (64 * wn + 16 * tp + 4 * nb) * 2, 4 * F1_P);
                bf16x8 Cf[2], Sf[2];
#pragma unroll
                for (int mb = 0; mb < 2; ++mb) { const int off = F1_CS + (32 * wm + 16 * mb + fr) * 272 + (32 * (ks & 3) + 8 * fq) * 2; Cf[mb] = *(const LAS bf16x8*)(lds + off); Sf[mb] = *(const LAS bf16x8*)(lds + off + 34816); }
#pragma unroll
                for (int mb = 0; mb < 2; ++mb)
#pragma unroll
                    for (int nb = 0; nb < 4; ++nb) {
                        if (ks < 4) { Ar[mb][nb] = __builtin_amdgcn_mfma_f32_16x16x32_bf16(Bf[nb], Cf[mb], Ar[mb][nb], 0, 0, 0);
                                      Ai[mb][nb] = __builtin_amdgcn_mfma_f32_16x16x32_bf16(Bf[nb], negbf(Sf[mb]), Ai[mb][nb], 0, 0, 0); }
                        else        { Ar[mb][nb] = __builtin_amdgcn_mfma_f32_16x16x32_bf16(Bf[nb], Sf[mb], Ar[mb][nb], 0, 0, 0);
                                      Ai[mb][nb] = __builtin_amdgcn_mfma_f32_16x16x32_bf16(Bf[nb], Cf[mb], Ai[mb][nb], 0, 0, 0); }
                    }
            }
#pragma unroll
            for (int mb = 0; mb < 2; ++mb) { const int k1 = 32 * wm + 16 * mb + fr, c = cb * 128 + 64 * wn + 16 * fq;
                bf16* t0 = T + ((((size_t)(b * 128 + k1) * 2 + 0) * 64 + n2) * 512 + c); bf16* t1 = t0 + 64 * 512;
                *(u32x4*)t0 = pack8(Ar[mb][0], Ar[mb][1]); *(u32x4*)(t0 + 8) = pack8(Ar[mb][2], Ar[mb][3]);
                *(u32x4*)t1 = pack8(Ai[mb][0], Ai[mb][1]); *(u32x4*)(t1 + 8) = pack8(Ai[mb][2], Ai[mb][3]); }
        }
    }
    __syncthreads();
}

constexpr int F3_P = 1032;
__device__ __forceinline__ void fft3_phase(const bf16* T, const bf16* E3, bf16* AO, LAS unsigned char* lds, int G, int bid) {
    int tid = threadIdx.x; asm volatile("" : "+v"(tid));
    const int lane = tid & 63, wave = __builtin_amdgcn_readfirstlane(tid >> 6), fr = lane & 15, fq = lane >> 4, tq = fr >> 2, tp = fr & 3;
    LAS float* red = (LAS float*)(lds + 128 * F3_P);
    for (int unit = bid; unit < 512; unit += G) {
        const int b = unit >> 7, k1 = unit & 127;
        __syncthreads();
        const bf16* src = T + (size_t)unit * 65536;
#pragma unroll
        for (int j = 0; j < 16; ++j) { const int q = tid + 512 * j, row = q >> 6, cc = q & 63;
            const u32x4 v = *(const u32x4*)(src + row * 512 + cc * 8);
            LAS u32x2* d = (LAS u32x2*)(lds + row * F3_P + cc * 16); d[0] = (u32x2){v.x, v.y}; d[1] = (u32x2){v.z, v.w}; }
        __syncthreads();
        f32x4 acc[4][4];
#pragma unroll
        for (int mb = 0; mb < 4; ++mb)
#pragma unroll
            for (int nb = 0; nb < 4; ++nb) acc[mb][nb] = (f32x4){0.f, 0.f, 0.f, 0.f};
        bf16x8 Ef[4];
#pragma unroll
        for (int mb = 0; mb < 4; ++mb) Ef[mb] = *(const bf16x8*)(E3 + (16 * mb + fr) * 128 + 8 * fq);
#pragma nounroll
        for (int ks = 0; ks < 4; ++ks) {
            bf16x8 Bf[4], En[4];
            const int kn = ks < 3 ? ks + 1 : 3;
#pragma unroll
            for (int mb = 0; mb < 4; ++mb) En[mb] = *(const bf16x8*)(E3 + (16 * mb + fr) * 128 + 32 * kn + 8 * fq);
#pragma unroll
            for (int nb = 0; nb < 4; ++nb) Bf[nb] = tr_frag(lds + (32 * ks + 8 * fq + tq) * F3_P + (64 * wave + 16 * tp + 4 * nb) * 2, 4 * F3_P);
#pragma unroll
            for (int mb = 0; mb < 4; ++mb)
#pragma unroll
                for (int nb = 0; nb < 4; ++nb) acc[mb][nb] = __builtin_amdgcn_mfma_f32_16x16x32_bf16(Bf[nb], Ef[mb], acc[mb][nb], 0, 0, 0);
#pragma unroll
            for (int mb = 0; mb < 4; ++mb) Ef[mb] = En[mb];
        }
#pragma unroll
        for (int mb = 0; mb < 4; ++mb) { float s = 0.f;
#pragma unroll
            for (int nb = 0; nb < 4; ++nb)
#pragma unroll
                for (int j = 0; j < 4; ++j) s += acc[mb][nb][j] * acc[mb][nb][j];
            s += __shfl_xor(s, 16); s += __shfl_xor(s, 32);
            if (fq == 0) red[wave * 64 + 16 * mb + fr] = s; }
        __syncthreads();
#pragma unroll
        for (int mb = 0; mb < 4; ++mb) { float tot = 0.f;
#pragma unroll
            for (int w = 0; w < 8; ++w) tot += red[w * 64 + 16 * mb + fr];
            const float rinv = rsqrtf(tot * (1.0f / 512.0f) + EPS);
            const size_t token = (size_t)b * SEQ + k1 + 128 * (16 * mb + fr);
            bf16* o = AO + token * 1024 + 64 * wave + 16 * fq;
            *(u32x4*)o = pack8(acc[mb][0] * rinv, acc[mb][1] * rinv); *(u32x4*)(o + 8) = pack8(acc[mb][2] * rinv, acc[mb][3] * rinv); }
    }
    __syncthreads();
}

__device__ __forceinline__ void carry_phase(const Params& p, int ly, const float* Sloc, bf16* UB, LAS unsigned char* lds, int G, int bid) {
    int tid = threadIdx.x; asm volatile("" : "+v"(tid));
    const int lane = tid & 63, wave = __builtin_amdgcn_readfirstlane(tid >> 6);
    LAS f32x2* ex = (LAS f32x2*)lds;
    for (int w = bid; w < 256; w += G) {
        const int dir = w & 1, g = (w >> 1) & 31, b = w >> 6, pp = lane; const int idx = (ly * 2 + dir) * 32 + g;
        const float dt = expf(p.log_dt[idx]); const float lr = p.lam_re[idx * 64 + pp] * dt * 16.0f, li = p.lam_im[idx * 64 + pp] * dt * 16.0f;
        const float e = expf(lr); float sn, cs; sincosf(li, &sn, &cs); const float l_r = e * cs, l_i = e * sn;
        float Lr = l_r, Li = l_i;
#pragma unroll
        for (int k = 0; k < 6; ++k) { const float nr = Lr * Lr - Li * Li, ni = 2.0f * Lr * Li; Lr = nr; Li = ni; }
        const float* src = Sloc + ((size_t)(g * 2048 + b * 512)) * 256 + dir * 128 + 2 * pp;
        bf16* dst = UB + ((size_t)(g * 2048 + b * 512)) * 512 + 256 + dir * 128 + 2 * pp;
        const int ss0 = dir == 0 ? wave * 64 : 511 - wave * 64; const long stp = dir == 0 ? 256 : -256;
        float cr = 0.f, ci = 0.f;
        { const float* ptr = src + (size_t)ss0 * 256;
#pragma nounroll
          for (int hb = 0; hb < 2; ++hb) {
            f32x2 v[32];
#pragma unroll
            for (int j = 0; j < 32; ++j) { v[j] = *(const f32x2*)ptr; ptr += stp; }
#pragma unroll
            for (int j = 0; j < 32; ++j) { const float nr = l_r * cr - l_i * ci + v[j][0], ni = l_r * ci + l_i * cr + v[j][1]; cr = nr; ci = ni; }
          } }
        __syncthreads();
        ex[wave * 64 + lane] = (f32x2){cr, ci};
        __syncthreads();
        cr = 0.f; ci = 0.f;
        for (int u = 0; u < wave; ++u) { const f32x2 eu = ex[u * 64 + lane]; const float nr = Lr * cr - Li * ci + eu[0], ni = Lr * ci + Li * cr + eu[1]; cr = nr; ci = ni; }
        { const float* ptr = src + (size_t)ss0 * 256; bf16* dp = dst + (size_t)ss0 * 512;
#pragma nounroll
          for (int hb = 0; hb < 2; ++hb) {
            f32x2 v[32];
#pragma unroll
            for (int j = 0; j < 32; ++j) { v[j] = *(const f32x2*)ptr; ptr += stp; }
#pragma unroll
            for (int j = 0; j < 32; ++j) {
                *(unsigned*)dp = pk2(cr, ci); dp += 2 * stp;
                const float nr = l_r * cr - l_i * ci + v[j][0], ni = l_r * ci + l_i * cr + v[j][1]; cr = nr; ci = ni; }
          } }
    }
    __syncthreads();
}

__device__ __forceinline__ void norm_phase(float* out, const bf16* MF, const float* ss, const float* gain, bf16* XB, float* rnext, bool last, int G, int bid) {
    int tid = threadIdx.x; asm volatile("" : "+v"(tid));
    const int lane = tid & 63, wave = __builtin_amdgcn_readfirstlane(tid >> 6);
    const int gw = bid * 8 + wave, NGW = G * 8;
    const f32x4* gr = (const f32x4*)gain + lane;
    const f32x4 g0 = gr[0], g1 = gr[64], g2 = gr[128], g3 = gr[192];
    for (int row0 = gw; row0 < MT; row0 += 2 * NGW) {
        u32x2 xv[2][4], mv[2][4]; float tot[2];
#pragma unroll
        for (int rr = 0; rr < 2; ++rr) { const int row = row0 + rr * NGW;
            const u32x2* xr = (const u32x2*)(XB + (size_t)row * 1024) + lane; const u32x2* mr = (const u32x2*)(MF + (size_t)row * 1024) + lane;
#pragma unroll
            for (int j = 0; j < 4; ++j) { xv[rr][j] = xr[64 * j]; mv[rr][j] = mr[64 * j]; }
            const f32x4* sp = (const f32x4*)(ss + (size_t)row * 16); const f32x4 s0 = sp[0], s1 = sp[1], s2 = sp[2], s3 = sp[3];
            tot[rr] = ((((s0[0] + s0[1]) + s0[2]) + s0[3]) + (((s1[0] + s1[1]) + s1[2]) + s1[3])) + ((((s2[0] + s2[1]) + s2[2]) + s2[3]) + (((s3[0] + s3[1]) + s3[2]) + s3[3])); }
#pragma unroll
        for (int rr = 0; rr < 2; ++rr) { const int row = row0 + rr * NGW;
            const float rinv = rsqrtf(tot[rr] * (1.0f / 1024.0f) + EPS); float s2 = 0.f;
#pragma unroll
            for (int j = 0; j < 4; ++j) { const f32x4 gg = j == 0 ? g0 : (j == 1 ? g1 : (j == 2 ? g2 : g3)); const u32x2 xx = xv[rr][j], mm = mv[rr][j]; f32x4 v;
                v[0] = bflo(xx.x) + bflo(mm.x) * rinv * gg[0]; v[1] = bfhi(xx.x) + bfhi(mm.x) * rinv * gg[1]; v[2] = bflo(xx.y) + bflo(mm.y) * rinv * gg[2]; v[3] = bfhi(xx.y) + bfhi(mm.y) * rinv * gg[3];
                if (last) { ((f32x4*)(out + (size_t)row * 1024) + lane)[64 * j] = v; }
                else { u32x2 w; w.x = pk2(v[0], v[1]); w.y = pk2(v[2], v[3]); ((u32x2*)(XB + (size_t)row * 1024) + lane)[64 * j] = w;
                       const float a0 = bflo(w.x), a1 = bfhi(w.x), a2 = bflo(w.y), a3 = bfhi(w.y); s2 += a0 * a0 + a1 * a1 + a2 * a2 + a3 * a3; } }
            if (!last) { s2 = wave_sum(s2); if (lane == 0) rnext[row] = rsqrtf(s2 * (1.0f / 1024.0f) + EPS); } }
    }
}
__device__ __forceinline__ void rescale_phase(bf16* AO, const float* ss, int G, int bid) {
    int tid = threadIdx.x; asm volatile("" : "+v"(tid));
    const int lane = tid & 63, wave = __builtin_amdgcn_readfirstlane(tid >> 6);
    const int gw = bid * 8 + wave, NGW = G * 8;
    for (int row = gw; row < MT; row += NGW) {
        float tot = 0.f;
#pragma unroll
        for (int k = 0; k < 8; ++k) tot += ss[row * 8 + k];
        const float rinv = rsqrtf(tot * (1.0f / 512.0f) + EPS);
        u32x4* ptr = (u32x4*)(AO + (size_t)row * 1024 + 512) + lane; u32x4 v = *ptr;
        v.x = pk2(bflo(v.x) * rinv, bfhi(v.x) * rinv); v.y = pk2(bflo(v.y) * rinv, bfhi(v.y) * rinv); v.z = pk2(bflo(v.z) * rinv, bfhi(v.z) * rinv); v.w = pk2(bflo(v.w) * rinv, bfhi(v.w) * rinv);
        *ptr = v;
    }
}


#define XB_TMO      128
#define XB_XCNT(j)  (256  + 64 * (j))
#define XB_XSUB(j)  (1280 + 64 * (j))
#define XB_XGEN(j)  (2304 + 64 * (j))
#define XB_TOP      3328
#define XB_TOPGEN   3392
#define XCD_BAR_WORDS 3456
#define XB_SPIN_CAP (1u << 18)
__device__ __forceinline__ unsigned xb_ld(unsigned* p)              { return __hip_atomic_load(p, __ATOMIC_RELAXED, __HIP_MEMORY_SCOPE_AGENT); }
__device__ __forceinline__ unsigned xb_add(unsigned* p, unsigned v) { return __hip_atomic_fetch_add(p, v, __ATOMIC_RELAXED, __HIP_MEMORY_SCOPE_AGENT); }
__device__ __forceinline__ unsigned xb_xcc_id() { return (unsigned)__builtin_amdgcn_s_getreg((3 << 11) | 20) & 0xFu; }
#define XB_SPIN(cond, bar) do { unsigned _sp = 0; while (cond) { __builtin_amdgcn_s_sleep(1); \
    if ((++_sp & 255u) == 0u) { if (xb_ld(&(bar)[XB_TMO])) break; if (_sp > XB_SPIN_CAP) { atomicAdd(&(bar)[XB_TMO], 1u); break; } } } } while (0)
struct XcdBarrier { unsigned* bar; unsigned x; volatile LAS unsigned* st; };
__device__ __forceinline__ XcdBarrier xcd_barrier_post(unsigned* bar, volatile LAS unsigned* st) {
    XcdBarrier b; b.bar = bar; b.x = xb_xcc_id(); b.st = st;
    if (threadIdx.x == 0) (void)xb_add(&bar[XB_XCNT(b.x)], 1u);
    return b;
}
__device__ __forceinline__ void xcd_barrier_complete(unsigned* bar, unsigned x, unsigned& nloc, unsigned& nx) {
    const unsigned G = gridDim.x * gridDim.y * gridDim.z;
    unsigned sum, cnt, mine, sp = 0u;
    for (;;) {
        sum = 0u; cnt = 0u; mine = 0u;
#pragma unroll
        for (unsigned j = 0; j < 16; ++j) { const unsigned c = xb_ld(&bar[XB_XCNT(j)]); sum += c; cnt += (c > 0u) ? 1u : 0u; mine = (j == x) ? c : mine; }
        if (sum == G) break;
        __builtin_amdgcn_s_sleep(1);
        if ((++sp & 255u) == 0u) { if (xb_ld(&bar[XB_TMO])) break; if (sp > XB_SPIN_CAP) { atomicAdd(&bar[XB_TMO], 1u); break; } }
    }
    nloc = mine > 0u ? mine : 1u; nx = cnt > 0u ? cnt : 1u;
}
__device__ __forceinline__ void xcd_barrier(const XcdBarrier& b) {
    asm volatile("s_waitcnt vmcnt(0)" ::: "memory");
    __syncthreads();
    if (threadIdx.x == 0) {
        unsigned* bar = b.bar;
        __builtin_amdgcn_s_waitcnt(0);
        unsigned nloc = b.st[0], nx = b.st[1];
        if (nloc == 0u) { xcd_barrier_complete(bar, b.x, nloc, nx); b.st[0] = nloc; b.st[1] = nx; }
        const unsigned old = xb_add(&bar[XB_XSUB(b.x)], 1u);
        const unsigned gen = old / nloc;
        if (old + 1u == (gen + 1u) * nloc) {
            __builtin_amdgcn_fence(__ATOMIC_RELEASE, "agent");
            asm volatile("s_waitcnt vmcnt(0)" ::: "memory");
            const unsigned og = xb_add(&bar[XB_TOP], 1u);
            const unsigned tg = og / nx;
            if (og + 1u == (tg + 1u) * nx) xb_add(&bar[XB_TOPGEN], 1u);
            else XB_SPIN(xb_ld(&bar[XB_TOPGEN]) == tg, bar);
            __builtin_amdgcn_fence(__ATOMIC_ACQUIRE, "agent");
            xb_add(&bar[XB_XGEN(b.x)], 1u);
            asm volatile("s_waitcnt vmcnt(0)" ::: "memory");
        } else {
            XB_SPIN(xb_ld(&bar[XB_XGEN(b.x)]) == gen, bar);
            __builtin_amdgcn_fence(__ATOMIC_ACQUIRE, "agent");
            asm volatile("s_waitcnt vmcnt(0)" ::: "memory");
        }
    }
    __syncthreads();
}

#ifndef REP_P0
#define REP_P0 1
#endif
#ifndef REP_SYNC
#define REP_SYNC 1
#endif
#ifndef REP_MASK_V
#define REP_MASK_V 0u
#endif
constexpr unsigned REP_MASK = REP_MASK_V;
constexpr int PH_PER_LAYER = 11, N_PHASES = 1 + 2 * PH_PER_LAYER;
__global__ void __launch_bounds__(512) hybrid_fwd(Params p) {
    extern __shared__ __attribute__((aligned(16))) unsigned char lds_raw[];
    LAS unsigned char* lds = (LAS unsigned char*)lds_raw;
    cg::grid_group grid = cg::this_grid();
    volatile LAS unsigned* xst = (volatile LAS unsigned*)(lds + LDS_BYTES - 16);
    if (threadIdx.x < 4) xst[threadIdx.x] = 0u;
    __syncthreads();
    const XcdBarrier xbar = xcd_barrier_post((unsigned*)(p.ws + OFF_BAR), xst);
    if (p.ph_hi > 1000) grid.sync();
    const int Gk = gridDim.x, bk = blockIdx.x;
    unsigned char* ws = p.ws;
    float* sss = (float*)(ws + OFF_SSS); float* ssm = (float*)(ws + OFF_SSM); float* ssf = (float*)(ws + OFF_SSF); float* rA = (float*)(ws + OFF_RA); float* rB = (float*)(ws + OFF_RB);
    bf16* XB = (bf16*)(ws + OFF_XB); bf16* MF = (bf16*)(ws + OFF_MF); bf16* GB = (bf16*)(ws + OFF_G); bf16* HB = (bf16*)(ws + OFF_H);
    bf16* PQ = (bf16*)(ws + OFF_PQ); bf16* AO = (bf16*)(ws + OFF_AO); bf16* UB = (bf16*)(ws + OFF_UB); bf16* TB = (bf16*)(ws + OFF_T); float* SL = (float*)(ws + OFF_SLOC);

#pragma nounroll
    for (int ph = p.ph_lo; ph < p.ph_hi; ++ph) {
        int G = Gk, bid = bk; asm volatile("" : "+s"(G), "+s"(bid));
        if (ph == 0) { for (int rep = 0; rep < REP_P0; ++rep) p0_prologue(p, lds, G, bid); }
        else {
            const int ly = (ph - 1) / PH_PER_LAYER, sp = (ph - 1) % PH_PER_LAYER;
            unsigned char* wb = ws + OFF_W + (size_t)ly * W_LAYER;
            pg8::Order S;
            const int nrep = ((REP_MASK >> sp) & 1u) ? 2 : 1;
            for (int rep = 0; rep < nrep; ++rep)
            switch (sp) {
            case 0: {
                pg8::Gemm g{XB, (const bf16*)(wb + W_IN), MT, NIN, 1024, 1024, 1024, 0, 0, 1}; S.init(MT, NIN, 1, G, bid);
                EpiIn E{PQ, UB, rA}; pg8::gemm_phase<EpiIn>(lds, g, S, E); } break;
            case 1: {
                fft1_phase(PQ, (const bf16*)(ws + OFF_D1), TB, lds, G, bid);
                pg8::Gemm g{UB, (const bf16*)(ws + OFF_MST) + (size_t)ly * 32 * 256 * 256, 2048, 256, 256, 512, 256, (size_t)2048 * 512, (size_t)256 * 256, 32}; S.init(2048, 256, 32, G, bid);
                EpiSloc E{SL}; pg8::gemm_phase<EpiSloc>(lds, g, S, E); } break;
            case 2: {
                carry_phase(p, ly, SL, UB, lds, G, bid);
                fft3_phase(TB, (const bf16*)(ws + OFF_E3), AO, lds, G, bid); } break;
            case 3: {
                pg8::Gemm g{UB, (const bf16*)(ws + OFF_TM) + (size_t)ly * 32 * 256 * 512, 2048, 256, 512, 512, 512, (size_t)2048 * 512, (size_t)256 * 512, 32}; S.init(2048, 256, 32, G, bid);
                EpiSsmOut E{GB}; pg8::gemm_phase<EpiSsmOut>(lds, g, S, E); } break;
            case 4: {
                pg8::Gemm g{GB, (const bf16*)(wb + W_GLU), MT, 512, 512, 512, 512, 0, 0, 1}; S.init(MT, 512, 1, G, bid);
                EpiGlu E{GB, p.b_glu + ly * 512, AO, sss}; pg8::gemm_phase<EpiGlu>(lds, g, S, E); } break;
            case 5: rescale_phase(AO, sss, G, bid); break;
            case 6: {
                pg8::Gemm g{AO, (const bf16*)(wb + W_OUT), MT, 1024, 1024, 1024, 1024, 0, 0, 1}; S.init(MT, 1024, 1, G, bid);
                EpiOutSS E{MF, ssm}; pg8::gemm_phase<EpiOutSS>(lds, g, S, E); } break;
            case 7: norm_phase(p.out, MF, ssm, p.post_mix_g + ly * 1024, XB, rB, false, G, bid); break;
            case 8: {
                pg8::Gemm g{XB, (const bf16*)(wb + W_1), MT, DFF, 1024, 1024, 1024, 0, 0, 1}; S.init(MT, DFF, 1, G, bid);
                EpiFF1 E{HB, rB}; pg8::gemm_phase<EpiFF1>(lds, g, S, E); } break;
            case 9: {
                pg8::Gemm g{HB, (const bf16*)(wb + W_2), MT, 1024, DFF, DFF, DFF, 0, 0, 1}; S.init(MT, 1024, 1, G, bid);
                EpiOutSS E{MF, ssf}; pg8::gemm_phase<EpiOutSS>(lds, g, S, E); } break;
            case 10: norm_phase(p.out, MF, ssf, p.post_mlp_g + ly * 1024, XB, rA, ly == 1, G, bid); break;
            }
        }
        if (ph + 1 < p.ph_hi) for (int rep = 0; rep < REP_SYNC; ++rep) xcd_barrier(xbar);
    }
}

extern "C" void kernel_launch(void* const* d_in, const int* in_sizes, int n_in, void* d_out, int out_size, void* d_ws, size_t ws_size, hipStream_t stream) {
    static int grid = 0;
    if (grid == 0) {
        if (n_in != 22 || ws_size < WS_END) { fprintf(stderr, "kernel_launch: unexpected n_in %d or ws_size %zu (< %zu)\n", n_in, ws_size, (size_t)WS_END); grid = -1; return; }
        int dev = 0, cus = 0, per_cu = 0;
        hipGetDevice(&dev); hipDeviceGetAttribute(&cus, hipDeviceAttributeMultiprocessorCount, dev);
        if (hipFuncSetAttribute((const void*)hybrid_fwd, hipFuncAttributeMaxDynamicSharedMemorySize, LDS_BYTES) != hipSuccess) { fprintf(stderr, "kernel_launch: hipFuncSetAttribute failed\n"); grid = -1; return; }
        if (hipOccupancyMaxActiveBlocksPerMultiprocessor(&per_cu, (const void*)hybrid_fwd, 512, LDS_BYTES) != hipSuccess || per_cu < 1) { fprintf(stderr, "kernel_launch: occupancy query says %d blocks per CU\n", per_cu); per_cu = 1; }
        (void)hipGetLastError();
        grid = cus;
    }
    if (grid < 0) return;
    if (hipMemsetAsync((char*)d_ws + OFF_BAR, 0, BAR_BYTES, stream) != hipSuccess) { fprintf(stderr, "kernel_launch: memset of the barrier words failed\n"); return; }
    Params p{};
    const float** f = (const float**)&p;
    for (int i = 0; i < 22; ++i) f[i] = (const float*)d_in[i];
    p.out = (float*)d_out; p.ws = (unsigned char*)d_ws; p.ph_lo = 0; p.ph_hi = N_PHASES;
    void* args[] = {&p};
    hipError_t e = hipLaunchCooperativeKernel((const void*)hybrid_fwd, dim3(grid), dim3(512), args, LDS_BYTES, stream);
    if (e != hipSuccess) fprintf(stderr, "kernel_launch: cooperative launch failed: %s (grid %d)\n", hipGetErrorString(e), grid);
}
```

```cpp
#include <hip/hip_runtime.h>
#include <hip/hip_cooperative_groups.h>
#include <cstdio>
namespace cg = cooperative_groups;

#define P0_REP_A 1
#define P0_REP_F 1
#define P0_REP_S 1
#define P0_REP_B 1
#define P0_REP_C 1
#define LAS __attribute__((address_space(3)))
typedef unsigned short bf16;
typedef short bf16x8 __attribute__((ext_vector_type(8)));
typedef float f32x4 __attribute__((ext_vector_type(4)));
typedef float f32x2 __attribute__((ext_vector_type(2)));
typedef unsigned u32x4 __attribute__((ext_vector_type(4)));
typedef unsigned u32x2 __attribute__((ext_vector_type(2)));

constexpr int NB = 4, SEQ = 8192, DM = 1024, MT = NB * SEQ, DFO = 512, NHEAD = 8, SG = 32, SP = 64, DFF = 4096, NIN = 1536;
constexpr float EPS = 1e-6f;
constexpr int LDS_BYTES = 147456;
constexpr size_t MiB = 1u << 20;
constexpr size_t OFF_RA = 384 * 1024, OFF_RB = 512 * 1024, OFF_BAR = 640 * 1024, BAR_BYTES = 16384;
constexpr size_t OFF_E3 = 1 * MiB, OFF_D1 = 2 * MiB, OFF_TM = 6 * MiB, OFF_MST = 22 * MiB, OFF_W = 30 * MiB;
constexpr size_t W_IN = 0, W_OUT = 3 * MiB, W_1 = 5 * MiB, W_2 = 13 * MiB, W_GLU = 21 * MiB, W_LAYER = 22 * MiB;
constexpr size_t OFF_XB = 76 * MiB, OFF_MF = 140 * MiB, OFF_G = 140 * MiB, OFF_H = 204 * MiB;
constexpr size_t OFF_PQ = 204 * MiB, OFF_AO = 204 * MiB, OFF_UB = 268 * MiB, OFF_T = 332 * MiB, OFF_SLOC = 396 * MiB, OFF_SSS = 460 * MiB, OFF_SSM = 461 * MiB, OFF_SSF = 463 * MiB, WS_END = 465 * MiB;

struct Params {
    const float *x, *w_in, *w_out, *pre_mix_g, *post_mix_g, *pre_mlp_g, *post_mlp_g, *fourier_out_g, *ssm_out_g, *w_fourier,
        *lam_re, *lam_im, *log_dt, *b_re, *b_im, *c_re, *c_im, *d_skip, *w_glu, *b_glu, *w_ff1, *w_ff2;
    float* out; unsigned char* ws;
    int ph_lo, ph_hi;
};

__device__ __forceinline__ unsigned f2bf(float f) { unsigned u = __builtin_bit_cast(unsigned, f); return (u + 0x7fffu + ((u >> 16) & 1u)) >> 16; }
__device__ __forceinline__ unsigned pk2(float lo, float hi) { return f2bf(lo) | (f2bf(hi) << 16); }
__device__ __forceinline__ float bflo(unsigned w) { return __builtin_bit_cast(float, w << 16); }
__device__ __forceinline__ float bfhi(unsigned w) { return __builtin_bit_cast(float, w & 0xffff0000u); }
__device__ __forceinline__ float wave_sum(float v) {
#pragma unroll
    for (int o = 1; o < 64; o <<= 1) v += __shfl_xor(v, o);
    return v;
}
__device__ __forceinline__ float gelu_t(float x) { const float u = 0.7978845608f * (x + 0.044715f * x * x * x); return x / (1.0f + __expf(-2.0f * u)); }
__device__ __forceinline__ float sigm(float v) { return 1.0f / (1.0f + __expf(-v)); }

namespace pg8 {
#define PG8_LAS __attribute__((address_space(3)))
typedef unsigned short bf16_t;
constexpr int BM = 256, BK = 64, HALF = 128, HTB = HALF * BK * 2, STAGE_BYTES = 8 * HTB, NXCD = 8, WGM = 8;
__host__ __device__ __forceinline__ int lds_byte(int r, int c) { const int st = (r >> 4) * 2 + (c >> 5), rr = r & 15, cc = c & 31, ob = rr * 64 + cc * 2; return st * 1024 + (ob ^ (((ob >> 9) & 1) << 5)); }
__host__ __device__ __forceinline__ void stage_rc(int b, int& R, int& C) { const int st = b / 1024, sb = b % 1024, swz = sb ^ (((sb >> 9) & 1) << 5); R = (st >> 1) * 16 + swz / 64; C = (st & 1) * 32 + (swz % 64) / 2; }
__host__ __device__ __forceinline__ int perm32(int rho) { const int n = rho >> 4, i = rho & 15; return 8 * (i >> 2) + 4 * n + (i & 3); }

struct Unit { int pm, pn, z, ui; };
struct Gemm { const bf16_t* A; const bf16_t* Bt; int M, N, K, lda, ldb; size_t sA, sB; int nZ; };

struct Order {
    int nM, nN, nwg, nZ, G, c;
    __device__ void init(int M, int N, int nZ_, int G_, int c_) { nM = M / BM; nN = N / BM; nwg = nM * nN; nZ = nZ_; G = G_; c = c_; }
    __device__ bool next(int i, Unit& u) const {
        const long L = (long)i * G + c; if (L >= (long)nwg * nZ) return false;
        u.z = (int)(L / nwg); u.ui = i;
        int wgid = (int)(L % nwg); { const int q = nwg / NXCD, r = nwg % NXCD, xcd = wgid % NXCD, off = wgid / NXCD; wgid = (xcd < r ? xcd * (q + 1) : r * (q + 1) + (xcd - r) * q) + off; }
        const int nig = WGM * nN, gid = wgid / nig, fm = gid * WGM, gsz = (nM - fm) < WGM ? (nM - fm) : WGM;
        u.pm = fm + ((wgid % nig) % gsz); u.pn = (wgid % nig) / gsz; return true;
    }
};

template <class Epi>
__device__ __forceinline__ void gemm_phase(PG8_LAS unsigned char* lds, const Gemm g, const Order& S, const Epi& E) {
    int tid = threadIdx.x; asm volatile("" : "+v"(tid));
    const int wid = __builtin_amdgcn_readfirstlane(tid >> 6), lane = tid & 63, wr = wid >> 2, wc = wid & 3, fr = lane & 15, fq = lane >> 4;
    const int K = g.K, nt = K / BK;
    unsigned voffA[2], voffB[2];
#pragma unroll
    for (int i = 0; i < 2; ++i) { int R, C; stage_rc(tid * 16 + i * 8192, R, C); const int Rb = Epi::PERM ? ((R & ~31) + perm32(R & 31)) : R;
        voffA[i] = (unsigned)(R * g.lda + C) * 2u; voffB[i] = (unsigned)(Rb * g.ldb + C) * 2u; }
    const size_t kstep = (size_t)(BK * 2);
    const size_t hA = (size_t)HALF * g.lda * 2, hB = (size_t)HALF * g.ldb * 2;
    const size_t tA = 2 * hA, tB = 2 * hB;
    const unsigned ldsw = (unsigned)wid * 1024u;
    const int aoff = lds_byte(wr * 64 + fr, fq * 8), boff = lds_byte(wc * 32 + fr, fq * 8);
#define PG8_SA(b, h) (((b) * 2 + (h)) * HTB)
#define PG8_SB(b, h) ((4 + (b) * 2 + (h)) * HTB)
#define PG8_STAGE(bufoff, gbase, voff) do { _Pragma("unroll") for (int _i = 0; _i < 2; ++_i) \
        __builtin_amdgcn_global_load_lds((const unsigned*)((const char*)(gbase) + (voff)[_i]), (PG8_LAS unsigned*)(lds + (bufoff) + ldsw + _i * 8192), 16, 0, 0); } while (0)
#define PG8_LDA(dst, b, h) do { _Pragma("unroll") for (int m = 0; m < 4; ++m) _Pragma("unroll") for (int k = 0; k < 2; ++k) dst[m][k] = *(const PG8_LAS bf16x8*)(lds + PG8_SA(b, h) + aoff + m * 2048 + k * 1024); } while (0)
#define PG8_LDB(dst, b, h) do { _Pragma("unroll") for (int n = 0; n < 2; ++n) _Pragma("unroll") for (int k = 0; k < 2; ++k) dst[n][k] = *(const PG8_LAS bf16x8*)(lds + PG8_SB(b, h) + boff + n * 2048 + k * 1024); } while (0)
#define PG8_MMA(ai, bj, At, Bt) do { __builtin_amdgcn_s_setprio(1); _Pragma("unroll") for (int m = 0; m < 4; ++m) _Pragma("unroll") for (int n = 0; n < 2; ++n) _Pragma("unroll") for (int k = 0; k < 2; ++k) \
        acc[ai][bj][m][n] = __builtin_amdgcn_mfma_f32_16x16x32_bf16(Bt[n][k], At[m][k], acc[ai][bj][m][n], 0, 0, 0); __builtin_amdgcn_s_setprio(0); } while (0)
#define PG8_WAIT_V(n) asm volatile("s_waitcnt vmcnt(" #n ")" ::: "memory")
#define PG8_WAIT_L(n) asm volatile("s_waitcnt lgkmcnt(" #n ")" ::: "memory")
#define PG8_BAR __builtin_amdgcn_s_barrier()
#define PG8_SCHED __builtin_amdgcn_sched_barrier(0)
    Unit cur, nxt; int ui = 0;
    if (!S.next(0, cur)) return;
    f32x4 acc[2][2][4][2];
#pragma unroll
    for (int a = 0; a < 2; ++a)
#pragma unroll
        for (int b = 0; b < 2; ++b)
#pragma unroll
            for (int m = 0; m < 4; ++m)
#pragma unroll
                for (int n = 0; n < 2; ++n) acc[a][b][m][n] = (f32x4){0.f, 0.f, 0.f, 0.f};
    bf16x8 At[4][2], B0[2][2], B1[2][2];
    const char* cA = (const char*)g.A + ((size_t)cur.z * g.sA) * 2 + (size_t)cur.pm * tA; const char* cB = (const char*)g.Bt + ((size_t)cur.z * g.sB) * 2 + (size_t)cur.pn * tB;
    PG8_STAGE(PG8_SB(0, 0), cB, voffB); PG8_STAGE(PG8_SA(0, 0), cA, voffA); PG8_STAGE(PG8_SB(0, 1), cB + hB, voffB); PG8_STAGE(PG8_SA(0, 1), cA + hA, voffA);
    if (wr == 1) PG8_BAR;
    PG8_WAIT_V(4); PG8_BAR;
    PG8_STAGE(PG8_SB(1, 0), cB + kstep, voffB); PG8_STAGE(PG8_SA(1, 0), cA + kstep, voffA); PG8_STAGE(PG8_SB(1, 1), cB + hB + kstep, voffB);
    PG8_WAIT_V(6); PG8_BAR;
    for (;;) {
        const bool has_next = S.next(ui + 1, nxt);
        const char* nA = has_next ? (const char*)g.A + ((size_t)nxt.z * g.sA) * 2 + (size_t)nxt.pm * tA : cA; const char* nB = has_next ? (const char*)g.Bt + ((size_t)nxt.z * g.sB) * 2 + (size_t)nxt.pn * tB : cB;
        for (int t = 0; t < nt; t += 2) {
            const bool last = (t == nt - 2);
            if constexpr (Epi::MID) { if (t == (nt >> 1)) E.mid(acc, cur, wr, fr); }
            const char* a1 = cA + (size_t)(t + 1) * kstep;
            const char* a2 = last ? nA : cA + (size_t)(t + 2) * kstep; const char* b2 = last ? nB : cB + (size_t)(t + 2) * kstep;
            const char* a3 = a2 + kstep; const char* b3 = b2 + kstep;
            PG8_LDB(B0, 0, 0); PG8_SCHED; PG8_LDA(At, 0, 0); PG8_STAGE(PG8_SA(1, 1), a1 + hA, voffA);
            PG8_WAIT_L(8); PG8_BAR; PG8_WAIT_L(0); PG8_MMA(0, 0, At, B0); PG8_BAR; PG8_SCHED;
            PG8_LDB(B1, 0, 1); PG8_STAGE(PG8_SB(0, 0), b2, voffB);
            PG8_BAR; PG8_WAIT_L(0); PG8_MMA(0, 1, At, B1); PG8_BAR;
            PG8_LDA(At, 0, 1); PG8_STAGE(PG8_SA(0, 0), a2, voffA);
            PG8_BAR; PG8_WAIT_L(0); PG8_MMA(1, 0, At, B0); PG8_BAR; PG8_SCHED;
            PG8_STAGE(PG8_SB(0, 1), b2 + hB, voffB);
            PG8_WAIT_V(6); PG8_BAR; PG8_MMA(1, 1, At, B1); PG8_BAR;
            PG8_LDB(B0, 1, 0); PG8_SCHED; PG8_LDA(At, 1, 0); PG8_STAGE(PG8_SA(0, 1), a2 + hA, voffA);
            PG8_WAIT_L(8); PG8_BAR; PG8_WAIT_L(0); PG8_MMA(0, 0, At, B0); PG8_BAR; PG8_SCHED;
            PG8_LDB(B1, 1, 1); PG8_STAGE(PG8_SB(1, 0), b3, voffB);
            PG8_BAR; PG8_WAIT_L(0); PG8_MMA(0, 1, At, B1); PG8_BAR;
            PG8_LDA(At, 1, 1); PG8_STAGE(PG8_SA(1, 0), a3, voffA);
            PG8_BAR; PG8_WAIT_L(0); PG8_MMA(1, 0, At, B0); PG8_BAR; PG8_SCHED;
            PG8_STAGE(PG8_SB(1, 1), b3 + hB, voffB);
            PG8_WAIT_V(6); PG8_BAR; PG8_MMA(1, 1, At, B1); PG8_BAR;
        }
        E(acc, cur, wr, wc, fr, fq);
        if (!has_next) break;
#pragma unroll
        for (int a = 0; a < 2; ++a)
#pragma unroll
            for (int b = 0; b < 2; ++b)
#pragma unroll
                for (int m = 0; m < 4; ++m)
#pragma unroll
                    for (int n = 0; n < 2; ++n) acc[a][b][m][n] = (f32x4){0.f, 0.f, 0.f, 0.f};
        cur = nxt; cA = nA; cB = nB; ++ui;
    }
    PG8_WAIT_V(0);
    if (wr == 0) PG8_BAR;
    PG8_BAR;
#undef PG8_SA
#undef PG8_SB
#undef PG8_STAGE
#undef PG8_LDA
#undef PG8_LDB
#undef PG8_MMA
#undef PG8_WAIT_V
#undef PG8_WAIT_L
#undef PG8_BAR
#undef PG8_SCHED
}
}

typedef const f32x4 (&AccRef)[2][2][4][2];
__device__ __forceinline__ u32x4 pack8(f32x4 a, f32x4 b) { u32x4 w; w.x = pk2(a[0], a[1]); w.y = pk2(a[2], a[3]); w.z = pk2(b[0], b[1]); w.w = pk2(b[2], b[3]); return w; }

struct EpiIn {
    static constexpr bool PERM = true, MID = false;
    bf16* PQ; bf16* UB; const float* r;
    __device__ __forceinline__ void operator()(AccRef acc, const pg8::Unit& u, int wr, int wc, int fr, int fq) const {
#pragma unroll
        for (int ai = 0; ai < 2; ++ai)
#pragma unroll
            for (int m = 0; m < 4; ++m) {
                const int row = u.pm * 256 + ai * 128 + wr * 64 + m * 16 + fr; const float rs = r[row];
#pragma unroll
                for (int bj = 0; bj < 2; ++bj) {
                    const int col0 = u.pn * 256 + bj * 128 + wc * 32 + 8 * fq;
                    const u32x4 w = pack8(acc[ai][bj][m][0] * rs, acc[ai][bj][m][1] * rs);
                    if (col0 < 1024) *(u32x4*)(PQ + (size_t)row * 1024 + col0) = w;
                    else { const int c2 = col0 - 1024, gg = c2 >> 4, h0 = c2 & 15; *(u32x4*)(UB + ((size_t)(gg * 2048 + (row >> 4)) * 512 + (row & 15) * 16 + h0)) = w; }
                }
            }
    }
};
struct EpiSloc {
    static constexpr bool PERM = false, MID = false;
    float* S;
    __device__ __forceinline__ void operator()(AccRef acc, const pg8::Unit& u, int wr, int wc, int fr, int fq) const {
#pragma unroll
        for (int ai = 0; ai < 2; ++ai)
#pragma unroll
            for (int m = 0; m < 4; ++m) {
                const int row = u.pm * 256 + ai * 128 + wr * 64 + m * 16 + fr;
                float* rp = S + ((size_t)u.z * 2048 + row) * 256 + wc * 32 + 4 * fq;
#pragma unroll
                for (int bj = 0; bj < 2; ++bj)
#pragma unroll
                    for (int n = 0; n < 2; ++n) *(f32x4*)(rp + bj * 128 + n * 16) = acc[ai][bj][m][n];
            }
    }
};
struct EpiSsmOut {
    static constexpr bool PERM = true, MID = false;
    bf16* G;
    __device__ __forceinline__ void operator()(AccRef acc, const pg8::Unit& u, int wr, int wc, int fr, int fq) const {
#pragma unroll
        for (int ai = 0; ai < 2; ++ai)
#pragma unroll
            for (int m = 0; m < 4; ++m) {
                const int row = u.pm * 256 + ai * 128 + wr * 64 + m * 16 + fr;
#pragma unroll
                for (int bj = 0; bj < 2; ++bj) {
                    const int col0 = bj * 128 + wc * 32 + 8 * fq, t = col0 >> 4, i0 = col0 & 15;
                    f32x4 a = acc[ai][bj][m][0], b = acc[ai][bj][m][1];
#pragma unroll
                    for (int j = 0; j < 4; ++j) { a[j] = gelu_t(a[j]); b[j] = gelu_t(b[j]); }
                    *(u32x4*)(G + ((size_t)row * 16 + t) * 512 + u.z * 16 + i0) = pack8(a, b);
                }
            }
    }
};
struct EpiGlu {
    static constexpr bool PERM = true, MID = false;
    const bf16* G; const float* bias; bf16* AO; float* ss;
    __device__ __forceinline__ void operator()(AccRef acc, const pg8::Unit& u, int wr, int wc, int fr, int fq) const {
#pragma unroll
        for (int ai = 0; ai < 2; ++ai)
#pragma unroll
            for (int m = 0; m < 4; ++m) {
                const int row = u.pm * 256 + ai * 128 + wr * 64 + m * 16 + fr; float s2 = 0.f;
#pragma unroll
                for (int bj = 0; bj < 2; ++bj) {
                    const int col0 = u.pn * 256 + bj * 128 + wc * 32 + 8 * fq;
                    const u32x4 gv = *(const u32x4*)(G + (size_t)row * 512 + col0);
                    const f32x4 b0 = *(const f32x4*)(bias + col0), b1 = *(const f32x4*)(bias + col0 + 4);
                    f32x4 a = acc[ai][bj][m][0] + b0, b = acc[ai][bj][m][1] + b1;
                    a[0] = bflo(gv.x) * sigm(a[0]); a[1] = bfhi(gv.x) * sigm(a[1]); a[2] = bflo(gv.y) * sigm(a[2]); a[3] = bfhi(gv.y) * sigm(a[3]);
                    b[0] = bflo(gv.z) * sigm(b[0]); b[1] = bfhi(gv.z) * sigm(b[1]); b[2] = bflo(gv.w) * sigm(b[2]); b[3] = bfhi(gv.w) * sigm(b[3]);
#pragma unroll
                    for (int j = 0; j < 4; ++j) s2 += a[j] * a[j] + b[j] * b[j];
                    *(u32x4*)(AO + (size_t)row * 1024 + 512 + col0) = pack8(a, b);
                }
                s2 += __shfl_xor(s2, 16); s2 += __shfl_xor(s2, 32);
                if (fq == 0) ss[row * 8 + u.pn * 4 + wc] = s2;
            }
    }
};
struct EpiOutSS {
    static constexpr bool PERM = true, MID = false;
    bf16* O; float* ss;
    __device__ __forceinline__ void operator()(AccRef acc, const pg8::Unit& u, int wr, int wc, int fr, int fq) const {
#pragma unroll
        for (int ai = 0; ai < 2; ++ai)
#pragma unroll
            for (int m = 0; m < 4; ++m) {
                const int row = u.pm * 256 + ai * 128 + wr * 64 + m * 16 + fr; float s2 = 0.f;
#pragma unroll
                for (int bj = 0; bj < 2; ++bj) {
                    const int col0 = u.pn * 256 + bj * 128 + wc * 32 + 8 * fq;
                    const f32x4 a = acc[ai][bj][m][0], b = acc[ai][bj][m][1];
#pragma unroll
                    for (int j = 0; j < 4; ++j) s2 += a[j] * a[j] + b[j] * b[j];
                    *(u32x4*)(O + (size_t)row * 1024 + col0) = pack8(a, b);
                }
                s2 += __shfl_xor(s2, 16); s2 += __shfl_xor(s2, 32);
                if (fq == 0) ss[row * 16 + u.pn * 4 + wc] = s2;
            }
    }
};
struct EpiOutMix {
    static constexpr bool PERM = true, MID = true;
    bf16* O; float* ss; const LAS float* qv;
    __device__ __forceinline__ void mid(f32x4 (&acc)[2][2][4][2], const pg8::Unit& u, int wr, int fr) const {
#pragma unroll
        for (int ai = 0; ai < 2; ++ai)
#pragma unroll
            for (int m = 0; m < 4; ++m) { const float q = qv[u.ui * 256 + ai * 128 + wr * 64 + m * 16 + fr];
#pragma unroll
                for (int bj = 0; bj < 2; ++bj)
#pragma unroll
                    for (int n = 0; n < 2; ++n) acc[ai][bj][m][n] *= q; }
    }
    __device__ __forceinline__ void operator()(AccRef acc, const pg8::Unit& u, int wr, int wc, int fr, int fq) const {
#pragma unroll
        for (int ai = 0; ai < 2; ++ai)
#pragma unroll
            for (int m = 0; m < 4; ++m) {
                const int rl = ai * 128 + wr * 64 + m * 16 + fr, row = u.pm * 256 + rl; float s2 = 0.f; const float rs = qv[1024 + u.ui * 256 + rl];
#pragma unroll
                for (int bj = 0; bj < 2; ++bj) {
                    const int col0 = u.pn * 256 + bj * 128 + wc * 32 + 8 * fq;
                    const f32x4 a = acc[ai][bj][m][0] * rs, b = acc[ai][bj][m][1] * rs;
#pragma unroll
                    for (int j = 0; j < 4; ++j) s2 += a[j] * a[j] + b[j] * b[j];
                    *(u32x4*)(O + (size_t)row * 1024 + col0) = pack8(a, b);
                }
                s2 += __shfl_xor(s2, 16); s2 += __shfl_xor(s2, 32);
                if (fq == 0) ss[row * 16 + u.pn * 4 + wc] = s2;
            }
    }
};
struct EpiFF1 {
    static constexpr bool PERM = true, MID = false;
    bf16* H; const float* r;
    __device__ __forceinline__ void operator()(AccRef acc, const pg8::Unit& u, int wr, int wc, int fr, int fq) const {
#pragma unroll
        for (int ai = 0; ai < 2; ++ai)
#pragma unroll
            for (int m = 0; m < 4; ++m) {
                const int row = u.pm * 256 + ai * 128 + wr * 64 + m * 16 + fr; const float rs = r[row];
#pragma unroll
                for (int bj = 0; bj < 2; ++bj) {
                    const int col0 = u.pn * 256 + bj * 128 + wc * 32 + 8 * fq;
                    f32x4 a = acc[ai][bj][m][0] * rs, b = acc[ai][bj][m][1] * rs;
#pragma unroll
                    for (int j = 0; j < 4; ++j) { a[j] = fmaxf(a[j], 0.f); a[j] *= a[j]; b[j] = fmaxf(b[j], 0.f); b[j] *= b[j]; }
                    *(u32x4*)(H + (size_t)row * 4096 + col0) = pack8(a, b);
                }
            }
    }
};

__device__ __forceinline__ void transpose_item(const float* W, int ldw, bf16* WT, int ldt, const float* sc_lo, const float* sc_hi, int split,
                                               LAS float* scr, int item, int nblk, int lane) {
    const int kb = item / nblk, nb = item % nblk, k0 = 64 * kb, n0 = 32 * nb;
#pragma unroll 16
    for (int i = 0; i < 32; ++i) { const int kk = 2 * i + (lane >> 5), k = k0 + kk;
        float s = 1.f; if (sc_lo) s = (k < split) ? sc_lo[k] : sc_hi[k - split];
        scr[kk * 33 + (lane & 31)] = W[(size_t)k * ldw + n0 + (lane & 31)] * s; }
    asm volatile("s_waitcnt lgkmcnt(0)" ::: "memory");
    const int c = lane & 7;
#pragma unroll
    for (int j = 0; j < 4; ++j) { const int n = (lane >> 3) + 8 * j; const LAS float* s = scr + (8 * c) * 33 + n;
        u32x4 o; o.x = pk2(s[0 * 33], s[1 * 33]); o.y = pk2(s[2 * 33], s[3 * 33]); o.z = pk2(s[4 * 33], s[5 * 33]); o.w = pk2(s[6 * 33], s[7 * 33]);
        *(u32x4*)(WT + (size_t)(n0 + n) * ldt + k0 + 8 * c) = o; }
    asm volatile("s_waitcnt lgkmcnt(0)" ::: "memory");
}

__device__ __forceinline__ void fold_item(const Params& p, int item, LAS unsigned char* lds) {
    int tid = threadIdx.x; asm volatile("" : "+v"(tid)); const int ly = item >> 7, h = (item >> 4) & 7, kb = item & 15, k0 = kb * 64;
    LAS float* Wt = (LAS float*)lds;
    LAS float* Wf = Wt + 64 * 65;
    LAS float* TC = Wf + 64 * 65;
    LAS float* TS = TC + 64 * 65;
    LAS float* cs = TS + 64 * 65;
    __syncthreads();
    const float* win = p.w_in + (size_t)ly * 1024 * 1024; const float* wf = p.w_fourier + ((size_t)ly * 8 + h) * 4096; const float* g = p.pre_mix_g + ly * 1024;
    for (int i = tid; i < 4096; i += 512) { const int k = i >> 6, c = i & 63; Wt[k * 65 + c] = win[(size_t)(k0 + k) * 1024 + 64 * h + c] * g[k0 + k]; Wf[k * 65 + c] = wf[i]; }
    if (tid < 64) { float s, c; sincospif((float)tid / 32.0f, &s, &c); cs[tid] = c; cs[64 + tid] = s; }
    __syncthreads();
    { const int d = tid & 63, kg = tid >> 6; float ac[8], as[8];
#pragma unroll
      for (int j = 0; j < 8; ++j) { ac[j] = 0.f; as[j] = 0.f; }
#pragma unroll 2
      for (int c = 0; c < 64; ++c) { const int ph = (c * d) & 63; const float cv = cs[ph], sv = cs[64 + ph];
#pragma unroll
          for (int j = 0; j < 8; ++j) { const float w = Wt[(kg * 8 + j) * 65 + c]; ac[j] += w * cv; as[j] += w * sv; } }
#pragma unroll
      for (int j = 0; j < 8; ++j) { TC[(kg * 8 + j) * 65 + d] = ac[j]; TS[(kg * 8 + j) * 65 + d] = as[j]; } }
    __syncthreads();
    const float scale = 1.0f / 724.0773439350247f;
    bf16* WT = (bf16*)(p.ws + OFF_W + (size_t)ly * W_LAYER + W_IN);
    { const int k = tid & 63, eg = tid >> 6; float ap[8], aq[8];
#pragma unroll
      for (int j = 0; j < 8; ++j) { ap[j] = 0.f; aq[j] = 0.f; }
#pragma unroll 2
      for (int d = 0; d < 64; ++d) { const float tc = TC[k * 65 + d], ts = TS[k * 65 + d];
#pragma unroll
          for (int j = 0; j < 8; ++j) { const float w = Wf[d * 65 + eg * 8 + j]; ap[j] += tc * w; aq[j] += ts * w; } }
#pragma unroll
      for (int j = 0; j < 8; ++j) { const int e = eg * 8 + j;
          WT[(size_t)(64 * h + e) * 1024 + k0 + k] = (bf16)f2bf(ap[j] * scale);
          WT[(size_t)(512 + 64 * h + e) * 1024 + k0 + k] = (bf16)f2bf(-aq[j] * scale); } }
}

__device__ __forceinline__ void ssm_mat_item(const Params& p, int item, LAS unsigned char* lds) {
    int tid = threadIdx.x; asm volatile("" : "+v"(tid)); const int ly = item >> 7, g = (item >> 2) & 31, qt = item & 3;
    LAS float* pwr = (LAS float*)lds;
    LAS float* pwi = pwr + 2 * 17 * 64;
    LAS float* bbr = pwi + 2 * 17 * 64;
    LAS float* bbi = bbr + 2 * 64 * 16;
    LAS float* ccr = bbi + 2 * 64 * 16;
    LAS float* cci = ccr + 2 * 16 * 64;
    LAS float* Gt = cci + 2 * 16 * 64;
    __syncthreads();
    { const int k = (tid >> 6) & 1, pp = tid & 63, tg = tid >> 7; const int idx = (ly * 2 + k) * 32 + g;
      const float dt = expf(p.log_dt[idx]); const float lr = p.lam_re[idx * 64 + pp] * dt, li = p.lam_im[idx * 64 + pp] * dt;
#pragma unroll
      for (int j = 0; j < 5; ++j) { const int tau = tg * 5 + j; if (tau <= 16) { const float e = __expf(lr * tau); float sn, cs; __sincosf(li * tau, &sn, &cs); pwr[(k * 17 + tau) * 64 + pp] = e * cs; pwi[(k * 17 + tau) * 64 + pp] = e * sn; } } }
    for (int i = tid; i < 2048; i += 512) { const int k = i >> 10, r = i & 1023; const int idx = (ly * 2 + k) * 32 + g; ccr[i] = p.c_re[(size_t)idx * 1024 + r]; cci[i] = p.c_im[(size_t)idx * 1024 + r]; }
    __syncthreads();
#pragma unroll
    for (int j = 0; j < 4; ++j) { const int o = tid + 512 * j, k = o >> 10, pp = (o >> 4) & 63, h = o & 15; const int idx = (ly * 2 + k) * 32 + g;
        const float lr = p.lam_re[idx * 64 + pp], li = p.lam_im[idx * 64 + pp], dt = expf(p.log_dt[idx]);
        float sn, cs; sincosf(li * dt, &sn, &cs); const float em1 = expm1f(lr * dt), sh = sinf(0.5f * li * dt);
        const float lbr = em1 * cs - 2.0f * sh * sh, lbi = (em1 + 1.0f) * sn;
        const float den = 1.0f / (lr * lr + li * li); const float cr = (lbr * lr + lbi * li) * den, ci = (lbi * lr - lbr * li) * den;
        const float br = p.b_re[(size_t)idx * 1024 + pp * 16 + h], bi = p.b_im[(size_t)idx * 1024 + pp * 16 + h];
        bbr[o] = cr * br - ci * bi; bbi[o] = cr * bi + ci * br; }
    __syncthreads();
    { const int k = tid >> 8, i = (tid >> 4) & 15, h = tid & 15; float a[16];
#pragma unroll
      for (int tau = 0; tau < 16; ++tau) a[tau] = 0.f;
#pragma nounroll
      for (int pp = 0; pp < 64; ++pp) { const float c_r = ccr[(k * 16 + i) * 64 + pp], c_i = cci[(k * 16 + i) * 64 + pp], b_r = bbr[(k * 64 + pp) * 16 + h], b_i = bbi[(k * 64 + pp) * 16 + h];
          const float xr = c_r * b_r - c_i * b_i, xi = c_r * b_i + c_i * b_r;
#pragma unroll
          for (int tau = 0; tau < 16; ++tau) a[tau] += xr * pwr[(k * 17 + tau) * 64 + pp] - xi * pwi[(k * 17 + tau) * 64 + pp]; }
#pragma unroll
      for (int tau = 0; tau < 16; ++tau) Gt[((k * 16 + tau) * 16 + i) * 16 + h] = a[tau]; }
    __syncthreads();
    bf16* TM = (bf16*)(p.ws + OFF_TM) + (size_t)(ly * 32 + g) * 256 * 512; bf16* MS = (bf16*)(p.ws + OFF_MST) + (size_t)(ly * 32 + g) * 256 * 256;
    const float* dsk = p.d_skip + (ly * 32 + g) * 16;
    for (int o = qt * 64 * 512 + tid; o < (qt + 1) * 64 * 512; o += 512) { const int r = o >> 9, col = o & 511, t = r >> 4, i = r & 15; float v;
        if (col < 256) { const int j = col >> 4, h = col & 15; v = 0.f;
            if (j <= t) v += Gt[((0 * 16 + (t - j)) * 16 + i) * 16 + h];
            if (j >= t) v += Gt[((1 * 16 + (j - t)) * 16 + i) * 16 + h];
            if (j == t && h == i) v += dsk[i]; }
        else { const int k = (col - 256) >> 7, q = (col - 256) & 127, pp = q >> 1, part = q & 1; const int tau = k == 0 ? (t + 1) : (16 - t);
            const float c_r = ccr[(k * 16 + i) * 64 + pp], c_i = cci[(k * 16 + i) * 64 + pp], l_r = pwr[(k * 17 + tau) * 64 + pp], l_i = pwi[(k * 17 + tau) * 64 + pp];
            v = part == 0 ? (c_r * l_r - c_i * l_i) : -(c_r * l_i + c_i * l_r); }
        TM[o] = (bf16)f2bf(v); }
    for (int o = qt * 64 * 256 + tid; o < (qt + 1) * 64 * 256; o += 512) { const int r = o >> 8, col = o & 255, k = r >> 7, q = r & 127, pp = q >> 1, part = q & 1, j = col >> 4, h = col & 15;
        const int tau = k == 0 ? (15 - j) : j;
        const float l_r = pwr[(k * 17 + tau) * 64 + pp], l_i = pwi[(k * 17 + tau) * 64 + pp], b_r = bbr[(k * 64 + pp) * 16 + h], b_i = bbi[(k * 64 + pp) * 16 + h];
        const float v = part == 0 ? (l_r * b_r - l_i * b_i) : (l_r * b_i + l_i * b_r);
        MS[o] = (bf16)f2bf(v); }
}

__device__ __forceinline__ void p0_prologue(const Params& p, LAS unsigned char* lds, int G, int bid) {
    int tid = threadIdx.x; asm volatile("" : "+v"(tid));
    const int lane = tid & 63, wave = __builtin_amdgcn_readfirstlane(tid >> 6);
    for (int rp = 0; rp < P0_REP_A; ++rp)
    for (int it = bid; it < 512; it += G) { if (it < 256) { for (int r2 = 0; r2 < P0_REP_F; ++r2) fold_item(p, it, lds); } else { for (int r2 = 0; r2 < P0_REP_S; ++r2) ssm_mat_item(p, it - 256, lds); } }
    __syncthreads();
    {
        LAS float* scr = (LAS float*)(lds + wave * 8448);
        const int gw = bid * 8 + wave, NGW = G * 8;
        constexpr int I_IN = 16 * 16, I_OUT = 16 * 32, I_1 = 16 * 128, I_2 = 64 * 32, I_G = 8 * 16, I_L = I_IN + I_OUT + I_1 + I_2 + I_G;
        for (int rp = 0; rp < P0_REP_B; ++rp)
        for (int it = gw; it < 2 * I_L; it += NGW) {
            const int ly = it / I_L; int r = it % I_L; unsigned char* wb = p.ws + OFF_W + (size_t)ly * W_LAYER;
            if (r < I_IN) { transpose_item(p.w_in + (size_t)ly * 1024 * 1024 + 512, 1024, (bf16*)(wb + W_IN) + (size_t)1024 * 1024, 1024, p.pre_mix_g + ly * 1024, nullptr, 1 << 30, scr, r, 16, lane); continue; } r -= I_IN;
            if (r < I_OUT) { transpose_item(p.w_out + (size_t)ly * 1024 * 1024, 1024, (bf16*)(wb + W_OUT), 1024, p.fourier_out_g + ly * 512, p.ssm_out_g + ly * 512, 512, scr, r, 32, lane); continue; } r -= I_OUT;
            if (r < I_1) { transpose_item(p.w_ff1 + (size_t)ly * 1024 * 4096, 4096, (bf16*)(wb + W_1), 1024, p.pre_mlp_g + ly * 1024, nullptr, 1 << 30, scr, r, 128, lane); continue; } r -= I_1;
            if (r < I_2) { transpose_item(p.w_ff2 + (size_t)ly * 4096 * 1024, 1024, (bf16*)(wb + W_2), 4096, nullptr, nullptr, 0, scr, r, 32, lane); continue; } r -= I_2;
            transpose_item(p.w_glu + (size_t)ly * 512 * 512, 512, (bf16*)(wb + W_GLU), 512, nullptr, nullptr, 0, scr, r, 16, lane);
        }
        bf16* XB = (bf16*)(p.ws + OFF_XB); float* rA = (float*)(p.ws + OFF_RA);
        for (int rp = 0; rp < P0_REP_C; ++rp)
        for (int row0 = gw; row0 < MT; row0 += 4 * NGW) {
            f32x4 v[4][4];
#pragma unroll
            for (int rr = 0; rr < 4; ++rr) { const f32x4* xr = (const f32x4*)(p.x + (size_t)(row0 + rr * NGW) * 1024) + lane;
#pragma unroll
                for (int j = 0; j < 4; ++j) v[rr][j] = xr[64 * j]; }
#pragma unroll
            for (int rr = 0; rr < 4; ++rr) { const int row = row0 + rr * NGW; float s2 = 0.f;
                u32x2* o = (u32x2*)(XB + (size_t)row * 1024) + lane;
#pragma unroll
                for (int j = 0; j < 4; ++j) { const f32x4 t = v[rr][j]; s2 += t[0] * t[0] + t[1] * t[1] + t[2] * t[2] + t[3] * t[3]; u32x2 w; w.x = pk2(t[0], t[1]); w.y = pk2(t[2], t[3]); o[64 * j] = w; }
                s2 = wave_sum(s2);
                if (lane == 0) rA[row] = rsqrtf(s2 * (1.0f / 1024.0f) + EPS); }
        }
    }
    {
        bf16* D1 = (bf16*)(p.ws + OFF_D1); bf16* E3 = (bf16*)(p.ws + OFF_E3);
        const int gt = bid * 512 + tid, NT = G * 512;
        for (int idx = gt; idx < 64 * 2 * 128 * 128; idx += NT) { const int n2 = idx >> 15, sel = (idx >> 14) & 1, k1 = (idx >> 7) & 127, n1 = idx & 127;
            const int ph = (k1 * (64 * n1 + n2)) & 8191; float s, c; sincospif((float)ph * (1.0f / 4096.0f), &s, &c); D1[idx] = (bf16)f2bf(sel ? s : c); }
        for (int idx = gt; idx < 64 * 128; idx += NT) { const int k2 = idx >> 7, col = idx & 127, part = col >> 6, n2 = col & 63;
            const int ph = (n2 * k2) & 63; float s, c; sincospif((float)ph * (1.0f / 32.0f), &s, &c); E3[idx] = (bf16)f2bf(part ? s : c); }
    }
}

typedef short v4s16 __attribute__((ext_vector_type(4)));
__device__ __forceinline__ bf16x8 negbf(bf16x8 v) { u32x4 t = __builtin_bit_cast(u32x4, v); t = t ^ 0x80008000u; return __builtin_bit_cast(bf16x8, t); }
__device__ __forceinline__ bf16x8 tr_frag(const LAS unsigned char* a, int hs) {
    const v4s16 lo = __builtin_amdgcn_ds_read_tr16_b64_v4i16((LAS v4s16*)a), hi = __builtin_amdgcn_ds_read_tr16_b64_v4i16((LAS v4s16*)(a + hs));
    return __builtin_shufflevector(lo, hi, 0, 1, 2, 3, 4, 5, 6, 7);
}
constexpr int F1_P = 264, F1_CS = 256 * F1_P;
__device__ __forceinline__ void fft1_phase(const bf16* PQ, const bf16* D1, bf16* T, LAS unsigned char* lds, int G, int bid) {
    int tid = threadIdx.x; asm volatile("" : "+v"(tid));
    const int lane = tid & 63, wave = __builtin_amdgcn_readfirstlane(tid >> 6), wm = wave & 3, wn = wave >> 2, fr = lane & 15, fq = lane >> 4, tq = fr >> 2, tp = fr & 3;
    for (int pr = bid; pr < 256; pr += G) {
        const int n2 = pr & 63, cb = pr >> 6;
        __syncthreads();
        {
            const bf16* src = D1 + (size_t)n2 * 2 * 128 * 128;
#pragma unroll
            for (int j = 0; j < 8; ++j) { const int q = tid + 512 * j, sel = q >> 11, row = (q >> 4) & 127, cc = q & 15;
                *(LAS u32x4*)(lds + F1_CS + sel * 34816 + row * 272 + cc * 16) = *(const u32x4*)(src + sel * 16384 + row * 128 + 8 * cc); }
        }
        for (int b = 0; b < NB; ++b) {
            __syncthreads();
#pragma unroll
            for (int j = 0; j < 8; ++j) { const int q = tid + 512 * j, row = q >> 4, cc = q & 15, part = row >> 7, n1 = row & 127;
                const u32x4 v = *(const u32x4*)(PQ + ((size_t)(b * SEQ + 64 * n1 + n2)) * 1024 + part * 512 + cb * 128 + 8 * cc);
                LAS u32x2* d = (LAS u32x2*)(lds + row * F1_P + cc * 16); d[0] = (u32x2){v.x, v.y}; d[1] = (u32x2){v.z, v.w}; }
            __syncthreads();
            f32x4 Ar[2][4], Ai[2][4];
#pragma unroll
            for (int mb = 0; mb < 2; ++mb)
#pragma unroll
                for (int nb = 0; nb < 4; ++nb) { Ar[mb][nb] = (f32x4){0.f, 0.f, 0.f, 0.f}; Ai[mb][nb] = (f32x4){0.f, 0.f, 0.f, 0.f}; }
#pragma nounroll
            for (int ks = 0; ks < 8; ++ks) {
                bf16x8 Bf[4];
#pragma unroll
                for (int nb = 0; nb < 4; ++nb) Bf[nb] = tr_frag(lds + (32 * ks + 8 * fq + tq) * F1_P + (64 * wn + 16 * tp + 4 * nb) * 2, 4 * F1_P);
                bf16x8 Cf[2], Sf[2];
#pragma unroll
                for (int mb = 0; mb < 2; ++mb) { const int off = F1_CS + (32 * wm + 16 * mb + fr) * 272 + (32 * (ks & 3) + 8 * fq) * 2; Cf[mb] = *(const LAS bf16x8*)(lds + off); Sf[mb] = *(const LAS bf16x8*)(lds + off + 34816); }
#pragma unroll
                for (int mb = 0; mb < 2; ++mb)
#pragma unroll
                    for (int nb = 0; nb < 4; ++nb) {
                        if (ks < 4) { Ar[mb][nb] = __builtin_amdgcn_mfma_f32_16x16x32_bf16(Bf[nb], Cf[mb], Ar[mb][nb], 0, 0, 0);
                                      Ai[mb][nb] = __builtin_amdgcn_mfma_f32_16x16x32_bf16(Bf[nb], negbf(Sf[mb]), Ai[mb][nb], 0, 0, 0); }
                        else        { Ar[mb][nb] = __builtin_amdgcn_mfma_f32_16x16x32_bf16(Bf[nb], Sf[mb], Ar[mb][nb], 0, 0, 0);
                                      Ai[mb][nb] = __builtin_amdgcn_mfma_f32_16x16x32_bf16(Bf[nb], Cf[mb], Ai[mb][nb], 0, 0, 0); }
                    }
            }
#pragma unroll
            for (int mb = 0; mb < 2; ++mb) { const int k1 = 32 * wm + 16 * mb + fr, c = cb * 128 + 64 * wn + 16 * fq;
                bf16* t0 = T + ((((size_t)(b * 128 + k1) * 2 + 0) * 64 + n2) * 512 + c); bf16* t1 = t0 + 64 * 512;
                *(u32x4*)t0 = pack8(Ar[mb][0], Ar[mb][1]); *(u32x4*)(t0 + 8) = pack8(Ar[mb][2], Ar[mb][3]);
                *(u32x4*)t1 = pack8(Ai[mb][0], Ai[mb][1]); *(u32x4*)(t1 + 8) = pack8(Ai[mb][2], Ai[mb][3]); }
        }
    }
    __syncthreads();
}

constexpr int F3_P = 1032;
__device__ __forceinline__ void fft3_phase(const bf16* T, const bf16* E3, bf16* AO, LAS unsigned char* lds, int G, int bid) {
    int tid = threadIdx.x; asm volatile("" : "+v"(tid));
    const int lane = tid & 63, wave = __builtin_amdgcn_readfirstlane(tid >> 6), fr = lane & 15, fq = lane >> 4, tq = fr >> 2, tp = fr & 3;
    LAS float* red = (LAS float*)(lds + 128 * F3_P);
    for (int unit = bid; unit < 512; unit += G) {
        const int b = unit >> 7, k1 = unit & 127;
        __syncthreads();
        const bf16* src = T + (size_t)unit * 65536;
#pragma unroll
        for (int j = 0; j < 16; ++j) { const int q = tid + 512 * j, row = q >> 6, cc = q & 63;
            const u32x4 v = *(const u32x4*)(src + row * 512 + cc * 8);
            LAS u32x2* d = (LAS u32x2*)(lds + row * F3_P + cc * 16); d[0] = (u32x2){v.x, v.y}; d[1] = (u32x2){v.z, v.w}; }
        __syncthreads();
        f32x4 acc[4][4];
#pragma unroll
        for (int mb = 0; mb < 4; ++mb)
#pragma unroll
            for (int nb = 0; nb < 4; ++nb) acc[mb][nb] = (f32x4){0.f, 0.f, 0.f, 0.f};
        bf16x8 Ef[4];
#pragma unroll
        for (int mb = 0; mb < 4; ++mb) Ef[mb] = *(const bf16x8*)(E3 + (16 * mb + fr) * 128 + 8 * fq);
#pragma nounroll
        for (int ks = 0; ks < 4; ++ks) {
            bf16x8 Bf[4], En[4];
            const int kn = ks < 3 ? ks + 1 : 3;
#pragma unroll
            for (int mb = 0; mb < 4; ++mb) En[mb] = *(const bf16x8*)(E3 + (16 * mb + fr) * 128 + 32 * kn + 8 * fq);
#pragma unroll
            for (int nb = 0; nb < 4; ++nb) Bf[nb] = tr_frag(lds + (32 * ks + 8 * fq + tq) * F3_P + (64 * wave + 16 * tp + 4 * nb) * 2, 4 * F3_P);
#pragma unroll
            for (int mb = 0; mb < 4; ++mb)
#pragma unroll
                for (int nb = 0; nb < 4; ++nb) acc[mb][nb] = __builtin_amdgcn_mfma_f32_16x16x32_bf16(Bf[nb], Ef[mb], acc[mb][nb], 0, 0, 0);
#pragma unroll
            for (int mb = 0; mb < 4; ++mb) Ef[mb] = En[mb];
        }
#pragma unroll
        for (int mb = 0; mb < 4; ++mb) { float s = 0.f;
#pragma unroll
            for (int nb = 0; nb < 4; ++nb)
#pragma unroll
                for (int j = 0; j < 4; ++j) s += acc[mb][nb][j] * acc[mb][nb][j];
            s += __shfl_xor(s, 16); s += __shfl_xor(s, 32);
            if (fq == 0) red[wave * 64 + 16 * mb + fr] = s; }
        __syncthreads();
#pragma unroll
        for (int mb = 0; mb < 4; ++mb) { float tot = 0.f;
#pragma unroll
            for (int w = 0; w < 8; ++w) tot += red[w * 64 + 16 * mb + fr];
            const float rinv = rsqrtf(tot * (1.0f / 512.0f) + EPS);
            const size_t token = (size_t)b * SEQ + k1 + 128 * (16 * mb + fr);
            bf16* o = AO + token * 1024 + 64 * wave + 16 * fq;
            *(u32x4*)o = pack8(acc[mb][0] * rinv, acc[mb][1] * rinv); *(u32x4*)(o + 8) = pack8(acc[mb][2] * rinv, acc[mb][3] * rinv); }
    }
    __syncthreads();
}

__device__ __forceinline__ void carry_phase(const Params& p, int ly, const float* Sloc, bf16* UB, LAS unsigned char* lds, int G, int bid) {
    int tid = threadIdx.x; asm volatile("" : "+v"(tid));
    const int lane = tid & 63, wave = __builtin_amdgcn_readfirstlane(tid >> 6);
    LAS f32x2* ex = (LAS f32x2*)lds;
    for (int w = bid; w < 256; w += G) {
        const int dir = w & 1, g = (w >> 1) & 31, b = w >> 6, pp = lane; const int idx = (ly * 2 + dir) * 32 + g;
        const float dt = expf(p.log_dt[idx]); const float lr = p.lam_re[idx * 64 + pp] * dt * 16.0f, li = p.lam_im[idx * 64 + pp] * dt * 16.0f;
        const float e = expf(lr); float sn, cs; sincosf(li, &sn, &cs); const float l_r = e * cs, l_i = e * sn;
        float Lr = l_r, Li = l_i;
#pragma unroll
        for (int k = 0; k < 6; ++k) { const float nr = Lr * Lr - Li * Li, ni = 2.0f * Lr * Li; Lr = nr; Li = ni; }
        const float* src = Sloc + ((size_t)(g * 2048 + b * 512)) * 256 + dir * 128 + 2 * pp;
        bf16* dst = UB + ((size_t)(g * 2048 + b * 512)) * 512 + 256 + dir * 128 + 2 * pp;
        const int ss0 = dir == 0 ? wave * 64 : 511 - wave * 64; const long stp = dir == 0 ? 256 : -256;
        float cr = 0.f, ci = 0.f;
        { const float* ptr = src + (size_t)ss0 * 256;
#pragma nounroll
          for (int hb = 0; hb < 2; ++hb) {
            f32x2 v[32];
#pragma unroll
            for (int j = 0; j < 32; ++j) { v[j] = *(const f32x2*)ptr; ptr += stp; }
#pragma unroll
            for (int j = 0; j < 32; ++j) { const float nr = l_r * cr - l_i * ci + v[j][0], ni = l_r * ci + l_i * cr + v[j][1]; cr = nr; ci = ni; }
          } }
        __syncthreads();
        ex[wave * 64 + lane] = (f32x2){cr, ci};
        __syncthreads();
        cr = 0.f; ci = 0.f;
        for (int u = 0; u < wave; ++u) { const f32x2 eu = ex[u * 64 + lane]; const float nr = Lr * cr - Li * ci + eu[0], ni = Lr * ci + Li * cr + eu[1]; cr = nr; ci = ni; }
        { const float* ptr = src + (size_t)ss0 * 256; bf16* dp = dst + (size_t)ss0 * 512;
#pragma nounroll
          for (int hb = 0; hb < 2; ++hb) {
            f32x2 v[32];
#pragma unroll
            for (int j = 0; j < 32; ++j) { v[j] = *(const f32x2*)ptr; ptr += stp; }
#pragma unroll
            for (int j = 0; j < 32; ++j) {
                *(unsigned*)dp = pk2(cr, ci); dp += 2 * stp;
                const float nr = l_r * cr - l_i * ci + v[j][0], ni = l_r * ci + l_i * cr + v[j][1]; cr = nr; ci = ni; }
          } }
    }
    __syncthreads();
}

__device__ __forceinline__ void norm_phase(float* out, const bf16* MF, const float* ss, const float* gain, bf16* XB, float* rnext, bool last, int G, int bid) {
    int tid = threadIdx.x; asm volatile("" : "+v"(tid));
    const int lane = tid & 63, wave = __builtin_amdgcn_readfirstlane(tid >> 6);
    const int gw = bid * 8 + wave, NGW = G * 8;
    const f32x4* gr = (const f32x4*)gain + lane;
    const f32x4 g0 = gr[0], g1 = gr[64], g2 = gr[128], g3 = gr[192];
    for (int row0 = gw; row0 < MT; row0 += 2 * NGW) {
        u32x2 xv[2][4], mv[2][4]; float tot[2];
#pragma unroll
        for (int rr = 0; rr < 2; ++rr) { const int row = row0 + rr * NGW;
            const u32x2* xr = (const u32x2*)(XB + (size_t)row * 1024) + lane; const u32x2* mr = (const u32x2*)(MF + (size_t)row * 1024) + lane;
#pragma unroll
            for (int j = 0; j < 4; ++j) { xv[rr][j] = xr[64 * j]; mv[rr][j] = mr[64 * j]; }
            const f32x4* sp = (const f32x4*)(ss + (size_t)row * 16); const f32x4 s0 = sp[0], s1 = sp[1], s2 = sp[2], s3 = sp[3];
            tot[rr] = ((((s0[0] + s0[1]) + s0[2]) + s0[3]) + (((s1[0] + s1[1]) + s1[2]) + s1[3])) + ((((s2[0] + s2[1]) + s2[2]) + s2[3]) + (((s3[0] + s3[1]) + s3[2]) + s3[3])); }
#pragma unroll
        for (int rr = 0; rr < 2; ++rr) { const int row = row0 + rr * NGW;
            const float rinv = rsqrtf(tot[rr] * (1.0f / 1024.0f) + EPS); float s2 = 0.f;
#pragma unroll
            for (int j = 0; j < 4; ++j) { const f32x4 gg = j == 0 ? g0 : (j == 1 ? g1 : (j == 2 ? g2 : g3)); const u32x2 xx = xv[rr][j], mm = mv[rr][j]; f32x4 v;
                v[0] = bflo(xx.x) + bflo(mm.x) * rinv * gg[0]; v[1] = bfhi(xx.x) + bfhi(mm.x) * rinv * gg[1]; v[2] = bflo(xx.y) + bflo(mm.y) * rinv * gg[2]; v[3] = bfhi(xx.y) + bfhi(mm.y) * rinv * gg[3];
                if (last) { ((f32x4*)(out + (size_t)row * 1024) + lane)[64 * j] = v; }
                else { u32x2 w; w.x = pk2(v[0], v[1]); w.y = pk2(v[2], v[3]); ((u32x2*)(XB + (size_t)row * 1024) + lane)[64 * j] = w;
                       const float a0 = bflo(w.x), a1 = bfhi(w.x), a2 = bflo(w.y), a3 = bfhi(w.y); s2 += a0 * a0 + a1 * a1 + a2 * a2 + a3 * a3; } }
            if (!last) { s2 = wave_sum(s2); if (lane == 0) rnext[row] = rsqrtf(s2 * (1.0f / 1024.0f) + EPS); } }
    }
}
__device__ __forceinline__ void rescale_phase(bf16* AO, const float* ss, int G, int bid) {
    int tid = threadIdx.x; asm volatile("" : "+v"(tid));
    const int lane = tid & 63, wave = __builtin_amdgcn_readfirstlane(tid >> 6);
    const int gw = bid * 8 + wave, NGW = G * 8;
    for (int row = gw; row < MT; row += NGW) {
        float tot = 0.f;
#pragma unroll
        for (int k = 0; k < 8; ++k) tot += ss[row * 8 + k];
        const float rinv = rsqrtf(tot * (1.0f / 512.0f) + EPS);
        u32x4* ptr = (u32x4*)(AO + (size_t)row * 1024 + 512) + lane; u32x4 v = *ptr;
        v.x = pk2(bflo(v.x) * rinv, bfhi(v.x) * rinv); v.y = pk2(bflo(v.y) * rinv, bfhi(v.y) * rinv); v.z = pk2(bflo(v.z) * rinv, bfhi(v.z) * rinv); v.w = pk2(bflo(v.w) * rinv, bfhi(v.w) * rinv);
        *ptr = v;
    }
}


#define XB_TMO      128
#define XB_XCNT(j)  (256  + 64 * (j))
#define XB_XSUB(j)  (1280 + 64 * (j))
#define XB_XGEN(j)  (2304 + 64 * (j))
#define XB_TOP      3328
#define XB_TOPGEN   3392
#define XCD_BAR_WORDS 3456
#define XB_SPIN_CAP (1u << 18)
__device__ __forceinline__ unsigned xb_ld(unsigned* p)              { return __hip_atomic_load(p, __ATOMIC_RELAXED, __HIP_MEMORY_SCOPE_AGENT); }
__device__ __forceinline__ unsigned xb_add(unsigned* p, unsigned v) { return __hip_atomic_fetch_add(p, v, __ATOMIC_RELAXED, __HIP_MEMORY_SCOPE_AGENT); }
__device__ __forceinline__ unsigned xb_xcc_id() { return (unsigned)__builtin_amdgcn_s_getreg((3 << 11) | 20) & 0xFu; }
#define XB_SPIN(cond, bar) do { unsigned _sp = 0; while (cond) { __builtin_amdgcn_s_sleep(1); \
    if ((++_sp & 255u) == 0u) { if (xb_ld(&(bar)[XB_TMO])) break; if (_sp > XB_SPIN_CAP) { atomicAdd(&(bar)[XB_TMO], 1u); break; } } } } while (0)
struct XcdBarrier { unsigned* bar; unsigned x; volatile LAS unsigned* st; };
__device__ __forceinline__ XcdBarrier xcd_barrier_post(unsigned* bar, volatile LAS unsigned* st) {
    XcdBarrier b; b.bar = bar; b.x = xb_xcc_id(); b.st = st;
    if (threadIdx.x == 0) (void)xb_add(&bar[XB_XCNT(b.x)], 1u);
    return b;
}
__device__ __forceinline__ void xcd_barrier_complete(unsigned* bar, unsigned x, unsigned& nloc, unsigned& nx) {
    const unsigned G = gridDim.x * gridDim.y * gridDim.z;
    unsigned sum, cnt, mine, sp = 0u;
    for (;;) {
        sum = 0u; cnt = 0u; mine = 0u;
#pragma unroll
        for (unsigned j = 0; j < 16; ++j) { const unsigned c = xb_ld(&bar[XB_XCNT(j)]); sum += c; cnt += (c > 0u) ? 1u : 0u; mine = (j == x) ? c : mine; }
        if (sum == G) break;
        __builtin_amdgcn_s_sleep(1);
        if ((++sp & 255u) == 0u) { if (xb_ld(&bar[XB_TMO])) break; if (sp > XB_SPIN_CAP) { atomicAdd(&bar[XB_TMO], 1u); break; } }
    }
    nloc = mine > 0u ? mine : 1u; nx = cnt > 0u ? cnt : 1u;
}
__device__ __forceinline__ void xcd_barrier(const XcdBarrier& b) {
    asm volatile("s_waitcnt vmcnt(0)" ::: "memory");
    __syncthreads();
    if (threadIdx.x == 0) {
        unsigned* bar = b.bar;
        __builtin_amdgcn_s_waitcnt(0);
        unsigned nloc = b.st[0], nx = b.st[1];
        if (nloc == 0u) { xcd_barrier_complete(bar, b.x, nloc, nx); b.st[0] = nloc; b.st[1] = nx; }
        const unsigned old = xb_add(&bar[XB_XSUB(b.x)], 1u);
        const unsigned gen = old / nloc;
        if (old + 1u == (gen + 1u) * nloc) {
            __builtin_amdgcn_fence(__ATOMIC_RELEASE, "agent");
            asm volatile("s_waitcnt vmcnt(0)" ::: "memory");
            const unsigned og = xb_add(&bar[XB_TOP], 1u);
            const unsigned tg = og / nx;
            if (og + 1u == (tg + 1u) * nx) xb_add(&bar[XB_TOPGEN], 1u);
            else XB_SPIN(xb_ld(&bar[XB_TOPGEN]) == tg, bar);
            __builtin_amdgcn_fence(__ATOMIC_ACQUIRE, "agent");
            xb_add(&bar[XB_XGEN(b.x)], 1u);
            asm volatile("s_waitcnt vmcnt(0)" ::: "memory");
        } else {
            XB_SPIN(xb_ld(&bar[XB_XGEN(b.x)]) == gen, bar);
            __builtin_amdgcn_fence(__ATOMIC_ACQUIRE, "agent");
            asm volatile("s_waitcnt vmcnt(0)" ::: "memory");
        }
    }
    __syncthreads();
}

#ifndef REP_P0
#define REP_P0 1
#endif
#ifndef REP_SYNC
#define REP_SYNC 1
#endif
#ifndef REP_MASK_V
#define REP_MASK_V 0u
#endif
constexpr unsigned REP_MASK = REP_MASK_V;
constexpr int PH_PER_LAYER = 10, N_PHASES = 1 + 2 * PH_PER_LAYER;
__global__ void __launch_bounds__(512) hybrid_fwd(Params p) {
    extern __shared__ __attribute__((aligned(16))) unsigned char lds_raw[];
    LAS unsigned char* lds = (LAS unsigned char*)lds_raw;
    cg::grid_group grid = cg::this_grid();
    volatile LAS unsigned* xst = (volatile LAS unsigned*)(lds + LDS_BYTES - 16);
    if (threadIdx.x < 4) xst[threadIdx.x] = 0u;
    __syncthreads();
    const XcdBarrier xbar = xcd_barrier_post((unsigned*)(p.ws + OFF_BAR), xst);
    if (p.ph_hi > 1000) grid.sync();
    const int Gk = gridDim.x, bk = blockIdx.x;
    unsigned char* ws = p.ws;
    float* sss = (float*)(ws + OFF_SSS); float* ssm = (float*)(ws + OFF_SSM); float* ssf = (float*)(ws + OFF_SSF); float* rA = (float*)(ws + OFF_RA); float* rB = (float*)(ws + OFF_RB);
    bf16* XB = (bf16*)(ws + OFF_XB); bf16* MF = (bf16*)(ws + OFF_MF); bf16* GB = (bf16*)(ws + OFF_G); bf16* HB = (bf16*)(ws + OFF_H);
    bf16* PQ = (bf16*)(ws + OFF_PQ); bf16* AO = (bf16*)(ws + OFF_AO); bf16* UB = (bf16*)(ws + OFF_UB); bf16* TB = (bf16*)(ws + OFF_T); float* SL = (float*)(ws + OFF_SLOC);

#pragma nounroll
    for (int ph = p.ph_lo; ph < p.ph_hi; ++ph) {
        int G = Gk, bid = bk; asm volatile("" : "+s"(G), "+s"(bid));
        if (ph == 0) { for (int rep = 0; rep < REP_P0; ++rep) p0_prologue(p, lds, G, bid); }
        else {
            const int ly = (ph - 1) / PH_PER_LAYER, sp = (ph - 1) % PH_PER_LAYER;
            unsigned char* wb = ws + OFF_W + (size_t)ly * W_LAYER;
            pg8::Order S;
            const int nrep = ((REP_MASK >> sp) & 1u) ? 2 : 1;
            for (int rep = 0; rep < nrep; ++rep)
            switch (sp) {
            case 0: {
                pg8::Gemm g{XB, (const bf16*)(wb + W_IN), MT, NIN, 1024, 1024, 1024, 0, 0, 1}; S.init(MT, NIN, 1, G, bid);
                EpiIn E{PQ, UB, rA}; pg8::gemm_phase<EpiIn>(lds, g, S, E); } break;
            case 1: {
                fft1_phase(PQ, (const bf16*)(ws + OFF_D1), TB, lds, G, bid);
                pg8::Gemm g{UB, (const bf16*)(ws + OFF_MST) + (size_t)ly * 32 * 256 * 256, 2048, 256, 256, 512, 256, (size_t)2048 * 512, (size_t)256 * 256, 32}; S.init(2048, 256, 32, G, bid);
                EpiSloc E{SL}; pg8::gemm_phase<EpiSloc>(lds, g, S, E); } break;
            case 2: {
                carry_phase(p, ly, SL, UB, lds, G, bid);
                fft3_phase(TB, (const bf16*)(ws + OFF_E3), AO, lds, G, bid); } break;
            case 3: {
                pg8::Gemm g{UB, (const bf16*)(ws + OFF_TM) + (size_t)ly * 32 * 256 * 512, 2048, 256, 512, 512, 512, (size_t)2048 * 512, (size_t)256 * 512, 32}; S.init(2048, 256, 32, G, bid);
                EpiSsmOut E{GB}; pg8::gemm_phase<EpiSsmOut>(lds, g, S, E); } break;
            case 4: {
                pg8::Gemm g{GB, (const bf16*)(wb + W_GLU), MT, 512, 512, 512, 512, 0, 0, 1}; S.init(MT, 512, 1, G, bid);
                EpiGlu E{GB, p.b_glu + ly * 512, AO, sss}; pg8::gemm_phase<EpiGlu>(lds, g, S, E); } break;
            case 5: {
                pg8::Gemm g{AO, (const bf16*)(wb + W_OUT), MT, 1024, 1024, 1024, 1024, 0, 0, 1}; S.init(MT, 1024, 1, G, bid);
                LAS float* qv = (LAS float*)(lds + 131072);
                { int tid = threadIdx.x; asm volatile("" : "+v"(tid));
                  for (int i = 0; i < 4; ++i) { pg8::Unit u; if (!S.next(i, u)) break;
                      if (tid < 256) { const f32x4* sp = (const f32x4*)(sss + (size_t)(u.pm * 256 + tid) * 8); const f32x4 a = sp[0], b = sp[1];
                          const float ms = ((((a[0] + a[1]) + a[2]) + a[3]) + (((b[0] + b[1]) + b[2]) + b[3])) * (1.0f / 512.0f) + EPS;
                          qv[i * 256 + tid] = sqrtf(ms); qv[1024 + i * 256 + tid] = rsqrtf(ms); } }
                  __syncthreads(); }
                EpiOutMix E{MF, ssm, qv}; pg8::gemm_phase<EpiOutMix>(lds, g, S, E); } break;
            case 6: norm_phase(p.out, MF, ssm, p.post_mix_g + ly * 1024, XB, rB, false, G, bid); break;
            case 7: {
                pg8::Gemm g{XB, (const bf16*)(wb + W_1), MT, DFF, 1024, 1024, 1024, 0, 0, 1}; S.init(MT, DFF, 1, G, bid);
                EpiFF1 E{HB, rB}; pg8::gemm_phase<EpiFF1>(lds, g, S, E); } break;
            case 8: {
                pg8::Gemm g{HB, (const bf16*)(wb + W_2), MT, 1024, DFF, DFF, DFF, 0, 0, 1}; S.init(MT, 1024, 1, G, bid);
                EpiOutSS E{MF, ssf}; pg8::gemm_phase<EpiOutSS>(lds, g, S, E); } break;
            case 9: norm_phase(p.out, MF, ssf, p.post_mlp_g + ly * 1024, XB, rA, ly == 1, G, bid); break;
            }
        }
        if (ph + 1 < p.ph_hi) for (int rep = 0; rep < REP_SYNC; ++rep) xcd_barrier(xbar);
    }
}

extern "C" void kernel_launch(void* const* d_in, const int* in_sizes, int n_in, void* d_out, int out_size, void* d_ws, size_t ws_size, hipStream_t stream) {
    static int grid = 0;
    if (grid == 0) {
        if (n_in != 22 || ws_size < WS_END) { fprintf(stderr, "kernel_launch: unexpected n_in %d or ws_size %zu (< %zu)\n", n_in, ws_size, (size_t)WS_END); grid = -1; return; }
        int dev = 0, cus = 0, per_cu = 0;
        hipGetDevice(&dev); hipDeviceGetAttribute(&cus, hipDeviceAttributeMultiprocessorCount, dev);
        if (hipFuncSetAttribute((const void*)hybrid_fwd, hipFuncAttributeMaxDynamicSharedMemorySize, LDS_BYTES) != hipSuccess) { fprintf(stderr, "kernel_launch: hipFuncSetAttribute failed\n"); grid = -1; return; }
        if (hipOccupancyMaxActiveBlocksPerMultiprocessor(&per_cu, (const void*)hybrid_fwd, 512, LDS_BYTES) != hipSuccess || per_cu < 1) { fprintf(stderr, "kernel_launch: occupancy query says %d blocks per CU\n", per_cu); per_cu = 1; }
        (void)hipGetLastError();
        grid = cus;
    }
    if (grid < 0) return;
    if (hipMemsetAsync((char*)d_ws + OFF_BAR, 0, BAR_BYTES, stream) != hipSuccess) { fprintf(stderr, "kernel_launch: memset of the barrier words failed\n"); return; }
    Params p{};
    const float** f = (const float**)&p;
    for (int i = 0; i < 22; ++i) f[i] = (const float*)d_in[i];
    p.out = (float*)d_out; p.ws = (unsigned char*)d_ws; p.ph_lo = 0; p.ph_hi = N_PHASES;
    void* args[] = {&p};
    hipError_t e = hipLaunchCooperativeKernel((const void*)hybrid_fwd, dim3(grid), dim3(512), args, LDS_BYTES, stream);
    if (e != hipSuccess) fprintf(stderr, "kernel_launch: cooperative launch failed: %s (grid %d)\n", hipGetErrorString(e), grid);
}
```

```cpp
#include <hip/hip_runtime.h>
#include <hip/hip_cooperative_groups.h>
#include <cstdio>
namespace cg = cooperative_groups;

#define P0_REP_A 1
#define P0_REP_F 1
#define P0_REP_S 1
#define P0_REP_B 1
#define P0_REP_C 1
#define LAS __attribute__((address_space(3)))
typedef unsigned short bf16;
typedef short bf16x8 __attribute__((ext_vector_type(8)));
typedef float f32x4 __attribute__((ext_vector_type(4)));
typedef float f32x2 __attribute__((ext_vector_type(2)));
typedef unsigned u32x4 __attribute__((ext_vector_type(4)));
typedef unsigned u32x2 __attribute__((ext_vector_type(2)));

constexpr int NB = 4, SEQ = 8192, DM = 1024, MT = NB * SEQ, DFO = 512, NHEAD = 8, SG = 32, SP = 64, DFF = 4096, NIN = 1536;
constexpr float EPS = 1e-6f;
constexpr int LDS_BYTES = 147456;
constexpr size_t MiB = 1u << 20;
constexpr size_t OFF_RA = 384 * 1024, OFF_RB = 512 * 1024, OFF_BAR = 640 * 1024, BAR_BYTES = 16384;
constexpr size_t OFF_E3 = 1 * MiB, OFF_D1 = 2 * MiB, OFF_TM = 6 * MiB, OFF_MST = 22 * MiB, OFF_W = 30 * MiB;
constexpr size_t W_IN = 0, W_OUT = 3 * MiB, W_1 = 5 * MiB, W_2 = 13 * MiB, W_GLU = 21 * MiB, W_LAYER = 22 * MiB;
constexpr size_t OFF_XB = 76 * MiB, OFF_MF = 140 * MiB, OFF_G = 140 * MiB, OFF_H = 204 * MiB;
constexpr size_t OFF_PQ = 204 * MiB, OFF_AO = 204 * MiB, OFF_UB = 268 * MiB, OFF_T = 332 * MiB, OFF_SLOC = 396 * MiB, OFF_SSS = 460 * MiB, OFF_SSM = 461 * MiB, OFF_SSF = 463 * MiB, WS_END = 465 * MiB;

struct Params {
    const float *x, *w_in, *w_out, *pre_mix_g, *post_mix_g, *pre_mlp_g, *post_mlp_g, *fourier_out_g, *ssm_out_g, *w_fourier,
        *lam_re, *lam_im, *log_dt, *b_re, *b_im, *c_re, *c_im, *d_skip, *w_glu, *b_glu, *w_ff1, *w_ff2;
    float* out; unsigned char* ws;
    int ph_lo, ph_hi;
};

__device__ __forceinline__ unsigned f2bf(float f) { unsigned u = __builtin_bit_cast(unsigned, f); return (u + 0x7fffu + ((u >> 16) & 1u)) >> 16; }
__device__ __forceinline__ unsigned pk2(float lo, float hi) { return f2bf(lo) | (f2bf(hi) << 16); }
__device__ __forceinline__ float bflo(unsigned w) { return __builtin_bit_cast(float, w << 16); }
__device__ __forceinline__ float bfhi(unsigned w) { return __builtin_bit_cast(float, w & 0xffff0000u); }
__device__ __forceinline__ float wave_sum(float v) {
#pragma unroll
    for (int o = 1; o < 64; o <<= 1) v += __shfl_xor(v, o);
    return v;
}
__device__ __forceinline__ float gelu_t(float x) { const float u = 0.7978845608f * (x + 0.044715f * x * x * x); return x / (1.0f + __expf(-2.0f * u)); }
__device__ __forceinline__ float sigm(float v) { return 1.0f / (1.0f + __expf(-v)); }

namespace pg8 {
#define PG8_LAS __attribute__((address_space(3)))
typedef unsigned short bf16_t;
constexpr int BM = 256, BK = 64, HALF = 128, HTB = HALF * BK * 2, STAGE_BYTES = 8 * HTB, NXCD = 8, WGM = 8;
__host__ __device__ __forceinline__ int lds_byte(int r, int c) { const int st = (r >> 4) * 2 + (c >> 5), rr = r & 15, cc = c & 31, ob = rr * 64 + cc * 2; return st * 1024 + (ob ^ (((ob >> 9) & 1) << 5)); }
__host__ __device__ __forceinline__ void stage_rc(int b, int& R, int& C) { const int st = b / 1024, sb = b % 1024, swz = sb ^ (((sb >> 9) & 1) << 5); R = (st >> 1) * 16 + swz / 64; C = (st & 1) * 32 + (swz % 64) / 2; }
__host__ __device__ __forceinline__ int perm32(int rho) { const int n = rho >> 4, i = rho & 15; return 8 * (i >> 2) + 4 * n + (i & 3); }

struct Unit { int pm, pn, z, ui; };
struct Gemm { const bf16_t* A; const bf16_t* Bt; int M, N, K, lda, ldb; size_t sA, sB; int nZ; };

struct Order {
    int nM, nN, nwg, nZ, G, c;
    __device__ void init(int M, int N, int nZ_, int G_, int c_) { nM = M / BM; nN = N / BM; nwg = nM * nN; nZ = nZ_; G = G_; c = c_; }
    __device__ bool next(int i, Unit& u) const {
        const long L = (long)i * G + c; if (L >= (long)nwg * nZ) return false;
        u.ui = i;
        if (nZ > 1 && (nZ % NXCD) == 0) {
            const int xcd = (int)(L % NXCD), idx = (int)(L / NXCD); u.z = xcd * (nZ / NXCD) + idx / nwg; const int wg = idx % nwg; u.pm = wg % nM; u.pn = wg / nM; return true; }
        u.z = (int)(L / nwg);
        int wgid = (int)(L % nwg); { const int q = nwg / NXCD, r = nwg % NXCD, xcd = wgid % NXCD, off = wgid / NXCD; wgid = (xcd < r ? xcd * (q + 1) : r * (q + 1) + (xcd - r) * q) + off; }
        const int nig = WGM * nN, gid = wgid / nig, fm = gid * WGM, gsz = (nM - fm) < WGM ? (nM - fm) : WGM;
        u.pm = fm + ((wgid % nig) % gsz); u.pn = (wgid % nig) / gsz; return true;
    }
};

template <class Epi>
__device__ __forceinline__ void gemm_phase(PG8_LAS unsigned char* lds, const Gemm g, const Order& S, const Epi& E) {
    int tid = threadIdx.x; asm volatile("" : "+v"(tid));
    const int wid = __builtin_amdgcn_readfirstlane(tid >> 6), lane = tid & 63, wr = wid >> 2, wc = wid & 3, fr = lane & 15, fq = lane >> 4;
    const int K = g.K, nt = K / BK;
    unsigned voffA[2], voffB[2];
#pragma unroll
    for (int i = 0; i < 2; ++i) { int R, C; stage_rc(tid * 16 + i * 8192, R, C); const int Rb = Epi::PERM ? ((R & ~31) + perm32(R & 31)) : R;
        voffA[i] = (unsigned)(R * g.lda + C) * 2u; voffB[i] = (unsigned)(Rb * g.ldb + C) * 2u; }
    const size_t kstep = (size_t)(BK * 2);
    const size_t hA = (size_t)HALF * g.lda * 2, hB = (size_t)HALF * g.ldb * 2;
    const size_t tA = 2 * hA, tB = 2 * hB;
    const unsigned ldsw = (unsigned)wid * 1024u;
    const int aoff = lds_byte(wr * 64 + fr, fq * 8), boff = lds_byte(wc * 32 + fr, fq * 8);
#define PG8_SA(b, h) (((b) * 2 + (h)) * HTB)
#define PG8_SB(b, h) ((4 + (b) * 2 + (h)) * HTB)
#define PG8_STAGE(bufoff, gbase, voff) do { _Pragma("unroll") for (int _i = 0; _i < 2; ++_i) \
        __builtin_amdgcn_global_load_lds((const unsigned*)((const char*)(gbase) + (voff)[_i]), (PG8_LAS unsigned*)(lds + (bufoff) + ldsw + _i * 8192), 16, 0, 0); } while (0)
#define PG8_LDA(dst, b, h) do { _Pragma("unroll") for (int m = 0; m < 4; ++m) _Pragma("unroll") for (int k = 0; k < 2; ++k) dst[m][k] = *(const PG8_LAS bf16x8*)(lds + PG8_SA(b, h) + aoff + m * 2048 + k * 1024); } while (0)
#define PG8_LDB(dst, b, h) do { _Pragma("unroll") for (int n = 0; n < 2; ++n) _Pragma("unroll") for (int k = 0; k < 2; ++k) dst[n][k] = *(const PG8_LAS bf16x8*)(lds + PG8_SB(b, h) + boff + n * 2048 + k * 1024); } while (0)
#define PG8_MMA(ai, bj, At, Bt) do { __builtin_amdgcn_s_setprio(1); _Pragma("unroll") for (int m = 0; m < 4; ++m) _Pragma("unroll") for (int n = 0; n < 2; ++n) _Pragma("unroll") for (int k = 0; k < 2; ++k) \
        acc[ai][bj][m][n] = __builtin_amdgcn_mfma_f32_16x16x32_bf16(Bt[n][k], At[m][k], acc[ai][bj][m][n], 0, 0, 0); __builtin_amdgcn_s_setprio(0); } while (0)
#define PG8_WAIT_V(n) asm volatile("s_waitcnt vmcnt(" #n ")" ::: "memory")
#define PG8_WAIT_L(n) asm volatile("s_waitcnt lgkmcnt(" #n ")" ::: "memory")
#define PG8_BAR __builtin_amdgcn_s_barrier()
#define PG8_SCHED __builtin_amdgcn_sched_barrier(0)
    Unit cur, nxt; int ui = 0;
    if (!S.next(0, cur)) return;
    f32x4 acc[2][2][4][2];
#pragma unroll
    for (int a = 0; a < 2; ++a)
#pragma unroll
        for (int b = 0; b < 2; ++b)
#pragma unroll
            for (int m = 0; m < 4; ++m)
#pragma unroll
                for (int n = 0; n < 2; ++n) acc[a][b][m][n] = (f32x4){0.f, 0.f, 0.f, 0.f};
    bf16x8 At[4][2], B0[2][2], B1[2][2];
    const char* cA = (const char*)g.A + ((size_t)cur.z * g.sA) * 2 + (size_t)cur.pm * tA; const char* cB = (const char*)g.Bt + ((size_t)cur.z * g.sB) * 2 + (size_t)cur.pn * tB;
    PG8_STAGE(PG8_SB(0, 0), cB, voffB); PG8_STAGE(PG8_SA(0, 0), cA, voffA); PG8_STAGE(PG8_SB(0, 1), cB + hB, voffB); PG8_STAGE(PG8_SA(0, 1), cA + hA, voffA);
    if (wr == 1) PG8_BAR;
    PG8_WAIT_V(4); PG8_BAR;
    PG8_STAGE(PG8_SB(1, 0), cB + kstep, voffB); PG8_STAGE(PG8_SA(1, 0), cA + kstep, voffA); PG8_STAGE(PG8_SB(1, 1), cB + hB + kstep, voffB);
    PG8_WAIT_V(6); PG8_BAR;
    for (;;) {
        const bool has_next = S.next(ui + 1, nxt);
        const char* nA = has_next ? (const char*)g.A + ((size_t)nxt.z * g.sA) * 2 + (size_t)nxt.pm * tA : cA; const char* nB = has_next ? (const char*)g.Bt + ((size_t)nxt.z * g.sB) * 2 + (size_t)nxt.pn * tB : cB;
        for (int t = 0; t < nt; t += 2) {
            const bool last = (t == nt - 2);
            if constexpr (Epi::MID) { if (t == (nt >> 1)) E.mid(acc, cur, wr, fr); }
            const char* a1 = cA + (size_t)(t + 1) * kstep;
            const char* a2 = last ? nA : cA + (size_t)(t + 2) * kstep; const char* b2 = last ? nB : cB + (size_t)(t + 2) * kstep;
            const char* a3 = a2 + kstep; const char* b3 = b2 + kstep;
            PG8_LDB(B0, 0, 0); PG8_SCHED; PG8_LDA(At, 0, 0); PG8_STAGE(PG8_SA(1, 1), a1 + hA, voffA);
            PG8_WAIT_L(8); PG8_BAR; PG8_WAIT_L(0); PG8_MMA(0, 0, At, B0); PG8_BAR; PG8_SCHED;
            PG8_LDB(B1, 0, 1); PG8_STAGE(PG8_SB(0, 0), b2, voffB);
            PG8_BAR; PG8_WAIT_L(0); PG8_MMA(0, 1, At, B1); PG8_BAR;
            PG8_LDA(At, 0, 1); PG8_STAGE(PG8_SA(0, 0), a2, voffA);
            PG8_BAR; PG8_WAIT_L(0); PG8_MMA(1, 0, At, B0); PG8_BAR; PG8_SCHED;
            PG8_STAGE(PG8_SB(0, 1), b2 + hB, voffB);
            PG8_WAIT_V(6); PG8_BAR; PG8_MMA(1, 1, At, B1); PG8_BAR;
            PG8_LDB(B0, 1, 0); PG8_SCHED; PG8_LDA(At, 1, 0); PG8_STAGE(PG8_SA(0, 1), a2 + hA, voffA);
            PG8_WAIT_L(8); PG8_BAR; PG8_WAIT_L(0); PG8_MMA(0, 0, At, B0); PG8_BAR; PG8_SCHED;
            PG8_LDB(B1, 1, 1); PG8_STAGE(PG8_SB(1, 0), b3, voffB);
            PG8_BAR; PG8_WAIT_L(0); PG8_MMA(0, 1, At, B1); PG8_BAR;
            PG8_LDA(At, 1, 1); PG8_STAGE(PG8_SA(1, 0), a3, voffA);
            PG8_BAR; PG8_WAIT_L(0); PG8_MMA(1, 0, At, B0); PG8_BAR; PG8_SCHED;
            PG8_STAGE(PG8_SB(1, 1), b3 + hB, voffB);
            PG8_WAIT_V(6); PG8_BAR; PG8_MMA(1, 1, At, B1); PG8_BAR;
        }
        E(acc, cur, wr, wc, fr, fq);
        if (!has_next) break;
#pragma unroll
        for (int a = 0; a < 2; ++a)
#pragma unroll
            for (int b = 0; b < 2; ++b)
#pragma unroll
                for (int m = 0; m < 4; ++m)
#pragma unroll
                    for (int n = 0; n < 2; ++n) acc[a][b][m][n] = (f32x4){0.f, 0.f, 0.f, 0.f};
        cur = nxt; cA = nA; cB = nB; ++ui;
    }
    PG8_WAIT_V(0);
    if (wr == 0) PG8_BAR;
    PG8_BAR;
#undef PG8_SA
#undef PG8_SB
#undef PG8_STAGE
#undef PG8_LDA
#undef PG8_LDB
#undef PG8_MMA
#undef PG8_WAIT_V
#undef PG8_WAIT_L
#undef PG8_BAR
#undef PG8_SCHED
}
}

typedef const f32x4 (&AccRef)[2][2][4][2];
__device__ __forceinline__ u32x4 pack8(f32x4 a, f32x4 b) { u32x4 w; w.x = pk2(a[0], a[1]); w.y = pk2(a[2], a[3]); w.z = pk2(b[0], b[1]); w.w = pk2(b[2], b[3]); return w; }

struct EpiIn {
    static constexpr bool PERM = true, MID = false;
    bf16* PQ; bf16* UB; const float* r;
    __device__ __forceinline__ void operator()(AccRef acc, const pg8::Unit& u, int wr, int wc, int fr, int fq) const {
#pragma unroll
        for (int ai = 0; ai < 2; ++ai)
#pragma unroll
            for (int m = 0; m < 4; ++m) {
                const int row = u.pm * 256 + ai * 128 + wr * 64 + m * 16 + fr; const float rs = r[row];
#pragma unroll
                for (int bj = 0; bj < 2; ++bj) {
                    const int col0 = u.pn * 256 + bj * 128 + wc * 32 + 8 * fq;
                    const u32x4 w = pack8(acc[ai][bj][m][0] * rs, acc[ai][bj][m][1] * rs);
                    if (col0 < 1024) *(u32x4*)(PQ + (size_t)row * 1024 + col0) = w;
                    else { const int c2 = col0 - 1024, gg = c2 >> 4, h0 = c2 & 15; *(u32x4*)(UB + ((size_t)(gg * 2048 + (row >> 4)) * 512 + (row & 15) * 16 + h0)) = w; }
                }
            }
    }
};
struct EpiSloc {
    static constexpr bool PERM = false, MID = false;
    float* S;
    __device__ __forceinline__ void operator()(AccRef acc, const pg8::Unit& u, int wr, int wc, int fr, int fq) const {
#pragma unroll
        for (int ai = 0; ai < 2; ++ai)
#pragma unroll
            for (int m = 0; m < 4; ++m) {
                const int row = u.pm * 256 + ai * 128 + wr * 64 + m * 16 + fr;
                float* rp = S + ((size_t)u.z * 2048 + row) * 256 + wc * 32 + 4 * fq;
#pragma unroll
                for (int bj = 0; bj < 2; ++bj)
#pragma unroll
                    for (int n = 0; n < 2; ++n) *(f32x4*)(rp + bj * 128 + n * 16) = acc[ai][bj][m][n];
            }
    }
};
struct EpiSsmOut {
    static constexpr bool PERM = true, MID = false;
    bf16* G;
    __device__ __forceinline__ void operator()(AccRef acc, const pg8::Unit& u, int wr, int wc, int fr, int fq) const {
#pragma unroll
        for (int ai = 0; ai < 2; ++ai)
#pragma unroll
            for (int m = 0; m < 4; ++m) {
                const int row = u.pm * 256 + ai * 128 + wr * 64 + m * 16 + fr;
#pragma unroll
                for (int bj = 0; bj < 2; ++bj) {
                    const int col0 = bj * 128 + wc * 32 + 8 * fq, t = col0 >> 4, i0 = col0 & 15;
                    f32x4 a = acc[ai][bj][m][0], b = acc[ai][bj][m][1];
#pragma unroll
                    for (int j = 0; j < 4; ++j) { a[j] = gelu_t(a[j]); b[j] = gelu_t(b[j]); }
                    *(u32x4*)(G + ((size_t)row * 16 + t) * 512 + u.z * 16 + i0) = pack8(a, b);
                }
            }
    }
};
struct EpiGlu {
    static constexpr bool PERM = true, MID = false;
    const bf16* G; const float* bias; bf16* AO; float* ss;
    __device__ __forceinline__ void operator()(AccRef acc, const pg8::Unit& u, int wr, int wc, int fr, int fq) const {
#pragma unroll
        for (int ai = 0; ai < 2; ++ai)
#pragma unroll
            for (int m = 0; m < 4; ++m) {
                const int row = u.pm * 256 + ai * 128 + wr * 64 + m * 16 + fr; float s2 = 0.f;
#pragma unroll
                for (int bj = 0; bj < 2; ++bj) {
                    const int col0 = u.pn * 256 + bj * 128 + wc * 32 + 8 * fq;
                    const u32x4 gv = *(const u32x4*)(G + (size_t)row * 512 + col0);
                    const f32x4 b0 = *(const f32x4*)(bias + col0), b1 = *(const f32x4*)(bias + col0 + 4);
                    f32x4 a = acc[ai][bj][m][0] + b0, b = acc[ai][bj][m][1] + b1;
                    a[0] = bflo(gv.x) * sigm(a[0]); a[1] = bfhi(gv.x) * sigm(a[1]); a[2] = bflo(gv.y) * sigm(a[2]); a[3] = bfhi(gv.y) * sigm(a[3]);
                    b[0] = bflo(gv.z) * sigm(b[0]); b[1] = bfhi(gv.z) * sigm(b[1]); b[2] = bflo(gv.w) * sigm(b[2]); b[3] = bfhi(gv.w) * sigm(b[3]);
#pragma unroll
                    for (int j = 0; j < 4; ++j) s2 += a[j] * a[j] + b[j] * b[j];
                    *(u32x4*)(AO + (size_t)row * 1024 + 512 + col0) = pack8(a, b);
                }
                s2 += __shfl_xor(s2, 16); s2 += __shfl_xor(s2, 32);
                if (fq == 0) ss[row * 8 + u.pn * 4 + wc] = s2;
            }
    }
};
struct EpiOutSS {
    static constexpr bool PERM = true, MID = false;
    bf16* O; float* ss;
    __device__ __forceinline__ void operator()(AccRef acc, const pg8::Unit& u, int wr, int wc, int fr, int fq) const {
#pragma unroll
        for (int ai = 0; ai < 2; ++ai)
#pragma unroll
            for (int m = 0; m < 4; ++m) {
                const int row = u.pm * 256 + ai * 128 + wr * 64 + m * 16 + fr; float s2 = 0.f;
#pragma unroll
                for (int bj = 0; bj < 2; ++bj) {
                    const int col0 = u.pn * 256 + bj * 128 + wc * 32 + 8 * fq;
                    const f32x4 a = acc[ai][bj][m][0], b = acc[ai][bj][m][1];
#pragma unroll
                    for (int j = 0; j < 4; ++j) s2 += a[j] * a[j] + b[j] * b[j];
                    *(u32x4*)(O + (size_t)row * 1024 + col0) = pack8(a, b);
                }
                s2 += __shfl_xor(s2, 16); s2 += __shfl_xor(s2, 32);
                if (fq == 0) ss[row * 16 + u.pn * 4 + wc] = s2;
            }
    }
};
struct EpiOutMix {
    static constexpr bool PERM = true, MID = true;
    bf16* O; float* ss; const LAS float* qv;
    __device__ __forceinline__ void mid(f32x4 (&acc)[2][2][4][2], const pg8::Unit& u, int wr, int fr) const {
#pragma unroll
        for (int ai = 0; ai < 2; ++ai)
#pragma unroll
            for (int m = 0; m < 4; ++m) { const float q = qv[u.ui * 256 + ai * 128 + wr * 64 + m * 16 + fr];
#pragma unroll
                for (int bj = 0; bj < 2; ++bj)
#pragma unroll
                    for (int n = 0; n < 2; ++n) acc[ai][bj][m][n] *= q; }
    }
    __device__ __forceinline__ void operator()(AccRef acc, const pg8::Unit& u, int wr, int wc, int fr, int fq) const {
#pragma unroll
        for (int ai = 0; ai < 2; ++ai)
#pragma unroll
            for (int m = 0; m < 4; ++m) {
                const int rl = ai * 128 + wr * 64 + m * 16 + fr, row = u.pm * 256 + rl; float s2 = 0.f; const float rs = qv[1024 + u.ui * 256 + rl];
#pragma unroll
                for (int bj = 0; bj < 2; ++bj) {
                    const int col0 = u.pn * 256 + bj * 128 + wc * 32 + 8 * fq;
                    const f32x4 a = acc[ai][bj][m][0] * rs, b = acc[ai][bj][m][1] * rs;
#pragma unroll
                    for (int j = 0; j < 4; ++j) s2 += a[j] * a[j] + b[j] * b[j];
                    *(u32x4*)(O + (size_t)row * 1024 + col0) = pack8(a, b);
                }
                s2 += __shfl_xor(s2, 16); s2 += __shfl_xor(s2, 32);
                if (fq == 0) ss[row * 16 + u.pn * 4 + wc] = s2;
            }
    }
};
struct EpiFF1 {
    static constexpr bool PERM = true, MID = false;
    bf16* H; const float* r;
    __device__ __forceinline__ void operator()(AccRef acc, const pg8::Unit& u, int wr, int wc, int fr, int fq) const {
#pragma unroll
        for (int ai = 0; ai < 2; ++ai)
#pragma unroll
            for (int m = 0; m < 4; ++m) {
                const int row = u.pm * 256 + ai * 128 + wr * 64 + m * 16 + fr; const float rs = r[row];
#pragma unroll
                for (int bj = 0; bj < 2; ++bj) {
                    const int col0 = u.pn * 256 + bj * 128 + wc * 32 + 8 * fq;
                    f32x4 a = acc[ai][bj][m][0] * rs, b = acc[ai][bj][m][1] * rs;
#pragma unroll
                    for (int j = 0; j < 4; ++j) { a[j] = fmaxf(a[j], 0.f); a[j] *= a[j]; b[j] = fmaxf(b[j], 0.f); b[j] *= b[j]; }
                    *(u32x4*)(H + (size_t)row * 4096 + col0) = pack8(a, b);
                }
            }
    }
};

__device__ __forceinline__ void transpose_item(const float* W, int ldw, bf16* WT, int ldt, const float* sc_lo, const float* sc_hi, int split,
                                               LAS float* scr, int item, int nblk, int lane) {
    const int kb = item / nblk, nb = item % nblk, k0 = 64 * kb, n0 = 32 * nb;
#pragma unroll 16
    for (int i = 0; i < 32; ++i) { const int kk = 2 * i + (lane >> 5), k = k0 + kk;
        float s = 1.f; if (sc_lo) s = (k < split) ? sc_lo[k] : sc_hi[k - split];
        scr[kk * 33 + (lane & 31)] = W[(size_t)k * ldw + n0 + (lane & 31)] * s; }
    asm volatile("s_waitcnt lgkmcnt(0)" ::: "memory");
    const int c = lane & 7;
#pragma unroll
    for (int j = 0; j < 4; ++j) { const int n = (lane >> 3) + 8 * j; const LAS float* s = scr + (8 * c) * 33 + n;
        u32x4 o; o.x = pk2(s[0 * 33], s[1 * 33]); o.y = pk2(s[2 * 33], s[3 * 33]); o.z = pk2(s[4 * 33], s[5 * 33]); o.w = pk2(s[6 * 33], s[7 * 33]);
        *(u32x4*)(WT + (size_t)(n0 + n) * ldt + k0 + 8 * c) = o; }
    asm volatile("s_waitcnt lgkmcnt(0)" ::: "memory");
}

__device__ __forceinline__ void fold_item(const Params& p, int item, LAS unsigned char* lds) {
    int tid = threadIdx.x; asm volatile("" : "+v"(tid)); const int ly = item >> 7, h = (item >> 4) & 7, kb = item & 15, k0 = kb * 64;
    LAS float* Wt = (LAS float*)lds;
    LAS float* Wf = Wt + 64 * 65;
    LAS float* TC = Wf + 64 * 65;
    LAS float* TS = TC + 64 * 65;
    LAS float* cs = TS + 64 * 65;
    __syncthreads();
    const float* win = p.w_in + (size_t)ly * 1024 * 1024; const float* wf = p.w_fourier + ((size_t)ly * 8 + h) * 4096; const float* g = p.pre_mix_g + ly * 1024;
    for (int i = tid; i < 4096; i += 512) { const int k = i >> 6, c = i & 63; Wt[k * 65 + c] = win[(size_t)(k0 + k) * 1024 + 64 * h + c] * g[k0 + k]; Wf[k * 65 + c] = wf[i]; }
    if (tid < 64) { float s, c; sincospif((float)tid / 32.0f, &s, &c); cs[tid] = c; cs[64 + tid] = s; }
    __syncthreads();
    { const int d = tid & 63, kg = tid >> 6; float ac[8], as[8];
#pragma unroll
      for (int j = 0; j < 8; ++j) { ac[j] = 0.f; as[j] = 0.f; }
#pragma unroll 2
      for (int c = 0; c < 64; ++c) { const int ph = (c * d) & 63; const float cv = cs[ph], sv = cs[64 + ph];
#pragma unroll
          for (int j = 0; j < 8; ++j) { const float w = Wt[(kg * 8 + j) * 65 + c]; ac[j] += w * cv; as[j] += w * sv; } }
#pragma unroll
      for (int j = 0; j < 8; ++j) { TC[(kg * 8 + j) * 65 + d] = ac[j]; TS[(kg * 8 + j) * 65 + d] = as[j]; } }
    __syncthreads();
    const float scale = 1.0f / 724.0773439350247f;
    bf16* WT = (bf16*)(p.ws + OFF_W + (size_t)ly * W_LAYER + W_IN);
    { const int k = tid & 63, eg = tid >> 6; float ap[8], aq[8];
#pragma unroll
      for (int j = 0; j < 8; ++j) { ap[j] = 0.f; aq[j] = 0.f; }
#pragma unroll 2
      for (int d = 0; d < 64; ++d) { const float tc = TC[k * 65 + d], ts = TS[k * 65 + d];
#pragma unroll
          for (int j = 0; j < 8; ++j) { const float w = Wf[d * 65 + eg * 8 + j]; ap[j] += tc * w; aq[j] += ts * w; } }
#pragma unroll
      for (int j = 0; j < 8; ++j) { const int e = eg * 8 + j;
          WT[(size_t)(64 * h + e) * 1024 + k0 + k] = (bf16)f2bf(ap[j] * scale);
          WT[(size_t)(512 + 64 * h + e) * 1024 + k0 + k] = (bf16)f2bf(-aq[j] * scale); } }
}

__device__ __forceinline__ void ssm_mat_item(const Params& p, int item, LAS unsigned char* lds) {
    int tid = threadIdx.x; asm volatile("" : "+v"(tid)); const int ly = item >> 7, g = (item >> 2) & 31, qt = item & 3;
    LAS float* pwr = (LAS float*)lds;
    LAS float* pwi = pwr + 2 * 64 * 20;
    LAS float* bbr = pwi + 2 * 64 * 20;
    LAS float* bbi = bbr + 2 * 64 * 16;
    LAS float* ccr = bbi + 2 * 64 * 16;
    LAS float* cci = ccr + 2 * 16 * 64;
    LAS float* Gt = cci + 2 * 16 * 64;
    __syncthreads();
    { const int k = (tid >> 6) & 1, pp = tid & 63, tg = tid >> 7; const int idx = (ly * 2 + k) * 32 + g;
      const float dt = expf(p.log_dt[idx]); const float lr = p.lam_re[idx * 64 + pp] * dt, li = p.lam_im[idx * 64 + pp] * dt;
#pragma unroll
      for (int j = 0; j < 5; ++j) { const int tau = tg * 5 + j; if (tau <= 16) { const float e = __expf(lr * tau); float sn, cs; __sincosf(li * tau, &sn, &cs); pwr[(k * 64 + pp) * 20 + tau] = e * cs; pwi[(k * 64 + pp) * 20 + tau] = e * sn; } } }
    for (int i = tid; i < 2048; i += 512) { const int k = i >> 10, r = i & 1023; const int idx = (ly * 2 + k) * 32 + g; ccr[i] = p.c_re[(size_t)idx * 1024 + r]; cci[i] = p.c_im[(size_t)idx * 1024 + r]; }
    __syncthreads();
#pragma unroll
    for (int j = 0; j < 4; ++j) { const int o = tid + 512 * j, k = o >> 10, pp = (o >> 4) & 63, h = o & 15; const int idx = (ly * 2 + k) * 32 + g;
        const float lr = p.lam_re[idx * 64 + pp], li = p.lam_im[idx * 64 + pp], dt = expf(p.log_dt[idx]);
        float sn, cs; sincosf(li * dt, &sn, &cs); const float em1 = expm1f(lr * dt), sh = sinf(0.5f * li * dt);
        const float lbr = em1 * cs - 2.0f * sh * sh, lbi = (em1 + 1.0f) * sn;
        const float den = 1.0f / (lr * lr + li * li); const float cr = (lbr * lr + lbi * li) * den, ci = (lbi * lr - lbr * li) * den;
        const float br = p.b_re[(size_t)idx * 1024 + pp * 16 + h], bi = p.b_im[(size_t)idx * 1024 + pp * 16 + h];
        bbr[o] = cr * br - ci * bi; bbi[o] = cr * bi + ci * br; }
    __syncthreads();
    { const int k = tid >> 8, i = (tid >> 4) & 15, h = tid & 15; float a[16];
#pragma unroll
      for (int tau = 0; tau < 16; ++tau) a[tau] = 0.f;
#pragma nounroll
      for (int pp = 0; pp < 64; ++pp) { const float c_r = ccr[(k * 16 + i) * 64 + pp], c_i = cci[(k * 16 + i) * 64 + pp], b_r = bbr[(k * 64 + pp) * 16 + h], b_i = bbi[(k * 64 + pp) * 16 + h];
          const float xr = c_r * b_r - c_i * b_i, xi = c_r * b_i + c_i * b_r;
          const LAS f32x4* pr4 = (const LAS f32x4*)(pwr + (k * 64 + pp) * 20); const LAS f32x4* pi4 = (const LAS f32x4*)(pwi + (k * 64 + pp) * 20);
#pragma unroll
          for (int t4 = 0; t4 < 4; ++t4) { const f32x4 vr = pr4[t4], vi = pi4[t4];
#pragma unroll
              for (int e = 0; e < 4; ++e) a[t4 * 4 + e] += xr * vr[e] - xi * vi[e]; } }
#pragma unroll
      for (int tau = 0; tau < 16; ++tau) Gt[((k * 16 + tau) * 16 + i) * 16 + h] = a[tau]; }
    __syncthreads();
    bf16* TM = (bf16*)(p.ws + OFF_TM) + (size_t)(ly * 32 + g) * 256 * 512; bf16* MS = (bf16*)(p.ws + OFF_MST) + (size_t)(ly * 32 + g) * 256 * 256;
    const float* dsk = p.d_skip + (ly * 32 + g) * 16;
    for (int o = qt * 64 * 512 + tid; o < (qt + 1) * 64 * 512; o += 512) { const int r = o >> 9, col = o & 511, t = r >> 4, i = r & 15; float v;
        if (col < 256) { const int j = col >> 4, h = col & 15; v = 0.f;
            if (j <= t) v += Gt[((0 * 16 + (t - j)) * 16 + i) * 16 + h];
            if (j >= t) v += Gt[((1 * 16 + (j - t)) * 16 + i) * 16 + h];
            if (j == t && h == i) v += dsk[i]; }
        else { const int k = (col - 256) >> 7, q = (col - 256) & 127, pp = q >> 1, part = q & 1; const int tau = k == 0 ? (t + 1) : (16 - t);
            const float c_r = ccr[(k * 16 + i) * 64 + pp], c_i = cci[(k * 16 + i) * 64 + pp], l_r = pwr[(k * 64 + pp) * 20 + tau], l_i = pwi[(k * 64 + pp) * 20 + tau];
            v = part == 0 ? (c_r * l_r - c_i * l_i) : -(c_r * l_i + c_i * l_r); }
        TM[o] = (bf16)f2bf(v); }
    for (int o = qt * 64 * 256 + tid; o < (qt + 1) * 64 * 256; o += 512) { const int r = o >> 8, col = o & 255, k = r >> 7, q = r & 127, pp = q >> 1, part = q & 1, j = col >> 4, h = col & 15;
        const int tau = k == 0 ? (15 - j) : j;
        const float l_r = pwr[(k * 64 + pp) * 20 + tau], l_i = pwi[(k * 64 + pp) * 20 + tau], b_r = bbr[(k * 64 + pp) * 16 + h], b_i = bbi[(k * 64 + pp) * 16 + h];
        const float v = part == 0 ? (l_r * b_r - l_i * b_i) : (l_r * b_i + l_i * b_r);
        MS[o] = (bf16)f2bf(v); }
}

__device__ __forceinline__ void p0_prologue(const Params& p, LAS unsigned char* lds, int G, int bid) {
    int tid = threadIdx.x; asm volatile("" : "+v"(tid));
    const int lane = tid & 63, wave = __builtin_amdgcn_readfirstlane(tid >> 6);
    for (int rp = 0; rp < P0_REP_A; ++rp)
    for (int it = bid; it < 512; it += G) { if (it < 256) { for (int r2 = 0; r2 < P0_REP_F; ++r2) fold_item(p, it, lds); } else { for (int r2 = 0; r2 < P0_REP_S; ++r2) ssm_mat_item(p, it - 256, lds); } }
    __syncthreads();
    {
        LAS float* scr = (LAS float*)(lds + wave * 8448);
        const int gw = bid * 8 + wave, NGW = G * 8;
        constexpr int I_IN = 16 * 16, I_OUT = 16 * 32, I_1 = 16 * 128, I_2 = 64 * 32, I_G = 8 * 16, I_L = I_IN + I_OUT + I_1 + I_2 + I_G;
        for (int rp = 0; rp < P0_REP_B; ++rp)
        for (int it = gw; it < 2 * I_L; it += NGW) {
            const int ly = it / I_L; int r = it % I_L; unsigned char* wb = p.ws + OFF_W + (size_t)ly * W_LAYER;
            if (r < I_IN) { transpose_item(p.w_in + (size_t)ly * 1024 * 1024 + 512, 1024, (bf16*)(wb + W_IN) + (size_t)1024 * 1024, 1024, p.pre_mix_g + ly * 1024, nullptr, 1 << 30, scr, r, 16, lane); continue; } r -= I_IN;
            if (r < I_OUT) { transpose_item(p.w_out + (size_t)ly * 1024 * 1024, 1024, (bf16*)(wb + W_OUT), 1024, p.fourier_out_g + ly * 512, p.ssm_out_g + ly * 512, 512, scr, r, 32, lane); continue; } r -= I_OUT;
            if (r < I_1) { transpose_item(p.w_ff1 + (size_t)ly * 1024 * 4096, 4096, (bf16*)(wb + W_1), 1024, p.pre_mlp_g + ly * 1024, nullptr, 1 << 30, scr, r, 128, lane); continue; } r -= I_1;
            if (r < I_2) { transpose_item(p.w_ff2 + (size_t)ly * 4096 * 1024, 1024, (bf16*)(wb + W_2), 4096, nullptr, nullptr, 0, scr, r, 32, lane); continue; } r -= I_2;
            transpose_item(p.w_glu + (size_t)ly * 512 * 512, 512, (bf16*)(wb + W_GLU), 512, nullptr, nullptr, 0, scr, r, 16, lane);
        }
        bf16* XB = (bf16*)(p.ws + OFF_XB); float* rA = (float*)(p.ws + OFF_RA);
        for (int rp = 0; rp < P0_REP_C; ++rp)
        for (int row0 = gw; row0 < MT; row0 += 4 * NGW) {
            f32x4 v[4][4];
#pragma unroll
            for (int rr = 0; rr < 4; ++rr) { const f32x4* xr = (const f32x4*)(p.x + (size_t)(row0 + rr * NGW) * 1024) + lane;
#pragma unroll
                for (int j = 0; j < 4; ++j) v[rr][j] = xr[64 * j]; }
#pragma unroll
            for (int rr = 0; rr < 4; ++rr) { const int row = row0 + rr * NGW; float s2 = 0.f;
                u32x2* o = (u32x2*)(XB + (size_t)row * 1024) + lane;
#pragma unroll
                for (int j = 0; j < 4; ++j) { const f32x4 t = v[rr][j]; s2 += t[0] * t[0] + t[1] * t[1] + t[2] * t[2] + t[3] * t[3]; u32x2 w; w.x = pk2(t[0], t[1]); w.y = pk2(t[2], t[3]); o[64 * j] = w; }
                s2 = wave_sum(s2);
                if (lane == 0) rA[row] = rsqrtf(s2 * (1.0f / 1024.0f) + EPS); }
        }
    }
    {
        bf16* D1 = (bf16*)(p.ws + OFF_D1); bf16* E3 = (bf16*)(p.ws + OFF_E3);
        const int gt = bid * 512 + tid, NT = G * 512;
        for (int idx = gt; idx < 64 * 2 * 128 * 128; idx += NT) { const int n2 = idx >> 15, sel = (idx >> 14) & 1, k1 = (idx >> 7) & 127, n1 = idx & 127;
            const int ph = (k1 * (64 * n1 + n2)) & 8191; float s, c; sincospif((float)ph * (1.0f / 4096.0f), &s, &c); D1[idx] = (bf16)f2bf(sel ? s : c); }
        for (int idx = gt; idx < 64 * 128; idx += NT) { const int k2 = idx >> 7, col = idx & 127, part = col >> 6, n2 = col & 63;
            const int ph = (n2 * k2) & 63; float s, c; sincospif((float)ph * (1.0f / 32.0f), &s, &c); E3[idx] = (bf16)f2bf(part ? s : c); }
    }
}

typedef short v4s16 __attribute__((ext_vector_type(4)));
__device__ __forceinline__ bf16x8 negbf(bf16x8 v) { u32x4 t = __builtin_bit_cast(u32x4, v); t = t ^ 0x80008000u; return __builtin_bit_cast(bf16x8, t); }
__device__ __forceinline__ bf16x8 tr_frag(const LAS unsigned char* a, int hs) {
    const v4s16 lo = __builtin_amdgcn_ds_read_tr16_b64_v4i16((LAS v4s16*)a), hi = __builtin_amdgcn_ds_read_tr16_b64_v4i16((LAS v4s16*)(a + hs));
    return __builtin_shufflevector(lo, hi, 0, 1, 2, 3, 4, 5, 6, 7);
}
constexpr int F1_P = 264, F1_CS = 256 * F1_P;
__device__ __forceinline__ void fft1_phase(const bf16* PQ, const bf16* D1, bf16* T, LAS unsigned char* lds, int G, int bid) {
    int tid = threadIdx.x; asm volatile("" : "+v"(tid));
    const int lane = tid & 63, wave = __builtin_amdgcn_readfirstlane(tid >> 6), wm = wave & 3, wn = wave >> 2, fr = lane & 15, fq = lane >> 4, tq = fr >> 2, tp = fr & 3;
    for (int pr = bid; pr < 256; pr += G) {
        const int n2 = pr & 63, cb = pr >> 6;
        __syncthreads();
        {
            const bf16* src = D1 + (size_t)n2 * 2 * 128 * 128;
#pragma unroll
            for (int j = 0; j < 8; ++j) { const int q = tid + 512 * j, sel = q >> 11, row = (q >> 4) & 127, cc = q & 15;
                *(LAS u32x4*)(lds + F1_CS + sel * 34816 + row * 272 + cc * 16) = *(const u32x4*)(src + sel * 16384 + row * 128 + 8 * cc); }
        }
        for (int b = 0; b < NB; ++b) {
            __syncthreads();
#pragma unroll
            for (int j = 0; j < 8; ++j) { const int q = tid + 512 * j, row = q >> 4, cc = q & 15, part = row >> 7, n1 = row & 127;
                const u32x4 v = *(const u32x4*)(PQ + ((size_t)(b * SEQ + 64 * n1 + n2)) * 1024 + part * 512 + cb * 128 + 8 * cc);
                LAS u32x2* d = (LAS u32x2*)(lds + row * F1_P + cc * 16); d[0] = (u32x2){v.x, v.y}; d[1] = (u32x2){v.z, v.w}; }
            __syncthreads();
            f32x4 Ar[2][4], Ai[2][4];
#pragma unroll
            for (int mb = 0; mb < 2; ++mb)
#pragma unroll
                for (int nb = 0; nb < 4; ++nb) { Ar[mb][nb] = (f32x4){0.f, 0.f, 0.f, 0.f}; Ai[mb][nb] = (f32x4){0.f, 0.f, 0.f, 0.f}; }
#pragma nounroll
            for (int ks = 0; ks < 8; ++ks) {
                bf16x8 Bf[4];
#pragma unroll
                for (int nb = 0; nb < 4; ++nb) Bf[nb] = tr_frag(lds + (32 * ks + 8 * fq + tq) * F1_P + (64 * wn + 16 * tp + 4 * nb) * 2, 4 * F1_P);
                bf16x8 Cf[2], Sf[2];
#pragma unroll
                for (int mb = 0; mb < 2; ++mb) { const int off = F1_CS + (32 * wm + 16 * mb + fr) * 272 + (32 * (ks & 3) + 8 * fq) * 2; Cf[mb] = *(const LAS bf16x8*)(lds + off); Sf[mb] = *(const LAS bf16x8*)(lds + off + 34816); }
#pragma unroll
                for (int mb = 0; mb < 2; ++mb)
#pragma unroll
                    for (int nb = 0; nb < 4; ++nb) {
                        if (ks < 4) { Ar[mb][nb] = __builtin_amdgcn_mfma_f32_16x16x32_bf16(Bf[nb], Cf[mb], Ar[mb][nb], 0, 0, 0);
                                      Ai[mb][nb] = __builtin_amdgcn_mfma_f32_16x16x32_bf16(Bf[nb], negbf(Sf[mb]), Ai[mb][nb], 0, 0, 0); }
                        else        { Ar[mb][nb] = __builtin_amdgcn_mfma_f32_16x16x32_bf16(Bf[nb], Sf[mb], Ar[mb][nb], 0, 0, 0);
                                      Ai[mb][nb] = __builtin_amdgcn_mfma_f32_16x16x32_bf16(Bf[nb], Cf[mb], Ai[mb][nb], 0, 0, 0); }
                    }
            }
#pragma unroll
            for (int mb = 0; mb < 2; ++mb) { const int k1 = 32 * wm + 16 * mb + fr, c = cb * 128 + 64 * wn + 16 * fq;
                bf16* t0 = T + ((((size_t)(b * 128 + k1) * 2 + 0) * 64 + n2) * 512 + c); bf16* t1 = t0 + 64 * 512;
                *(u32x4*)t0 = pack8(Ar[mb][0], Ar[mb][1]); *(u32x4*)(t0 + 8) = pack8(Ar[mb][2], Ar[mb][3]);
                *(u32x4*)t1 = pack8(Ai[mb][0], Ai[mb][1]); *(u32x4*)(t1 + 8) = pack8(Ai[mb][2], Ai[mb][3]); }
        }
    }
    __syncthreads();
}

constexpr int F3_P = 1032;
__device__ __forceinline__ void fft3_phase(const bf16* T, const bf16* E3, bf16* AO, LAS unsigned char* lds, int G, int bid) {
    int tid = threadIdx.x; asm volatile("" : "+v"(tid));
    const int lane = tid & 63, wave = __builtin_amdgcn_readfirstlane(tid >> 6), fr = lane & 15, fq = lane >> 4, tq = fr >> 2, tp = fr & 3;
    LAS float* red = (LAS float*)(lds + 128 * F3_P);
    for (int unit = bid; unit < 512; unit += G) {
        const int b = unit >> 7, k1 = unit & 127;
        __syncthreads();
        const bf16* src = T + (size_t)unit * 65536;
#pragma unroll
        for (int j = 0; j < 16; ++j) { const int q = tid + 512 * j, row = q >> 6, cc = q & 63;
            const u32x4 v = *(const u32x4*)(src + row * 512 + cc * 8);
            LAS u32x2* d = (LAS u32x2*)(lds + row * F3_P + cc * 16); d[0] = (u32x2){v.x, v.y}; d[1] = (u32x2){v.z, v.w}; }
        __syncthreads();
        f32x4 acc[4][4];
#pragma unroll
        for (int mb = 0; mb < 4; ++mb)
#pragma unroll
            for (int nb = 0; nb < 4; ++nb) acc[mb][nb] = (f32x4){0.f, 0.f, 0.f, 0.f};
        bf16x8 Ef[4];
#pragma unroll
        for (int mb = 0; mb < 4; ++mb) Ef[mb] = *(const bf16x8*)(E3 + (16 * mb + fr) * 128 + 8 * fq);
#pragma nounroll
        for (int ks = 0; ks < 4; ++ks) {
            bf16x8 Bf[4], En[4];
            const int kn = ks < 3 ? ks + 1 : 3;
#pragma unroll
            for (int mb = 0; mb < 4; ++mb) En[mb] = *(const bf16x8*)(E3 + (16 * mb + fr) * 128 + 32 * kn + 8 * fq);
#pragma unroll
            for (int nb = 0; nb < 4; ++nb) Bf[nb] = tr_frag(lds + (32 * ks + 8 * fq + tq) * F3_P + (64 * wave + 16 * tp + 4 * nb) * 2, 4 * F3_P);
#pragma unroll
            for (int mb = 0; mb < 4; ++mb)
#pragma unroll
                for (int nb = 0; nb < 4; ++nb) acc[mb][nb] = __builtin_amdgcn_mfma_f32_16x16x32_bf16(Bf[nb], Ef[mb], acc[mb][nb], 0, 0, 0);
#pragma unroll
            for (int mb = 0; mb < 4; ++mb) Ef[mb] = En[mb];
        }
#pragma unroll
        for (int mb = 0; mb < 4; ++mb) { float s = 0.f;
#pragma unroll
            for (int nb = 0; nb < 4; ++nb)
#pragma unroll
                for (int j = 0; j < 4; ++j) s += acc[mb][nb][j] * acc[mb][nb][j];
            s += __shfl_xor(s, 16); s += __shfl_xor(s, 32);
            if (fq == 0) red[wave * 64 + 16 * mb + fr] = s; }
        __syncthreads();
#pragma unroll
        for (int mb = 0; mb < 4; ++mb) { float tot = 0.f;
#pragma unroll
            for (int w = 0; w < 8; ++w) tot += red[w * 64 + 16 * mb + fr];
            const float rinv = rsqrtf(tot * (1.0f / 512.0f) + EPS);
            const size_t token = (size_t)b * SEQ + k1 + 128 * (16 * mb + fr);
            bf16* o = AO + token * 1024 + 64 * wave + 16 * fq;
            *(u32x4*)o = pack8(acc[mb][0] * rinv, acc[mb][1] * rinv); *(u32x4*)(o + 8) = pack8(acc[mb][2] * rinv, acc[mb][3] * rinv); }
    }
    __syncthreads();
}

__device__ __forceinline__ void carry_phase(const Params& p, int ly, const float* Sloc, bf16* UB, LAS unsigned char* lds, int G, int bid) {
    int tid = threadIdx.x; asm volatile("" : "+v"(tid));
    const int lane = tid & 63, wave = __builtin_amdgcn_readfirstlane(tid >> 6);
    LAS f32x2* ex = (LAS f32x2*)lds;
    for (int w = bid; w < 256; w += G) {
        const int dir = w & 1, g = (w >> 1) & 31, b = w >> 6, pp = lane; const int idx = (ly * 2 + dir) * 32 + g;
        const float dt = expf(p.log_dt[idx]); const float lr = p.lam_re[idx * 64 + pp] * dt * 16.0f, li = p.lam_im[idx * 64 + pp] * dt * 16.0f;
        const float e = expf(lr); float sn, cs; sincosf(li, &sn, &cs); const float l_r = e * cs, l_i = e * sn;
        float Lr = l_r, Li = l_i;
#pragma unroll
        for (int k = 0; k < 6; ++k) { const float nr = Lr * Lr - Li * Li, ni = 2.0f * Lr * Li; Lr = nr; Li = ni; }
        const float* src = Sloc + ((size_t)(g * 2048 + b * 512)) * 256 + dir * 128 + 2 * pp;
        bf16* dst = UB + ((size_t)(g * 2048 + b * 512)) * 512 + 256 + dir * 128 + 2 * pp;
        const int ss0 = dir == 0 ? wave * 64 : 511 - wave * 64; const long stp = dir == 0 ? 256 : -256;
        float cr = 0.f, ci = 0.f;
        { const float* ptr = src + (size_t)ss0 * 256;
#pragma nounroll
          for (int hb = 0; hb < 2; ++hb) {
            f32x2 v[32];
#pragma unroll
            for (int j = 0; j < 32; ++j) { v[j] = *(const f32x2*)ptr; ptr += stp; }
#pragma unroll
            for (int j = 0; j < 32; ++j) { const float nr = l_r * cr - l_i * ci + v[j][0], ni = l_r * ci + l_i * cr + v[j][1]; cr = nr; ci = ni; }
          } }
        __syncthreads();
        ex[wave * 64 + lane] = (f32x2){cr, ci};
        __syncthreads();
        cr = 0.f; ci = 0.f;
        for (int u = 0; u < wave; ++u) { const f32x2 eu = ex[u * 64 + lane]; const float nr = Lr * cr - Li * ci + eu[0], ni = Lr * ci + Li * cr + eu[1]; cr = nr; ci = ni; }
        { const float* ptr = src + (size_t)ss0 * 256; bf16* dp = dst + (size_t)ss0 * 512;
#pragma nounroll
          for (int hb = 0; hb < 2; ++hb) {
            f32x2 v[32];
#pragma unroll
            for (int j = 0; j < 32; ++j) { v[j] = *(const f32x2*)ptr; ptr += stp; }
#pragma unroll
            for (int j = 0; j < 32; ++j) {
                *(unsigned*)dp = pk2(cr, ci); dp += 2 * stp;
                const float nr = l_r * cr - l_i * ci + v[j][0], ni = l_r * ci + l_i * cr + v[j][1]; cr = nr; ci = ni; }
          } }
    }
    __syncthreads();
}

__device__ __forceinline__ void norm_phase(float* out, const bf16* MF, const float* ss, const float* gain, bf16* XB, float* rnext, bool last, int G, int bid) {
    int tid = threadIdx.x; asm volatile("" : "+v"(tid));
    const int lane = tid & 63, wave = __builtin_amdgcn_readfirstlane(tid >> 6);
    const int gw = bid * 8 + wave, NGW = G * 8;
    const f32x4* gr = (const f32x4*)gain + lane;
    const f32x4 g0 = gr[0], g1 = gr[64], g2 = gr[128], g3 = gr[192];
    for (int row0 = gw; row0 < MT; row0 += 2 * NGW) {
        u32x2 xv[2][4], mv[2][4]; float tot[2];
#pragma unroll
        for (int rr = 0; rr < 2; ++rr) { const int row = row0 + rr * NGW;
            const u32x2* xr = (const u32x2*)(XB + (size_t)row * 1024) + lane; const u32x2* mr = (const u32x2*)(MF + (size_t)row * 1024) + lane;
#pragma unroll
            for (int j = 0; j < 4; ++j) { xv[rr][j] = xr[64 * j]; mv[rr][j] = mr[64 * j]; }
            const f32x4* sp = (const f32x4*)(ss + (size_t)row * 16); const f32x4 s0 = sp[0], s1 = sp[1], s2 = sp[2], s3 = sp[3];
            tot[rr] = ((((s0[0] + s0[1]) + s0[2]) + s0[3]) + (((s1[0] + s1[1]) + s1[2]) + s1[3])) + ((((s2[0] + s2[1]) + s2[2]) + s2[3]) + (((s3[0] + s3[1]) + s3[2]) + s3[3])); }
#pragma unroll
        for (int rr = 0; rr < 2; ++rr) { const int row = row0 + rr * NGW;
            const float rinv = rsqrtf(tot[rr] * (1.0f / 1024.0f) + EPS); float s2 = 0.f;
#pragma unroll
            for (int j = 0; j < 4; ++j) { const f32x4 gg = j == 0 ? g0 : (j == 1 ? g1 : (j == 2 ? g2 : g3)); const u32x2 xx = xv[rr][j], mm = mv[rr][j]; f32x4 v;
                v[0] = bflo(xx.x) + bflo(mm.x) * rinv * gg[0]; v[1] = bfhi(xx.x) + bfhi(mm.x) * rinv * gg[1]; v[2] = bflo(xx.y) + bflo(mm.y) * rinv * gg[2]; v[3] = bfhi(xx.y) + bfhi(mm.y) * rinv * gg[3];
                if (last) { ((f32x4*)(out + (size_t)row * 1024) + lane)[64 * j] = v; }
                else { u32x2 w; w.x = pk2(v[0], v[1]); w.y = pk2(v[2], v[3]); ((u32x2*)(XB + (size_t)row * 1024) + lane)[64 * j] = w;
                       const float a0 = bflo(w.x), a1 = bfhi(w.x), a2 = bflo(w.y), a3 = bfhi(w.y); s2 += a0 * a0 + a1 * a1 + a2 * a2 + a3 * a3; } }
            if (!last) { s2 = wave_sum(s2); if (lane == 0) rnext[row] = rsqrtf(s2 * (1.0f / 1024.0f) + EPS); } }
    }
}
__device__ __forceinline__ void rescale_phase(bf16* AO, const float* ss, int G, int bid) {
    int tid = threadIdx.x; asm volatile("" : "+v"(tid));
    const int lane = tid & 63, wave = __builtin_amdgcn_readfirstlane(tid >> 6);
    const int gw = bid * 8 + wave, NGW = G * 8;
    for (int row = gw; row < MT; row += NGW) {
        float tot = 0.f;
#pragma unroll
        for (int k = 0; k < 8; ++k) tot += ss[row * 8 + k];
        const float rinv = rsqrtf(tot * (1.0f / 512.0f) + EPS);
        u32x4* ptr = (u32x4*)(AO + (size_t)row * 1024 + 512) + lane; u32x4 v = *ptr;
        v.x = pk2(bflo(v.x) * rinv, bfhi(v.x) * rinv); v.y = pk2(bflo(v.y) * rinv, bfhi(v.y) * rinv); v.z = pk2(bflo(v.z) * rinv, bfhi(v.z) * rinv); v.w = pk2(bflo(v.w) * rinv, bfhi(v.w) * rinv);
        *ptr = v;
    }
}


#define XB_TMO      128
#define XB_XCNT(j)  (256  + 64 * (j))
#define XB_XSUB(j)  (1280 + 64 * (j))
#define XB_XGEN(j)  (2304 + 64 * (j))
#define XB_TOP      3328
#define XB_TOPGEN   3392
#define XCD_BAR_WORDS 3456
#define XB_SPIN_CAP (1u << 18)
__device__ __forceinline__ unsigned xb_ld(unsigned* p)              { return __hip_atomic_load(p, __ATOMIC_RELAXED, __HIP_MEMORY_SCOPE_AGENT); }
__device__ __forceinline__ unsigned xb_add(unsigned* p, unsigned v) { return __hip_atomic_fetch_add(p, v, __ATOMIC_RELAXED, __HIP_MEMORY_SCOPE_AGENT); }
__device__ __forceinline__ unsigned xb_xcc_id() { return (unsigned)__builtin_amdgcn_s_getreg((3 << 11) | 20) & 0xFu; }
#define XB_SPIN(cond, bar) do { unsigned _sp = 0; while (cond) { __builtin_amdgcn_s_sleep(1); \
    if ((++_sp & 255u) == 0u) { if (xb_ld(&(bar)[XB_TMO])) break; if (_sp > XB_SPIN_CAP) { atomicAdd(&(bar)[XB_TMO], 1u); break; } } } } while (0)
struct XcdBarrier { unsigned* bar; unsigned x; volatile LAS unsigned* st; };
__device__ __forceinline__ XcdBarrier xcd_barrier_post(unsigned* bar, volatile LAS unsigned* st) {
    XcdBarrier b; b.bar = bar; b.x = xb_xcc_id(); b.st = st;
    if (threadIdx.x == 0) (void)xb_add(&bar[XB_XCNT(b.x)], 1u);
    return b;
}
__device__ __forceinline__ void xcd_barrier_complete(unsigned* bar, unsigned x, unsigned& nloc, unsigned& nx) {
    const unsigned G = gridDim.x * gridDim.y * gridDim.z;
    unsigned sum, cnt, mine, sp = 0u;
    for (;;) {
        sum = 0u; cnt = 0u; mine = 0u;
#pragma unroll
        for (unsigned j = 0; j < 16; ++j) { const unsigned c = xb_ld(&bar[XB_XCNT(j)]); sum += c; cnt += (c > 0u) ? 1u : 0u; mine = (j == x) ? c : mine; }
        if (sum == G) break;
        __builtin_amdgcn_s_sleep(1);
        if ((++sp & 255u) == 0u) { if (xb_ld(&bar[XB_TMO])) break; if (sp > XB_SPIN_CAP) { atomicAdd(&bar[XB_TMO], 1u); break; } }
    }
    nloc = mine > 0u ? mine : 1u; nx = cnt > 0u ? cnt : 1u;
}
__device__ __forceinline__ void xcd_barrier(const XcdBarrier& b) {
    asm volatile("s_waitcnt vmcnt(0)" ::: "memory");
    __syncthreads();
    if (threadIdx.x == 0) {
        unsigned* bar = b.bar;
        __builtin_amdgcn_s_waitcnt(0);
        unsigned nloc = b.st[0], nx = b.st[1];
        if (nloc == 0u) { xcd_barrier_complete(bar, b.x, nloc, nx); b.st[0] = nloc; b.st[1] = nx; }
        const unsigned old = xb_add(&bar[XB_XSUB(b.x)], 1u);
        const unsigned gen = old / nloc;
        if (old + 1u == (gen + 1u) * nloc) {
            __builtin_amdgcn_fence(__ATOMIC_RELEASE, "agent");
            asm volatile("s_waitcnt vmcnt(0)" ::: "memory");
            const unsigned og = xb_add(&bar[XB_TOP], 1u);
            const unsigned tg = og / nx;
            if (og + 1u == (tg + 1u) * nx) xb_add(&bar[XB_TOPGEN], 1u);
            else XB_SPIN(xb_ld(&bar[XB_TOPGEN]) == tg, bar);
            __builtin_amdgcn_fence(__ATOMIC_ACQUIRE, "agent");
            xb_add(&bar[XB_XGEN(b.x)], 1u);
            asm volatile("s_waitcnt vmcnt(0)" ::: "memory");
        } else {
            XB_SPIN(xb_ld(&bar[XB_XGEN(b.x)]) == gen, bar);
            __builtin_amdgcn_fence(__ATOMIC_ACQUIRE, "agent");
            asm volatile("s_waitcnt vmcnt(0)" ::: "memory");
        }
    }
    __syncthreads();
}

#ifndef REP_P0
#define REP_P0 1
#endif
#ifndef REP_SYNC
#define REP_SYNC 1
#endif
#ifndef REP_MASK_V
#define REP_MASK_V 0u
#endif
constexpr unsigned REP_MASK = REP_MASK_V;
constexpr int PH_PER_LAYER = 10, N_PHASES = 1 + 2 * PH_PER_LAYER;
__global__ void __launch_bounds__(512) hybrid_fwd(Params p) {
    extern __shared__ __attribute__((aligned(16))) unsigned char lds_raw[];
    LAS unsigned char* lds = (LAS unsigned char*)lds_raw;
    cg::grid_group grid = cg::this_grid();
    volatile LAS unsigned* xst = (volatile LAS unsigned*)(lds + LDS_BYTES - 16);
    if (threadIdx.x < 4) xst[threadIdx.x] = 0u;
    __syncthreads();
    const XcdBarrier xbar = xcd_barrier_post((unsigned*)(p.ws + OFF_BAR), xst);
    if (p.ph_hi > 1000) grid.sync();
    const int Gk = gridDim.x, bk = blockIdx.x;
    unsigned char* ws = p.ws;
    float* sss = (float*)(ws + OFF_SSS); float* ssm = (float*)(ws + OFF_SSM); float* ssf = (float*)(ws + OFF_SSF); float* rA = (float*)(ws + OFF_RA); float* rB = (float*)(ws + OFF_RB);
    bf16* XB = (bf16*)(ws + OFF_XB); bf16* MF = (bf16*)(ws + OFF_MF); bf16* GB = (bf16*)(ws + OFF_G); bf16* HB = (bf16*)(ws + OFF_H);
    bf16* PQ = (bf16*)(ws + OFF_PQ); bf16* AO = (bf16*)(ws + OFF_AO); bf16* UB = (bf16*)(ws + OFF_UB); bf16* TB = (bf16*)(ws + OFF_T); float* SL = (float*)(ws + OFF_SLOC);

#pragma nounroll
    for (int ph = p.ph_lo; ph < p.ph_hi; ++ph) {
        int G = Gk, bid = bk; asm volatile("" : "+s"(G), "+s"(bid));
        if (ph == 0) { for (int rep = 0; rep < REP_P0; ++rep) p0_prologue(p, lds, G, bid); }
        else {
            const int ly = (ph - 1) / PH_PER_LAYER, sp = (ph - 1) % PH_PER_LAYER;
            unsigned char* wb = ws + OFF_W + (size_t)ly * W_LAYER;
            pg8::Order S;
            const int nrep = ((REP_MASK >> sp) & 1u) ? 2 : 1;
            for (int rep = 0; rep < nrep; ++rep)
            switch (sp) {
            case 0: {
                pg8::Gemm g{XB, (const bf16*)(wb + W_IN), MT, NIN, 1024, 1024, 1024, 0, 0, 1}; S.init(MT, NIN, 1, G, bid);
                EpiIn E{PQ, UB, rA}; pg8::gemm_phase<EpiIn>(lds, g, S, E); } break;
            case 1: {
                fft1_phase(PQ, (const bf16*)(ws + OFF_D1), TB, lds, G, bid);
                pg8::Gemm g{UB, (const bf16*)(ws + OFF_MST) + (size_t)ly * 32 * 256 * 256, 2048, 256, 256, 512, 256, (size_t)2048 * 512, (size_t)256 * 256, 32}; S.init(2048, 256, 32, G, bid);
                EpiSloc E{SL}; pg8::gemm_phase<EpiSloc>(lds, g, S, E); } break;
            case 2: {
                carry_phase(p, ly, SL, UB, lds, G, bid);
                fft3_phase(TB, (const bf16*)(ws + OFF_E3), AO, lds, G, bid); } break;
            case 3: {
                pg8::Gemm g{UB, (const bf16*)(ws + OFF_TM) + (size_t)ly * 32 * 256 * 512, 2048, 256, 512, 512, 512, (size_t)2048 * 512, (size_t)256 * 512, 32}; S.init(2048, 256, 32, G, bid);
                EpiSsmOut E{GB}; pg8::gemm_phase<EpiSsmOut>(lds, g, S, E); } break;
            case 4: {
                pg8::Gemm g{GB, (const bf16*)(wb + W_GLU), MT, 512, 512, 512, 512, 0, 0, 1}; S.init(MT, 512, 1, G, bid);
                EpiGlu E{GB, p.b_glu + ly * 512, AO, sss}; pg8::gemm_phase<EpiGlu>(lds, g, S, E); } break;
            case 5: {
                pg8::Gemm g{AO, (const bf16*)(wb + W_OUT), MT, 1024, 1024, 1024, 1024, 0, 0, 1}; S.init(MT, 1024, 1, G, bid);
                LAS float* qv = (LAS float*)(lds + 131072);
                { int tid = threadIdx.x; asm volatile("" : "+v"(tid));
                  for (int i = 0; i < 4; ++i) { pg8::Unit u; if (!S.next(i, u)) break;
                      if (tid < 256) { const f32x4* sp = (const f32x4*)(sss + (size_t)(u.pm * 256 + tid) * 8); const f32x4 a = sp[0], b = sp[1];
                          const float ms = ((((a[0] + a[1]) + a[2]) + a[3]) + (((b[0] + b[1]) + b[2]) + b[3])) * (1.0f / 512.0f) + EPS;
                          qv[i * 256 + tid] = sqrtf(ms); qv[1024 + i * 256 + tid] = rsqrtf(ms); } }
                  __syncthreads(); }
                EpiOutMix E{MF, ssm, qv}; pg8::gemm_phase<EpiOutMix>(lds, g, S, E); } break;
            case 6: norm_phase(p.out, MF, ssm, p.post_mix_g + ly * 1024, XB, rB, false, G, bid); break;
            case 7: {
                pg8::Gemm g{XB, (const bf16*)(wb + W_1), MT, DFF, 1024, 1024, 1024, 0, 0, 1}; S.init(MT, DFF, 1, G, bid);
                EpiFF1 E{HB, rB}; pg8::gemm_phase<EpiFF1>(lds, g, S, E); } break;
            case 8: {
                pg8::Gemm g{HB, (const bf16*)(wb + W_2), MT, 1024, DFF, DFF, DFF, 0, 0, 1}; S.init(MT, 1024, 1, G, bid);
                EpiOutSS E{MF, ssf}; pg8::gemm_phase<EpiOutSS>(lds, g, S, E); } break;
            case 9: norm_phase(p.out, MF, ssf, p.post_mlp_g + ly * 1024, XB, rA, ly == 1, G, bid); break;
            }
        }
        if (ph + 1 < p.ph_hi) for (int rep = 0; rep < REP_SYNC; ++rep) xcd_barrier(xbar);
    }
}

extern "C" void kernel_launch(void* const* d_in, const int* in_sizes, int n_in, void* d_out, int out_size, void* d_ws, size_t ws_size, hipStream_t stream) {
    static int grid = 0;
    if (grid == 0) {
        if (n_in != 22 || ws_size < WS_END) { fprintf(stderr, "kernel_launch: unexpected n_in %d or ws_size %zu (< %zu)\n", n_in, ws_size, (size_t)WS_END); grid = -1; return; }
        int dev = 0, cus = 0, per_cu = 0;
        hipGetDevice(&dev); hipDeviceGetAttribute(&cus, hipDeviceAttributeMultiprocessorCount, dev);
        if (hipFuncSetAttribute((const void*)hybrid_fwd, hipFuncAttributeMaxDynamicSharedMemorySize, LDS_BYTES) != hipSuccess) { fprintf(stderr, "kernel_launch: hipFuncSetAttribute failed\n"); grid = -1; return; }
        if (hipOccupancyMaxActiveBlocksPerMultiprocessor(&per_cu, (const void*)hybrid_fwd, 512, LDS_BYTES) != hipSuccess || per_cu < 1) { fprintf(stderr, "kernel_launch: occupancy query says %d blocks per CU\n", per_cu); per_cu = 1; }
        (void)hipGetLastError();
        grid = cus;
    }
    if (grid < 0) return;
    if (hipMemsetAsync((char*)d_ws + OFF_BAR, 0, BAR_BYTES, stream) != hipSuccess) { fprintf(stderr, "kernel_launch: memset of the barrier words failed\n"); return; }
    Params p{};
    const float** f = (const float**)&p;
    for (int i = 0; i < 22; ++i) f[i] = (const float*)d_in[i];
    p.out = (float*)d_out; p.ws = (unsigned char*)d_ws; p.ph_lo = 0; p.ph_hi = N_PHASES;
    void* args[] = {&p};
    hipError_t e = hipLaunchCooperativeKernel((const void*)hybrid_fwd, dim3(grid), dim3(512), args, LDS_BYTES, stream);
    if (e != hipSuccess) fprintf(stderr, "kernel_launch: cooperative launch failed: %s (grid %d)\n", hipGetErrorString(e), grid);
}
```

```cpp
#include <hip/hip_runtime.h>
#include <hip/hip_cooperative_groups.h>
#include <cstdio>
namespace cg = cooperative_groups;

#define P0_REP_A 1
#define P0_REP_F 1
#define P0_REP_S 1
#define P0_REP_B 1
#define P0_REP_C 1
#define LAS __attribute__((address_space(3)))
typedef unsigned short bf16;
typedef short bf16x8 __attribute__((ext_vector_type(8)));
typedef float f32x4 __attribute__((ext_vector_type(4)));
typedef float f32x2 __attribute__((ext_vector_type(2)));
typedef unsigned u32x4 __attribute__((ext_vector_type(4)));
typedef unsigned u32x2 __attribute__((ext_vector_type(2)));

constexpr int NB = 4, SEQ = 8192, DM = 1024, MT = NB * SEQ, DFO = 512, NHEAD = 8, SG = 32, SP = 64, DFF = 4096, NIN = 1536;
constexpr float EPS = 1e-6f;
constexpr int LDS_BYTES = 147456;
constexpr size_t MiB = 1u << 20;
constexpr size_t OFF_RA = 384 * 1024, OFF_RB = 512 * 1024, OFF_BAR = 640 * 1024, BAR_BYTES = 16384;
constexpr size_t OFF_E3 = 1 * MiB, OFF_D1 = 2 * MiB, OFF_TM = 6 * MiB, OFF_MST = 22 * MiB, OFF_W = 30 * MiB;
constexpr size_t W_IN = 0, W_OUT = 3 * MiB, W_1 = 5 * MiB, W_2 = 13 * MiB, W_GLU = 21 * MiB, W_LAYER = 22 * MiB;
constexpr size_t OFF_XB = 76 * MiB, OFF_MF = 140 * MiB, OFF_G = 140 * MiB, OFF_H = 204 * MiB;
constexpr size_t OFF_PQ = 204 * MiB, OFF_AO = 204 * MiB, OFF_UB = 268 * MiB, OFF_T = 332 * MiB, OFF_SLOC = 396 * MiB, OFF_SSS = 460 * MiB, OFF_SSM = 461 * MiB, OFF_SSF = 463 * MiB, WS_END = 465 * MiB;

struct Params {
    const float *x, *w_in, *w_out, *pre_mix_g, *post_mix_g, *pre_mlp_g, *post_mlp_g, *fourier_out_g, *ssm_out_g, *w_fourier,
        *lam_re, *lam_im, *log_dt, *b_re, *b_im, *c_re, *c_im, *d_skip, *w_glu, *b_glu, *w_ff1, *w_ff2;
    float* out; unsigned char* ws;
    int ph_lo, ph_hi;
};

__device__ __forceinline__ unsigned f2bf(float f) { unsigned u = __builtin_bit_cast(unsigned, f); return (u + 0x7fffu + ((u >> 16) & 1u)) >> 16; }
__device__ __forceinline__ unsigned pk2(float lo, float hi) { return f2bf(lo) | (f2bf(hi) << 16); }
__device__ __forceinline__ float bflo(unsigned w) { return __builtin_bit_cast(float, w << 16); }
__device__ __forceinline__ float bfhi(unsigned w) { return __builtin_bit_cast(float, w & 0xffff0000u); }
__device__ __forceinline__ float wave_sum(float v) {
#pragma unroll
    for (int o = 1; o < 64; o <<= 1) v += __shfl_xor(v, o);
    return v;
}
__device__ __forceinline__ float gelu_t(float x) { const float u = 0.7978845608f * (x + 0.044715f * x * x * x); return x / (1.0f + __expf(-2.0f * u)); }
__device__ __forceinline__ float sigm(float v) { return 1.0f / (1.0f + __expf(-v)); }

namespace pg8 {
#define PG8_LAS __attribute__((address_space(3)))
typedef unsigned short bf16_t;
constexpr int BM = 256, BK = 64, HALF = 128, HTB = HALF * BK * 2, STAGE_BYTES = 8 * HTB, NXCD = 8, WGM = 4;
__host__ __device__ __forceinline__ int lds_byte(int r, int c) { const int st = (r >> 4) * 2 + (c >> 5), rr = r & 15, cc = c & 31, ob = rr * 64 + cc * 2; return st * 1024 + (ob ^ (((ob >> 9) & 1) << 5)); }
__host__ __device__ __forceinline__ void stage_rc(int b, int& R, int& C) { const int st = b / 1024, sb = b % 1024, swz = sb ^ (((sb >> 9) & 1) << 5); R = (st >> 1) * 16 + swz / 64; C = (st & 1) * 32 + (swz % 64) / 2; }
__host__ __device__ __forceinline__ int perm32(int rho) { const int n = rho >> 4, i = rho & 15; return 8 * (i >> 2) + 4 * n + (i & 3); }

struct Unit { int pm, pn, z, ui; };
struct Gemm { const bf16_t* A; const bf16_t* Bt; int M, N, K, lda, ldb; size_t sA, sB; int nZ; };

struct Order {
    int nM, nN, nwg, nZ, G, c;
    __device__ void init(int M, int N, int nZ_, int G_, int c_) { nM = M / BM; nN = N / BM; nwg = nM * nN; nZ = nZ_; G = G_; c = c_; }
    __device__ bool next(int i, Unit& u) const {
        const long L = (long)i * G + c; if (L >= (long)nwg * nZ) return false;
        u.ui = i;
        if (nZ > 1 && (nZ % NXCD) == 0) {
            const int xcd = (int)(L % NXCD), idx = (int)(L / NXCD); u.z = xcd * (nZ / NXCD) + idx / nwg; const int wg = idx % nwg; u.pm = wg % nM; u.pn = wg / nM; return true; }
        u.z = (int)(L / nwg);
        int wgid = (int)(L % nwg); { const int q = nwg / NXCD, r = nwg % NXCD, xcd = wgid % NXCD, off = wgid / NXCD; wgid = (xcd < r ? xcd * (q + 1) : r * (q + 1) + (xcd - r) * q) + off; }
        const int nig = WGM * nN, gid = wgid / nig, fm = gid * WGM, gsz = (nM - fm) < WGM ? (nM - fm) : WGM;
        u.pm = fm + ((wgid % nig) % gsz); u.pn = (wgid % nig) / gsz; return true;
    }
};

template <class Epi>
__device__ __forceinline__ void gemm_phase(PG8_LAS unsigned char* lds, const Gemm g, const Order& S, const Epi& E) {
    int tid = threadIdx.x; asm volatile("" : "+v"(tid));
    const int wid = __builtin_amdgcn_readfirstlane(tid >> 6), lane = tid & 63, wr = wid >> 2, wc = wid & 3, fr = lane & 15, fq = lane >> 4;
    const int K = g.K, nt = K / BK;
    unsigned voffA[2], voffB[2];
#pragma unroll
    for (int i = 0; i < 2; ++i) { int R, C; stage_rc(tid * 16 + i * 8192, R, C); const int Rb = Epi::PERM ? ((R & ~31) + perm32(R & 31)) : R;
        voffA[i] = (unsigned)(R * g.lda + C) * 2u; voffB[i] = (unsigned)(Rb * g.ldb + C) * 2u; }
    const size_t kstep = (size_t)(BK * 2);
    const size_t hA = (size_t)HALF * g.lda * 2, hB = (size_t)HALF * g.ldb * 2;
    const size_t tA = 2 * hA, tB = 2 * hB;
    const unsigned ldsw = (unsigned)wid * 1024u;
    const int aoff = lds_byte(wr * 64 + fr, fq * 8), boff = lds_byte(wc * 32 + fr, fq * 8);
#define PG8_SA(b, h) (((b) * 2 + (h)) * HTB)
#define PG8_SB(b, h) ((4 + (b) * 2 + (h)) * HTB)
#define PG8_STAGE(bufoff, gbase, voff) do { _Pragma("unroll") for (int _i = 0; _i < 2; ++_i) \
        __builtin_amdgcn_global_load_lds((const unsigned*)((const char*)(gbase) + (voff)[_i]), (PG8_LAS unsigned*)(lds + (bufoff) + ldsw + _i * 8192), 16, 0, 0); } while (0)
#define PG8_LDA(dst, b, h) do { _Pragma("unroll") for (int m = 0; m < 4; ++m) _Pragma("unroll") for (int k = 0; k < 2; ++k) dst[m][k] = *(const PG8_LAS bf16x8*)(lds + PG8_SA(b, h) + aoff + m * 2048 + k * 1024); } while (0)
#define PG8_LDB(dst, b, h) do { _Pragma("unroll") for (int n = 0; n < 2; ++n) _Pragma("unroll") for (int k = 0; k < 2; ++k) dst[n][k] = *(const PG8_LAS bf16x8*)(lds + PG8_SB(b, h) + boff + n * 2048 + k * 1024); } while (0)
#define PG8_MMA(ai, bj, At, Bt) do { __builtin_amdgcn_s_setprio(1); _Pragma("unroll") for (int m = 0; m < 4; ++m) _Pragma("unroll") for (int n = 0; n < 2; ++n) _Pragma("unroll") for (int k = 0; k < 2; ++k) \
        acc[ai][bj][m][n] = __builtin_amdgcn_mfma_f32_16x16x32_bf16(Bt[n][k], At[m][k], acc[ai][bj][m][n], 0, 0, 0); __builtin_amdgcn_s_setprio(0); } while (0)
#define PG8_WAIT_V(n) asm volatile("s_waitcnt vmcnt(" #n ")" ::: "memory")
#define PG8_WAIT_L(n) asm volatile("s_waitcnt lgkmcnt(" #n ")" ::: "memory")
#define PG8_BAR __builtin_amdgcn_s_barrier()
#define PG8_SCHED __builtin_amdgcn_sched_barrier(0)
    Unit cur, nxt; int ui = 0;
    if (!S.next(0, cur)) return;
    f32x4 acc[2][2][4][2];
#pragma unroll
    for (int a = 0; a < 2; ++a)
#pragma unroll
        for (int b = 0; b < 2; ++b)
#pragma unroll
            for (int m = 0; m < 4; ++m)
#pragma unroll
                for (int n = 0; n < 2; ++n) acc[a][b][m][n] = (f32x4){0.f, 0.f, 0.f, 0.f};
    bf16x8 At[4][2], B0[2][2], B1[2][2];
    const char* cA = (const char*)g.A + ((size_t)cur.z * g.sA) * 2 + (size_t)cur.pm * tA; const char* cB = (const char*)g.Bt + ((size_t)cur.z * g.sB) * 2 + (size_t)cur.pn * tB;
    PG8_STAGE(PG8_SB(0, 0), cB, voffB); PG8_STAGE(PG8_SA(0, 0), cA, voffA); PG8_STAGE(PG8_SB(0, 1), cB + hB, voffB); PG8_STAGE(PG8_SA(0, 1), cA + hA, voffA);
    if (wr == 1) PG8_BAR;
    PG8_WAIT_V(4); PG8_BAR;
    PG8_STAGE(PG8_SB(1, 0), cB + kstep, voffB); PG8_STAGE(PG8_SA(1, 0), cA + kstep, voffA); PG8_STAGE(PG8_SB(1, 1), cB + hB + kstep, voffB);
    PG8_WAIT_V(6); PG8_BAR;
    for (;;) {
        const bool has_next = S.next(ui + 1, nxt);
        const char* nA = has_next ? (const char*)g.A + ((size_t)nxt.z * g.sA) * 2 + (size_t)nxt.pm * tA : cA; const char* nB = has_next ? (const char*)g.Bt + ((size_t)nxt.z * g.sB) * 2 + (size_t)nxt.pn * tB : cB;
        for (int t = 0; t < nt; t += 2) {
            const bool last = (t == nt - 2);
            if constexpr (Epi::MID) { if (t == (nt >> 1)) E.mid(acc, cur, wr, fr); }
            const char* a1 = cA + (size_t)(t + 1) * kstep;
            const char* a2 = last ? nA : cA + (size_t)(t + 2) * kstep; const char* b2 = last ? nB : cB + (size_t)(t + 2) * kstep;
            const char* a3 = a2 + kstep; const char* b3 = b2 + kstep;
            PG8_LDB(B0, 0, 0); PG8_SCHED; PG8_LDA(At, 0, 0); PG8_STAGE(PG8_SA(1, 1), a1 + hA, voffA);
            PG8_WAIT_L(8); PG8_BAR; PG8_WAIT_L(0); PG8_MMA(0, 0, At, B0); PG8_BAR; PG8_SCHED;
            PG8_LDB(B1, 0, 1); PG8_STAGE(PG8_SB(0, 0), b2, voffB);
            PG8_BAR; PG8_WAIT_L(0); PG8_MMA(0, 1, At, B1); PG8_BAR;
            PG8_LDA(At, 0, 1); PG8_STAGE(PG8_SA(0, 0), a2, voffA);
            PG8_BAR; PG8_WAIT_L(0); PG8_MMA(1, 0, At, B0); PG8_BAR; PG8_SCHED;
            PG8_STAGE(PG8_SB(0, 1), b2 + hB, voffB);
            PG8_WAIT_V(6); PG8_BAR; PG8_MMA(1, 1, At, B1); PG8_BAR;
            PG8_LDB(B0, 1, 0); PG8_SCHED; PG8_LDA(At, 1, 0); PG8_STAGE(PG8_SA(0, 1), a2 + hA, voffA);
            PG8_WAIT_L(8); PG8_BAR; PG8_WAIT_L(0); PG8_MMA(0, 0, At, B0); PG8_BAR; PG8_SCHED;
            PG8_LDB(B1, 1, 1); PG8_STAGE(PG8_SB(1, 0), b3, voffB);
            PG8_BAR; PG8_WAIT_L(0); PG8_MMA(0, 1, At, B1); PG8_BAR;
            PG8_LDA(At, 1, 1); PG8_STAGE(PG8_SA(1, 0), a3, voffA);
            PG8_BAR; PG8_WAIT_L(0); PG8_MMA(1, 0, At, B0); PG8_BAR; PG8_SCHED;
            PG8_STAGE(PG8_SB(1, 1), b3 + hB, voffB);
            PG8_WAIT_V(6); PG8_BAR; PG8_MMA(1, 1, At, B1); PG8_BAR;
        }
        E(acc, cur, wr, wc, fr, fq);
        if (!has_next) break;
#pragma unroll
        for (int a = 0; a < 2; ++a)
#pragma unroll
            for (int b = 0; b < 2; ++b)
#pragma unroll
                for (int m = 0; m < 4; ++m)
#pragma unroll
                    for (int n = 0; n < 2; ++n) acc[a][b][m][n] = (f32x4){0.f, 0.f, 0.f, 0.f};
        cur = nxt; cA = nA; cB = nB; ++ui;
    }
    PG8_WAIT_V(0);
    if (wr == 0) PG8_BAR;
    PG8_BAR;
#undef PG8_SA
#undef PG8_SB
#undef PG8_STAGE
#undef PG8_LDA
#undef PG8_LDB
#undef PG8_MMA
#undef PG8_WAIT_V
#undef PG8_WAIT_L
#undef PG8_BAR
#undef PG8_SCHED
}
}

typedef const f32x4 (&AccRef)[2][2][4][2];
__device__ __forceinline__ u32x4 pack8(f32x4 a, f32x4 b) { u32x4 w; w.x = pk2(a[0], a[1]); w.y = pk2(a[2], a[3]); w.z = pk2(b[0], b[1]); w.w = pk2(b[2], b[3]); return w; }

struct EpiIn {
    static constexpr bool PERM = true, MID = false;
    bf16* PQ; bf16* UB; const float* r;
    __device__ __forceinline__ void operator()(AccRef acc, const pg8::Unit& u, int wr, int wc, int fr, int fq) const {
#pragma unroll
        for (int ai = 0; ai < 2; ++ai)
#pragma unroll
            for (int m = 0; m < 4; ++m) {
                const int row = u.pm * 256 + ai * 128 + wr * 64 + m * 16 + fr; const float rs = r[row];
#pragma unroll
                for (int bj = 0; bj < 2; ++bj) {
                    const int col0 = u.pn * 256 + bj * 128 + wc * 32 + 8 * fq;
                    const u32x4 w = pack8(acc[ai][bj][m][0] * rs, acc[ai][bj][m][1] * rs);
                    if (col0 < 1024) *(u32x4*)(PQ + (size_t)row * 1024 + col0) = w;
                    else { const int c2 = col0 - 1024, gg = c2 >> 4, h0 = c2 & 15; *(u32x4*)(UB + ((size_t)(gg * 2048 + (row >> 4)) * 512 + (row & 15) * 16 + h0)) = w; }
                }
            }
    }
};
struct EpiSloc {
    static constexpr bool PERM = false, MID = false;
    float* S;
    __device__ __forceinline__ void operator()(AccRef acc, const pg8::Unit& u, int wr, int wc, int fr, int fq) const {
#pragma unroll
        for (int ai = 0; ai < 2; ++ai)
#pragma unroll
            for (int m = 0; m < 4; ++m) {
                const int row = u.pm * 256 + ai * 128 + wr * 64 + m * 16 + fr;
                float* rp = S + ((size_t)u.z * 2048 + row) * 256 + wc * 32 + 4 * fq;
#pragma unroll
                for (int bj = 0; bj < 2; ++bj)
#pragma unroll
                    for (int n = 0; n < 2; ++n) *(f32x4*)(rp + bj * 128 + n * 16) = acc[ai][bj][m][n];
            }
    }
};
struct EpiSsmOut {
    static constexpr bool PERM = true, MID = false;
    bf16* G;
    __device__ __forceinline__ void operator()(AccRef acc, const pg8::Unit& u, int wr, int wc, int fr, int fq) const {
#pragma unroll
        for (int ai = 0; ai < 2; ++ai)
#pragma unroll
            for (int m = 0; m < 4; ++m) {
                const int row = u.pm * 256 + ai * 128 + wr * 64 + m * 16 + fr;
#pragma unroll
                for (int bj = 0; bj < 2; ++bj) {
                    const int col0 = bj * 128 + wc * 32 + 8 * fq, t = col0 >> 4, i0 = col0 & 15;
                    f32x4 a = acc[ai][bj][m][0], b = acc[ai][bj][m][1];
#pragma unroll
                    for (int j = 0; j < 4; ++j) { a[j] = gelu_t(a[j]); b[j] = gelu_t(b[j]); }
                    *(u32x4*)(G + ((size_t)row * 16 + t) * 512 + u.z * 16 + i0) = pack8(a, b);
                }
            }
    }
};
struct EpiGlu {
    static constexpr bool PERM = true, MID = false;
    const bf16* G; const float* bias; bf16* AO; float* ss;
    __device__ __forceinline__ void operator()(AccRef acc, const pg8::Unit& u, int wr, int wc, int fr, int fq) const {
#pragma unroll
        for (int ai = 0; ai < 2; ++ai)
#pragma unroll
            for (int m = 0; m < 4; ++m) {
                const int row = u.pm * 256 + ai * 128 + wr * 64 + m * 16 + fr; float s2 = 0.f;
#pragma unroll
                for (int bj = 0; bj < 2; ++bj) {
                    const int col0 = u.pn * 256 + bj * 128 + wc * 32 + 8 * fq;
                    const u32x4 gv = *(const u32x4*)(G + (size_t)row * 512 + col0);
                    const f32x4 b0 = *(const f32x4*)(bias + col0), b1 = *(const f32x4*)(bias + col0 + 4);
                    f32x4 a = acc[ai][bj][m][0] + b0, b = acc[ai][bj][m][1] + b1;
                    a[0] = bflo(gv.x) * sigm(a[0]); a[1] = bfhi(gv.x) * sigm(a[1]); a[2] = bflo(gv.y) * sigm(a[2]); a[3] = bfhi(gv.y) * sigm(a[3]);
                    b[0] = bflo(gv.z) * sigm(b[0]); b[1] = bfhi(gv.z) * sigm(b[1]); b[2] = bflo(gv.w) * sigm(b[2]); b[3] = bfhi(gv.w) * sigm(b[3]);
#pragma unroll
                    for (int j = 0; j < 4; ++j) s2 += a[j] * a[j] + b[j] * b[j];
                    *(u32x4*)(AO + (size_t)row * 1024 + 512 + col0) = pack8(a, b);
                }
                s2 += __shfl_xor(s2, 16); s2 += __shfl_xor(s2, 32);
                if (fq == 0) ss[row * 8 + u.pn * 4 + wc] = s2;
            }
    }
};
struct EpiOutSS {
    static constexpr bool PERM = true, MID = false;
    bf16* O; float* ss;
    __device__ __forceinline__ void operator()(AccRef acc, const pg8::Unit& u, int wr, int wc, int fr, int fq) const {
#pragma unroll
        for (int ai = 0; ai < 2; ++ai)
#pragma unroll
            for (int m = 0; m < 4; ++m) {
                const int row = u.pm * 256 + ai * 128 + wr * 64 + m * 16 + fr; float s2 = 0.f;
#pragma unroll
                for (int bj = 0; bj < 2; ++bj) {
                    const int col0 = u.pn * 256 + bj * 128 + wc * 32 + 8 * fq;
                    const f32x4 a = acc[ai][bj][m][0], b = acc[ai][bj][m][1];
#pragma unroll
                    for (int j = 0; j < 4; ++j) s2 += a[j] * a[j] + b[j] * b[j];
                    *(u32x4*)(O + (size_t)row * 1024 + col0) = pack8(a, b);
                }
                s2 += __shfl_xor(s2, 16); s2 += __shfl_xor(s2, 32);
                if (fq == 0) ss[row * 16 + u.pn * 4 + wc] = s2;
            }
    }
};
struct EpiOutMix {
    static constexpr bool PERM = true, MID = true;
    bf16* O; float* ss; const LAS float* qv;
    __device__ __forceinline__ void mid(f32x4 (&acc)[2][2][4][2], const pg8::Unit& u, int wr, int fr) const {
#pragma unroll
        for (int ai = 0; ai < 2; ++ai)
#pragma unroll
            for (int m = 0; m < 4; ++m) { const float q = qv[u.ui * 256 + ai * 128 + wr * 64 + m * 16 + fr];
#pragma unroll
                for (int bj = 0; bj < 2; ++bj)
#pragma unroll
                    for (int n = 0; n < 2; ++n) acc[ai][bj][m][n] *= q; }
    }
    __device__ __forceinline__ void operator()(AccRef acc, const pg8::Unit& u, int wr, int wc, int fr, int fq) const {
#pragma unroll
        for (int ai = 0; ai < 2; ++ai)
#pragma unroll
            for (int m = 0; m < 4; ++m) {
                const int rl = ai * 128 + wr * 64 + m * 16 + fr, row = u.pm * 256 + rl; float s2 = 0.f; const float rs = qv[1024 + u.ui * 256 + rl];
#pragma unroll
                for (int bj = 0; bj < 2; ++bj) {
                    const int col0 = u.pn * 256 + bj * 128 + wc * 32 + 8 * fq;
                    const f32x4 a = acc[ai][bj][m][0] * rs, b = acc[ai][bj][m][1] * rs;
#pragma unroll
                    for (int j = 0; j < 4; ++j) s2 += a[j] * a[j] + b[j] * b[j];
                    *(u32x4*)(O + (size_t)row * 1024 + col0) = pack8(a, b);
                }
                s2 += __shfl_xor(s2, 16); s2 += __shfl_xor(s2, 32);
                if (fq == 0) ss[row * 16 + u.pn * 4 + wc] = s2;
            }
    }
};
struct EpiFF1 {
    static constexpr bool PERM = true, MID = false;
    bf16* H; const float* r;
    __device__ __forceinline__ void operator()(AccRef acc, const pg8::Unit& u, int wr, int wc, int fr, int fq) const {
#pragma unroll
        for (int ai = 0; ai < 2; ++ai)
#pragma unroll
            for (int m = 0; m < 4; ++m) {
                const int row = u.pm * 256 + ai * 128 + wr * 64 + m * 16 + fr; const float rs = r[row];
#pragma unroll
                for (int bj = 0; bj < 2; ++bj) {
                    const int col0 = u.pn * 256 + bj * 128 + wc * 32 + 8 * fq;
                    f32x4 a = acc[ai][bj][m][0] * rs, b = acc[ai][bj][m][1] * rs;
#pragma unroll
                    for (int j = 0; j < 4; ++j) { a[j] = fmaxf(a[j], 0.f); a[j] *= a[j]; b[j] = fmaxf(b[j], 0.f); b[j] *= b[j]; }
                    *(u32x4*)(H + (size_t)row * 4096 + col0) = pack8(a, b);
                }
            }
    }
};

__device__ __forceinline__ void transpose_item(const float* W, int ldw, bf16* WT, int ldt, const float* sc_lo, const float* sc_hi, int split,
                                               LAS float* scr, int item, int nblk, int lane) {
    const int kb = item / nblk, nb = item % nblk, k0 = 64 * kb, n0 = 32 * nb;
#pragma unroll 16
    for (int i = 0; i < 32; ++i) { const int kk = 2 * i + (lane >> 5), k = k0 + kk;
        float s = 1.f; if (sc_lo) s = (k < split) ? sc_lo[k] : sc_hi[k - split];
        scr[kk * 33 + (lane & 31)] = W[(size_t)k * ldw + n0 + (lane & 31)] * s; }
    asm volatile("s_waitcnt lgkmcnt(0)" ::: "memory");
    const int c = lane & 7;
#pragma unroll
    for (int j = 0; j < 4; ++j) { const int n = (lane >> 3) + 8 * j; const LAS float* s = scr + (8 * c) * 33 + n;
        u32x4 o; o.x = pk2(s[0 * 33], s[1 * 33]); o.y = pk2(s[2 * 33], s[3 * 33]); o.z = pk2(s[4 * 33], s[5 * 33]); o.w = pk2(s[6 * 33], s[7 * 33]);
        *(u32x4*)(WT + (size_t)(n0 + n) * ldt + k0 + 8 * c) = o; }
    asm volatile("s_waitcnt lgkmcnt(0)" ::: "memory");
}

__device__ __forceinline__ void fold_item(const Params& p, int item, LAS unsigned char* lds) {
    int tid = threadIdx.x; asm volatile("" : "+v"(tid)); const int ly = item >> 7, h = (item >> 4) & 7, kb = item & 15, k0 = kb * 64;
    LAS float* Wt = (LAS float*)lds;
    LAS float* Wf = Wt + 64 * 65;
    LAS float* TC = Wf + 64 * 65;
    LAS float* TS = TC + 64 * 65;
    LAS float* cs = TS + 64 * 65;
    __syncthreads();
    const float* win = p.w_in + (size_t)ly * 1024 * 1024; const float* wf = p.w_fourier + ((size_t)ly * 8 + h) * 4096; const float* g = p.pre_mix_g + ly * 1024;
    for (int i = tid; i < 4096; i += 512) { const int k = i >> 6, c = i & 63; Wt[k * 65 + c] = win[(size_t)(k0 + k) * 1024 + 64 * h + c] * g[k0 + k]; Wf[k * 65 + c] = wf[i]; }
    if (tid < 64) { float s, c; sincospif((float)tid / 32.0f, &s, &c); cs[tid] = c; cs[64 + tid] = s; }
    __syncthreads();
    { const int d = tid & 63, kg = tid >> 6; float ac[8], as[8];
#pragma unroll
      for (int j = 0; j < 8; ++j) { ac[j] = 0.f; as[j] = 0.f; }
#pragma unroll 2
      for (int c = 0; c < 64; ++c) { const int ph = (c * d) & 63; const float cv = cs[ph], sv = cs[64 + ph];
#pragma unroll
          for (int j = 0; j < 8; ++j) { const float w = Wt[(kg * 8 + j) * 65 + c]; ac[j] += w * cv; as[j] += w * sv; } }
#pragma unroll
      for (int j = 0; j < 8; ++j) { TC[(kg * 8 + j) * 65 + d] = ac[j]; TS[(kg * 8 + j) * 65 + d] = as[j]; } }
    __syncthreads();
    const float scale = 1.0f / 724.0773439350247f;
    bf16* WT = (bf16*)(p.ws + OFF_W + (size_t)ly * W_LAYER + W_IN);
    { const int k = tid & 63, eg = tid >> 6; float ap[8], aq[8];
#pragma unroll
      for (int j = 0; j < 8; ++j) { ap[j] = 0.f; aq[j] = 0.f; }
#pragma unroll 2
      for (int d = 0; d < 64; ++d) { const float tc = TC[k * 65 + d], ts = TS[k * 65 + d];
#pragma unroll
          for (int j = 0; j < 8; ++j) { const float w = Wf[d * 65 + eg * 8 + j]; ap[j] += tc * w; aq[j] += ts * w; } }
#pragma unroll
      for (int j = 0; j < 8; ++j) { const int e = eg * 8 + j;
          WT[(size_t)(64 * h + e) * 1024 + k0 + k] = (bf16)f2bf(ap[j] * scale);
          WT[(size_t)(512 + 64 * h + e) * 1024 + k0 + k] = (bf16)f2bf(-aq[j] * scale); } }
}

__device__ __forceinline__ void ssm_mat_item(const Params& p, int item, LAS unsigned char* lds) {
    int tid = threadIdx.x; asm volatile("" : "+v"(tid)); const int ly = item >> 7, g = (item >> 2) & 31, qt = item & 3;
    LAS float* pwr = (LAS float*)lds;
    LAS float* pwi = pwr + 2 * 64 * 20;
    LAS float* bbr = pwi + 2 * 64 * 20;
    LAS float* bbi = bbr + 2 * 64 * 16;
    LAS float* ccr = bbi + 2 * 64 * 16;
    LAS float* cci = ccr + 2 * 16 * 64;
    LAS float* Gt = cci + 2 * 16 * 64;
    __syncthreads();
    { const int k = (tid >> 6) & 1, pp = tid & 63, tg = tid >> 7; const int idx = (ly * 2 + k) * 32 + g;
      const float dt = expf(p.log_dt[idx]); const float lr = p.lam_re[idx * 64 + pp] * dt, li = p.lam_im[idx * 64 + pp] * dt;
#pragma unroll
      for (int j = 0; j < 5; ++j) { const int tau = tg * 5 + j; if (tau <= 16) { const float e = __expf(lr * tau); float sn, cs; __sincosf(li * tau, &sn, &cs); pwr[(k * 64 + pp) * 20 + tau] = e * cs; pwi[(k * 64 + pp) * 20 + tau] = e * sn; } } }
    for (int i = tid; i < 2048; i += 512) { const int k = i >> 10, r = i & 1023; const int idx = (ly * 2 + k) * 32 + g; ccr[i] = p.c_re[(size_t)idx * 1024 + r]; cci[i] = p.c_im[(size_t)idx * 1024 + r]; }
    __syncthreads();
#pragma unroll
    for (int j = 0; j < 4; ++j) { const int o = tid + 512 * j, k = o >> 10, pp = (o >> 4) & 63, h = o & 15; const int idx = (ly * 2 + k) * 32 + g;
        const float lr = p.lam_re[idx * 64 + pp], li = p.lam_im[idx * 64 + pp], dt = expf(p.log_dt[idx]);
        float sn, cs; sincosf(li * dt, &sn, &cs); const float em1 = expm1f(lr * dt), sh = sinf(0.5f * li * dt);
        const float lbr = em1 * cs - 2.0f * sh * sh, lbi = (em1 + 1.0f) * sn;
        const float den = 1.0f / (lr * lr + li * li); const float cr = (lbr * lr + lbi * li) * den, ci = (lbi * lr - lbr * li) * den;
        const float br = p.b_re[(size_t)idx * 1024 + pp * 16 + h], bi = p.b_im[(size_t)idx * 1024 + pp * 16 + h];
        bbr[o] = cr * br - ci * bi; bbi[o] = cr * bi + ci * br; }
    __syncthreads();
    { const int k = tid >> 8, i = (tid >> 4) & 15, h = tid & 15; float a[16];
#pragma unroll
      for (int tau = 0; tau < 16; ++tau) a[tau] = 0.f;
#pragma nounroll
      for (int pp = 0; pp < 64; ++pp) { const float c_r = ccr[(k * 16 + i) * 64 + pp], c_i = cci[(k * 16 + i) * 64 + pp], b_r = bbr[(k * 64 + pp) * 16 + h], b_i = bbi[(k * 64 + pp) * 16 + h];
          const float xr = c_r * b_r - c_i * b_i, xi = c_r * b_i + c_i * b_r;
          const LAS f32x4* pr4 = (const LAS f32x4*)(pwr + (k * 64 + pp) * 20); const LAS f32x4* pi4 = (const LAS f32x4*)(pwi + (k * 64 + pp) * 20);
#pragma unroll
          for (int t4 = 0; t4 < 4; ++t4) { const f32x4 vr = pr4[t4], vi = pi4[t4];
#pragma unroll
              for (int e = 0; e < 4; ++e) a[t4 * 4 + e] += xr * vr[e] - xi * vi[e]; } }
#pragma unroll
      for (int tau = 0; tau < 16; ++tau) Gt[((k * 16 + tau) * 16 + i) * 16 + h] = a[tau]; }
    __syncthreads();
    bf16* TM = (bf16*)(p.ws + OFF_TM) + (size_t)(ly * 32 + g) * 256 * 512; bf16* MS = (bf16*)(p.ws + OFF_MST) + (size_t)(ly * 32 + g) * 256 * 256;
    const float* dsk = p.d_skip + (ly * 32 + g) * 16;
    for (int o = qt * 64 * 512 + tid; o < (qt + 1) * 64 * 512; o += 512) { const int r = o >> 9, col = o & 511, t = r >> 4, i = r & 15; float v;
        if (col < 256) { const int j = col >> 4, h = col & 15; v = 0.f;
            if (j <= t) v += Gt[((0 * 16 + (t - j)) * 16 + i) * 16 + h];
            if (j >= t) v += Gt[((1 * 16 + (j - t)) * 16 + i) * 16 + h];
            if (j == t && h == i) v += dsk[i]; }
        else { const int k = (col - 256) >> 7, q = (col - 256) & 127, pp = q >> 1, part = q & 1; const int tau = k == 0 ? (t + 1) : (16 - t);
            const float c_r = ccr[(k * 16 + i) * 64 + pp], c_i = cci[(k * 16 + i) * 64 + pp], l_r = pwr[(k * 64 + pp) * 20 + tau], l_i = pwi[(k * 64 + pp) * 20 + tau];
            v = part == 0 ? (c_r * l_r - c_i * l_i) : -(c_r * l_i + c_i * l_r); }
        TM[o] = (bf16)f2bf(v); }
    for (int o = qt * 64 * 256 + tid; o < (qt + 1) * 64 * 256; o += 512) { const int r = o >> 8, col = o & 255, k = r >> 7, q = r & 127, pp = q >> 1, part = q & 1, j = col >> 4, h = col & 15;
        const int tau = k == 0 ? (15 - j) : j;
        const float l_r = pwr[(k * 64 + pp) * 20 + tau], l_i = pwi[(k * 64 + pp) * 20 + tau], b_r = bbr[(k * 64 + pp) * 16 + h], b_i = bbi[(k * 64 + pp) * 16 + h];
        const float v = part == 0 ? (l_r * b_r - l_i * b_i) : (l_r * b_i + l_i * b_r);
        MS[o] = (bf16)f2bf(v); }
}

__device__ __forceinline__ void p0_prologue(const Params& p, LAS unsigned char* lds, int G, int bid) {
    int tid = threadIdx.x; asm volatile("" : "+v"(tid));
    const int lane = tid & 63, wave = __builtin_amdgcn_readfirstlane(tid >> 6);
    for (int rp = 0; rp < P0_REP_A; ++rp)
    for (int it = bid; it < 512; it += G) { if (it < 256) { for (int r2 = 0; r2 < P0_REP_F; ++r2) fold_item(p, it, lds); } else { for (int r2 = 0; r2 < P0_REP_S; ++r2) ssm_mat_item(p, it - 256, lds); } }
    __syncthreads();
    {
        LAS float* scr = (LAS float*)(lds + wave * 8448);
        const int gw = bid * 8 + wave, NGW = G * 8;
        constexpr int I_IN = 16 * 16, I_OUT = 16 * 32, I_1 = 16 * 128, I_2 = 64 * 32, I_G = 8 * 16, I_L = I_IN + I_OUT + I_1 + I_2 + I_G;
        for (int rp = 0; rp < P0_REP_B; ++rp)
        for (int it = gw; it < 2 * I_L; it += NGW) {
            const int ly = it / I_L; int r = it % I_L; unsigned char* wb = p.ws + OFF_W + (size_t)ly * W_LAYER;
            if (r < I_IN) { transpose_item(p.w_in + (size_t)ly * 1024 * 1024 + 512, 1024, (bf16*)(wb + W_IN) + (size_t)1024 * 1024, 1024, p.pre_mix_g + ly * 1024, nullptr, 1 << 30, scr, r, 16, lane); continue; } r -= I_IN;
            if (r < I_OUT) { transpose_item(p.w_out + (size_t)ly * 1024 * 1024, 1024, (bf16*)(wb + W_OUT), 1024, p.fourier_out_g + ly * 512, p.ssm_out_g + ly * 512, 512, scr, r, 32, lane); continue; } r -= I_OUT;
            if (r < I_1) { transpose_item(p.w_ff1 + (size_t)ly * 1024 * 4096, 4096, (bf16*)(wb + W_1), 1024, p.pre_mlp_g + ly * 1024, nullptr, 1 << 30, scr, r, 128, lane); continue; } r -= I_1;
            if (r < I_2) { transpose_item(p.w_ff2 + (size_t)ly * 4096 * 1024, 1024, (bf16*)(wb + W_2), 4096, nullptr, nullptr, 0, scr, r, 32, lane); continue; } r -= I_2;
            transpose_item(p.w_glu + (size_t)ly * 512 * 512, 512, (bf16*)(wb + W_GLU), 512, nullptr, nullptr, 0, scr, r, 16, lane);
        }
        bf16* XB = (bf16*)(p.ws + OFF_XB); float* rA = (float*)(p.ws + OFF_RA);
        for (int rp = 0; rp < P0_REP_C; ++rp)
        for (int row0 = gw; row0 < MT; row0 += 4 * NGW) {
            f32x4 v[4][4];
#pragma unroll
            for (int rr = 0; rr < 4; ++rr) { const f32x4* xr = (const f32x4*)(p.x + (size_t)(row0 + rr * NGW) * 1024) + lane;
#pragma unroll
                for (int j = 0; j < 4; ++j) v[rr][j] = xr[64 * j]; }
#pragma unroll
            for (int rr = 0; rr < 4; ++rr) { const int row = row0 + rr * NGW; float s2 = 0.f;
                u32x2* o = (u32x2*)(XB + (size_t)row * 1024) + lane;
#pragma unroll
                for (int j = 0; j < 4; ++j) { const f32x4 t = v[rr][j]; s2 += t[0] * t[0] + t[1] * t[1] + t[2] * t[2] + t[3] * t[3]; u32x2 w; w.x = pk2(t[0], t[1]); w.y = pk2(t[2], t[3]); o[64 * j] = w; }
                s2 = wave_sum(s2);
                if (lane == 0) rA[row] = rsqrtf(s2 * (1.0f / 1024.0f) + EPS); }
        }
    }
    {
        bf16* D1 = (bf16*)(p.ws + OFF_D1); bf16* E3 = (bf16*)(p.ws + OFF_E3);
        const int gt = bid * 512 + tid, NT = G * 512;
        for (int idx = gt; idx < 64 * 2 * 128 * 128; idx += NT) { const int n2 = idx >> 15, sel = (idx >> 14) & 1, k1 = (idx >> 7) & 127, n1 = idx & 127;
            const int ph = (k1 * (64 * n1 + n2)) & 8191; float s, c; sincospif((float)ph * (1.0f / 4096.0f), &s, &c); D1[idx] = (bf16)f2bf(sel ? s : c); }
        for (int idx = gt; idx < 64 * 128; idx += NT) { const int k2 = idx >> 7, col = idx & 127, part = col >> 6, n2 = col & 63;
            const int ph = (n2 * k2) & 63; float s, c; sincospif((float)ph * (1.0f / 32.0f), &s, &c); E3[idx] = (bf16)f2bf(part ? s : c); }
    }
}

typedef short v4s16 __attribute__((ext_vector_type(4)));
__device__ __forceinline__ bf16x8 negbf(bf16x8 v) { u32x4 t = __builtin_bit_cast(u32x4, v); t = t ^ 0x80008000u; return __builtin_bit_cast(bf16x8, t); }
__device__ __forceinline__ bf16x8 tr_frag(const LAS unsigned char* a, int hs) {
    const v4s16 lo = __builtin_amdgcn_ds_read_tr16_b64_v4i16((LAS v4s16*)a), hi = __builtin_amdgcn_ds_read_tr16_b64_v4i16((LAS v4s16*)(a + hs));
    return __builtin_shufflevector(lo, hi, 0, 1, 2, 3, 4, 5, 6, 7);
}
constexpr int F1_P = 264, F1_CS = 256 * F1_P;
__device__ __forceinline__ void fft1_phase(const bf16* PQ, const bf16* D1, bf16* T, LAS unsigned char* lds, int G, int bid) {
    int tid = threadIdx.x; asm volatile("" : "+v"(tid));
    const int lane = tid & 63, wave = __builtin_amdgcn_readfirstlane(tid >> 6), wm = wave & 3, wn = wave >> 2, fr = lane & 15, fq = lane >> 4, tq = fr >> 2, tp = fr & 3;
    for (int pr = bid; pr < 256; pr += G) {
        const int n2 = pr & 63, cb = pr >> 6;
        __syncthreads();
        {
            const bf16* src = D1 + (size_t)n2 * 2 * 128 * 128;
#pragma unroll
            for (int j = 0; j < 8; ++j) { const int q = tid + 512 * j, sel = q >> 11, row = (q >> 4) & 127, cc = q & 15;
                *(LAS u32x4*)(lds + F1_CS + sel * 34816 + row * 272 + cc * 16) = *(const u32x4*)(src + sel * 16384 + row * 128 + 8 * cc); }
        }
        for (int b = 0; b < NB; ++b) {
            __syncthreads();
#pragma unroll
            for (int j = 0; j < 8; ++j) { const int q = tid + 512 * j, row = q >> 4, cc = q & 15, part = row >> 7, n1 = row & 127;
                const u32x4 v = *(const u32x4*)(PQ + ((size_t)(b * SEQ + 64 * n1 + n2)) * 1024 + part * 512 + cb * 128 + 8 * cc);
                LAS u32x2* d = (LAS u32x2*)(lds + row * F1_P + cc * 16); d[0] = (u32x2){v.x, v.y}; d[1] = (u32x2){v.z, v.w}; }
            __syncthreads();
            f32x4 Ar[2][4], Ai[2][4];
#pragma unroll
            for (int mb = 0; mb < 2; ++mb)
#pragma unroll
                for (int nb = 0; nb < 4; ++nb) { Ar[mb][nb] = (f32x4){0.f, 0.f, 0.f, 0.f}; Ai[mb][nb] = (f32x4){0.f, 0.f, 0.f, 0.f}; }
#pragma nounroll
            for (int ks = 0; ks < 8; ++ks) {
                bf16x8 Bf[4];
#pragma unroll
                for (int nb = 0; nb < 4; ++nb) Bf[nb] = tr_frag(lds + (32 * ks + 8 * fq + tq) * F1_P + (64 * wn + 16 * tp + 4 * nb) * 2, 4 * F1_P);
                bf16x8 Cf[2], Sf[2];
#pragma unroll
                for (int mb = 0; mb < 2; ++mb) { const int off = F1_CS + (32 * wm + 16 * mb + fr) * 272 + (32 * (ks & 3) + 8 * fq) * 2; Cf[mb] = *(const LAS bf16x8*)(lds + off); Sf[mb] = *(const LAS bf16x8*)(lds + off + 34816); }
#pragma unroll
                for (int mb = 0; mb < 2; ++mb)
#pragma unroll
                    for (int nb = 0; nb < 4; ++nb) {
                        if (ks < 4) { Ar[mb][nb] = __builtin_amdgcn_mfma_f32_16x16x32_bf16(Bf[nb], Cf[mb], Ar[mb][nb], 0, 0, 0);
                                      Ai[mb][nb] = __builtin_amdgcn_mfma_f32_16x16x32_bf16(Bf[nb], negbf(Sf[mb]), Ai[mb][nb], 0, 0, 0); }
                        else        { Ar[mb][nb] = __builtin_amdgcn_mfma_f32_16x16x32_bf16(Bf[nb], Sf[mb], Ar[mb][nb], 0, 0, 0);
                                      Ai[mb][nb] = __builtin_amdgcn_mfma_f32_16x16x32_bf16(Bf[nb], Cf[mb], Ai[mb][nb], 0, 0, 0); }
                    }
            }
#pragma unroll
            for (int mb = 0; mb < 2; ++mb) { const int k1 = 32 * wm + 16 * mb + fr, c = cb * 128 + 64 * wn + 16 * fq;
                bf16* t0 = T + ((((size_t)(b * 128 + k1) * 2 + 0) * 64 + n2) * 512 + c); bf16* t1 = t0 + 64 * 512;
                *(u32x4*)t0 = pack8(Ar[mb][0], Ar[mb][1]); *(u32x4*)(t0 + 8) = pack8(Ar[mb][2], Ar[mb][3]);
                *(u32x4*)t1 = pack8(Ai[mb][0], Ai[mb][1]); *(u32x4*)(t1 + 8) = pack8(Ai[mb][2], Ai[mb][3]); }
        }
    }
    __syncthreads();
}

constexpr int F3_P = 1032;
__device__ __forceinline__ void fft3_phase(const bf16* T, const bf16* E3, bf16* AO, LAS unsigned char* lds, int G, int bid) {
    int tid = threadIdx.x; asm volatile("" : "+v"(tid));
    const int lane = tid & 63, wave = __builtin_amdgcn_readfirstlane(tid >> 6), fr = lane & 15, fq = lane >> 4, tq = fr >> 2, tp = fr & 3;
    LAS float* red = (LAS float*)(lds + 128 * F3_P);
    for (int unit = bid; unit < 512; unit += G) {
        const int b = unit >> 7, k1 = unit & 127;
        __syncthreads();
        const bf16* src = T + (size_t)unit * 65536;
#pragma unroll
        for (int j = 0; j < 16; ++j) { const int q = tid + 512 * j, row = q >> 6, cc = q & 63;
            const u32x4 v = *(const u32x4*)(src + row * 512 + cc * 8);
            LAS u32x2* d = (LAS u32x2*)(lds + row * F3_P + cc * 16); d[0] = (u32x2){v.x, v.y}; d[1] = (u32x2){v.z, v.w}; }
        __syncthreads();
        f32x4 acc[4][4];
#pragma unroll
        for (int mb = 0; mb < 4; ++mb)
#pragma unroll
            for (int nb = 0; nb < 4; ++nb) acc[mb][nb] = (f32x4){0.f, 0.f, 0.f, 0.f};
        bf16x8 Ef[4];
#pragma unroll
        for (int mb = 0; mb < 4; ++mb) Ef[mb] = *(const bf16x8*)(E3 + (16 * mb + fr) * 128 + 8 * fq);
#pragma nounroll
        for (int ks = 0; ks < 4; ++ks) {
            bf16x8 Bf[4], En[4];
            const int kn = ks < 3 ? ks + 1 : 3;
#pragma unroll
            for (int mb = 0; mb < 4; ++mb) En[mb] = *(const bf16x8*)(E3 + (16 * mb + fr) * 128 + 32 * kn + 8 * fq);
#pragma unroll
            for (int nb = 0; nb < 4; ++nb) Bf[nb] = tr_frag(lds + (32 * ks + 8 * fq + tq) * F3_P + (64 * wave + 16 * tp + 4 * nb) * 2, 4 * F3_P);
#pragma unroll
            for (int mb = 0; mb < 4; ++mb)
#pragma unroll
                for (int nb = 0; nb < 4; ++nb) acc[mb][nb] = __builtin_amdgcn_mfma_f32_16x16x32_bf16(Bf[nb], Ef[mb], acc[mb][nb], 0, 0, 0);
#pragma unroll
            for (int mb = 0; mb < 4; ++mb) Ef[mb] = En[mb];
        }
#pragma unroll
        for (int mb = 0; mb < 4; ++mb) { float s = 0.f;
#pragma unroll
            for (int nb = 0; nb < 4; ++nb)
#pragma unroll
                for (int j = 0; j < 4; ++j) s += acc[mb][nb][j] * acc[mb][nb][j];
            s += __shfl_xor(s, 16); s += __shfl_xor(s, 32);
            if (fq == 0) red[wave * 64 + 16 * mb + fr] = s; }
        __syncthreads();
#pragma unroll
        for (int mb = 0; mb < 4; ++mb) { float tot = 0.f;
#pragma unroll
            for (int w = 0; w < 8; ++w) tot += red[w * 64 + 16 * mb + fr];
            const float rinv = rsqrtf(tot * (1.0f / 512.0f) + EPS);
            const size_t token = (size_t)b * SEQ + k1 + 128 * (16 * mb + fr);
            bf16* o = AO + token * 1024 + 64 * wave + 16 * fq;
            *(u32x4*)o = pack8(acc[mb][0] * rinv, acc[mb][1] * rinv); *(u32x4*)(o + 8) = pack8(acc[mb][2] * rinv, acc[mb][3] * rinv); }
    }
    __syncthreads();
}

__device__ __forceinline__ void carry_phase(const Params& p, int ly, const float* Sloc, bf16* UB, LAS unsigned char* lds, int G, int bid) {
    int tid = threadIdx.x; asm volatile("" : "+v"(tid));
    const int lane = tid & 63, wave = __builtin_amdgcn_readfirstlane(tid >> 6);
    LAS f32x2* ex = (LAS f32x2*)lds;
    for (int w = bid; w < 256; w += G) {
        const int dir = w & 1, g = (w >> 1) & 31, b = w >> 6, pp = lane; const int idx = (ly * 2 + dir) * 32 + g;
        const float dt = expf(p.log_dt[idx]); const float lr = p.lam_re[idx * 64 + pp] * dt * 16.0f, li = p.lam_im[idx * 64 + pp] * dt * 16.0f;
        const float e = expf(lr); float sn, cs; sincosf(li, &sn, &cs); const float l_r = e * cs, l_i = e * sn;
        float Lr = l_r, Li = l_i;
#pragma unroll
        for (int k = 0; k < 6; ++k) { const float nr = Lr * Lr - Li * Li, ni = 2.0f * Lr * Li; Lr = nr; Li = ni; }
        const float* src = Sloc + ((size_t)(g * 2048 + b * 512)) * 256 + dir * 128 + 2 * pp;
        bf16* dst = UB + ((size_t)(g * 2048 + b * 512)) * 512 + 256 + dir * 128 + 2 * pp;
        const int ss0 = dir == 0 ? wave * 64 : 511 - wave * 64; const long stp = dir == 0 ? 256 : -256;
        float cr = 0.f, ci = 0.f;
        { const float* ptr = src + (size_t)ss0 * 256;
#pragma nounroll
          for (int hb = 0; hb < 2; ++hb) {
            f32x2 v[32];
#pragma unroll
            for (int j = 0; j < 32; ++j) { v[j] = *(const f32x2*)ptr; ptr += stp; }
#pragma unroll
            for (int j = 0; j < 32; ++j) { const float nr = l_r * cr - l_i * ci + v[j][0], ni = l_r * ci + l_i * cr + v[j][1]; cr = nr; ci = ni; }
          } }
        __syncthreads();
        ex[wave * 64 + lane] = (f32x2){cr, ci};
        __syncthreads();
        cr = 0.f; ci = 0.f;
        for (int u = 0; u < wave; ++u) { const f32x2 eu = ex[u * 64 + lane]; const float nr = Lr * cr - Li * ci + eu[0], ni = Lr * ci + Li * cr + eu[1]; cr = nr; ci = ni; }
        { const float* ptr = src + (size_t)ss0 * 256; bf16* dp = dst + (size_t)ss0 * 512;
#pragma nounroll
          for (int hb = 0; hb < 2; ++hb) {
            f32x2 v[32];
#pragma unroll
            for (int j = 0; j < 32; ++j) { v[j] = *(const f32x2*)ptr; ptr += stp; }
#pragma unroll
            for (int j = 0; j < 32; ++j) {
                *(unsigned*)dp = pk2(cr, ci); dp += 2 * stp;
                const float nr = l_r * cr - l_i * ci + v[j][0], ni = l_r * ci + l_i * cr + v[j][1]; cr = nr; ci = ni; }
          } }
    }
    __syncthreads();
}

__device__ __forceinline__ void norm_phase(float* out, const bf16* MF, const float* ss, const float* gain, bf16* XB, float* rnext, bool last, int G, int bid) {
    int tid = threadIdx.x; asm volatile("" : "+v"(tid));
    const int lane = tid & 63, wave = __builtin_amdgcn_readfirstlane(tid >> 6);
    const int gw = bid * 8 + wave, NGW = G * 8;
    const f32x4* gr = (const f32x4*)gain + lane;
    const f32x4 g0 = gr[0], g1 = gr[64], g2 = gr[128], g3 = gr[192];
    for (int row0 = gw; row0 < MT; row0 += 2 * NGW) {
        u32x2 xv[2][4], mv[2][4]; float tot[2];
#pragma unroll
        for (int rr = 0; rr < 2; ++rr) { const int row = row0 + rr * NGW;
            const u32x2* xr = (const u32x2*)(XB + (size_t)row * 1024) + lane; const u32x2* mr = (const u32x2*)(MF + (size_t)row * 1024) + lane;
#pragma unroll
            for (int j = 0; j < 4; ++j) { xv[rr][j] = xr[64 * j]; mv[rr][j] = mr[64 * j]; }
            const f32x4* sp = (const f32x4*)(ss + (size_t)row * 16); const f32x4 s0 = sp[0], s1 = sp[1], s2 = sp[2], s3 = sp[3];
            tot[rr] = ((((s0[0] + s0[1]) + s0[2]) + s0[3]) + (((s1[0] + s1[1]) + s1[2]) + s1[3])) + ((((s2[0] + s2[1]) + s2[2]) + s2[3]) + (((s3[0] + s3[1]) + s3[2]) + s3[3])); }
#pragma unroll
        for (int rr = 0; rr < 2; ++rr) { const int row = row0 + rr * NGW;
            const float rinv = rsqrtf(tot[rr] * (1.0f / 1024.0f) + EPS); float s2 = 0.f;
#pragma unroll
            for (int j = 0; j < 4; ++j) { const f32x4 gg = j == 0 ? g0 : (j == 1 ? g1 : (j == 2 ? g2 : g3)); const u32x2 xx = xv[rr][j], mm = mv[rr][j]; f32x4 v;
                v[0] = bflo(xx.x) + bflo(mm.x) * rinv * gg[0]; v[1] = bfhi(xx.x) + bfhi(mm.x) * rinv * gg[1]; v[2] = bflo(xx.y) + bflo(mm.y) * rinv * gg[2]; v[3] = bfhi(xx.y) + bfhi(mm.y) * rinv * gg[3];
                if (last) { ((f32x4*)(out + (size_t)row * 1024) + lane)[64 * j] = v; }
                else { u32x2 w; w.x = pk2(v[0], v[1]); w.y = pk2(v[2], v[3]); ((u32x2*)(XB + (size_t)row * 1024) + lane)[64 * j] = w;
                       const float a0 = bflo(w.x), a1 = bfhi(w.x), a2 = bflo(w.y), a3 = bfhi(w.y); s2 += a0 * a0 + a1 * a1 + a2 * a2 + a3 * a3; } }
            if (!last) { s2 = wave_sum(s2); if (lane == 0) rnext[row] = rsqrtf(s2 * (1.0f / 1024.0f) + EPS); } }
    }
}
__device__ __forceinline__ void rescale_phase(bf16* AO, const float* ss, int G, int bid) {
    int tid = threadIdx.x; asm volatile("" : "+v"(tid));
    const int lane = tid & 63, wave = __builtin_amdgcn_readfirstlane(tid >> 6);
    const int gw = bid * 8 + wave, NGW = G * 8;
    for (int row = gw; row < MT; row += NGW) {
        float tot = 0.f;
#pragma unroll
        for (int k = 0; k < 8; ++k) tot += ss[row * 8 + k];
        const float rinv = rsqrtf(tot * (1.0f / 512.0f) + EPS);
        u32x4* ptr = (u32x4*)(AO + (size_t)row * 1024 + 512) + lane; u32x4 v = *ptr;
        v.x = pk2(bflo(v.x) * rinv, bfhi(v.x) * rinv); v.y = pk2(bflo(v.y) * rinv, bfhi(v.y) * rinv); v.z = pk2(bflo(v.z) * rinv, bfhi(v.z) * rinv); v.w = pk2(bflo(v.w) * rinv, bfhi(v.w) * rinv);
        *ptr = v;
    }
}


#define XB_TMO      128
#define XB_XCNT(j)  (256  + 64 * (j))
#define XB_XSUB(j)  (1280 + 64 * (j))
#define XB_XGEN(j)  (2304 + 64 * (j))
#define XB_TOP      3328
#define XB_TOPGEN   3392
#define XCD_BAR_WORDS 3456
#define XB_SPIN_CAP (1u << 18)
__device__ __forceinline__ unsigned xb_ld(unsigned* p)              { return __hip_atomic_load(p, __ATOMIC_RELAXED, __HIP_MEMORY_SCOPE_AGENT); }
__device__ __forceinline__ unsigned xb_add(unsigned* p, unsigned v) { return __hip_atomic_fetch_add(p, v, __ATOMIC_RELAXED, __HIP_MEMORY_SCOPE_AGENT); }
__device__ __forceinline__ unsigned xb_xcc_id() { return (unsigned)__builtin_amdgcn_s_getreg((3 << 11) | 20) & 0xFu; }
#define XB_SPIN(cond, bar) do { unsigned _sp = 0; while (cond) { __builtin_amdgcn_s_sleep(1); \
    if ((++_sp & 255u) == 0u) { if (xb_ld(&(bar)[XB_TMO])) break; if (_sp > XB_SPIN_CAP) { atomicAdd(&(bar)[XB_TMO], 1u); break; } } } } while (0)
struct XcdBarrier { unsigned* bar; unsigned x; volatile LAS unsigned* st; };
__device__ __forceinline__ XcdBarrier xcd_barrier_post(unsigned* bar, volatile LAS unsigned* st) {
    XcdBarrier b; b.bar = bar; b.x = xb_xcc_id(); b.st = st;
    if (threadIdx.x == 0) (void)xb_add(&bar[XB_XCNT(b.x)], 1u);
    return b;
}
__device__ __forceinline__ void xcd_barrier_complete(unsigned* bar, unsigned x, unsigned& nloc, unsigned& nx) {
    const unsigned G = gridDim.x * gridDim.y * gridDim.z;
    unsigned sum, cnt, mine, sp = 0u;
    for (;;) {
        sum = 0u; cnt = 0u; mine = 0u;
#pragma unroll
        for (unsigned j = 0; j < 16; ++j) { const unsigned c = xb_ld(&bar[XB_XCNT(j)]); sum += c; cnt += (c > 0u) ? 1u : 0u; mine = (j == x) ? c : mine; }
        if (sum == G) break;
        __builtin_amdgcn_s_sleep(1);
        if ((++sp & 255u) == 0u) { if (xb_ld(&bar[XB_TMO])) break; if (sp > XB_SPIN_CAP) { atomicAdd(&bar[XB_TMO], 1u); break; } }
    }
    nloc = mine > 0u ? mine : 1u; nx = cnt > 0u ? cnt : 1u;
}
__device__ __forceinline__ void xcd_barrier(const XcdBarrier& b) {
    asm volatile("s_waitcnt vmcnt(0)" ::: "memory");
    __syncthreads();
    if (threadIdx.x == 0) {
        unsigned* bar = b.bar;
        __builtin_amdgcn_s_waitcnt(0);
        unsigned nloc = b.st[0], nx = b.st[1];
        if (nloc == 0u) { xcd_barrier_complete(bar, b.x, nloc, nx); b.st[0] = nloc; b.st[1] = nx; }
        const unsigned old = xb_add(&bar[XB_XSUB(b.x)], 1u);
        const unsigned gen = old / nloc;
        if (old + 1u == (gen + 1u) * nloc) {
            __builtin_amdgcn_fence(__ATOMIC_RELEASE, "agent");
            asm volatile("s_waitcnt vmcnt(0)" ::: "memory");
            const unsigned og = xb_add(&bar[XB_TOP], 1u);
            const unsigned tg = og / nx;
            if (og + 1u == (tg + 1u) * nx) xb_add(&bar[XB_TOPGEN], 1u);
            else XB_SPIN(xb_ld(&bar[XB_TOPGEN]) == tg, bar);
            __builtin_amdgcn_fence(__ATOMIC_ACQUIRE, "agent");
            xb_add(&bar[XB_XGEN(b.x)], 1u);
            asm volatile("s_waitcnt vmcnt(0)" ::: "memory");
        } else {
            XB_SPIN(xb_ld(&bar[XB_XGEN(b.x)]) == gen, bar);
            __builtin_amdgcn_fence(__ATOMIC_ACQUIRE, "agent");
            asm volatile("s_waitcnt vmcnt(0)" ::: "memory");
        }
    }
    __syncthreads();
}

#ifndef REP_P0
#define REP_P0 1
#endif
#ifndef REP_SYNC
#define REP_SYNC 1
#endif
#ifndef REP_MASK_V
#define REP_MASK_V 0u
#endif
constexpr unsigned REP_MASK = REP_MASK_V;
constexpr int PH_PER_LAYER = 10, N_PHASES = 1 + 2 * PH_PER_LAYER;
__global__ void __launch_bounds__(512) hybrid_fwd(Params p) {
    extern __shared__ __attribute__((aligned(16))) unsigned char lds_raw[];
    LAS unsigned char* lds = (LAS unsigned char*)lds_raw;
    cg::grid_group grid = cg::this_grid();
    volatile LAS unsigned* xst = (volatile LAS unsigned*)(lds + LDS_BYTES - 16);
    if (threadIdx.x < 4) xst[threadIdx.x] = 0u;
    __syncthreads();
    const XcdBarrier xbar = xcd_barrier_post((unsigned*)(p.ws + OFF_BAR), xst);
    if (p.ph_hi > 1000) grid.sync();
    const int Gk = gridDim.x, bk = blockIdx.x;
    unsigned char* ws = p.ws;
    float* sss = (float*)(ws + OFF_SSS); float* ssm = (float*)(ws + OFF_SSM); float* ssf = (float*)(ws + OFF_SSF); float* rA = (float*)(ws + OFF_RA); float* rB = (float*)(ws + OFF_RB);
    bf16* XB = (bf16*)(ws + OFF_XB); bf16* MF = (bf16*)(ws + OFF_MF); bf16* GB = (bf16*)(ws + OFF_G); bf16* HB = (bf16*)(ws + OFF_H);
    bf16* PQ = (bf16*)(ws + OFF_PQ); bf16* AO = (bf16*)(ws + OFF_AO); bf16* UB = (bf16*)(ws + OFF_UB); bf16* TB = (bf16*)(ws + OFF_T); float* SL = (float*)(ws + OFF_SLOC);

#pragma nounroll
    for (int ph = p.ph_lo; ph < p.ph_hi; ++ph) {
        int G = Gk, bid = bk; asm volatile("" : "+s"(G), "+s"(bid));
        if (ph == 0) { for (int rep = 0; rep < REP_P0; ++rep) p0_prologue(p, lds, G, bid); }
        else {
            const int ly = (ph - 1) / PH_PER_LAYER, sp = (ph - 1) % PH_PER_LAYER;
            unsigned char* wb = ws + OFF_W + (size_t)ly * W_LAYER;
            pg8::Order S;
            const int nrep = ((REP_MASK >> sp) & 1u) ? 2 : 1;
            for (int rep = 0; rep < nrep; ++rep)
            switch (sp) {
            case 0: {
                pg8::Gemm g{XB, (const bf16*)(wb + W_IN), MT, NIN, 1024, 1024, 1024, 0, 0, 1}; S.init(MT, NIN, 1, G, bid);
                EpiIn E{PQ, UB, rA}; pg8::gemm_phase<EpiIn>(lds, g, S, E); } break;
            case 1: {
                fft1_phase(PQ, (const bf16*)(ws + OFF_D1), TB, lds, G, bid);
                pg8::Gemm g{UB, (const bf16*)(ws + OFF_MST) + (size_t)ly * 32 * 256 * 256, 2048, 256, 256, 512, 256, (size_t)2048 * 512, (size_t)256 * 256, 32}; S.init(2048, 256, 32, G, bid);
                EpiSloc E{SL}; pg8::gemm_phase<EpiSloc>(lds, g, S, E); } break;
            case 2: {
                carry_phase(p, ly, SL, UB, lds, G, bid);
                fft3_phase(TB, (const bf16*)(ws + OFF_E3), AO, lds, G, bid); } break;
            case 3: {
                pg8::Gemm g{UB, (const bf16*)(ws + OFF_TM) + (size_t)ly * 32 * 256 * 512, 2048, 256, 512, 512, 512, (size_t)2048 * 512, (size_t)256 * 512, 32}; S.init(2048, 256, 32, G, bid);
                EpiSsmOut E{GB}; pg8::gemm_phase<EpiSsmOut>(lds, g, S, E); } break;
            case 4: {
                pg8::Gemm g{GB, (const bf16*)(wb + W_GLU), MT, 512, 512, 512, 512, 0, 0, 1}; S.init(MT, 512, 1, G, bid);
                EpiGlu E{GB, p.b_glu + ly * 512, AO, sss}; pg8::gemm_phase<EpiGlu>(lds, g, S, E); } break;
            case 5: {
                pg8::Gemm g{AO, (const bf16*)(wb + W_OUT), MT, 1024, 1024, 1024, 1024, 0, 0, 1}; S.init(MT, 1024, 1, G, bid);
                LAS float* qv = (LAS float*)(lds + 131072);
                { int tid = threadIdx.x; asm volatile("" : "+v"(tid));
                  for (int i = 0; i < 4; ++i) { pg8::Unit u; if (!S.next(i, u)) break;
                      if (tid < 256) { const f32x4* sp = (const f32x4*)(sss + (size_t)(u.pm * 256 + tid) * 8); const f32x4 a = sp[0], b = sp[1];
                          const float ms = ((((a[0] + a[1]) + a[2]) + a[3]) + (((b[0] + b[1]) + b[2]) + b[3])) * (1.0f / 512.0f) + EPS;
                          qv[i * 256 + tid] = sqrtf(ms); qv[1024 + i * 256 + tid] = rsqrtf(ms); } }
                  __syncthreads(); }
                EpiOutMix E{MF, ssm, qv}; pg8::gemm_phase<EpiOutMix>(lds, g, S, E); } break;
            case 6: norm_phase(p.out, MF, ssm, p.post_mix_g + ly * 1024, XB, rB, false, G, bid); break;
            case 7: {
                pg8::Gemm g{XB, (const bf16*)(wb + W_1), MT, DFF, 1024, 1024, 1024, 0, 0, 1}; S.init(MT, DFF, 1, G, bid);
                EpiFF1 E{HB, rB}; pg8::gemm_phase<EpiFF1>(lds, g, S, E); } break;
            case 8: {
                pg8::Gemm g{HB, (const bf16*)(wb + W_2), MT, 1024, DFF, DFF, DFF, 0, 0, 1}; S.init(MT, 1024, 1, G, bid);
                EpiOutSS E{MF, ssf}; pg8::gemm_phase<EpiOutSS>(lds, g, S, E); } break;
            case 9: norm_phase(p.out, MF, ssf, p.post_mlp_g + ly * 1024, XB, rA, ly == 1, G, bid); break;
            }
        }
        if (ph + 1 < p.ph_hi) for (int rep = 0; rep < REP_SYNC; ++rep) xcd_barrier(xbar);
    }
}

extern "C" void kernel_launch(void* const* d_in, const int* in_sizes, int n_in, void* d_out, int out_size, void* d_ws, size_t ws_size, hipStream_t stream) {
    static int grid = 0;
    if (grid == 0) {
        if (n_in != 22 || ws_size < WS_END) { fprintf(stderr, "kernel_launch: unexpected n_in %d or ws_size %zu (< %zu)\n", n_in, ws_size, (size_t)WS_END); grid = -1; return; }
        int dev = 0, cus = 0, per_cu = 0;
        hipGetDevice(&dev); hipDeviceGetAttribute(&cus, hipDeviceAttributeMultiprocessorCount, dev);
        if (hipFuncSetAttribute((const void*)hybrid_fwd, hipFuncAttributeMaxDynamicSharedMemorySize, LDS_BYTES) != hipSuccess) { fprintf(stderr, "kernel_launch: hipFuncSetAttribute failed\n"); grid = -1; return; }
        if (hipOccupancyMaxActiveBlocksPerMultiprocessor(&per_cu, (const void*)hybrid_fwd, 512, LDS_BYTES) != hipSuccess || per_cu < 1) { fprintf(stderr, "kernel_launch: occupancy query says %d blocks per CU\n", per_cu); per_cu = 1; }
        (void)hipGetLastError();
        grid = cus;
    }
    if (grid < 0) return;
    if (hipMemsetAsync((char*)d_ws + OFF_BAR, 0, BAR_BYTES, stream) != hipSuccess) { fprintf(stderr, "kernel_launch: memset of the barrier words failed\n"); return; }
    Params p{};
    const float** f = (const float**)&p;
    for (int i = 0; i < 22; ++i) f[i] = (const float*)d_in[i];
    p.out = (float*)d_out; p.ws = (unsigned char*)d_ws; p.ph_lo = 0; p.ph_hi = N_PHASES;
    void* args[] = {&p};
    hipError_t e = hipLaunchCooperativeKernel((const void*)hybrid_fwd, dim3(grid), dim3(512), args, LDS_BYTES, stream);
    if (e != hipSuccess) fprintf(stderr, "kernel_launch: cooperative launch failed: %s (grid %d)\n", hipGetErrorString(e), grid);
}
```

```cpp
#include <hip/hip_runtime.h>
#include <hip/hip_cooperative_groups.h>
#include <cstdio>
namespace cg = cooperative_groups;

#define P0_REP_A 1
#define P0_REP_F 1
#define P0_REP_S 1
#define P0_REP_B 1
#define P0_REP_C 1
#define LAS __attribute__((address_space(3)))
typedef unsigned short bf16;
typedef short bf16x8 __attribute__((ext_vector_type(8)));
typedef float f32x4 __attribute__((ext_vector_type(4)));
typedef float f32x2 __attribute__((ext_vector_type(2)));
typedef unsigned u32x4 __attribute__((ext_vector_type(4)));
typedef unsigned u32x2 __attribute__((ext_vector_type(2)));

constexpr int NB = 4, SEQ = 8192, DM = 1024, MT = NB * SEQ, DFO = 512, NHEAD = 8, SG = 32, SP = 64, DFF = 4096, NIN = 1536;
constexpr float EPS = 1e-6f;
constexpr int LDS_BYTES = 147456;
constexpr size_t MiB = 1u << 20;
constexpr size_t OFF_RA = 384 * 1024, OFF_RB = 512 * 1024, OFF_BAR = 640 * 1024, BAR_BYTES = 16384;
constexpr size_t OFF_E3 = 1 * MiB, OFF_D1 = 2 * MiB, OFF_TM = 6 * MiB, OFF_MST = 22 * MiB, OFF_W = 30 * MiB;
constexpr size_t W_IN = 0, W_OUT = 3 * MiB, W_1 = 5 * MiB, W_2 = 13 * MiB, W_GLU = 21 * MiB, W_LAYER = 22 * MiB;
constexpr size_t OFF_XB = 76 * MiB, OFF_MF = 140 * MiB, OFF_G = 140 * MiB, OFF_H = 204 * MiB;
constexpr size_t OFF_PQ = 204 * MiB, OFF_AO = 204 * MiB, OFF_UB = 268 * MiB, OFF_T = 332 * MiB, OFF_SLOC = 396 * MiB, OFF_SSS = 460 * MiB, OFF_SSM = 461 * MiB, OFF_SSF = 463 * MiB, WS_END = 465 * MiB;

struct Params {
    const float *x, *w_in, *w_out, *pre_mix_g, *post_mix_g, *pre_mlp_g, *post_mlp_g, *fourier_out_g, *ssm_out_g, *w_fourier,
        *lam_re, *lam_im, *log_dt, *b_re, *b_im, *c_re, *c_im, *d_skip, *w_glu, *b_glu, *w_ff1, *w_ff2;
    float* out; unsigned char* ws;
    int ph_lo, ph_hi;
};

__device__ __forceinline__ unsigned f2bf(float f) { unsigned u = __builtin_bit_cast(unsigned, f); return (u + 0x7fffu + ((u >> 16) & 1u)) >> 16; }
__device__ __forceinline__ unsigned pk2(float lo, float hi) { return f2bf(lo) | (f2bf(hi) << 16); }
__device__ __forceinline__ float bflo(unsigned w) { return __builtin_bit_cast(float, w << 16); }
__device__ __forceinline__ float bfhi(unsigned w) { return __builtin_bit_cast(float, w & 0xffff0000u); }
__device__ __forceinline__ float wave_sum(float v) {
#pragma unroll
    for (int o = 1; o < 64; o <<= 1) v += __shfl_xor(v, o);
    return v;
}
__device__ __forceinline__ float gelu_t(float x) { const float u = 0.7978845608f * (x + 0.044715f * x * x * x); return x * __builtin_amdgcn_rcpf(1.0f + __expf(-2.0f * u)); }
__device__ __forceinline__ float sigm(float v) { return __builtin_amdgcn_rcpf(1.0f + __expf(-v)); }

namespace pg8 {
#define PG8_LAS __attribute__((address_space(3)))
typedef unsigned short bf16_t;
constexpr int BM = 256, BK = 64, HALF = 128, HTB = HALF * BK * 2, STAGE_BYTES = 8 * HTB, NXCD = 8, WGM = 4;
__host__ __device__ __forceinline__ int lds_byte(int r, int c) { const int st = (r >> 4) * 2 + (c >> 5), rr = r & 15, cc = c & 31, ob = rr * 64 + cc * 2; return st * 1024 + (ob ^ (((ob >> 9) & 1) << 5)); }
__host__ __device__ __forceinline__ void stage_rc(int b, int& R, int& C) { const int st = b / 1024, sb = b % 1024, swz = sb ^ (((sb >> 9) & 1) << 5); R = (st >> 1) * 16 + swz / 64; C = (st & 1) * 32 + (swz % 64) / 2; }
__host__ __device__ __forceinline__ int perm32(int rho) { const int n = rho >> 4, i = rho & 15; return 8 * (i >> 2) + 4 * n + (i & 3); }

struct Unit { int pm, pn, z, ui; };
struct Gemm { const bf16_t* A; const bf16_t* Bt; int M, N, K, lda, ldb; size_t sA, sB; int nZ; };

struct Order {
    int nM, nN, nwg, nZ, G, c;
    __device__ void init(int M, int N, int nZ_, int G_, int c_) { nM = M / BM; nN = N / BM; nwg = nM * nN; nZ = nZ_; G = G_; c = c_; }
    __device__ bool next(int i, Unit& u) const {
        const long L = (long)i * G + c; if (L >= (long)nwg * nZ) return false;
        u.ui = i;
        if (nZ > 1 && (nZ % NXCD) == 0) {
            const int xcd = (int)(L % NXCD), idx = (int)(L / NXCD); u.z = xcd * (nZ / NXCD) + idx / nwg; const int wg = idx % nwg; u.pm = wg % nM; u.pn = wg / nM; return true; }
        u.z = (int)(L / nwg);
        int wgid = (int)(L % nwg); { const int q = nwg / NXCD, r = nwg % NXCD, xcd = wgid % NXCD, off = wgid / NXCD; wgid = (xcd < r ? xcd * (q + 1) : r * (q + 1) + (xcd - r) * q) + off; }
        const int nig = WGM * nN, gid = wgid / nig, fm = gid * WGM, gsz = (nM - fm) < WGM ? (nM - fm) : WGM;
        u.pm = fm + ((wgid % nig) % gsz); u.pn = (wgid % nig) / gsz; return true;
    }
};

template <class Epi>
__device__ __forceinline__ void gemm_phase(PG8_LAS unsigned char* lds, const Gemm g, const Order& S, const Epi& E) {
    int tid = threadIdx.x; asm volatile("" : "+v"(tid));
    const int wid = __builtin_amdgcn_readfirstlane(tid >> 6), lane = tid & 63, wr = wid >> 2, wc = wid & 3, fr = lane & 15, fq = lane >> 4;
    const int K = g.K, nt = K / BK;
    unsigned voffA[2], voffB[2];
#pragma unroll
    for (int i = 0; i < 2; ++i) { int R, C; stage_rc(tid * 16 + i * 8192, R, C); const int Rb = Epi::PERM ? ((R & ~31) + perm32(R & 31)) : R;
        voffA[i] = (unsigned)(R * g.lda + C) * 2u; voffB[i] = (unsigned)(Rb * g.ldb + C) * 2u; }
    const size_t kstep = (size_t)(BK * 2);
    const size_t hA = (size_t)HALF * g.lda * 2, hB = (size_t)HALF * g.ldb * 2;
    const size_t tA = 2 * hA, tB = 2 * hB;
    const unsigned ldsw = (unsigned)wid * 1024u;
    const int aoff = lds_byte(wr * 64 + fr, fq * 8), boff = lds_byte(wc * 32 + fr, fq * 8);
#define PG8_SA(b, h) (((b) * 2 + (h)) * HTB)
#define PG8_SB(b, h) ((4 + (b) * 2 + (h)) * HTB)
#define PG8_STAGE(bufoff, gbase, voff) do { _Pragma("unroll") for (int _i = 0; _i < 2; ++_i) \
        __builtin_amdgcn_global_load_lds((const unsigned*)((const char*)(gbase) + (voff)[_i]), (PG8_LAS unsigned*)(lds + (bufoff) + ldsw + _i * 8192), 16, 0, 0); } while (0)
#define PG8_LDA(dst, b, h) do { _Pragma("unroll") for (int m = 0; m < 4; ++m) _Pragma("unroll") for (int k = 0; k < 2; ++k) dst[m][k] = *(const PG8_LAS bf16x8*)(lds + PG8_SA(b, h) + aoff + m * 2048 + k * 1024); } while (0)
#define PG8_LDB(dst, b, h) do { _Pragma("unroll") for (int n = 0; n < 2; ++n) _Pragma("unroll") for (int k = 0; k < 2; ++k) dst[n][k] = *(const PG8_LAS bf16x8*)(lds + PG8_SB(b, h) + boff + n * 2048 + k * 1024); } while (0)
#define PG8_MMA(ai, bj, At, Bt) do { __builtin_amdgcn_s_setprio(1); _Pragma("unroll") for (int m = 0; m < 4; ++m) _Pragma("unroll") for (int n = 0; n < 2; ++n) _Pragma("unroll") for (int k = 0; k < 2; ++k) \
        acc[ai][bj][m][n] = __builtin_amdgcn_mfma_f32_16x16x32_bf16(Bt[n][k], At[m][k], acc[ai][bj][m][n], 0, 0, 0); __builtin_amdgcn_s_setprio(0); } while (0)
#define PG8_WAIT_V(n) asm volatile("s_waitcnt vmcnt(" #n ")" ::: "memory")
#define PG8_WAIT_L(n) asm volatile("s_waitcnt lgkmcnt(" #n ")" ::: "memory")
#define PG8_BAR __builtin_amdgcn_s_barrier()
#define PG8_SCHED __builtin_amdgcn_sched_barrier(0)
    Unit cur, nxt; int ui = 0;
    if (!S.next(0, cur)) return;
    f32x4 acc[2][2][4][2];
#pragma unroll
    for (int a = 0; a < 2; ++a)
#pragma unroll
        for (int b = 0; b < 2; ++b)
#pragma unroll
            for (int m = 0; m < 4; ++m)
#pragma unroll
                for (int n = 0; n < 2; ++n) acc[a][b][m][n] = (f32x4){0.f, 0.f, 0.f, 0.f};
    bf16x8 At[4][2], B0[2][2], B1[2][2];
    const char* cA = (const char*)g.A + ((size_t)cur.z * g.sA) * 2 + (size_t)cur.pm * tA; const char* cB = (const char*)g.Bt + ((size_t)cur.z * g.sB) * 2 + (size_t)cur.pn * tB;
    PG8_STAGE(PG8_SB(0, 0), cB, voffB); PG8_STAGE(PG8_SA(0, 0), cA, voffA); PG8_STAGE(PG8_SB(0, 1), cB + hB, voffB); PG8_STAGE(PG8_SA(0, 1), cA + hA, voffA);
    if (wr == 1) PG8_BAR;
    PG8_WAIT_V(4); PG8_BAR;
    PG8_STAGE(PG8_SB(1, 0), cB + kstep, voffB); PG8_STAGE(PG8_SA(1, 0), cA + kstep, voffA); PG8_STAGE(PG8_SB(1, 1), cB + hB + kstep, voffB);
    PG8_WAIT_V(6); PG8_BAR;
    for (;;) {
        const bool has_next = S.next(ui + 1, nxt);
        const char* nA = has_next ? (const char*)g.A + ((size_t)nxt.z * g.sA) * 2 + (size_t)nxt.pm * tA : cA; const char* nB = has_next ? (const char*)g.Bt + ((size_t)nxt.z * g.sB) * 2 + (size_t)nxt.pn * tB : cB;
        for (int t = 0; t < nt; t += 2) {
            const bool last = (t == nt - 2);
            if constexpr (Epi::MID) { if (t == (nt >> 1)) E.mid(acc, cur, wr, fr); }
            const char* a1 = cA + (size_t)(t + 1) * kstep;
            const char* a2 = last ? nA : cA + (size_t)(t + 2) * kstep; const char* b2 = last ? nB : cB + (size_t)(t + 2) * kstep;
            const char* a3 = a2 + kstep; const char* b3 = b2 + kstep;
            PG8_LDB(B0, 0, 0); PG8_SCHED; PG8_LDA(At, 0, 0); PG8_STAGE(PG8_SA(1, 1), a1 + hA, voffA);
            PG8_WAIT_L(8); PG8_BAR; PG8_WAIT_L(0); PG8_MMA(0, 0, At, B0); PG8_BAR; PG8_SCHED;
            PG8_LDB(B1, 0, 1); PG8_STAGE(PG8_SB(0, 0), b2, voffB);
            PG8_BAR; PG8_WAIT_L(0); PG8_MMA(0, 1, At, B1); PG8_BAR;
            PG8_LDA(At, 0, 1); PG8_STAGE(PG8_SA(0, 0), a2, voffA);
            PG8_BAR; PG8_WAIT_L(0); PG8_MMA(1, 0, At, B0); PG8_BAR; PG8_SCHED;
            PG8_STAGE(PG8_SB(0, 1), b2 + hB, voffB);
            PG8_WAIT_V(6); PG8_BAR; PG8_MMA(1, 1, At, B1); PG8_BAR;
            PG8_LDB(B0, 1, 0); PG8_SCHED; PG8_LDA(At, 1, 0); PG8_STAGE(PG8_SA(0, 1), a2 + hA, voffA);
            PG8_WAIT_L(8); PG8_BAR; PG8_WAIT_L(0); PG8_MMA(0, 0, At, B0); PG8_BAR; PG8_SCHED;
            PG8_LDB(B1, 1, 1); PG8_STAGE(PG8_SB(1, 0), b3, voffB);
            PG8_BAR; PG8_WAIT_L(0); PG8_MMA(0, 1, At, B1); PG8_BAR;
            PG8_LDA(At, 1, 1); PG8_STAGE(PG8_SA(1, 0), a3, voffA);
            PG8_BAR; PG8_WAIT_L(0); PG8_MMA(1, 0, At, B0); PG8_BAR; PG8_SCHED;
            PG8_STAGE(PG8_SB(1, 1), b3 + hB, voffB);
            PG8_WAIT_V(6); PG8_BAR; PG8_MMA(1, 1, At, B1); PG8_BAR;
        }
        E(acc, cur, wr, wc, fr, fq);
        if (!has_next) break;
#pragma unroll
        for (int a = 0; a < 2; ++a)
#pragma unroll
            for (int b = 0; b < 2; ++b)
#pragma unroll
                for (int m = 0; m < 4; ++m)
#pragma unroll
                    for (int n = 0; n < 2; ++n) acc[a][b][m][n] = (f32x4){0.f, 0.f, 0.f, 0.f};
        cur = nxt; cA = nA; cB = nB; ++ui;
    }
    PG8_WAIT_V(0);
    if (wr == 0) PG8_BAR;
    PG8_BAR;
#undef PG8_SA
#undef PG8_SB
#undef PG8_STAGE
#undef PG8_LDA
#undef PG8_LDB
#undef PG8_MMA
#undef PG8_WAIT_V
#undef PG8_WAIT_L
#undef PG8_BAR
#undef PG8_SCHED
}
}

typedef const f32x4 (&AccRef)[2][2][4][2];
__device__ __forceinline__ u32x4 pack8(f32x4 a, f32x4 b) { u32x4 w; w.x = pk2(a[0], a[1]); w.y = pk2(a[2], a[3]); w.z = pk2(b[0], b[1]); w.w = pk2(b[2], b[3]); return w; }

struct EpiIn {
    static constexpr bool PERM = true, MID = false;
    bf16* PQ; bf16* UB; const float* r;
    __device__ __forceinline__ void operator()(AccRef acc, const pg8::Unit& u, int wr, int wc, int fr, int fq) const {
#pragma unroll
        for (int ai = 0; ai < 2; ++ai)
#pragma unroll
            for (int m = 0; m < 4; ++m) {
                const int row = u.pm * 256 + ai * 128 + wr * 64 + m * 16 + fr; const float rs = r[row];
#pragma unroll
                for (int bj = 0; bj < 2; ++bj) {
                    const int col0 = u.pn * 256 + bj * 128 + wc * 32 + 8 * fq;
                    const u32x4 w = pack8(acc[ai][bj][m][0] * rs, acc[ai][bj][m][1] * rs);
                    if (col0 < 1024) *(u32x4*)(PQ + (size_t)row * 1024 + col0) = w;
                    else { const int c2 = col0 - 1024, gg = c2 >> 4, h0 = c2 & 15; *(u32x4*)(UB + ((size_t)(gg * 2048 + (row >> 4)) * 512 + (row & 15) * 16 + h0)) = w; }
                }
            }
    }
};
struct EpiSloc {
    static constexpr bool PERM = false, MID = false;
    float* S;
    __device__ __forceinline__ void operator()(AccRef acc, const pg8::Unit& u, int wr, int wc, int fr, int fq) const {
#pragma unroll
        for (int ai = 0; ai < 2; ++ai)
#pragma unroll
            for (int m = 0; m < 4; ++m) {
                const int row = u.pm * 256 + ai * 128 + wr * 64 + m * 16 + fr;
                float* rp = S + ((size_t)u.z * 2048 + row) * 256 + wc * 32 + 4 * fq;
#pragma unroll
                for (int bj = 0; bj < 2; ++bj)
#pragma unroll
                    for (int n = 0; n < 2; ++n) *(f32x4*)(rp + bj * 128 + n * 16) = acc[ai][bj][m][n];
            }
    }
};
struct EpiSsmOut {
    static constexpr bool PERM = true, MID = false;
    bf16* G;
    __device__ __forceinline__ void operator()(AccRef acc, const pg8::Unit& u, int wr, int wc, int fr, int fq) const {
#pragma unroll
        for (int ai = 0; ai < 2; ++ai)
#pragma unroll
            for (int m = 0; m < 4; ++m) {
                const int row = u.pm * 256 + ai * 128 + wr * 64 + m * 16 + fr;
#pragma unroll
                for (int bj = 0; bj < 2; ++bj) {
                    const int col0 = bj * 128 + wc * 32 + 8 * fq, t = col0 >> 4, i0 = col0 & 15;
                    f32x4 a = acc[ai][bj][m][0], b = acc[ai][bj][m][1];
#pragma unroll
                    for (int j = 0; j < 4; ++j) { a[j] = gelu_t(a[j]); b[j] = gelu_t(b[j]); }
                    *(u32x4*)(G + ((size_t)row * 16 + t) * 512 + u.z * 16 + i0) = pack8(a, b);
                }
            }
    }
};
struct EpiGlu {
    static constexpr bool PERM = true, MID = false;
    const bf16* G; const float* bias; bf16* AO; float* ss;
    __device__ __forceinline__ void operator()(AccRef acc, const pg8::Unit& u, int wr, int wc, int fr, int fq) const {
#pragma unroll
        for (int ai = 0; ai < 2; ++ai)
#pragma unroll
            for (int m = 0; m < 4; ++m) {
                const int row = u.pm * 256 + ai * 128 + wr * 64 + m * 16 + fr; float s2 = 0.f;
#pragma unroll
                for (int bj = 0; bj < 2; ++bj) {
                    const int col0 = u.pn * 256 + bj * 128 + wc * 32 + 8 * fq;
                    const u32x4 gv = *(const u32x4*)(G + (size_t)row * 512 + col0);
                    const f32x4 b0 = *(const f32x4*)(bias + col0), b1 = *(const f32x4*)(bias + col0 + 4);
                    f32x4 a = acc[ai][bj][m][0] + b0, b = acc[ai][bj][m][1] + b1;
                    a[0] = bflo(gv.x) * sigm(a[0]); a[1] = bfhi(gv.x) * sigm(a[1]); a[2] = bflo(gv.y) * sigm(a[2]); a[3] = bfhi(gv.y) * sigm(a[3]);
                    b[0] = bflo(gv.z) * sigm(b[0]); b[1] = bfhi(gv.z) * sigm(b[1]); b[2] = bflo(gv.w) * sigm(b[2]); b[3] = bfhi(gv.w) * sigm(b[3]);
#pragma unroll
                    for (int j = 0; j < 4; ++j) s2 += a[j] * a[j] + b[j] * b[j];
                    *(u32x4*)(AO + (size_t)row * 1024 + 512 + col0) = pack8(a, b);
                }
                s2 += __shfl_xor(s2, 16); s2 += __shfl_xor(s2, 32);
                if (fq == 0) ss[row * 8 + u.pn * 4 + wc] = s2;
            }
    }
};
struct EpiOutSS {
    static constexpr bool PERM = true, MID = false;
    bf16* O; float* ss;
    __device__ __forceinline__ void operator()(AccRef acc, const pg8::Unit& u, int wr, int wc, int fr, int fq) const {
#pragma unroll
        for (int ai = 0; ai < 2; ++ai)
#pragma unroll
            for (int m = 0; m < 4; ++m) {
                const int row = u.pm * 256 + ai * 128 + wr * 64 + m * 16 + fr; float s2 = 0.f;
#pragma unroll
                for (int bj = 0; bj < 2; ++bj) {
                    const int col0 = u.pn * 256 + bj * 128 + wc * 32 + 8 * fq;
                    const f32x4 a = acc[ai][bj][m][0], b = acc[ai][bj][m][1];
#pragma unroll
                    for (int j = 0; j < 4; ++j) s2 += a[j] * a[j] + b[j] * b[j];
                    *(u32x4*)(O + (size_t)row * 1024 + col0) = pack8(a, b);
                }
                s2 += __shfl_xor(s2, 16); s2 += __shfl_xor(s2, 32);
                if (fq == 0) ss[row * 16 + u.pn * 4 + wc] = s2;
            }
    }
};
struct EpiOutMix {
    static constexpr bool PERM = true, MID = true;
    bf16* O; float* ss; const LAS float* qv;
    __device__ __forceinline__ void mid(f32x4 (&acc)[2][2][4][2], const pg8::Unit& u, int wr, int fr) const {
#pragma unroll
        for (int ai = 0; ai < 2; ++ai)
#pragma unroll
            for (int m = 0; m < 4; ++m) { const float q = qv[u.ui * 256 + ai * 128 + wr * 64 + m * 16 + fr];
#pragma unroll
                for (int bj = 0; bj < 2; ++bj)
#pragma unroll
                    for (int n = 0; n < 2; ++n) acc[ai][bj][m][n] *= q; }
    }
    __device__ __forceinline__ void operator()(AccRef acc, const pg8::Unit& u, int wr, int wc, int fr, int fq) const {
#pragma unroll
        for (int ai = 0; ai < 2; ++ai)
#pragma unroll
            for (int m = 0; m < 4; ++m) {
                const int rl = ai * 128 + wr * 64 + m * 16 + fr, row = u.pm * 256 + rl; float s2 = 0.f; const float rs = qv[1024 + u.ui * 256 + rl];
#pragma unroll
                for (int bj = 0; bj < 2; ++bj) {
                    const int col0 = u.pn * 256 + bj * 128 + wc * 32 + 8 * fq;
                    const f32x4 a = acc[ai][bj][m][0] * rs, b = acc[ai][bj][m][1] * rs;
#pragma unroll
                    for (int j = 0; j < 4; ++j) s2 += a[j] * a[j] + b[j] * b[j];
                    *(u32x4*)(O + (size_t)row * 1024 + col0) = pack8(a, b);
                }
                s2 += __shfl_xor(s2, 16); s2 += __shfl_xor(s2, 32);
                if (fq == 0) ss[row * 16 + u.pn * 4 + wc] = s2;
            }
    }
};
struct EpiFF1 {
    static constexpr bool PERM = true, MID = false;
    bf16* H; const float* r;
    __device__ __forceinline__ void operator()(AccRef acc, const pg8::Unit& u, int wr, int wc, int fr, int fq) const {
#pragma unroll
        for (int ai = 0; ai < 2; ++ai)
#pragma unroll
            for (int m = 0; m < 4; ++m) {
                const int row = u.pm * 256 + ai * 128 + wr * 64 + m * 16 + fr; const float rs = r[row];
#pragma unroll
                for (int bj = 0; bj < 2; ++bj) {
                    const int col0 = u.pn * 256 + bj * 128 + wc * 32 + 8 * fq;
                    f32x4 a = acc[ai][bj][m][0] * rs, b = acc[ai][bj][m][1] * rs;
#pragma unroll
                    for (int j = 0; j < 4; ++j) { a[j] = fmaxf(a[j], 0.f); a[j] *= a[j]; b[j] = fmaxf(b[j], 0.f); b[j] *= b[j]; }
                    *(u32x4*)(H + (size_t)row * 4096 + col0) = pack8(a, b);
                }
            }
    }
};

__device__ __forceinline__ void transpose_item(const float* W, int ldw, bf16* WT, int ldt, const float* sc_lo, const float* sc_hi, int split,
                                               LAS float* scr, int item, int nblk, int lane) {
    const int kb = item / nblk, nb = item % nblk, k0 = 64 * kb, n0 = 32 * nb;
#pragma unroll 16
    for (int i = 0; i < 32; ++i) { const int kk = 2 * i + (lane >> 5), k = k0 + kk;
        float s = 1.f; if (sc_lo) s = (k < split) ? sc_lo[k] : sc_hi[k - split];
        scr[kk * 33 + (lane & 31)] = W[(size_t)k * ldw + n0 + (lane & 31)] * s; }
    asm volatile("s_waitcnt lgkmcnt(0)" ::: "memory");
    const int c = lane & 7;
#pragma unroll
    for (int j = 0; j < 4; ++j) { const int n = (lane >> 3) + 8 * j; const LAS float* s = scr + (8 * c) * 33 + n;
        u32x4 o; o.x = pk2(s[0 * 33], s[1 * 33]); o.y = pk2(s[2 * 33], s[3 * 33]); o.z = pk2(s[4 * 33], s[5 * 33]); o.w = pk2(s[6 * 33], s[7 * 33]);
        *(u32x4*)(WT + (size_t)(n0 + n) * ldt + k0 + 8 * c) = o; }
    asm volatile("s_waitcnt lgkmcnt(0)" ::: "memory");
}

__device__ __forceinline__ void fold_item(const Params& p, int item, LAS unsigned char* lds) {
    int tid = threadIdx.x; asm volatile("" : "+v"(tid)); const int ly = item >> 7, h = (item >> 4) & 7, kb = item & 15, k0 = kb * 64;
    LAS float* Wt = (LAS float*)lds;
    LAS float* Wf = Wt + 64 * 65;
    LAS float* TC = Wf + 64 * 65;
    LAS float* TS = TC + 64 * 65;
    LAS float* cs = TS + 64 * 65;
    __syncthreads();
    const float* win = p.w_in + (size_t)ly * 1024 * 1024; const float* wf = p.w_fourier + ((size_t)ly * 8 + h) * 4096; const float* g = p.pre_mix_g + ly * 1024;
    for (int i = tid; i < 4096; i += 512) { const int k = i >> 6, c = i & 63; Wt[k * 65 + c] = win[(size_t)(k0 + k) * 1024 + 64 * h + c] * g[k0 + k]; Wf[k * 65 + c] = wf[i]; }
    if (tid < 64) { float s, c; sincospif((float)tid / 32.0f, &s, &c); cs[tid] = c; cs[64 + tid] = s; }
    __syncthreads();
    { const int d = tid & 63, kg = tid >> 6; float ac[8], as[8];
#pragma unroll
      for (int j = 0; j < 8; ++j) { ac[j] = 0.f; as[j] = 0.f; }
#pragma unroll 2
      for (int c = 0; c < 64; ++c) { const int ph = (c * d) & 63; const float cv = cs[ph], sv = cs[64 + ph];
#pragma unroll
          for (int j = 0; j < 8; ++j) { const float w = Wt[(kg * 8 + j) * 65 + c]; ac[j] += w * cv; as[j] += w * sv; } }
#pragma unroll
      for (int j = 0; j < 8; ++j) { TC[(kg * 8 + j) * 65 + d] = ac[j]; TS[(kg * 8 + j) * 65 + d] = as[j]; } }
    __syncthreads();
    const float scale = 1.0f / 724.0773439350247f;
    bf16* WT = (bf16*)(p.ws + OFF_W + (size_t)ly * W_LAYER + W_IN);
    { const int k = tid & 63, eg = tid >> 6; float ap[8], aq[8];
#pragma unroll
      for (int j = 0; j < 8; ++j) { ap[j] = 0.f; aq[j] = 0.f; }
#pragma unroll 2
      for (int d = 0; d < 64; ++d) { const float tc = TC[k * 65 + d], ts = TS[k * 65 + d];
#pragma unroll
          for (int j = 0; j < 8; ++j) { const float w = Wf[d * 65 + eg * 8 + j]; ap[j] += tc * w; aq[j] += ts * w; } }
#pragma unroll
      for (int j = 0; j < 8; ++j) { const int e = eg * 8 + j;
          WT[(size_t)(64 * h + e) * 1024 + k0 + k] = (bf16)f2bf(ap[j] * scale);
          WT[(size_t)(512 + 64 * h + e) * 1024 + k0 + k] = (bf16)f2bf(-aq[j] * scale); } }
}

__device__ __forceinline__ void ssm_mat_item(const Params& p, int item, LAS unsigned char* lds) {
    int tid = threadIdx.x; asm volatile("" : "+v"(tid)); const int ly = item >> 7, g = (item >> 2) & 31, qt = item & 3;
    LAS float* pwr = (LAS float*)lds;
    LAS float* pwi = pwr + 2 * 64 * 20;
    LAS float* bbr = pwi + 2 * 64 * 20;
    LAS float* bbi = bbr + 2 * 64 * 16;
    LAS float* ccr = bbi + 2 * 64 * 16;
    LAS float* cci = ccr + 2 * 16 * 64;
    LAS float* Gt = cci + 2 * 16 * 64;
    __syncthreads();
    { const int k = (tid >> 6) & 1, pp = tid & 63, tg = tid >> 7; const int idx = (ly * 2 + k) * 32 + g;
      const float dt = expf(p.log_dt[idx]); const float lr = p.lam_re[idx * 64 + pp] * dt, li = p.lam_im[idx * 64 + pp] * dt;
#pragma unroll
      for (int j = 0; j < 5; ++j) { const int tau = tg * 5 + j; if (tau <= 16) { const float e = __expf(lr * tau); float sn, cs; __sincosf(li * tau, &sn, &cs); pwr[(k * 64 + pp) * 20 + tau] = e * cs; pwi[(k * 64 + pp) * 20 + tau] = e * sn; } } }
    for (int i = tid; i < 2048; i += 512) { const int k = i >> 10, r = i & 1023; const int idx = (ly * 2 + k) * 32 + g; ccr[i] = p.c_re[(size_t)idx * 1024 + r]; cci[i] = p.c_im[(size_t)idx * 1024 + r]; }
    __syncthreads();
#pragma unroll
    for (int j = 0; j < 4; ++j) { const int o = tid + 512 * j, k = o >> 10, pp = (o >> 4) & 63, h = o & 15; const int idx = (ly * 2 + k) * 32 + g;
        const float lr = p.lam_re[idx * 64 + pp], li = p.lam_im[idx * 64 + pp], dt = expf(p.log_dt[idx]);
        float sn, cs; sincosf(li * dt, &sn, &cs); const float em1 = expm1f(lr * dt), sh = sinf(0.5f * li * dt);
        const float lbr = em1 * cs - 2.0f * sh * sh, lbi = (em1 + 1.0f) * sn;
        const float den = 1.0f / (lr * lr + li * li); const float cr = (lbr * lr + lbi * li) * den, ci = (lbi * lr - lbr * li) * den;
        const float br = p.b_re[(size_t)idx * 1024 + pp * 16 + h], bi = p.b_im[(size_t)idx * 1024 + pp * 16 + h];
        bbr[o] = cr * br - ci * bi; bbi[o] = cr * bi + ci * br; }
    __syncthreads();
    { const int k = tid >> 8, i = (tid >> 4) & 15, h = tid & 15; float a[16];
#pragma unroll
      for (int tau = 0; tau < 16; ++tau) a[tau] = 0.f;
#pragma nounroll
      for (int pp = 0; pp < 64; ++pp) { const float c_r = ccr[(k * 16 + i) * 64 + pp], c_i = cci[(k * 16 + i) * 64 + pp], b_r = bbr[(k * 64 + pp) * 16 + h], b_i = bbi[(k * 64 + pp) * 16 + h];
          const float xr = c_r * b_r - c_i * b_i, xi = c_r * b_i + c_i * b_r;
          const LAS f32x4* pr4 = (const LAS f32x4*)(pwr + (k * 64 + pp) * 20); const LAS f32x4* pi4 = (const LAS f32x4*)(pwi + (k * 64 + pp) * 20);
#pragma unroll
          for (int t4 = 0; t4 < 4; ++t4) { const f32x4 vr = pr4[t4], vi = pi4[t4];
#pragma unroll
              for (int e = 0; e < 4; ++e) a[t4 * 4 + e] += xr * vr[e] - xi * vi[e]; } }
#pragma unroll
      for (int tau = 0; tau < 16; ++tau) Gt[((k * 16 + tau) * 16 + i) * 16 + h] = a[tau]; }
    __syncthreads();
    bf16* TM = (bf16*)(p.ws + OFF_TM) + (size_t)(ly * 32 + g) * 256 * 512; bf16* MS = (bf16*)(p.ws + OFF_MST) + (size_t)(ly * 32 + g) * 256 * 256;
    const float* dsk = p.d_skip + (ly * 32 + g) * 16;
    for (int o = qt * 64 * 512 + tid; o < (qt + 1) * 64 * 512; o += 512) { const int r = o >> 9, col = o & 511, t = r >> 4, i = r & 15; float v;
        if (col < 256) { const int j = col >> 4, h = col & 15; v = 0.f;
            if (j <= t) v += Gt[((0 * 16 + (t - j)) * 16 + i) * 16 + h];
            if (j >= t) v += Gt[((1 * 16 + (j - t)) * 16 + i) * 16 + h];
            if (j == t && h == i) v += dsk[i]; }
        else { const int k = (col - 256) >> 7, q = (col - 256) & 127, pp = q >> 1, part = q & 1; const int tau = k == 0 ? (t + 1) : (16 - t);
            const float c_r = ccr[(k * 16 + i) * 64 + pp], c_i = cci[(k * 16 + i) * 64 + pp], l_r = pwr[(k * 64 + pp) * 20 + tau], l_i = pwi[(k * 64 + pp) * 20 + tau];
            v = part == 0 ? (c_r * l_r - c_i * l_i) : -(c_r * l_i + c_i * l_r); }
        TM[o] = (bf16)f2bf(v); }
    for (int o = qt * 64 * 256 + tid; o < (qt + 1) * 64 * 256; o += 512) { const int r = o >> 8, col = o & 255, k = r >> 7, q = r & 127, pp = q >> 1, part = q & 1, j = col >> 4, h = col & 15;
        const int tau = k == 0 ? (15 - j) : j;
        const float l_r = pwr[(k * 64 + pp) * 20 + tau], l_i = pwi[(k * 64 + pp) * 20 + tau], b_r = bbr[(k * 64 + pp) * 16 + h], b_i = bbi[(k * 64 + pp) * 16 + h];
        const float v = part == 0 ? (l_r * b_r - l_i * b_i) : (l_r * b_i + l_i * b_r);
        MS[o] = (bf16)f2bf(v); }
}

__device__ __forceinline__ void p0_prologue(const Params& p, LAS unsigned char* lds, int G, int bid) {
    int tid = threadIdx.x; asm volatile("" : "+v"(tid));
    const int lane = tid & 63, wave = __builtin_amdgcn_readfirstlane(tid >> 6);
    for (int rp = 0; rp < P0_REP_A; ++rp)
    for (int it = bid; it < 512; it += G) { if (it < 256) { for (int r2 = 0; r2 < P0_REP_F; ++r2) fold_item(p, it, lds); } else { for (int r2 = 0; r2 < P0_REP_S; ++r2) ssm_mat_item(p, it - 256, lds); } }
    __syncthreads();
    {
        LAS float* scr = (LAS float*)(lds + wave * 8448);
        const int gw = bid * 8 + wave, NGW = G * 8;
        constexpr int I_IN = 16 * 16, I_OUT = 16 * 32, I_1 = 16 * 128, I_2 = 64 * 32, I_G = 8 * 16, I_L = I_IN + I_OUT + I_1 + I_2 + I_G;
        for (int rp = 0; rp < P0_REP_B; ++rp)
        for (int it = gw; it < 2 * I_L; it += NGW) {
            const int ly = it / I_L; int r = it % I_L; unsigned char* wb = p.ws + OFF_W + (size_t)ly * W_LAYER;
            if (r < I_IN) { transpose_item(p.w_in + (size_t)ly * 1024 * 1024 + 512, 1024, (bf16*)(wb + W_IN) + (size_t)1024 * 1024, 1024, p.pre_mix_g + ly * 1024, nullptr, 1 << 30, scr, r, 16, lane); continue; } r -= I_IN;
            if (r < I_OUT) { transpose_item(p.w_out + (size_t)ly * 1024 * 1024, 1024, (bf16*)(wb + W_OUT), 1024, p.fourier_out_g + ly * 512, p.ssm_out_g + ly * 512, 512, scr, r, 32, lane); continue; } r -= I_OUT;
            if (r < I_1) { transpose_item(p.w_ff1 + (size_t)ly * 1024 * 4096, 4096, (bf16*)(wb + W_1), 1024, p.pre_mlp_g + ly * 1024, nullptr, 1 << 30, scr, r, 128, lane); continue; } r -= I_1;
            if (r < I_2) { transpose_item(p.w_ff2 + (size_t)ly * 4096 * 1024, 1024, (bf16*)(wb + W_2), 4096, nullptr, nullptr, 0, scr, r, 32, lane); continue; } r -= I_2;
            transpose_item(p.w_glu + (size_t)ly * 512 * 512, 512, (bf16*)(wb + W_GLU), 512, nullptr, nullptr, 0, scr, r, 16, lane);
        }
        bf16* XB = (bf16*)(p.ws + OFF_XB); float* rA = (float*)(p.ws + OFF_RA);
        for (int rp = 0; rp < P0_REP_C; ++rp)
        for (int row0 = gw; row0 < MT; row0 += 4 * NGW) {
            f32x4 v[4][4];
#pragma unroll
            for (int rr = 0; rr < 4; ++rr) { const f32x4* xr = (const f32x4*)(p.x + (size_t)(row0 + rr * NGW) * 1024) + lane;
#pragma unroll
                for (int j = 0; j < 4; ++j) v[rr][j] = xr[64 * j]; }
#pragma unroll
            for (int rr = 0; rr < 4; ++rr) { const int row = row0 + rr * NGW; float s2 = 0.f;
                u32x2* o = (u32x2*)(XB + (size_t)row * 1024) + lane;
#pragma unroll
                for (int j = 0; j < 4; ++j) { const f32x4 t = v[rr][j]; s2 += t[0] * t[0] + t[1] * t[1] + t[2] * t[2] + t[3] * t[3]; u32x2 w; w.x = pk2(t[0], t[1]); w.y = pk2(t[2], t[3]); o[64 * j] = w; }
                s2 = wave_sum(s2);
                if (lane == 0) rA[row] = rsqrtf(s2 * (1.0f / 1024.0f) + EPS); }
        }
    }
    {
        bf16* D1 = (bf16*)(p.ws + OFF_D1); bf16* E3 = (bf16*)(p.ws + OFF_E3);
        const int gt = bid * 512 + tid, NT = G * 512;
        for (int idx = gt; idx < 64 * 2 * 128 * 128; idx += NT) { const int n2 = idx >> 15, sel = (idx >> 14) & 1, k1 = (idx >> 7) & 127, n1 = idx & 127;
            const int ph = (k1 * (64 * n1 + n2)) & 8191; float s, c; sincospif((float)ph * (1.0f / 4096.0f), &s, &c); D1[idx] = (bf16)f2bf(sel ? s : c); }
        for (int idx = gt; idx < 64 * 128; idx += NT) { const int k2 = idx >> 7, col = idx & 127, part = col >> 6, n2 = col & 63;
            const int ph = (n2 * k2) & 63; float s, c; sincospif((float)ph * (1.0f / 32.0f), &s, &c); E3[idx] = (bf16)f2bf(part ? s : c); }
    }
}

typedef short v4s16 __attribute__((ext_vector_type(4)));
__device__ __forceinline__ bf16x8 negbf(bf16x8 v) { u32x4 t = __builtin_bit_cast(u32x4, v); t = t ^ 0x80008000u; return __builtin_bit_cast(bf16x8, t); }
__device__ __forceinline__ bf16x8 tr_frag(const LAS unsigned char* a, int hs) {
    const v4s16 lo = __builtin_amdgcn_ds_read_tr16_b64_v4i16((LAS v4s16*)a), hi = __builtin_amdgcn_ds_read_tr16_b64_v4i16((LAS v4s16*)(a + hs));
    return __builtin_shufflevector(lo, hi, 0, 1, 2, 3, 4, 5, 6, 7);
}
constexpr int F1_P = 264, F1_CS = 256 * F1_P;
__device__ __forceinline__ void fft1_phase(const bf16* PQ, const bf16* D1, bf16* T, LAS unsigned char* lds, int G, int bid) {
    int tid = threadIdx.x; asm volatile("" : "+v"(tid));
    const int lane = tid & 63, wave = __builtin_amdgcn_readfirstlane(tid >> 6), wm = wave & 3, wn = wave >> 2, fr = lane & 15, fq = lane >> 4, tq = fr >> 2, tp = fr & 3;
    for (int pr = bid; pr < 256; pr += G) {
        const int n2 = pr & 63, cb = pr >> 6;
        __syncthreads();
        {
            const bf16* src = D1 + (size_t)n2 * 2 * 128 * 128;
#pragma unroll
            for (int j = 0; j < 8; ++j) { const int q = tid + 512 * j, sel = q >> 11, row = (q >> 4) & 127, cc = q & 15;
                *(LAS u32x4*)(lds + F1_CS + sel * 34816 + row * 272 + cc * 16) = *(const u32x4*)(src + sel * 16384 + row * 128 + 8 * cc); }
        }
        for (int b = 0; b < NB; ++b) {
            __syncthreads();
#pragma unroll
            for (int j = 0; j < 8; ++j) { const int q = tid + 512 * j, row = q >> 4, cc = q & 15, part = row >> 7, n1 = row & 127;
                const u32x4 v = *(const u32x4*)(PQ + ((size_t)(b * SEQ + 64 * n1 + n2)) * 1024 + part * 512 + cb * 128 + 8 * cc);
                LAS u32x2* d = (LAS u32x2*)(lds + row * F1_P + cc * 16); d[0] = (u32x2){v.x, v.y}; d[1] = (u32x2){v.z, v.w}; }
            __syncthreads();
            f32x4 Ar[2][4], Ai[2][4];
#pragma unroll
            for (int mb = 0; mb < 2; ++mb)
#pragma unroll
                for (int nb = 0; nb < 4; ++nb) { Ar[mb][nb] = (f32x4){0.f, 0.f, 0.f, 0.f}; Ai[mb][nb] = (f32x4){0.f, 0.f, 0.f, 0.f}; }
#pragma nounroll
            for (int ks = 0; ks < 8; ++ks) {
                bf16x8 Bf[4];
#pragma unroll
                for (int nb = 0; nb < 4; ++nb) Bf[nb] = tr_frag(lds + (32 * ks + 8 * fq + tq) * F1_P + (64 * wn + 16 * tp + 4 * nb) * 2, 4 * F1_P);
                bf16x8 Cf[2], Sf[2];
#pragma unroll
                for (int mb = 0; mb < 2; ++mb) { const int off = F1_CS + (32 * wm + 16 * mb + fr) * 272 + (32 * (ks & 3) + 8 * fq) * 2; Cf[mb] = *(const LAS bf16x8*)(lds + off); Sf[mb] = *(const LAS bf16x8*)(lds + off + 34816); }
#pragma unroll
                for (int mb = 0; mb < 2; ++mb)
#pragma unroll
                    for (int nb = 0; nb < 4; ++nb) {
                        if (ks < 4) { Ar[mb][nb] = __builtin_amdgcn_mfma_f32_16x16x32_bf16(Bf[nb], Cf[mb], Ar[mb][nb], 0, 0, 0);
                                      Ai[mb][nb] = __builtin_amdgcn_mfma_f32_16x16x32_bf16(Bf[nb], negbf(Sf[mb]), Ai[mb][nb], 0, 0, 0); }
                        else        { Ar[mb][nb] = __builtin_amdgcn_mfma_f32_16x16x32_bf16(Bf[nb], Sf[mb], Ar[mb][nb], 0, 0, 0);
                                      Ai[mb][nb] = __builtin_amdgcn_mfma_f32_16x16x32_bf16(Bf[nb], Cf[mb], Ai[mb][nb], 0, 0, 0); }
                    }
            }
#pragma unroll
            for (int mb = 0; mb < 2; ++mb) { const int k1 = 32 * wm + 16 * mb + fr, c = cb * 128 + 64 * wn + 16 * fq;
                bf16* t0 = T + ((((size_t)(b * 128 + k1) * 2 + 0) * 64 + n2) * 512 + c); bf16* t1 = t0 + 64 * 512;
                *(u32x4*)t0 = pack8(Ar[mb][0], Ar[mb][1]); *(u32x4*)(t0 + 8) = pack8(Ar[mb][2], Ar[mb][3]);
                *(u32x4*)t1 = pack8(Ai[mb][0], Ai[mb][1]); *(u32x4*)(t1 + 8) = pack8(Ai[mb][2], Ai[mb][3]); }
        }
    }
    __syncthreads();
}

constexpr int F3_P = 1032;
__device__ __forceinline__ void fft3_phase(const bf16* T, const bf16* E3, bf16* AO, LAS unsigned char* lds, int G, int bid) {
    int tid = threadIdx.x; asm volatile("" : "+v"(tid));
    const int lane = tid & 63, wave = __builtin_amdgcn_readfirstlane(tid >> 6), fr = lane & 15, fq = lane >> 4, tq = fr >> 2, tp = fr & 3;
    LAS float* red = (LAS float*)(lds + 128 * F3_P);
    for (int unit = bid; unit < 512; unit += G) {
        const int b = unit >> 7, k1 = unit & 127;
        __syncthreads();
        const bf16* src = T + (size_t)unit * 65536;
#pragma unroll
        for (int j = 0; j < 16; ++j) { const int q = tid + 512 * j, row = q >> 6, cc = q & 63;
            const u32x4 v = *(const u32x4*)(src + row * 512 + cc * 8);
            LAS u32x2* d = (LAS u32x2*)(lds + row * F3_P + cc * 16); d[0] = (u32x2){v.x, v.y}; d[1] = (u32x2){v.z, v.w}; }
        __syncthreads();
        f32x4 acc[4][4];
#pragma unroll
        for (int mb = 0; mb < 4; ++mb)
#pragma unroll
            for (int nb = 0; nb < 4; ++nb) acc[mb][nb] = (f32x4){0.f, 0.f, 0.f, 0.f};
        bf16x8 Ef[4];
#pragma unroll
        for (int mb = 0; mb < 4; ++mb) Ef[mb] = *(const bf16x8*)(E3 + (16 * mb + fr) * 128 + 8 * fq);
#pragma nounroll
        for (int ks = 0; ks < 4; ++ks) {
            bf16x8 Bf[4], En[4];
            const int kn = ks < 3 ? ks + 1 : 3;
#pragma unroll
            for (int mb = 0; mb < 4; ++mb) En[mb] = *(const bf16x8*)(E3 + (16 * mb + fr) * 128 + 32 * kn + 8 * fq);
#pragma unroll
            for (int nb = 0; nb < 4; ++nb) Bf[nb] = tr_frag(lds + (32 * ks + 8 * fq + tq) * F3_P + (64 * wave + 16 * tp + 4 * nb) * 2, 4 * F3_P);
#pragma unroll
            for (int mb = 0; mb < 4; ++mb)
#pragma unroll
                for (int nb = 0; nb < 4; ++nb) acc[mb][nb] = __builtin_amdgcn_mfma_f32_16x16x32_bf16(Bf[nb], Ef[mb], acc[mb][nb], 0, 0, 0);
#pragma unroll
            for (int mb = 0; mb < 4; ++mb) Ef[mb] = En[mb];
        }
#pragma unroll
        for (int mb = 0; mb < 4; ++mb) { float s = 0.f;
#pragma unroll
            for (int nb = 0; nb < 4; ++nb)
#pragma unroll
                for (int j = 0; j < 4; ++j) s += acc[mb][nb][j] * acc[mb][nb][j];
            s += __shfl_xor(s, 16); s += __shfl_xor(s, 32);
            if (fq == 0) red[wave * 64 + 16 * mb + fr] = s; }
        __syncthreads();
#pragma unroll
        for (int mb = 0; mb < 4; ++mb) { float tot = 0.f;
#pragma unroll
            for (int w = 0; w < 8; ++w) tot += red[w * 64 + 16 * mb + fr];
            const float rinv = rsqrtf(tot * (1.0f / 512.0f) + EPS);
            const size_t token = (size_t)b * SEQ + k1 + 128 * (16 * mb + fr);
            bf16* o = AO + token * 1024 + 64 * wave + 16 * fq;
            *(u32x4*)o = pack8(acc[mb][0] * rinv, acc[mb][1] * rinv); *(u32x4*)(o + 8) = pack8(acc[mb][2] * rinv, acc[mb][3] * rinv); }
    }
    __syncthreads();
}

__device__ __forceinline__ void carry_phase(const Params& p, int ly, const float* Sloc, bf16* UB, LAS unsigned char* lds, int G, int bid) {
    int tid = threadIdx.x; asm volatile("" : "+v"(tid));
    const int lane = tid & 63, wave = __builtin_amdgcn_readfirstlane(tid >> 6);
    LAS f32x2* ex = (LAS f32x2*)lds;
    for (int w = bid; w < 256; w += G) {
        const int dir = w & 1, g = (w >> 1) & 31, b = w >> 6, pp = lane; const int idx = (ly * 2 + dir) * 32 + g;
        const float dt = expf(p.log_dt[idx]); const float lr = p.lam_re[idx * 64 + pp] * dt * 16.0f, li = p.lam_im[idx * 64 + pp] * dt * 16.0f;
        const float e = expf(lr); float sn, cs; sincosf(li, &sn, &cs); const float l_r = e * cs, l_i = e * sn;
        float Lr = l_r, Li = l_i;
#pragma unroll
        for (int k = 0; k < 6; ++k) { const float nr = Lr * Lr - Li * Li, ni = 2.0f * Lr * Li; Lr = nr; Li = ni; }
        const float* src = Sloc + ((size_t)(g * 2048 + b * 512)) * 256 + dir * 128 + 2 * pp;
        bf16* dst = UB + ((size_t)(g * 2048 + b * 512)) * 512 + 256 + dir * 128 + 2 * pp;
        const int ss0 = dir == 0 ? wave * 64 : 511 - wave * 64; const long stp = dir == 0 ? 256 : -256;
        float cr = 0.f, ci = 0.f;
        { const float* ptr = src + (size_t)ss0 * 256;
#pragma nounroll
          for (int hb = 0; hb < 2; ++hb) {
            f32x2 v[32];
#pragma unroll
            for (int j = 0; j < 32; ++j) { v[j] = *(const f32x2*)ptr; ptr += stp; }
#pragma unroll
            for (int j = 0; j < 32; ++j) { const float nr = l_r * cr - l_i * ci + v[j][0], ni = l_r * ci + l_i * cr + v[j][1]; cr = nr; ci = ni; }
          } }
        __syncthreads();
        ex[wave * 64 + lane] = (f32x2){cr, ci};
        __syncthreads();
        cr = 0.f; ci = 0.f;
        for (int u = 0; u < wave; ++u) { const f32x2 eu = ex[u * 64 + lane]; const float nr = Lr * cr - Li * ci + eu[0], ni = Lr * ci + Li * cr + eu[1]; cr = nr; ci = ni; }
        { const float* ptr = src + (size_t)ss0 * 256; bf16* dp = dst + (size_t)ss0 * 512;
#pragma nounroll
          for (int hb = 0; hb < 2; ++hb) {
            f32x2 v[32];
#pragma unroll
            for (int j = 0; j < 32; ++j) { v[j] = *(const f32x2*)ptr; ptr += stp; }
#pragma unroll
            for (int j = 0; j < 32; ++j) {
                *(unsigned*)dp = pk2(cr, ci); dp += 2 * stp;
                const float nr = l_r * cr - l_i * ci + v[j][0], ni = l_r * ci + l_i * cr + v[j][1]; cr = nr; ci = ni; }
          } }
    }
    __syncthreads();
}

__device__ __forceinline__ void norm_phase(float* out, const bf16* MF, const float* ss, const float* gain, bf16* XB, float* rnext, bool last, int G, int bid) {
    int tid = threadIdx.x; asm volatile("" : "+v"(tid));
    const int lane = tid & 63, wave = __builtin_amdgcn_readfirstlane(tid >> 6);
    const int gw = bid * 8 + wave, NGW = G * 8;
    const f32x4* gr = (const f32x4*)gain + lane;
    const f32x4 g0 = gr[0], g1 = gr[64], g2 = gr[128], g3 = gr[192];
    for (int row0 = gw; row0 < MT; row0 += 2 * NGW) {
        u32x2 xv[2][4], mv[2][4]; float tot[2];
#pragma unroll
        for (int rr = 0; rr < 2; ++rr) { const int row = row0 + rr * NGW;
            const u32x2* xr = (const u32x2*)(XB + (size_t)row * 1024) + lane; const u32x2* mr = (const u32x2*)(MF + (size_t)row * 1024) + lane;
#pragma unroll
            for (int j = 0; j < 4; ++j) { xv[rr][j] = xr[64 * j]; mv[rr][j] = mr[64 * j]; }
            const f32x4* sp = (const f32x4*)(ss + (size_t)row * 16); const f32x4 s0 = sp[0], s1 = sp[1], s2 = sp[2], s3 = sp[3];
            tot[rr] = ((((s0[0] + s0[1]) + s0[2]) + s0[3]) + (((s1[0] + s1[1]) + s1[2]) + s1[3])) + ((((s2[0] + s2[1]) + s2[2]) + s2[3]) + (((s3[0] + s3[1]) + s3[2]) + s3[3])); }
#pragma unroll
        for (int rr = 0; rr < 2; ++rr) { const int row = row0 + rr * NGW;
            const float rinv = rsqrtf(tot[rr] * (1.0f / 1024.0f) + EPS); float s2 = 0.f;
#pragma unroll
            for (int j = 0; j < 4; ++j) { const f32x4 gg = j == 0 ? g0 : (j == 1 ? g1 : (j == 2 ? g2 : g3)); const u32x2 xx = xv[rr][j], mm = mv[rr][j]; f32x4 v;
                v[0] = bflo(xx.x) + bflo(mm.x) * rinv * gg[0]; v[1] = bfhi(xx.x) + bfhi(mm.x) * rinv * gg[1]; v[2] = bflo(xx.y) + bflo(mm.y) * rinv * gg[2]; v[3] = bfhi(xx.y) + bfhi(mm.y) * rinv * gg[3];
                if (last) { ((f32x4*)(out + (size_t)row * 1024) + lane)[64 * j] = v; }
                else { u32x2 w; w.x = pk2(v[0], v[1]); w.y = pk2(v[2], v[3]); ((u32x2*)(XB + (size_t)row * 1024) + lane)[64 * j] = w;
                       const float a0 = bflo(w.x), a1 = bfhi(w.x), a2 = bflo(w.y), a3 = bfhi(w.y); s2 += a0 * a0 + a1 * a1 + a2 * a2 + a3 * a3; } }
            if (!last) { s2 = wave_sum(s2); if (lane == 0) rnext[row] = rsqrtf(s2 * (1.0f / 1024.0f) + EPS); } }
    }
}
__device__ __forceinline__ void rescale_phase(bf16* AO, const float* ss, int G, int bid) {
    int tid = threadIdx.x; asm volatile("" : "+v"(tid));
    const int lane = tid & 63, wave = __builtin_amdgcn_readfirstlane(tid >> 6);
    const int gw = bid * 8 + wave, NGW = G * 8;
    for (int row = gw; row < MT; row += NGW) {
        float tot = 0.f;
#pragma unroll
        for (int k = 0; k < 8; ++k) tot += ss[row * 8 + k];
        const float rinv = rsqrtf(tot * (1.0f / 512.0f) + EPS);
        u32x4* ptr = (u32x4*)(AO + (size_t)row * 1024 + 512) + lane; u32x4 v = *ptr;
        v.x = pk2(bflo(v.x) * rinv, bfhi(v.x) * rinv); v.y = pk2(bflo(v.y) * rinv, bfhi(v.y) * rinv); v.z = pk2(bflo(v.z) * rinv, bfhi(v.z) * rinv); v.w = pk2(bflo(v.w) * rinv, bfhi(v.w) * rinv);
        *ptr = v;
    }
}


#define XB_TMO      128
#define XB_XCNT(j)  (256  + 64 * (j))
#define XB_XSUB(j)  (1280 + 64 * (j))
#define XB_XGEN(j)  (2304 + 64 * (j))
#define XB_TOP      3328
#define XB_TOPGEN   3392
#define XCD_BAR_WORDS 3456
#define XB_SPIN_CAP (1u << 18)
__device__ __forceinline__ unsigned xb_ld(unsigned* p)              { return __hip_atomic_load(p, __ATOMIC_RELAXED, __HIP_MEMORY_SCOPE_AGENT); }
__device__ __forceinline__ unsigned xb_add(unsigned* p, unsigned v) { return __hip_atomic_fetch_add(p, v, __ATOMIC_RELAXED, __HIP_MEMORY_SCOPE_AGENT); }
__device__ __forceinline__ unsigned xb_xcc_id() { return (unsigned)__builtin_amdgcn_s_getreg((3 << 11) | 20) & 0xFu; }
#define XB_SPIN(cond, bar) do { unsigned _sp = 0; while (cond) { __builtin_amdgcn_s_sleep(1); \
    if ((++_sp & 255u) == 0u) { if (xb_ld(&(bar)[XB_TMO])) break; if (_sp > XB_SPIN_CAP) { atomicAdd(&(bar)[XB_TMO], 1u); break; } } } } while (0)
struct XcdBarrier { unsigned* bar; unsigned x; volatile LAS unsigned* st; };
__device__ __forceinline__ XcdBarrier xcd_barrier_post(unsigned* bar, volatile LAS unsigned* st) {
    XcdBarrier b; b.bar = bar; b.x = xb_xcc_id(); b.st = st;
    if (threadIdx.x == 0) (void)xb_add(&bar[XB_XCNT(b.x)], 1u);
    return b;
}
__device__ __forceinline__ void xcd_barrier_complete(unsigned* bar, unsigned x, unsigned& nloc, unsigned& nx) {
    const unsigned G = gridDim.x * gridDim.y * gridDim.z;
    unsigned sum, cnt, mine, sp = 0u;
    for (;;) {
        sum = 0u; cnt = 0u; mine = 0u;
#pragma unroll
        for (unsigned j = 0; j < 16; ++j) { const unsigned c = xb_ld(&bar[XB_XCNT(j)]); sum += c; cnt += (c > 0u) ? 1u : 0u; mine = (j == x) ? c : mine; }
        if (sum == G) break;
        __builtin_amdgcn_s_sleep(1);
        if ((++sp & 255u) == 0u) { if (xb_ld(&bar[XB_TMO])) break; if (sp > XB_SPIN_CAP) { atomicAdd(&bar[XB_TMO], 1u); break; } }
    }
    nloc = mine > 0u ? mine : 1u; nx = cnt > 0u ? cnt : 1u;
}
__device__ __forceinline__ void xcd_barrier(const XcdBarrier& b) {
    asm volatile("s_waitcnt vmcnt(0)" ::: "memory");
    __syncthreads();
    if (threadIdx.x == 0) {
        unsigned* bar = b.bar;
        __builtin_amdgcn_s_waitcnt(0);
        unsigned nloc = b.st[0], nx = b.st[1];
        if (nloc == 0u) { xcd_barrier_complete(bar, b.x, nloc, nx); b.st[0] = nloc; b.st[1] = nx; }
        const unsigned old = xb_add(&bar[XB_XSUB(b.x)], 1u);
        const unsigned gen = old / nloc;
        if (old + 1u == (gen + 1u) * nloc) {
            __builtin_amdgcn_fence(__ATOMIC_RELEASE, "agent");
            asm volatile("s_waitcnt vmcnt(0)" ::: "memory");
            const unsigned og = xb_add(&bar[XB_TOP], 1u);
            const unsigned tg = og / nx;
            if (og + 1u == (tg + 1u) * nx) xb_add(&bar[XB_TOPGEN], 1u);
            else XB_SPIN(xb_ld(&bar[XB_TOPGEN]) == tg, bar);
            __builtin_amdgcn_fence(__ATOMIC_ACQUIRE, "agent");
            xb_add(&bar[XB_XGEN(b.x)], 1u);
            asm volatile("s_waitcnt vmcnt(0)" ::: "memory");
        } else {
            XB_SPIN(xb_ld(&bar[XB_XGEN(b.x)]) == gen, bar);
            __builtin_amdgcn_fence(__ATOMIC_ACQUIRE, "agent");
            asm volatile("s_waitcnt vmcnt(0)" ::: "memory");
        }
    }
    __syncthreads();
}

#ifndef REP_P0
#define REP_P0 1
#endif
#ifndef REP_SYNC
#define REP_SYNC 1
#endif
#ifndef REP_MASK_V
#define REP_MASK_V 0u
#endif
constexpr unsigned REP_MASK = REP_MASK_V;
constexpr int PH_PER_LAYER = 10, N_PHASES = 1 + 2 * PH_PER_LAYER;
__global__ void __launch_bounds__(512) hybrid_fwd(Params p) {
    extern __shared__ __attribute__((aligned(16))) unsigned char lds_raw[];
    LAS unsigned char* lds = (LAS unsigned char*)lds_raw;
    cg::grid_group grid = cg::this_grid();
    volatile LAS unsigned* xst = (volatile LAS unsigned*)(lds + LDS_BYTES - 16);
    if (threadIdx.x < 4) xst[threadIdx.x] = 0u;
    __syncthreads();
    const XcdBarrier xbar = xcd_barrier_post((unsigned*)(p.ws + OFF_BAR), xst);
    if (p.ph_hi > 1000) grid.sync();
    const int Gk = gridDim.x, bk = blockIdx.x;
    unsigned char* ws = p.ws;
    float* sss = (float*)(ws + OFF_SSS); float* ssm = (float*)(ws + OFF_SSM); float* ssf = (float*)(ws + OFF_SSF); float* rA = (float*)(ws + OFF_RA); float* rB = (float*)(ws + OFF_RB);
    bf16* XB = (bf16*)(ws + OFF_XB); bf16* MF = (bf16*)(ws + OFF_MF); bf16* GB = (bf16*)(ws + OFF_G); bf16* HB = (bf16*)(ws + OFF_H);
    bf16* PQ = (bf16*)(ws + OFF_PQ); bf16* AO = (bf16*)(ws + OFF_AO); bf16* UB = (bf16*)(ws + OFF_UB); bf16* TB = (bf16*)(ws + OFF_T); float* SL = (float*)(ws + OFF_SLOC);

#pragma nounroll
    for (int ph = p.ph_lo; ph < p.ph_hi; ++ph) {
        int G = Gk, bid = bk; asm volatile("" : "+s"(G), "+s"(bid));
        if (ph == 0) { for (int rep = 0; rep < REP_P0; ++rep) p0_prologue(p, lds, G, bid); }
        else {
            const int ly = (ph - 1) / PH_PER_LAYER, sp = (ph - 1) % PH_PER_LAYER;
            unsigned char* wb = ws + OFF_W + (size_t)ly * W_LAYER;
            pg8::Order S;
            const int nrep = ((REP_MASK >> sp) & 1u) ? 2 : 1;
            for (int rep = 0; rep < nrep; ++rep)
            switch (sp) {
            case 0: {
                pg8::Gemm g{XB, (const bf16*)(wb + W_IN), MT, NIN, 1024, 1024, 1024, 0, 0, 1}; S.init(MT, NIN, 1, G, bid);
                EpiIn E{PQ, UB, rA}; pg8::gemm_phase<EpiIn>(lds, g, S, E); } break;
            case 1: {
                fft1_phase(PQ, (const bf16*)(ws + OFF_D1), TB, lds, G, bid);
                pg8::Gemm g{UB, (const bf16*)(ws + OFF_MST) + (size_t)ly * 32 * 256 * 256, 2048, 256, 256, 512, 256, (size_t)2048 * 512, (size_t)256 * 256, 32}; S.init(2048, 256, 32, G, bid);
                EpiSloc E{SL}; pg8::gemm_phase<EpiSloc>(lds, g, S, E); } break;
            case 2: {
                carry_phase(p, ly, SL, UB, lds, G, bid);
                fft3_phase(TB, (const bf16*)(ws + OFF_E3), AO, lds, G, bid); } break;
            case 3: {
                pg8::Gemm g{UB, (const bf16*)(ws + OFF_TM) + (size_t)ly * 32 * 256 * 512, 2048, 256, 512, 512, 512, (size_t)2048 * 512, (size_t)256 * 512, 32}; S.init(2048, 256, 32, G, bid);
                EpiSsmOut E{GB}; pg8::gemm_phase<EpiSsmOut>(lds, g, S, E); } break;
            case 4: {
                pg8::Gemm g{GB, (const bf16*)(wb + W_GLU), MT, 512, 512, 512, 512, 0, 0, 1}; S.init(MT, 512, 1, G, bid);
                EpiGlu E{GB, p.b_glu + ly * 512, AO, sss}; pg8::gemm_phase<EpiGlu>(lds, g, S, E); } break;
            case 5: {
                pg8::Gemm g{AO, (const bf16*)(wb + W_OUT), MT, 1024, 1024, 1024, 1024, 0, 0, 1}; S.init(MT, 1024, 1, G, bid);
                LAS float* qv = (LAS float*)(lds + 131072);
                { int tid = threadIdx.x; asm volatile("" : "+v"(tid));
                  for (int i = 0; i < 4; ++i) { pg8::Unit u; if (!S.next(i, u)) break;
                      if (tid < 256) { const f32x4* sp = (const f32x4*)(sss + (size_t)(u.pm * 256 + tid) * 8); const f32x4 a = sp[0], b = sp[1];
                          const float ms = ((((a[0] + a[1]) + a[2]) + a[3]) + (((b[0] + b[1]) + b[2]) + b[3])) * (1.0f / 512.0f) + EPS;
                          qv[i * 256 + tid] = sqrtf(ms); qv[1024 + i * 256 + tid] = rsqrtf(ms); } }
                  __syncthreads(); }
                EpiOutMix E{MF, ssm, qv}; pg8::gemm_phase<EpiOutMix>(lds, g, S, E); } break;
            case 6: norm_phase(p.out, MF, ssm, p.post_mix_g + ly * 1024, XB, rB, false, G, bid); break;
            case 7: {
                pg8::Gemm g{XB, (const bf16*)(wb + W_1), MT, DFF, 1024, 1024, 1024, 0, 0, 1}; S.init(MT, DFF, 1, G, bid);
                EpiFF1 E{HB, rB}; pg8::gemm_phase<EpiFF1>(lds, g, S, E); } break;
            case 8: {
                pg8::Gemm g{HB, (const bf16*)(wb + W_2), MT, 1024, DFF, DFF, DFF, 0, 0, 1}; S.init(MT, 1024, 1, G, bid);
                EpiOutSS E{MF, ssf}; pg8::gemm_phase<EpiOutSS>(lds, g, S, E); } break;
            case 9: norm_phase(p.out, MF, ssf, p.post_mlp_g + ly * 1024, XB, rA, ly == 1, G, bid); break;
            }
        }
        if (ph + 1 < p.ph_hi) for (int rep = 0; rep < REP_SYNC; ++rep) xcd_barrier(xbar);
    }
}

extern "C" void kernel_launch(void* const* d_in, const int* in_sizes, int n_in, void* d_out, int out_size, void* d_ws, size_t ws_size, hipStream_t stream) {
    static int grid = 0;
    if (grid == 0) {
        if (n_in != 22 || ws_size < WS_END) { fprintf(stderr, "kernel_launch: unexpected n_in %d or ws_size %zu (< %zu)\n", n_in, ws_size, (size_t)WS_END); grid = -1; return; }
        int dev = 0, cus = 0, per_cu = 0;
        hipGetDevice(&dev); hipDeviceGetAttribute(&cus, hipDeviceAttributeMultiprocessorCount, dev);
        if (hipFuncSetAttribute((const void*)hybrid_fwd, hipFuncAttributeMaxDynamicSharedMemorySize, LDS_BYTES) != hipSuccess) { fprintf(stderr, "kernel_launch: hipFuncSetAttribute failed\n"); grid = -1; return; }
        if (hipOccupancyMaxActiveBlocksPerMultiprocessor(&per_cu, (const void*)hybrid_fwd, 512, LDS_BYTES) != hipSuccess || per_cu < 1) { fprintf(stderr, "kernel_launch: occupancy query says %d blocks per CU\n", per_cu); per_cu = 1; }
        (void)hipGetLastError();
        grid = cus;
    }
    if (grid < 0) return;
    if (hipMemsetAsync((char*)d_ws + OFF_BAR, 0, BAR_BYTES, stream) != hipSuccess) { fprintf(stderr, "kernel_launch: memset of the barrier words failed\n"); return; }
    Params p{};
    const float** f = (const float**)&p;
    for (int i = 0; i < 22; ++i) f[i] = (const float*)d_in[i];
    p.out = (float*)d_out; p.ws = (unsigned char*)d_ws; p.ph_lo = 0; p.ph_hi = N_PHASES;
    void* args[] = {&p};
    hipError_t e = hipLaunchCooperativeKernel((const void*)hybrid_fwd, dim3(grid), dim3(512), args, LDS_BYTES, stream);
    if (e != hipSuccess) fprintf(stderr, "kernel_launch: cooperative launch failed: %s (grid %d)\n", hipGetErrorString(e), grid);
}
```

```cpp
#include <hip/hip_runtime.h>
#include <hip/hip_cooperative_groups.h>
#include <cstdio>
namespace cg = cooperative_groups;

#define P0_REP_A 1
#define WGM_FF1 4
#define WGM_IN 2
#define WGM_OUT 4
#define WGM_GLU 4
#define WGM_FF2 4
#define P0_REP_F 1
#define P0_REP_S 1
#define P0_REP_B 1
#define P0_REP_C 1
#define LAS __attribute__((address_space(3)))
typedef unsigned short bf16;
typedef short bf16x8 __attribute__((ext_vector_type(8)));
typedef float f32x4 __attribute__((ext_vector_type(4)));
typedef float f32x2 __attribute__((ext_vector_type(2)));
typedef unsigned u32x4 __attribute__((ext_vector_type(4)));
typedef unsigned u32x2 __attribute__((ext_vector_type(2)));

constexpr int NB = 4, SEQ = 8192, DM = 1024, MT = NB * SEQ, DFO = 512, NHEAD = 8, SG = 32, SP = 64, DFF = 4096, NIN = 1536;
constexpr float EPS = 1e-6f;
constexpr int LDS_BYTES = 147456;
constexpr size_t MiB = 1u << 20;
constexpr size_t OFF_RA = 384 * 1024, OFF_RB = 512 * 1024, OFF_BAR = 640 * 1024, BAR_BYTES = 16384;
constexpr size_t OFF_E3 = 1 * MiB, OFF_D1 = 2 * MiB, OFF_TM = 6 * MiB, OFF_MST = 22 * MiB, OFF_W = 30 * MiB;
constexpr size_t W_IN = 0, W_OUT = 3 * MiB, W_1 = 5 * MiB, W_2 = 13 * MiB, W_GLU = 21 * MiB, W_LAYER = 22 * MiB;
constexpr size_t OFF_XB = 76 * MiB, OFF_MF = 140 * MiB, OFF_G = 140 * MiB, OFF_H = 204 * MiB;
constexpr size_t OFF_PQ = 204 * MiB, OFF_AO = 204 * MiB, OFF_UB = 268 * MiB, OFF_T = 332 * MiB, OFF_SLOC = 396 * MiB, OFF_SSS = 460 * MiB, OFF_SSM = 461 * MiB, OFF_SSF = 463 * MiB, WS_END = 465 * MiB;

struct Params {
    const float *x, *w_in, *w_out, *pre_mix_g, *post_mix_g, *pre_mlp_g, *post_mlp_g, *fourier_out_g, *ssm_out_g, *w_fourier,
        *lam_re, *lam_im, *log_dt, *b_re, *b_im, *c_re, *c_im, *d_skip, *w_glu, *b_glu, *w_ff1, *w_ff2;
    float* out; unsigned char* ws;
    int ph_lo, ph_hi;
};

__device__ __forceinline__ unsigned f2bf(float f) { unsigned u = __builtin_bit_cast(unsigned, f); return (u + 0x7fffu + ((u >> 16) & 1u)) >> 16; }
__device__ __forceinline__ unsigned pk2(float lo, float hi) { return f2bf(lo) | (f2bf(hi) << 16); }
__device__ __forceinline__ float bflo(unsigned w) { return __builtin_bit_cast(float, w << 16); }
__device__ __forceinline__ float bfhi(unsigned w) { return __builtin_bit_cast(float, w & 0xffff0000u); }
__device__ __forceinline__ float wave_sum(float v) {
#pragma unroll
    for (int o = 1; o < 64; o <<= 1) v += __shfl_xor(v, o);
    return v;
}
__device__ __forceinline__ float gelu_t(float x) { const float u = 0.7978845608f * (x + 0.044715f * x * x * x); return x * __builtin_amdgcn_rcpf(1.0f + __expf(-2.0f * u)); }
__device__ __forceinline__ float sigm(float v) { return __builtin_amdgcn_rcpf(1.0f + __expf(-v)); }

namespace pg8 {
#define PG8_LAS __attribute__((address_space(3)))
typedef unsigned short bf16_t;
constexpr int BM = 256, BK = 64, HALF = 128, HTB = HALF * BK * 2, STAGE_BYTES = 8 * HTB, NXCD = 8, WGM = 4;
__host__ __device__ __forceinline__ int lds_byte(int r, int c) { const int st = (r >> 4) * 2 + (c >> 5), rr = r & 15, cc = c & 31, ob = rr * 64 + cc * 2; return st * 1024 + (ob ^ (((ob >> 9) & 1) << 5)); }
__host__ __device__ __forceinline__ void stage_rc(int b, int& R, int& C) { const int st = b / 1024, sb = b % 1024, swz = sb ^ (((sb >> 9) & 1) << 5); R = (st >> 1) * 16 + swz / 64; C = (st & 1) * 32 + (swz % 64) / 2; }
__host__ __device__ __forceinline__ int perm32(int rho) { const int n = rho >> 4, i = rho & 15; return 8 * (i >> 2) + 4 * n + (i & 3); }

struct Unit { int pm, pn, z, ui; };
struct Gemm { const bf16_t* A; const bf16_t* Bt; int M, N, K, lda, ldb; size_t sA, sB; int nZ; };

struct Order {
    int nM, nN, nwg, nZ, G, c, wgm;
    __device__ void init(int M, int N, int nZ_, int G_, int c_, int wgm_ = WGM) { nM = M / BM; nN = N / BM; nwg = nM * nN; nZ = nZ_; G = G_; c = c_; wgm = wgm_; }
    __device__ bool next(int i, Unit& u) const {
        const long L = (long)i * G + c; if (L >= (long)nwg * nZ) return false;
        u.ui = i;
        if (nZ > 1 && (nZ % NXCD) == 0) {
            const int xcd = (int)(L % NXCD), idx = (int)(L / NXCD); u.z = xcd * (nZ / NXCD) + idx / nwg; const int wg = idx % nwg; u.pm = wg % nM; u.pn = wg / nM; return true; }
        u.z = (int)(L / nwg);
        int wgid = (int)(L % nwg); { const int q = nwg / NXCD, r = nwg % NXCD, xcd = wgid % NXCD, off = wgid / NXCD; wgid = (xcd < r ? xcd * (q + 1) : r * (q + 1) + (xcd - r) * q) + off; }
        const int nig = wgm * nN, gid = wgid / nig, fm = gid * wgm, gsz = (nM - fm) < wgm ? (nM - fm) : wgm;
        u.pm = fm + ((wgid % nig) % gsz); u.pn = (wgid % nig) / gsz; return true;
    }
};

template <class Epi>
__device__ __forceinline__ void gemm_phase(PG8_LAS unsigned char* lds, const Gemm g, const Order& S, const Epi& E) {
    int tid = threadIdx.x; asm volatile("" : "+v"(tid));
    const int wid = __builtin_amdgcn_readfirstlane(tid >> 6), lane = tid & 63, wr = wid >> 2, wc = wid & 3, fr = lane & 15, fq = lane >> 4;
    const int K = g.K, nt = K / BK;
    unsigned voffA[2], voffB[2];
#pragma unroll
    for (int i = 0; i < 2; ++i) { int R, C; stage_rc(tid * 16 + i * 8192, R, C); const int Rb = Epi::PERM ? ((R & ~31) + perm32(R & 31)) : R;
        voffA[i] = (unsigned)(R * g.lda + C) * 2u; voffB[i] = (unsigned)(Rb * g.ldb + C) * 2u; }
    const size_t kstep = (size_t)(BK * 2);
    const size_t hA = (size_t)HALF * g.lda * 2, hB = (size_t)HALF * g.ldb * 2;
    const size_t tA = 2 * hA, tB = 2 * hB;
    const unsigned ldsw = (unsigned)wid * 1024u;
    const int aoff = lds_byte(wr * 64 + fr, fq * 8), boff = lds_byte(wc * 32 + fr, fq * 8);
#define PG8_SA(b, h) (((b) * 2 + (h)) * HTB)
#define PG8_SB(b, h) ((4 + (b) * 2 + (h)) * HTB)
#define PG8_STAGE(bufoff, gbase, voff) do { _Pragma("unroll") for (int _i = 0; _i < 2; ++_i) \
        __builtin_amdgcn_global_load_lds((const unsigned*)((const char*)(gbase) + (voff)[_i]), (PG8_LAS unsigned*)(lds + (bufoff) + ldsw + _i * 8192), 16, 0, 0); } while (0)
#define PG8_LDA(dst, b, h) do { _Pragma("unroll") for (int m = 0; m < 4; ++m) _Pragma("unroll") for (int k = 0; k < 2; ++k) dst[m][k] = *(const PG8_LAS bf16x8*)(lds + PG8_SA(b, h) + aoff + m * 2048 + k * 1024); } while (0)
#define PG8_LDB(dst, b, h) do { _Pragma("unroll") for (int n = 0; n < 2; ++n) _Pragma("unroll") for (int k = 0; k < 2; ++k) dst[n][k] = *(const PG8_LAS bf16x8*)(lds + PG8_SB(b, h) + boff + n * 2048 + k * 1024); } while (0)
#define PG8_MMA(ai, bj, At, Bt) do { __builtin_amdgcn_s_setprio(1); _Pragma("unroll") for (int m = 0; m < 4; ++m) _Pragma("unroll") for (int n = 0; n < 2; ++n) _Pragma("unroll") for (int k = 0; k < 2; ++k) \
        acc[ai][bj][m][n] = __builtin_amdgcn_mfma_f32_16x16x32_bf16(Bt[n][k], At[m][k], acc[ai][bj][m][n], 0, 0, 0); __builtin_amdgcn_s_setprio(0); } while (0)
#define PG8_WAIT_V(n) asm volatile("s_waitcnt vmcnt(" #n ")" ::: "memory")
#define PG8_WAIT_L(n) asm volatile("s_waitcnt lgkmcnt(" #n ")" ::: "memory")
#define PG8_BAR __builtin_amdgcn_s_barrier()
#define PG8_SCHED __builtin_amdgcn_sched_barrier(0)
    Unit cur, nxt; int ui = 0;
    if (!S.next(0, cur)) return;
    f32x4 acc[2][2][4][2];
#pragma unroll
    for (int a = 0; a < 2; ++a)
#pragma unroll
        for (int b = 0; b < 2; ++b)
#pragma unroll
            for (int m = 0; m < 4; ++m)
#pragma unroll
                for (int n = 0; n < 2; ++n) acc[a][b][m][n] = (f32x4){0.f, 0.f, 0.f, 0.f};
    bf16x8 At[4][2], B0[2][2], B1[2][2];
    const char* cA = (const char*)g.A + ((size_t)cur.z * g.sA) * 2 + (size_t)cur.pm * tA; const char* cB = (const char*)g.Bt + ((size_t)cur.z * g.sB) * 2 + (size_t)cur.pn * tB;
    PG8_STAGE(PG8_SB(0, 0), cB, voffB); PG8_STAGE(PG8_SA(0, 0), cA, voffA); PG8_STAGE(PG8_SB(0, 1), cB + hB, voffB); PG8_STAGE(PG8_SA(0, 1), cA + hA, voffA);
    if (wr == 1) PG8_BAR;
    PG8_WAIT_V(4); PG8_BAR;
    PG8_STAGE(PG8_SB(1, 0), cB + kstep, voffB); PG8_STAGE(PG8_SA(1, 0), cA + kstep, voffA); PG8_STAGE(PG8_SB(1, 1), cB + hB + kstep, voffB);
    PG8_WAIT_V(6); PG8_BAR;
    for (;;) {
        const bool has_next = S.next(ui + 1, nxt);
        const char* nA = has_next ? (const char*)g.A + ((size_t)nxt.z * g.sA) * 2 + (size_t)nxt.pm * tA : cA; const char* nB = has_next ? (const char*)g.Bt + ((size_t)nxt.z * g.sB) * 2 + (size_t)nxt.pn * tB : cB;
        for (int t = 0; t < nt; t += 2) {
            const bool last = (t == nt - 2);
            if constexpr (Epi::MID) { if (t == (nt >> 1)) E.mid(acc, cur, wr, fr); }
            const char* a1 = cA + (size_t)(t + 1) * kstep;
            const char* a2 = last ? nA : cA + (size_t)(t + 2) * kstep; const char* b2 = last ? nB : cB + (size_t)(t + 2) * kstep;
            const char* a3 = a2 + kstep; const char* b3 = b2 + kstep;
            PG8_LDB(B0, 0, 0); PG8_SCHED; PG8_LDA(At, 0, 0); PG8_STAGE(PG8_SA(1, 1), a1 + hA, voffA);
            PG8_WAIT_L(8); PG8_BAR; PG8_WAIT_L(0); PG8_MMA(0, 0, At, B0); PG8_BAR; PG8_SCHED;
            PG8_LDB(B1, 0, 1); PG8_STAGE(PG8_SB(0, 0), b2, voffB);
            PG8_BAR; PG8_WAIT_L(0); PG8_MMA(0, 1, At, B1); PG8_BAR;
            PG8_LDA(At, 0, 1); PG8_STAGE(PG8_SA(0, 0), a2, voffA);
            PG8_BAR; PG8_WAIT_L(0); PG8_MMA(1, 0, At, B0); PG8_BAR; PG8_SCHED;
            PG8_STAGE(PG8_SB(0, 1), b2 + hB, voffB);
            PG8_WAIT_V(6); PG8_BAR; PG8_MMA(1, 1, At, B1); PG8_BAR;
            PG8_LDB(B0, 1, 0); PG8_SCHED; PG8_LDA(At, 1, 0); PG8_STAGE(PG8_SA(0, 1), a2 + hA, voffA);
            PG8_WAIT_L(8); PG8_BAR; PG8_WAIT_L(0); PG8_MMA(0, 0, At, B0); PG8_BAR; PG8_SCHED;
            PG8_LDB(B1, 1, 1); PG8_STAGE(PG8_SB(1, 0), b3, voffB);
            PG8_BAR; PG8_WAIT_L(0); PG8_MMA(0, 1, At, B1); PG8_BAR;
            PG8_LDA(At, 1, 1); PG8_STAGE(PG8_SA(1, 0), a3, voffA);
            PG8_BAR; PG8_WAIT_L(0); PG8_MMA(1, 0, At, B0); PG8_BAR; PG8_SCHED;
            PG8_STAGE(PG8_SB(1, 1), b3 + hB, voffB);
            PG8_WAIT_V(6); PG8_BAR; PG8_MMA(1, 1, At, B1); PG8_BAR;
        }
        E(acc, cur, wr, wc, fr, fq);
        if (!has_next) break;
#pragma unroll
        for (int a = 0; a < 2; ++a)
#pragma unroll
            for (int b = 0; b < 2; ++b)
#pragma unroll
                for (int m = 0; m < 4; ++m)
#pragma unroll
                    for (int n = 0; n < 2; ++n) acc[a][b][m][n] = (f32x4){0.f, 0.f, 0.f, 0.f};
        cur = nxt; cA = nA; cB = nB; ++ui;
    }
    PG8_WAIT_V(0);
    if (wr == 0) PG8_BAR;
    PG8_BAR;
#undef PG8_SA
#undef PG8_SB
#undef PG8_STAGE
#undef PG8_LDA
#undef PG8_LDB
#undef PG8_MMA
#undef PG8_WAIT_V
#undef PG8_WAIT_L
#undef PG8_BAR
#undef PG8_SCHED
}
}

typedef const f32x4 (&AccRef)[2][2][4][2];
__device__ __forceinline__ u32x4 pack8(f32x4 a, f32x4 b) { u32x4 w; w.x = pk2(a[0], a[1]); w.y = pk2(a[2], a[3]); w.z = pk2(b[0], b[1]); w.w = pk2(b[2], b[3]); return w; }

struct EpiIn {
    static constexpr bool PERM = true, MID = false;
    bf16* PQ; bf16* UB; const float* r;
    __device__ __forceinline__ void operator()(AccRef acc, const pg8::Unit& u, int wr, int wc, int fr, int fq) const {
#pragma unroll
        for (int ai = 0; ai < 2; ++ai)
#pragma unroll
            for (int m = 0; m < 4; ++m) {
                const int row = u.pm * 256 + ai * 128 + wr * 64 + m * 16 + fr; const float rs = r[row];
#pragma unroll
                for (int bj = 0; bj < 2; ++bj) {
                    const int col0 = u.pn * 256 + bj * 128 + wc * 32 + 8 * fq;
                    const u32x4 w = pack8(acc[ai][bj][m][0] * rs, acc[ai][bj][m][1] * rs);
                    if (col0 < 1024) *(u32x4*)(PQ + (size_t)row * 1024 + col0) = w;
                    else { const int c2 = col0 - 1024, gg = c2 >> 4, h0 = c2 & 15; *(u32x4*)(UB + ((size_t)(gg * 2048 + (row >> 4)) * 512 + (row & 15) * 16 + h0)) = w; }
                }
            }
    }
};
struct EpiSloc {
    static constexpr bool PERM = false, MID = false;
    float* S;
    __device__ __forceinline__ void operator()(AccRef acc, const pg8::Unit& u, int wr, int wc, int fr, int fq) const {
#pragma unroll
        for (int ai = 0; ai < 2; ++ai)
#pragma unroll
            for (int m = 0; m < 4; ++m) {
                const int row = u.pm * 256 + ai * 128 + wr * 64 + m * 16 + fr;
                float* rp = S + ((size_t)u.z * 2048 + row) * 256 + wc * 32 + 4 * fq;
#pragma unroll
                for (int bj = 0; bj < 2; ++bj)
#pragma unroll
                    for (int n = 0; n < 2; ++n) *(f32x4*)(rp + bj * 128 + n * 16) = acc[ai][bj][m][n];
            }
    }
};
struct EpiSsmOut {
    static constexpr bool PERM = true, MID = false;
    bf16* G;
    __device__ __forceinline__ void operator()(AccRef acc, const pg8::Unit& u, int wr, int wc, int fr, int fq) const {
#pragma unroll
        for (int ai = 0; ai < 2; ++ai)
#pragma unroll
            for (int m = 0; m < 4; ++m) {
                const int row = u.pm * 256 + ai * 128 + wr * 64 + m * 16 + fr;
#pragma unroll
                for (int bj = 0; bj < 2; ++bj) {
                    const int col0 = bj * 128 + wc * 32 + 8 * fq, t = col0 >> 4, i0 = col0 & 15;
                    f32x4 a = acc[ai][bj][m][0], b = acc[ai][bj][m][1];
#pragma unroll
                    for (int j = 0; j < 4; ++j) { a[j] = gelu_t(a[j]); b[j] = gelu_t(b[j]); }
                    *(u32x4*)(G + ((size_t)row * 16 + t) * 512 + u.z * 16 + i0) = pack8(a, b);
                }
            }
    }
};
struct EpiGlu {
    static constexpr bool PERM = true, MID = false;
    const bf16* G; const float* bias; bf16* AO; float* ss;
    __device__ __forceinline__ void operator()(AccRef acc, const pg8::Unit& u, int wr, int wc, int fr, int fq) const {
#pragma unroll
        for (int ai = 0; ai < 2; ++ai)
#pragma unroll
            for (int m = 0; m < 4; ++m) {
                const int row = u.pm * 256 + ai * 128 + wr * 64 + m * 16 + fr; float s2 = 0.f;
#pragma unroll
                for (int bj = 0; bj < 2; ++bj) {
                    const int col0 = u.pn * 256 + bj * 128 + wc * 32 + 8 * fq;
                    const u32x4 gv = *(const u32x4*)(G + (size_t)row * 512 + col0);
                    const f32x4 b0 = *(const f32x4*)(bias + col0), b1 = *(const f32x4*)(bias + col0 + 4);
                    f32x4 a = acc[ai][bj][m][0] + b0, b = acc[ai][bj][m][1] + b1;
                    a[0] = bflo(gv.x) * sigm(a[0]); a[1] = bfhi(gv.x) * sigm(a[1]); a[2] = bflo(gv.y) * sigm(a[2]); a[3] = bfhi(gv.y) * sigm(a[3]);
                    b[0] = bflo(gv.z) * sigm(b[0]); b[1] = bfhi(gv.z) * sigm(b[1]); b[2] = bflo(gv.w) * sigm(b[2]); b[3] = bfhi(gv.w) * sigm(b[3]);
#pragma unroll
                    for (int j = 0; j < 4; ++j) s2 += a[j] * a[j] + b[j] * b[j];
                    *(u32x4*)(AO + (size_t)row * 1024 + 512 + col0) = pack8(a, b);
                }
                s2 += __shfl_xor(s2, 16); s2 += __shfl_xor(s2, 32);
                if (fq == 0) ss[row * 8 + u.pn * 4 + wc] = s2;
            }
    }
};
struct EpiOutSS {
    static constexpr bool PERM = true, MID = false;
    bf16* O; float* ss;
    __device__ __forceinline__ void operator()(AccRef acc, const pg8::Unit& u, int wr, int wc, int fr, int fq) const {
#pragma unroll
        for (int ai = 0; ai < 2; ++ai)
#pragma unroll
            for (int m = 0; m < 4; ++m) {
                const int row = u.pm * 256 + ai * 128 + wr * 64 + m * 16 + fr; float s2 = 0.f;
#pragma unroll
                for (int bj = 0; bj < 2; ++bj) {
                    const int col0 = u.pn * 256 + bj * 128 + wc * 32 + 8 * fq;
                    const f32x4 a = acc[ai][bj][m][0], b = acc[ai][bj][m][1];
#pragma unroll
                    for (int j = 0; j < 4; ++j) s2 += a[j] * a[j] + b[j] * b[j];
                    *(u32x4*)(O + (size_t)row * 1024 + col0) = pack8(a, b);
                }
                s2 += __shfl_xor(s2, 16); s2 += __shfl_xor(s2, 32);
                if (fq == 0) ss[row * 16 + u.pn * 4 + wc] = s2;
            }
    }
};
struct EpiOutMix {
    static constexpr bool PERM = true, MID = true;
    bf16* O; float* ss; const LAS float* qv;
    __device__ __forceinline__ void mid(f32x4 (&acc)[2][2][4][2], const pg8::Unit& u, int wr, int fr) const {
#pragma unroll
        for (int ai = 0; ai < 2; ++ai)
#pragma unroll
            for (int m = 0; m < 4; ++m) { const float q = qv[u.ui * 256 + ai * 128 + wr * 64 + m * 16 + fr];
#pragma unroll
                for (int bj = 0; bj < 2; ++bj)
#pragma unroll
                    for (int n = 0; n < 2; ++n) acc[ai][bj][m][n] *= q; }
    }
    __device__ __forceinline__ void operator()(AccRef acc, const pg8::Unit& u, int wr, int wc, int fr, int fq) const {
#pragma unroll
        for (int ai = 0; ai < 2; ++ai)
#pragma unroll
            for (int m = 0; m < 4; ++m) {
                const int rl = ai * 128 + wr * 64 + m * 16 + fr, row = u.pm * 256 + rl; float s2 = 0.f; const float rs = qv[1024 + u.ui * 256 + rl];
#pragma unroll
                for (int bj = 0; bj < 2; ++bj) {
                    const int col0 = u.pn * 256 + bj * 128 + wc * 32 + 8 * fq;
                    const f32x4 a = acc[ai][bj][m][0] * rs, b = acc[ai][bj][m][1] * rs;
#pragma unroll
                    for (int j = 0; j < 4; ++j) s2 += a[j] * a[j] + b[j] * b[j];
                    *(u32x4*)(O + (size_t)row * 1024 + col0) = pack8(a, b);
                }
                s2 += __shfl_xor(s2, 16); s2 += __shfl_xor(s2, 32);
                if (fq == 0) ss[row * 16 + u.pn * 4 + wc] = s2;
            }
    }
};
struct EpiFF1 {
    static constexpr bool PERM = true, MID = false;
    bf16* H; const float* r;
    __device__ __forceinline__ void operator()(AccRef acc, const pg8::Unit& u, int wr, int wc, int fr, int fq) const {
#pragma unroll
        for (int ai = 0; ai < 2; ++ai)
#pragma unroll
            for (int m = 0; m < 4; ++m) {
                const int row = u.pm * 256 + ai * 128 + wr * 64 + m * 16 + fr; const float rs = r[row];
#pragma unroll
                for (int bj = 0; bj < 2; ++bj) {
                    const int col0 = u.pn * 256 + bj * 128 + wc * 32 + 8 * fq;
                    f32x4 a = acc[ai][bj][m][0] * rs, b = acc[ai][bj][m][1] * rs;
#pragma unroll
                    for (int j = 0; j < 4; ++j) { a[j] = fmaxf(a[j], 0.f); a[j] *= a[j]; b[j] = fmaxf(b[j], 0.f); b[j] *= b[j]; }
                    *(u32x4*)(H + (size_t)row * 4096 + col0) = pack8(a, b);
                }
            }
    }
};

__device__ __forceinline__ void transpose_item(const float* W, int ldw, bf16* WT, int ldt, const float* sc_lo, const float* sc_hi, int split,
                                               LAS float* scr, int item, int nblk, int lane) {
    const int kb = item / nblk, nb = item % nblk, k0 = 64 * kb, n0 = 32 * nb;
#pragma unroll 16
    for (int i = 0; i < 32; ++i) { const int kk = 2 * i + (lane >> 5), k = k0 + kk;
        float s = 1.f; if (sc_lo) s = (k < split) ? sc_lo[k] : sc_hi[k - split];
        scr[kk * 33 + (lane & 31)] = W[(size_t)k * ldw + n0 + (lane & 31)] * s; }
    asm volatile("s_waitcnt lgkmcnt(0)" ::: "memory");
    const int c = lane & 7;
#pragma unroll
    for (int j = 0; j < 4; ++j) { const int n = (lane >> 3) + 8 * j; const LAS float* s = scr + (8 * c) * 33 + n;
        u32x4 o; o.x = pk2(s[0 * 33], s[1 * 33]); o.y = pk2(s[2 * 33], s[3 * 33]); o.z = pk2(s[4 * 33], s[5 * 33]); o.w = pk2(s[6 * 33], s[7 * 33]);
        *(u32x4*)(WT + (size_t)(n0 + n) * ldt + k0 + 8 * c) = o; }
    asm volatile("s_waitcnt lgkmcnt(0)" ::: "memory");
}

__device__ __forceinline__ void fold_item(const Params& p, int item, LAS unsigned char* lds) {
    int tid = threadIdx.x; asm volatile("" : "+v"(tid)); const int ly = item >> 7, h = (item >> 4) & 7, kb = item & 15, k0 = kb * 64;
    LAS float* Wt = (LAS float*)lds;
    LAS float* Wf = Wt + 64 * 65;
    LAS float* TC = Wf + 64 * 65;
    LAS float* TS = TC + 64 * 65;
    LAS float* cs = TS + 64 * 65;
    __syncthreads();
    const float* win = p.w_in + (size_t)ly * 1024 * 1024; const float* wf = p.w_fourier + ((size_t)ly * 8 + h) * 4096; const float* g = p.pre_mix_g + ly * 1024;
    for (int i = tid; i < 4096; i += 512) { const int k = i >> 6, c = i & 63; Wt[k * 65 + c] = win[(size_t)(k0 + k) * 1024 + 64 * h + c] * g[k0 + k]; Wf[k * 65 + c] = wf[i]; }
    if (tid < 64) { float s, c; sincospif((float)tid / 32.0f, &s, &c); cs[tid] = c; cs[64 + tid] = s; }
    __syncthreads();
    { const int d = tid & 63, kg = tid >> 6; float ac[8], as[8];
#pragma unroll
      for (int j = 0; j < 8; ++j) { ac[j] = 0.f; as[j] = 0.f; }
#pragma unroll 2
      for (int c = 0; c < 64; ++c) { const int ph = (c * d) & 63; const float cv = cs[ph], sv = cs[64 + ph];
#pragma unroll
          for (int j = 0; j < 8; ++j) { const float w = Wt[(kg * 8 + j) * 65 + c]; ac[j] += w * cv; as[j] += w * sv; } }
#pragma unroll
      for (int j = 0; j < 8; ++j) { TC[(kg * 8 + j) * 65 + d] = ac[j]; TS[(kg * 8 + j) * 65 + d] = as[j]; } }
    __syncthreads();
    const float scale = 1.0f / 724.0773439350247f;
    bf16* WT = (bf16*)(p.ws + OFF_W + (size_t)ly * W_LAYER + W_IN);
    { const int k = tid & 63, eg = tid >> 6; float ap[8], aq[8];
#pragma unroll
      for (int j = 0; j < 8; ++j) { ap[j] = 0.f; aq[j] = 0.f; }
#pragma unroll 2
      for (int d = 0; d < 64; ++d) { const float tc = TC[k * 65 + d], ts = TS[k * 65 + d];
#pragma unroll
          for (int j = 0; j < 8; ++j) { const float w = Wf[d * 65 + eg * 8 + j]; ap[j] += tc * w; aq[j] += ts * w; } }
#pragma unroll
      for (int j = 0; j < 8; ++j) { const int e = eg * 8 + j;
          WT[(size_t)(64 * h + e) * 1024 + k0 + k] = (bf16)f2bf(ap[j] * scale);
          WT[(size_t)(512 + 64 * h + e) * 1024 + k0 + k] = (bf16)f2bf(-aq[j] * scale); } }
}

__device__ __forceinline__ void ssm_mat_item(const Params& p, int item, LAS unsigned char* lds) {
    int tid = threadIdx.x; asm volatile("" : "+v"(tid)); const int ly = item >> 7, g = (item >> 2) & 31, qt = item & 3;
    LAS float* pwr = (LAS float*)lds;
    LAS float* pwi = pwr + 2 * 64 * 20;
    LAS float* bbr = pwi + 2 * 64 * 20;
    LAS float* bbi = bbr + 2 * 64 * 16;
    LAS float* ccr = bbi + 2 * 64 * 16;
    LAS float* cci = ccr + 2 * 16 * 64;
    LAS float* Gt = cci + 2 * 16 * 64;
    __syncthreads();
    { const int k = (tid >> 6) & 1, pp = tid & 63, tg = tid >> 7; const int idx = (ly * 2 + k) * 32 + g;
      const float dt = expf(p.log_dt[idx]); const float lr = p.lam_re[idx * 64 + pp] * dt, li = p.lam_im[idx * 64 + pp] * dt;
#pragma unroll
      for (int j = 0; j < 5; ++j) { const int tau = tg * 5 + j; if (tau <= 16) { const float e = __expf(lr * tau); float sn, cs; __sincosf(li * tau, &sn, &cs); pwr[(k * 64 + pp) * 20 + tau] = e * cs; pwi[(k * 64 + pp) * 20 + tau] = e * sn; } } }
    for (int i = tid; i < 2048; i += 512) { const int k = i >> 10, r = i & 1023; const int idx = (ly * 2 + k) * 32 + g; ccr[i] = p.c_re[(size_t)idx * 1024 + r]; cci[i] = p.c_im[(size_t)idx * 1024 + r]; }
    __syncthreads();
#pragma unroll
    for (int j = 0; j < 4; ++j) { const int o = tid + 512 * j, k = o >> 10, pp = (o >> 4) & 63, h = o & 15; const int idx = (ly * 2 + k) * 32 + g;
        const float lr = p.lam_re[idx * 64 + pp], li = p.lam_im[idx * 64 + pp], dt = expf(p.log_dt[idx]);
        float sn, cs; sincosf(li * dt, &sn, &cs); const float em1 = expm1f(lr * dt), sh = sinf(0.5f * li * dt);
        const float lbr = em1 * cs - 2.0f * sh * sh, lbi = (em1 + 1.0f) * sn;
        const float den = 1.0f / (lr * lr + li * li); const float cr = (lbr * lr + lbi * li) * den, ci = (lbi * lr - lbr * li) * den;
        const float br = p.b_re[(size_t)idx * 1024 + pp * 16 + h], bi = p.b_im[(size_t)idx * 1024 + pp * 16 + h];
        bbr[o] = cr * br - ci * bi; bbi[o] = cr * bi + ci * br; }
    __syncthreads();
    { const int k = tid >> 8, i = (tid >> 4) & 15, h = tid & 15; float a[16];
#pragma unroll
      for (int tau = 0; tau < 16; ++tau) a[tau] = 0.f;
#pragma nounroll
      for (int pp = 0; pp < 64; ++pp) { const float c_r = ccr[(k * 16 + i) * 64 + pp], c_i = cci[(k * 16 + i) * 64 + pp], b_r = bbr[(k * 64 + pp) * 16 + h], b_i = bbi[(k * 64 + pp) * 16 + h];
          const float xr = c_r * b_r - c_i * b_i, xi = c_r * b_i + c_i * b_r;
          const LAS f32x4* pr4 = (const LAS f32x4*)(pwr + (k * 64 + pp) * 20); const LAS f32x4* pi4 = (const LAS f32x4*)(pwi + (k * 64 + pp) * 20);
#pragma unroll
          for (int t4 = 0; t4 < 4; ++t4) { const f32x4 vr = pr4[t4], vi = pi4[t4];
#pragma unroll
              for (int e = 0; e < 4; ++e) a[t4 * 4 + e] += xr * vr[e] - xi * vi[e]; } }
#pragma unroll
      for (int tau = 0; tau < 16; ++tau) Gt[((k * 16 + tau) * 16 + i) * 16 + h] = a[tau]; }
    __syncthreads();
    bf16* TM = (bf16*)(p.ws + OFF_TM) + (size_t)(ly * 32 + g) * 256 * 512; bf16* MS = (bf16*)(p.ws + OFF_MST) + (size_t)(ly * 32 + g) * 256 * 256;
    const float* dsk = p.d_skip + (ly * 32 + g) * 16;
    for (int o = qt * 64 * 512 + tid; o < (qt + 1) * 64 * 512; o += 512) { const int r = o >> 9, col = o & 511, t = r >> 4, i = r & 15; float v;
        if (col < 256) { const int j = col >> 4, h = col & 15; v = 0.f;
            if (j <= t) v += Gt[((0 * 16 + (t - j)) * 16 + i) * 16 + h];
            if (j >= t) v += Gt[((1 * 16 + (j - t)) * 16 + i) * 16 + h];
            if (j == t && h == i) v += dsk[i]; }
        else { const int k = (col - 256) >> 7, q = (col - 256) & 127, pp = q >> 1, part = q & 1; const int tau = k == 0 ? (t + 1) : (16 - t);
            const float c_r = ccr[(k * 16 + i) * 64 + pp], c_i = cci[(k * 16 + i) * 64 + pp], l_r = pwr[(k * 64 + pp) * 20 + tau], l_i = pwi[(k * 64 + pp) * 20 + tau];
            v = part == 0 ? (c_r * l_r - c_i * l_i) : -(c_r * l_i + c_i * l_r); }
        TM[o] = (bf16)f2bf(v); }
    for (int o = qt * 64 * 256 + tid; o < (qt + 1) * 64 * 256; o += 512) { const int r = o >> 8, col = o & 255, k = r >> 7, q = r & 127, pp = q >> 1, part = q & 1, j = col >> 4, h = col & 15;
        const int tau = k == 0 ? (15 - j) : j;
        const float l_r = pwr[(k * 64 + pp) * 20 + tau], l_i = pwi[(k * 64 + pp) * 20 + tau], b_r = bbr[(k * 64 + pp) * 16 + h], b_i = bbi[(k * 64 + pp) * 16 + h];
        const float v = part == 0 ? (l_r * b_r - l_i * b_i) : (l_r * b_i + l_i * b_r);
        MS[o] = (bf16)f2bf(v); }
}

__device__ __forceinline__ void p0_prologue(const Params& p, LAS unsigned char* lds, int G, int bid) {
    int tid = threadIdx.x; asm volatile("" : "+v"(tid));
    const int lane = tid & 63, wave = __builtin_amdgcn_readfirstlane(tid >> 6);
    for (int rp = 0; rp < P0_REP_A; ++rp)
    for (int it = bid; it < 512; it += G) { if (it < 256) { for (int r2 = 0; r2 < P0_REP_F; ++r2) fold_item(p, it, lds); } else { for (int r2 = 0; r2 < P0_REP_S; ++r2) ssm_mat_item(p, it - 256, lds); } }
    __syncthreads();
    {
        LAS float* scr = (LAS float*)(lds + wave * 8448);
        const int gw = bid * 8 + wave, NGW = G * 8;
        constexpr int I_IN = 16 * 16, I_OUT = 16 * 32, I_1 = 16 * 128, I_2 = 64 * 32, I_G = 8 * 16, I_L = I_IN + I_OUT + I_1 + I_2 + I_G;
        for (int rp = 0; rp < P0_REP_B; ++rp)
        for (int it = gw; it < 2 * I_L; it += NGW) {
            const int ly = it / I_L; int r = it % I_L; unsigned char* wb = p.ws + OFF_W + (size_t)ly * W_LAYER;
            if (r < I_IN) { transpose_item(p.w_in + (size_t)ly * 1024 * 1024 + 512, 1024, (bf16*)(wb + W_IN) + (size_t)1024 * 1024, 1024, p.pre_mix_g + ly * 1024, nullptr, 1 << 30, scr, r, 16, lane); continue; } r -= I_IN;
            if (r < I_OUT) { transpose_item(p.w_out + (size_t)ly * 1024 * 1024, 1024, (bf16*)(wb + W_OUT), 1024, p.fourier_out_g + ly * 512, p.ssm_out_g + ly * 512, 512, scr, r, 32, lane); continue; } r -= I_OUT;
            if (r < I_1) { transpose_item(p.w_ff1 + (size_t)ly * 1024 * 4096, 4096, (bf16*)(wb + W_1), 1024, p.pre_mlp_g + ly * 1024, nullptr, 1 << 30, scr, r, 128, lane); continue; } r -= I_1;
            if (r < I_2) { transpose_item(p.w_ff2 + (size_t)ly * 4096 * 1024, 1024, (bf16*)(wb + W_2), 4096, nullptr, nullptr, 0, scr, r, 32, lane); continue; } r -= I_2;
            transpose_item(p.w_glu + (size_t)ly * 512 * 512, 512, (bf16*)(wb + W_GLU), 512, nullptr, nullptr, 0, scr, r, 16, lane);
        }
        bf16* XB = (bf16*)(p.ws + OFF_XB); float* rA = (float*)(p.ws + OFF_RA);
        for (int rp = 0; rp < P0_REP_C; ++rp)
        for (int row0 = gw; row0 < MT; row0 += 4 * NGW) {
            f32x4 v[4][4];
#pragma unroll
            for (int rr = 0; rr < 4; ++rr) { const f32x4* xr = (const f32x4*)(p.x + (size_t)(row0 + rr * NGW) * 1024) + lane;
#pragma unroll
                for (int j = 0; j < 4; ++j) v[rr][j] = xr[64 * j]; }
#pragma unroll
            for (int rr = 0; rr < 4; ++rr) { const int row = row0 + rr * NGW; float s2 = 0.f;
                u32x2* o = (u32x2*)(XB + (size_t)row * 1024) + lane;
#pragma unroll
                for (int j = 0; j < 4; ++j) { const f32x4 t = v[rr][j]; s2 += t[0] * t[0] + t[1] * t[1] + t[2] * t[2] + t[3] * t[3]; u32x2 w; w.x = pk2(t[0], t[1]); w.y = pk2(t[2], t[3]); o[64 * j] = w; }
                s2 = wave_sum(s2);
                if (lane == 0) rA[row] = rsqrtf(s2 * (1.0f / 1024.0f) + EPS); }
        }
    }
    {
        bf16* D1 = (bf16*)(p.ws + OFF_D1); bf16* E3 = (bf16*)(p.ws + OFF_E3);
        const int gt = bid * 512 + tid, NT = G * 512;
        for (int idx = gt; idx < 64 * 2 * 128 * 128; idx += NT) { const int n2 = idx >> 15, sel = (idx >> 14) & 1, k1 = (idx >> 7) & 127, n1 = idx & 127;
            const int ph = (k1 * (64 * n1 + n2)) & 8191; float s, c; sincospif((float)ph * (1.0f / 4096.0f), &s, &c); D1[idx] = (bf16)f2bf(sel ? s : c); }
        for (int idx = gt; idx < 64 * 128; idx += NT) { const int k2 = idx >> 7, col = idx & 127, part = col >> 6, n2 = col & 63;
            const int ph = (n2 * k2) & 63; float s, c; sincospif((float)ph * (1.0f / 32.0f), &s, &c); E3[idx] = (bf16)f2bf(part ? s : c); }
    }
}

typedef short v4s16 __attribute__((ext_vector_type(4)));
__device__ __forceinline__ bf16x8 negbf(bf16x8 v) { u32x4 t = __builtin_bit_cast(u32x4, v); t = t ^ 0x80008000u; return __builtin_bit_cast(bf16x8, t); }
__device__ __forceinline__ bf16x8 tr_frag(const LAS unsigned char* a, int hs) {
    const v4s16 lo = __builtin_amdgcn_ds_read_tr16_b64_v4i16((LAS v4s16*)a), hi = __builtin_amdgcn_ds_read_tr16_b64_v4i16((LAS v4s16*)(a + hs));
    return __builtin_shufflevector(lo, hi, 0, 1, 2, 3, 4, 5, 6, 7);
}
constexpr int F1_P = 264, F1_CS = 256 * F1_P;
__device__ __forceinline__ void fft1_phase(const bf16* PQ, const bf16* D1, bf16* T, LAS unsigned char* lds, int G, int bid) {
    int tid = threadIdx.x; asm volatile("" : "+v"(tid));
    const int lane = tid & 63, wave = __builtin_amdgcn_readfirstlane(tid >> 6), wm = wave & 3, wn = wave >> 2, fr = lane & 15, fq = lane >> 4, tq = fr >> 2, tp = fr & 3;
    for (int pr = bid; pr < 256; pr += G) {
        const int n2 = pr & 63, cb = pr >> 6;
        __syncthreads();
        {
            const bf16* src = D1 + (size_t)n2 * 2 * 128 * 128;
#pragma unroll
            for (int j = 0; j < 8; ++j) { const int q = tid + 512 * j, sel = q >> 11, row = (q >> 4) & 127, cc = q & 15;
                *(LAS u32x4*)(lds + F1_CS + sel * 34816 + row * 272 + cc * 16) = *(const u32x4*)(src + sel * 16384 + row * 128 + 8 * cc); }
        }
        for (int b = 0; b < NB; ++b) {
            __syncthreads();
#pragma unroll
            for (int j = 0; j < 8; ++j) { const int q = tid + 512 * j, row = q >> 4, cc = q & 15, part = row >> 7, n1 = row & 127;
                const u32x4 v = *(const u32x4*)(PQ + ((size_t)(b * SEQ + 64 * n1 + n2)) * 1024 + part * 512 + cb * 128 + 8 * cc);
                LAS u32x2* d = (LAS u32x2*)(lds + row * F1_P + cc * 16); d[0] = (u32x2){v.x, v.y}; d[1] = (u32x2){v.z, v.w}; }
            __syncthreads();
            f32x4 Ar[2][4], Ai[2][4];
#pragma unroll
            for (int mb = 0; mb < 2; ++mb)
#pragma unroll
                for (int nb = 0; nb < 4; ++nb) { Ar[mb][nb] = (f32x4){0.f, 0.f, 0.f, 0.f}; Ai[mb][nb] = (f32x4){0.f, 0.f, 0.f, 0.f}; }
#pragma nounroll
            for (int ks = 0; ks < 8; ++ks) {
                bf16x8 Bf[4];
#pragma unroll
                for (int nb = 0; nb < 4; ++nb) Bf[nb] = tr_frag(lds + (32 * ks + 8 * fq + tq) * F1_P + (64 * wn + 16 * tp + 4 * nb) * 2, 4 * F1_P);
                bf16x8 Cf[2], Sf[2];
#pragma unroll
                for (int mb = 0; mb < 2; ++mb) { const int off = F1_CS + (32 * wm + 16 * mb + fr) * 272 + (32 * (ks & 3) + 8 * fq) * 2; Cf[mb] = *(const LAS bf16x8*)(lds + off); Sf[mb] = *(const LAS bf16x8*)(lds + off + 34816); }
#pragma unroll
                for (int mb = 0; mb < 2; ++mb)
#pragma unroll
                    for (int nb = 0; nb < 4; ++nb) {
                        if (ks < 4) { Ar[mb][nb] = __builtin_amdgcn_mfma_f32_16x16x32_bf16(Bf[nb], Cf[mb], Ar[mb][nb], 0, 0, 0);
                                      Ai[mb][nb] = __builtin_amdgcn_mfma_f32_16x16x32_bf16(Bf[nb], negbf(Sf[mb]), Ai[mb][nb], 0, 0, 0); }
                        else        { Ar[mb][nb] = __builtin_amdgcn_mfma_f32_16x16x32_bf16(Bf[nb], Sf[mb], Ar[mb][nb], 0, 0, 0);
                                      Ai[mb][nb] = __builtin_amdgcn_mfma_f32_16x16x32_bf16(Bf[nb], Cf[mb], Ai[mb][nb], 0, 0, 0); }
                    }
            }
#pragma unroll
            for (int mb = 0; mb < 2; ++mb) { const int k1 = 32 * wm + 16 * mb + fr, c = cb * 128 + 64 * wn + 16 * fq;
                bf16* t0 = T + ((((size_t)(b * 128 + k1) * 2 + 0) * 64 + n2) * 512 + c); bf16* t1 = t0 + 64 * 512;
                *(u32x4*)t0 = pack8(Ar[mb][0], Ar[mb][1]); *(u32x4*)(t0 + 8) = pack8(Ar[mb][2], Ar[mb][3]);
                *(u32x4*)t1 = pack8(Ai[mb][0], Ai[mb][1]); *(u32x4*)(t1 + 8) = pack8(Ai[mb][2], Ai[mb][3]); }
        }
    }
    __syncthreads();
}

constexpr int F3_P = 1032;
__device__ __forceinline__ void fft3_phase(const bf16* T, const bf16* E3, bf16* AO, LAS unsigned char* lds, int G, int bid) {
    int tid = threadIdx.x; asm volatile("" : "+v"(tid));
    const int lane = tid & 63, wave = __builtin_amdgcn_readfirstlane(tid >> 6), fr = lane & 15, fq = lane >> 4, tq = fr >> 2, tp = fr & 3;
    LAS float* red = (LAS float*)(lds + 128 * F3_P);
    for (int unit = bid; unit < 512; unit += G) {
        const int b = unit >> 7, k1 = unit & 127;
        __syncthreads();
        const bf16* src = T + (size_t)unit * 65536;
#pragma unroll
        for (int j = 0; j < 16; ++j) { const int q = tid + 512 * j, row = q >> 6, cc = q & 63;
            const u32x4 v = *(const u32x4*)(src + row * 512 + cc * 8);
            LAS u32x2* d = (LAS u32x2*)(lds + row * F3_P + cc * 16); d[0] = (u32x2){v.x, v.y}; d[1] = (u32x2){v.z, v.w}; }
        __syncthreads();
        f32x4 acc[4][4];
#pragma unroll
        for (int mb = 0; mb < 4; ++mb)
#pragma unroll
            for (int nb = 0; nb < 4; ++nb) acc[mb][nb] = (f32x4){0.f, 0.f, 0.f, 0.f};
        bf16x8 Ef[4];
#pragma unroll
        for (int mb = 0; mb < 4; ++mb) Ef[mb] = *(const bf16x8*)(E3 + (16 * mb + fr) * 128 + 8 * fq);
#pragma nounroll
        for (int ks = 0; ks < 4; ++ks) {
            bf16x8 Bf[4], En[4];
            const int kn = ks < 3 ? ks + 1 : 3;
#pragma unroll
            for (int mb = 0; mb < 4; ++mb) En[mb] = *(const bf16x8*)(E3 + (16 * mb + fr) * 128 + 32 * kn + 8 * fq);
#pragma unroll
            for (int nb = 0; nb < 4; ++nb) Bf[nb] = tr_frag(lds + (32 * ks + 8 * fq + tq) * F3_P + (64 * wave + 16 * tp + 4 * nb) * 2, 4 * F3_P);
#pragma unroll
            for (int mb = 0; mb < 4; ++mb)
#pragma unroll
                for (int nb = 0; nb < 4; ++nb) acc[mb][nb] = __builtin_amdgcn_mfma_f32_16x16x32_bf16(Bf[nb], Ef[mb], acc[mb][nb], 0, 0, 0);
#pragma unroll
            for (int mb = 0; mb < 4; ++mb) Ef[mb] = En[mb];
        }
#pragma unroll
        for (int mb = 0; mb < 4; ++mb) { float s = 0.f;
#pragma unroll
            for (int nb = 0; nb < 4; ++nb)
#pragma unroll
                for (int j = 0; j < 4; ++j) s += acc[mb][nb][j] * acc[mb][nb][j];
            s += __shfl_xor(s, 16); s += __shfl_xor(s, 32);
            if (fq == 0) red[wave * 64 + 16 * mb + fr] = s; }
        __syncthreads();
#pragma unroll
        for (int mb = 0; mb < 4; ++mb) { float tot = 0.f;
#pragma unroll
            for (int w = 0; w < 8; ++w) tot += red[w * 64 + 16 * mb + fr];
            const float rinv = rsqrtf(tot * (1.0f / 512.0f) + EPS);
            const size_t token = (size_t)b * SEQ + k1 + 128 * (16 * mb + fr);
            bf16* o = AO + token * 1024 + 64 * wave + 16 * fq;
            *(u32x4*)o = pack8(acc[mb][0] * rinv, acc[mb][1] * rinv); *(u32x4*)(o + 8) = pack8(acc[mb][2] * rinv, acc[mb][3] * rinv); }
    }
    __syncthreads();
}

__device__ __forceinline__ void carry_phase(const Params& p, int ly, const float* Sloc, bf16* UB, LAS unsigned char* lds, int G, int bid) {
    int tid = threadIdx.x; asm volatile("" : "+v"(tid));
    const int lane = tid & 63, wave = __builtin_amdgcn_readfirstlane(tid >> 6);
    LAS f32x2* ex = (LAS f32x2*)lds;
    for (int w = bid; w < 256; w += G) {
        const int dir = w & 1, g = (w >> 1) & 31, b = w >> 6, pp = lane; const int idx = (ly * 2 + dir) * 32 + g;
        const float dt = expf(p.log_dt[idx]); const float lr = p.lam_re[idx * 64 + pp] * dt * 16.0f, li = p.lam_im[idx * 64 + pp] * dt * 16.0f;
        const float e = expf(lr); float sn, cs; sincosf(li, &sn, &cs); const float l_r = e * cs, l_i = e * sn;
        float Lr = l_r, Li = l_i;
#pragma unroll
        for (int k = 0; k < 6; ++k) { const float nr = Lr * Lr - Li * Li, ni = 2.0f * Lr * Li; Lr = nr; Li = ni; }
        const float* src = Sloc + ((size_t)(g * 2048 + b * 512)) * 256 + dir * 128 + 2 * pp;
        bf16* dst = UB + ((size_t)(g * 2048 + b * 512)) * 512 + 256 + dir * 128 + 2 * pp;
        const int ss0 = dir == 0 ? wave * 64 : 511 - wave * 64; const long stp = dir == 0 ? 256 : -256;
        float cr = 0.f, ci = 0.f;
        { const float* ptr = src + (size_t)ss0 * 256;
#pragma nounroll
          for (int hb = 0; hb < 2; ++hb) {
            f32x2 v[32];
#pragma unroll
            for (int j = 0; j < 32; ++j) { v[j] = *(const f32x2*)ptr; ptr += stp; }
#pragma unroll
            for (int j = 0; j < 32; ++j) { const float nr = l_r * cr - l_i * ci + v[j][0], ni = l_r * ci + l_i * cr + v[j][1]; cr = nr; ci = ni; }
          } }
        __syncthreads();
        ex[wave * 64 + lane] = (f32x2){cr, ci};
        __syncthreads();
        cr = 0.f; ci = 0.f;
        for (int u = 0; u < wave; ++u) { const f32x2 eu = ex[u * 64 + lane]; const float nr = Lr * cr - Li * ci + eu[0], ni = Lr * ci + Li * cr + eu[1]; cr = nr; ci = ni; }
        { const float* ptr = src + (size_t)ss0 * 256; bf16* dp = dst + (size_t)ss0 * 512;
#pragma nounroll
          for (int hb = 0; hb < 2; ++hb) {
            f32x2 v[32];
#pragma unroll
            for (int j = 0; j < 32; ++j) { v[j] = *(const f32x2*)ptr; ptr += stp; }
#pragma unroll
            for (int j = 0; j < 32; ++j) {
                *(unsigned*)dp = pk2(cr, ci); dp += 2 * stp;
                const float nr = l_r * cr - l_i * ci + v[j][0], ni = l_r * ci + l_i * cr + v[j][1]; cr = nr; ci = ni; }
          } }
    }
    __syncthreads();
}

__device__ __forceinline__ void norm_phase(float* out, const bf16* MF, const float* ss, const float* gain, bf16* XB, float* rnext, bool last, int G, int bid) {
    int tid = threadIdx.x; asm volatile("" : "+v"(tid));
    const int lane = tid & 63, wave = __builtin_amdgcn_readfirstlane(tid >> 6);
    const int gw = bid * 8 + wave, NGW = G * 8;
    const f32x4* gr = (const f32x4*)gain + lane;
    const f32x4 g0 = gr[0], g1 = gr[64], g2 = gr[128], g3 = gr[192];
    for (int row0 = gw; row0 < MT; row0 += 2 * NGW) {
        u32x2 xv[2][4], mv[2][4]; float tot[2];
#pragma unroll
        for (int rr = 0; rr < 2; ++rr) { const int row = row0 + rr * NGW;
            const u32x2* xr = (const u32x2*)(XB + (size_t)row * 1024) + lane; const u32x2* mr = (const u32x2*)(MF + (size_t)row * 1024) + lane;
#pragma unroll
            for (int j = 0; j < 4; ++j) { xv[rr][j] = xr[64 * j]; mv[rr][j] = mr[64 * j]; }
            const f32x4* sp = (const f32x4*)(ss + (size_t)row * 16); const f32x4 s0 = sp[0], s1 = sp[1], s2 = sp[2], s3 = sp[3];
            tot[rr] = ((((s0[0] + s0[1]) + s0[2]) + s0[3]) + (((s1[0] + s1[1]) + s1[2]) + s1[3])) + ((((s2[0] + s2[1]) + s2[2]) + s2[3]) + (((s3[0] + s3[1]) + s3[2]) + s3[3])); }
#pragma unroll
        for (int rr = 0; rr < 2; ++rr) { const int row = row0 + rr * NGW;
            const float rinv = rsqrtf(tot[rr] * (1.0f / 1024.0f) + EPS); float s2 = 0.f;
#pragma unroll
            for (int j = 0; j < 4; ++j) { const f32x4 gg = j == 0 ? g0 : (j == 1 ? g1 : (j == 2 ? g2 : g3)); const u32x2 xx = xv[rr][j], mm = mv[rr][j]; f32x4 v;
                v[0] = bflo(xx.x) + bflo(mm.x) * rinv * gg[0]; v[1] = bfhi(xx.x) + bfhi(mm.x) * rinv * gg[1]; v[2] = bflo(xx.y) + bflo(mm.y) * rinv * gg[2]; v[3] = bfhi(xx.y) + bfhi(mm.y) * rinv * gg[3];
                if (last) { ((f32x4*)(out + (size_t)row * 1024) + lane)[64 * j] = v; }
                else { u32x2 w; w.x = pk2(v[0], v[1]); w.y = pk2(v[2], v[3]); ((u32x2*)(XB + (size_t)row * 1024) + lane)[64 * j] = w;
                       const float a0 = bflo(w.x), a1 = bfhi(w.x), a2 = bflo(w.y), a3 = bfhi(w.y); s2 += a0 * a0 + a1 * a1 + a2 * a2 + a3 * a3; } }
            if (!last) { s2 = wave_sum(s2); if (lane == 0) rnext[row] = rsqrtf(s2 * (1.0f / 1024.0f) + EPS); } }
    }
}
__device__ __forceinline__ void rescale_phase(bf16* AO, const float* ss, int G, int bid) {
    int tid = threadIdx.x; asm volatile("" : "+v"(tid));
    const int lane = tid & 63, wave = __builtin_amdgcn_readfirstlane(tid >> 6);
    const int gw = bid * 8 + wave, NGW = G * 8;
    for (int row = gw; row < MT; row += NGW) {
        float tot = 0.f;
#pragma unroll
        for (int k = 0; k < 8; ++k) tot += ss[row * 8 + k];
        const float rinv = rsqrtf(tot * (1.0f / 512.0f) + EPS);
        u32x4* ptr = (u32x4*)(AO + (size_t)row * 1024 + 512) + lane; u32x4 v = *ptr;
        v.x = pk2(bflo(v.x) * rinv, bfhi(v.x) * rinv); v.y = pk2(bflo(v.y) * rinv, bfhi(v.y) * rinv); v.z = pk2(bflo(v.z) * rinv, bfhi(v.z) * rinv); v.w = pk2(bflo(v.w) * rinv, bfhi(v.w) * rinv);
        *ptr = v;
    }
}


#define XB_TMO      128
#define XB_XCNT(j)  (256  + 64 * (j))
#define XB_XSUB(j)  (1280 + 64 * (j))
#define XB_XGEN(j)  (2304 + 64 * (j))
#define XB_TOP      3328
#define XB_TOPGEN   3392
#define XCD_BAR_WORDS 3456
#define XB_SPIN_CAP (1u << 18)
__device__ __forceinline__ unsigned xb_ld(unsigned* p)              { return __hip_atomic_load(p, __ATOMIC_RELAXED, __HIP_MEMORY_SCOPE_AGENT); }
__device__ __forceinline__ unsigned xb_add(unsigned* p, unsigned v) { return __hip_atomic_fetch_add(p, v, __ATOMIC_RELAXED, __HIP_MEMORY_SCOPE_AGENT); }
__device__ __forceinline__ unsigned xb_xcc_id() { return (unsigned)__builtin_amdgcn_s_getreg((3 << 11) | 20) & 0xFu; }
#define XB_SPIN(cond, bar) do { unsigned _sp = 0; while (cond) { __builtin_amdgcn_s_sleep(1); \
    if ((++_sp & 255u) == 0u) { if (xb_ld(&(bar)[XB_TMO])) break; if (_sp > XB_SPIN_CAP) { atomicAdd(&(bar)[XB_TMO], 1u); break; } } } } while (0)
struct XcdBarrier { unsigned* bar; unsigned x; volatile LAS unsigned* st; };
__device__ __forceinline__ XcdBarrier xcd_barrier_post(unsigned* bar, volatile LAS unsigned* st) {
    XcdBarrier b; b.bar = bar; b.x = xb_xcc_id(); b.st = st;
    if (threadIdx.x == 0) (void)xb_add(&bar[XB_XCNT(b.x)], 1u);
    return b;
}
__device__ __forceinline__ void xcd_barrier_complete(unsigned* bar, unsigned x, unsigned& nloc, unsigned& nx) {
    const unsigned G = gridDim.x * gridDim.y * gridDim.z;
    unsigned sum, cnt, mine, sp = 0u;
    for (;;) {
        sum = 0u; cnt = 0u; mine = 0u;
#pragma unroll
        for (unsigned j = 0; j < 16; ++j) { const unsigned c = xb_ld(&bar[XB_XCNT(j)]); sum += c; cnt += (c > 0u) ? 1u : 0u; mine = (j == x) ? c : mine; }
        if (sum == G) break;
        __builtin_amdgcn_s_sleep(1);
        if ((++sp & 255u) == 0u) { if (xb_ld(&bar[XB_TMO])) break; if (sp > XB_SPIN_CAP) { atomicAdd(&bar[XB_TMO], 1u); break; } }
    }
    nloc = mine > 0u ? mine : 1u; nx = cnt > 0u ? cnt : 1u;
}
__device__ __forceinline__ void xcd_barrier(const XcdBarrier& b) {
    asm volatile("s_waitcnt vmcnt(0)" ::: "memory");
    __syncthreads();
    if (threadIdx.x == 0) {
        unsigned* bar = b.bar;
        __builtin_amdgcn_s_waitcnt(0);
        unsigned nloc = b.st[0], nx = b.st[1];
        if (nloc == 0u) { xcd_barrier_complete(bar, b.x, nloc, nx); b.st[0] = nloc; b.st[1] = nx; }
        const unsigned old = xb_add(&bar[XB_XSUB(b.x)], 1u);
        const unsigned gen = old / nloc;
        if (old + 1u == (gen + 1u) * nloc) {
            __builtin_amdgcn_fence(__ATOMIC_RELEASE, "agent");
            asm volatile("s_waitcnt vmcnt(0)" ::: "memory");
            const unsigned og = xb_add(&bar[XB_TOP], 1u);
            const unsigned tg = og / nx;
            if (og + 1u == (tg + 1u) * nx) xb_add(&bar[XB_TOPGEN], 1u);
            else XB_SPIN(xb_ld(&bar[XB_TOPGEN]) == tg, bar);
            __builtin_amdgcn_fence(__ATOMIC_ACQUIRE, "agent");
            xb_add(&bar[XB_XGEN(b.x)], 1u);
            asm volatile("s_waitcnt vmcnt(0)" ::: "memory");
        } else {
            XB_SPIN(xb_ld(&bar[XB_XGEN(b.x)]) == gen, bar);
            __builtin_amdgcn_fence(__ATOMIC_ACQUIRE, "agent");
            asm volatile("s_waitcnt vmcnt(0)" ::: "memory");
        }
    }
    __syncthreads();
}

#ifndef REP_P0
#define REP_P0 1
#endif
#ifndef REP_SYNC
#define REP_SYNC 1
#endif
#ifndef REP_MASK_V
#define REP_MASK_V 0u
#endif
constexpr unsigned REP_MASK = REP_MASK_V;
constexpr int PH_PER_LAYER = 10, N_PHASES = 1 + 2 * PH_PER_LAYER;
__global__ void __launch_bounds__(512) hybrid_fwd(Params p) {
    extern __shared__ __attribute__((aligned(16))) unsigned char lds_raw[];
    LAS unsigned char* lds = (LAS unsigned char*)lds_raw;
    cg::grid_group grid = cg::this_grid();
    volatile LAS unsigned* xst = (volatile LAS unsigned*)(lds + LDS_BYTES - 16);
    if (threadIdx.x < 4) xst[threadIdx.x] = 0u;
    __syncthreads();
    const XcdBarrier xbar = xcd_barrier_post((unsigned*)(p.ws + OFF_BAR), xst);
    if (p.ph_hi > 1000) grid.sync();
    const int Gk = gridDim.x, bk = blockIdx.x;
    unsigned char* ws = p.ws;
    float* sss = (float*)(ws + OFF_SSS); float* ssm = (float*)(ws + OFF_SSM); float* ssf = (float*)(ws + OFF_SSF); float* rA = (float*)(ws + OFF_RA); float* rB = (float*)(ws + OFF_RB);
    bf16* XB = (bf16*)(ws + OFF_XB); bf16* MF = (bf16*)(ws + OFF_MF); bf16* GB = (bf16*)(ws + OFF_G); bf16* HB = (bf16*)(ws + OFF_H);
    bf16* PQ = (bf16*)(ws + OFF_PQ); bf16* AO = (bf16*)(ws + OFF_AO); bf16* UB = (bf16*)(ws + OFF_UB); bf16* TB = (bf16*)(ws + OFF_T); float* SL = (float*)(ws + OFF_SLOC);

#pragma nounroll
    for (int ph = p.ph_lo; ph < p.ph_hi; ++ph) {
        int G = Gk, bid = bk; asm volatile("" : "+s"(G), "+s"(bid));
        if (ph == 0) { for (int rep = 0; rep < REP_P0; ++rep) p0_prologue(p, lds, G, bid); }
        else {
            const int ly = (ph - 1) / PH_PER_LAYER, sp = (ph - 1) % PH_PER_LAYER;
            unsigned char* wb = ws + OFF_W + (size_t)ly * W_LAYER;
            pg8::Order S;
            const int nrep = ((REP_MASK >> sp) & 1u) ? 2 : 1;
            for (int rep = 0; rep < nrep; ++rep)
            switch (sp) {
            case 0: {
                pg8::Gemm g{XB, (const bf16*)(wb + W_IN), MT, NIN, 1024, 1024, 1024, 0, 0, 1}; S.init(MT, NIN, 1, G, bid, WGM_IN);
                EpiIn E{PQ, UB, rA}; pg8::gemm_phase<EpiIn>(lds, g, S, E); } break;
            case 1: {
                fft1_phase(PQ, (const bf16*)(ws + OFF_D1), TB, lds, G, bid);
                pg8::Gemm g{UB, (const bf16*)(ws + OFF_MST) + (size_t)ly * 32 * 256 * 256, 2048, 256, 256, 512, 256, (size_t)2048 * 512, (size_t)256 * 256, 32}; S.init(2048, 256, 32, G, bid);
                EpiSloc E{SL}; pg8::gemm_phase<EpiSloc>(lds, g, S, E); } break;
            case 2: {
                carry_phase(p, ly, SL, UB, lds, G, bid);
                fft3_phase(TB, (const bf16*)(ws + OFF_E3), AO, lds, G, bid); } break;
            case 3: {
                pg8::Gemm g{UB, (const bf16*)(ws + OFF_TM) + (size_t)ly * 32 * 256 * 512, 2048, 256, 512, 512, 512, (size_t)2048 * 512, (size_t)256 * 512, 32}; S.init(2048, 256, 32, G, bid);
                EpiSsmOut E{GB}; pg8::gemm_phase<EpiSsmOut>(lds, g, S, E); } break;
            case 4: {
                pg8::Gemm g{GB, (const bf16*)(wb + W_GLU), MT, 512, 512, 512, 512, 0, 0, 1}; S.init(MT, 512, 1, G, bid, WGM_GLU);
                EpiGlu E{GB, p.b_glu + ly * 512, AO, sss}; pg8::gemm_phase<EpiGlu>(lds, g, S, E); } break;
            case 5: {
                pg8::Gemm g{AO, (const bf16*)(wb + W_OUT), MT, 1024, 1024, 1024, 1024, 0, 0, 1}; S.init(MT, 1024, 1, G, bid, WGM_OUT);
                LAS float* qv = (LAS float*)(lds + 131072);
                { int tid = threadIdx.x; asm volatile("" : "+v"(tid));
                  for (int i = 0; i < 4; ++i) { pg8::Unit u; if (!S.next(i, u)) break;
                      if (tid < 256) { const f32x4* sp = (const f32x4*)(sss + (size_t)(u.pm * 256 + tid) * 8); const f32x4 a = sp[0], b = sp[1];
                          const float ms = ((((a[0] + a[1]) + a[2]) + a[3]) + (((b[0] + b[1]) + b[2]) + b[3])) * (1.0f / 512.0f) + EPS;
                          qv[i * 256 + tid] = sqrtf(ms); qv[1024 + i * 256 + tid] = rsqrtf(ms); } }
                  __syncthreads(); }
                EpiOutMix E{MF, ssm, qv}; pg8::gemm_phase<EpiOutMix>(lds, g, S, E); } break;
            case 6: norm_phase(p.out, MF, ssm, p.post_mix_g + ly * 1024, XB, rB, false, G, bid); break;
            case 7: {
                pg8::Gemm g{XB, (const bf16*)(wb + W_1), MT, DFF, 1024, 1024, 1024, 0, 0, 1}; S.init(MT, DFF, 1, G, bid, WGM_FF1);
                EpiFF1 E{HB, rB}; pg8::gemm_phase<EpiFF1>(lds, g, S, E); } break;
            case 8: {
                pg8::Gemm g{HB, (const bf16*)(wb + W_2), MT, 1024, DFF, DFF, DFF, 0, 0, 1}; S.init(MT, 1024, 1, G, bid, WGM_FF2);
                EpiOutSS E{MF, ssf}; pg8::gemm_phase<EpiOutSS>(lds, g, S, E); } break;
            case 9: norm_phase(p.out, MF, ssf, p.post_mlp_g + ly * 1024, XB, rA, ly == 1, G, bid); break;
            }
        }
        if (ph + 1 < p.ph_hi) for (int rep = 0; rep < REP_SYNC; ++rep) xcd_barrier(xbar);
    }
}

extern "C" void kernel_launch(void* const* d_in, const int* in_sizes, int n_in, void* d_out, int out_size, void* d_ws, size_t ws_size, hipStream_t stream) {
    static int grid = 0;
    if (grid == 0) {
        if (n_in != 22 || ws_size < WS_END) { fprintf(stderr, "kernel_launch: unexpected n_in %d or ws_size %zu (< %zu)\n", n_in, ws_size, (size_t)WS_END); grid = -1; return; }
        int dev = 0, cus = 0, per_cu = 0;
        hipGetDevice(&dev); hipDeviceGetAttribute(&cus, hipDeviceAttributeMultiprocessorCount, dev);
        if (hipFuncSetAttribute((const void*)hybrid_fwd, hipFuncAttributeMaxDynamicSharedMemorySize, LDS_BYTES) != hipSuccess) { fprintf(stderr, "kernel_launch: hipFuncSetAttribute failed\n"); grid = -1; return; }
        if (hipOccupancyMaxActiveBlocksPerMultiprocessor(&per_cu, (const void*)hybrid_fwd, 512, LDS_BYTES) != hipSuccess || per_cu < 1) { fprintf(stderr, "kernel_launch: occupancy query says %d blocks per CU\n", per_cu); per_cu = 1; }
        (void)hipGetLastError();
        grid = cus;
    }
    if (grid < 0) return;
    if (hipMemsetAsync((char*)d_ws + OFF_BAR, 0, BAR_BYTES, stream) != hipSuccess) { fprintf(stderr, "kernel_launch: memset of the barrier words failed\n"); return; }
    Params p{};
    const float** f = (const float**)&p;
    for (int i = 0; i < 22; ++i) f[i] = (const float*)d_in[i];
    p.out = (float*)d_out; p.ws = (unsigned char*)d_ws; p.ph_lo = 0; p.ph_hi = N_PHASES;
    void* args[] = {&p};
    hipError_t e = hipLaunchCooperativeKernel((const void*)hybrid_fwd, dim3(grid), dim3(512), args, LDS_BYTES, stream);
    if (e != hipSuccess) fprintf(stderr, "kernel_launch: cooperative launch failed: %s (grid %d)\n", hipGetErrorString(e), grid);
}
```

```cpp
#include <hip/hip_runtime.h>
#include <hip/hip_cooperative_groups.h>
#include <cstdio>
namespace cg = cooperative_groups;

#define P0_REP_A 1
#define WGM_FF1 4
#define WGM_IN 2
#define WGM_OUT 4
#define WGM_GLU 4
#define WGM_FF2 4
#define P0_REP_F 1
#define P0_REP_S 1
#define P0_REP_B 1
#define P0_REP_C 1
#define LAS __attribute__((address_space(3)))
typedef unsigned short bf16;
typedef short bf16x8 __attribute__((ext_vector_type(8)));
typedef float f32x4 __attribute__((ext_vector_type(4)));
typedef float f32x2 __attribute__((ext_vector_type(2)));
typedef unsigned u32x4 __attribute__((ext_vector_type(4)));
typedef unsigned u32x2 __attribute__((ext_vector_type(2)));

constexpr int NB = 4, SEQ = 8192, DM = 1024, MT = NB * SEQ, DFO = 512, NHEAD = 8, SG = 32, SP = 64, DFF = 4096, NIN = 1024;
constexpr float EPS = 1e-6f;
constexpr int LDS_BYTES = 147456;
constexpr size_t MiB = 1u << 20;
constexpr size_t OFF_RA = 384 * 1024, OFF_RB = 512 * 1024, OFF_BAR = 640 * 1024, BAR_BYTES = 16384;
constexpr size_t OFF_E3I = 1 * MiB + 16384, OFF_FMIX = 1 * MiB + 65536;
constexpr size_t OFF_E3 = 1 * MiB, OFF_D1 = 2 * MiB, OFF_TM = 6 * MiB, OFF_MST = 22 * MiB, OFF_W = 30 * MiB;
constexpr size_t W_IN = 0, W_OUT = 3 * MiB, W_1 = 5 * MiB, W_2 = 13 * MiB, W_GLU = 21 * MiB, W_LAYER = 22 * MiB;
constexpr size_t OFF_XB = 76 * MiB, OFF_MF = 140 * MiB, OFF_G = 140 * MiB, OFF_H = 204 * MiB;
constexpr size_t OFF_PQ = 204 * MiB, OFF_AO = 204 * MiB, OFF_UB = 268 * MiB, OFF_T = 332 * MiB, OFF_SLOC = 396 * MiB, OFF_SSS = 460 * MiB, OFF_SSM = 461 * MiB, OFF_SSF = 463 * MiB, WS_END = 465 * MiB;

struct Params {
    const float *x, *w_in, *w_out, *pre_mix_g, *post_mix_g, *pre_mlp_g, *post_mlp_g, *fourier_out_g, *ssm_out_g, *w_fourier,
        *lam_re, *lam_im, *log_dt, *b_re, *b_im, *c_re, *c_im, *d_skip, *w_glu, *b_glu, *w_ff1, *w_ff2;
    float* out; unsigned char* ws;
    int ph_lo, ph_hi;
};

__device__ __forceinline__ unsigned f2bf(float f) { unsigned u = __builtin_bit_cast(unsigned, f); return (u + 0x7fffu + ((u >> 16) & 1u)) >> 16; }
__device__ __forceinline__ unsigned pk2(float lo, float hi) { return f2bf(lo) | (f2bf(hi) << 16); }
__device__ __forceinline__ float bflo(unsigned w) { return __builtin_bit_cast(float, w << 16); }
__device__ __forceinline__ float bfhi(unsigned w) { return __builtin_bit_cast(float, w & 0xffff0000u); }
__device__ __forceinline__ float wave_sum(float v) {
#pragma unroll
    for (int o = 1; o < 64; o <<= 1) v += __shfl_xor(v, o);
    return v;
}
__device__ __forceinline__ float gelu_t(float x) { const float u = 0.7978845608f * (x + 0.044715f * x * x * x); return x * __builtin_amdgcn_rcpf(1.0f + __expf(-2.0f * u)); }
__device__ __forceinline__ float sigm(float v) { return __builtin_amdgcn_rcpf(1.0f + __expf(-v)); }

namespace pg8 {
#define PG8_LAS __attribute__((address_space(3)))
typedef unsigned short bf16_t;
constexpr int BM = 256, BK = 64, HALF = 128, HTB = HALF * BK * 2, STAGE_BYTES = 8 * HTB, NXCD = 8, WGM = 4;
__host__ __device__ __forceinline__ int lds_byte(int r, int c) { const int st = (r >> 4) * 2 + (c >> 5), rr = r & 15, cc = c & 31, ob = rr * 64 + cc * 2; return st * 1024 + (ob ^ (((ob >> 9) & 1) << 5)); }
__host__ __device__ __forceinline__ void stage_rc(int b, int& R, int& C) { const int st = b / 1024, sb = b % 1024, swz = sb ^ (((sb >> 9) & 1) << 5); R = (st >> 1) * 16 + swz / 64; C = (st & 1) * 32 + (swz % 64) / 2; }
__host__ __device__ __forceinline__ int perm32(int rho) { const int n = rho >> 4, i = rho & 15; return 8 * (i >> 2) + 4 * n + (i & 3); }

struct Unit { int pm, pn, z, ui; };
struct Gemm { const bf16_t* A; const bf16_t* Bt; int M, N, K, lda, ldb; size_t sA, sB; int nZ; };

struct Order {
    int nM, nN, nwg, nZ, G, c, wgm;
    __device__ void init(int M, int N, int nZ_, int G_, int c_, int wgm_ = WGM) { nM = M / BM; nN = N / BM; nwg = nM * nN; nZ = nZ_; G = G_; c = c_; wgm = wgm_; }
    __device__ bool next(int i, Unit& u) const {
        const long L = (long)i * G + c; if (L >= (long)nwg * nZ) return false;
        u.ui = i;
        if (nZ > 1 && (nZ % NXCD) == 0) {
            const int xcd = (int)(L % NXCD), idx = (int)(L / NXCD); u.z = xcd * (nZ / NXCD) + idx / nwg; const int wg = idx % nwg; u.pm = wg % nM; u.pn = wg / nM; return true; }
        u.z = (int)(L / nwg);
        int wgid = (int)(L % nwg); { const int q = nwg / NXCD, r = nwg % NXCD, xcd = wgid % NXCD, off = wgid / NXCD; wgid = (xcd < r ? xcd * (q + 1) : r * (q + 1) + (xcd - r) * q) + off; }
        const int nig = wgm * nN, gid = wgid / nig, fm = gid * wgm, gsz = (nM - fm) < wgm ? (nM - fm) : wgm;
        u.pm = fm + ((wgid % nig) % gsz); u.pn = (wgid % nig) / gsz; return true;
    }
};

template <class Epi>
__device__ __forceinline__ void gemm_phase(PG8_LAS unsigned char* lds, const Gemm g, const Order& S, const Epi& E) {
    int tid = threadIdx.x; asm volatile("" : "+v"(tid));
    const int wid = __builtin_amdgcn_readfirstlane(tid >> 6), lane = tid & 63, wr = wid >> 2, wc = wid & 3, fr = lane & 15, fq = lane >> 4;
    const int K = g.K, nt = K / BK;
    unsigned voffA[2], voffB[2];
#pragma unroll
    for (int i = 0; i < 2; ++i) { int R, C; stage_rc(tid * 16 + i * 8192, R, C); const int Rb = Epi::PERM ? ((R & ~31) + perm32(R & 31)) : R;
        voffA[i] = (unsigned)(R * g.lda + C) * 2u; voffB[i] = (unsigned)(Rb * g.ldb + C) * 2u; }
    const size_t kstep = (size_t)(BK * 2);
    const size_t hA = (size_t)HALF * g.lda * 2, hB = (size_t)HALF * g.ldb * 2;
    const size_t tA = 2 * hA, tB = 2 * hB;
    const unsigned ldsw = (unsigned)wid * 1024u;
    const int aoff = lds_byte(wr * 64 + fr, fq * 8), boff = lds_byte(wc * 32 + fr, fq * 8);
#define PG8_SA(b, h) (((b) * 2 + (h)) * HTB)
#define PG8_SB(b, h) ((4 + (b) * 2 + (h)) * HTB)
#define PG8_STAGE(bufoff, gbase, voff) do { _Pragma("unroll") for (int _i = 0; _i < 2; ++_i) \
        __builtin_amdgcn_global_load_lds((const unsigned*)((const char*)(gbase) + (voff)[_i]), (PG8_LAS unsigned*)(lds + (bufoff) + ldsw + _i * 8192), 16, 0, 0); } while (0)
#define PG8_LDA(dst, b, h) do { _Pragma("unroll") for (int m = 0; m < 4; ++m) _Pragma("unroll") for (int k = 0; k < 2; ++k) dst[m][k] = *(const PG8_LAS bf16x8*)(lds + PG8_SA(b, h) + aoff + m * 2048 + k * 1024); } while (0)
#define PG8_LDB(dst, b, h) do { _Pragma("unroll") for (int n = 0; n < 2; ++n) _Pragma("unroll") for (int k = 0; k < 2; ++k) dst[n][k] = *(const PG8_LAS bf16x8*)(lds + PG8_SB(b, h) + boff + n * 2048 + k * 1024); } while (0)
#define PG8_MMA(ai, bj, At, Bt) do { __builtin_amdgcn_s_setprio(1); _Pragma("unroll") for (int m = 0; m < 4; ++m) _Pragma("unroll") for (int n = 0; n < 2; ++n) _Pragma("unroll") for (int k = 0; k < 2; ++k) \
        acc[ai][bj][m][n] = __builtin_amdgcn_mfma_f32_16x16x32_bf16(Bt[n][k], At[m][k], acc[ai][bj][m][n], 0, 0, 0); __builtin_amdgcn_s_setprio(0); } while (0)
#define PG8_WAIT_V(n) asm volatile("s_waitcnt vmcnt(" #n ")" ::: "memory")
#define PG8_WAIT_L(n) asm volatile("s_waitcnt lgkmcnt(" #n ")" ::: "memory")
#define PG8_BAR __builtin_amdgcn_s_barrier()
#define PG8_SCHED __builtin_amdgcn_sched_barrier(0)
    Unit cur, nxt; int ui = 0;
    if (!S.next(0, cur)) return;
    f32x4 acc[2][2][4][2];
#pragma unroll
    for (int a = 0; a < 2; ++a)
#pragma unroll
        for (int b = 0; b < 2; ++b)
#pragma unroll
            for (int m = 0; m < 4; ++m)
#pragma unroll
                for (int n = 0; n < 2; ++n) acc[a][b][m][n] = (f32x4){0.f, 0.f, 0.f, 0.f};
    bf16x8 At[4][2], B0[2][2], B1[2][2];
    const char* cA = (const char*)g.A + ((size_t)cur.z * g.sA) * 2 + (size_t)cur.pm * tA; const char* cB = (const char*)g.Bt + ((size_t)cur.z * g.sB) * 2 + (size_t)cur.pn * tB;
    PG8_STAGE(PG8_SB(0, 0), cB, voffB); PG8_STAGE(PG8_SA(0, 0), cA, voffA); PG8_STAGE(PG8_SB(0, 1), cB + hB, voffB); PG8_STAGE(PG8_SA(0, 1), cA + hA, voffA);
    if (wr == 1) PG8_BAR;
    PG8_WAIT_V(4); PG8_BAR;
    PG8_STAGE(PG8_SB(1, 0), cB + kstep, voffB); PG8_STAGE(PG8_SA(1, 0), cA + kstep, voffA); PG8_STAGE(PG8_SB(1, 1), cB + hB + kstep, voffB);
    PG8_WAIT_V(6); PG8_BAR;
    for (;;) {
        const bool has_next = S.next(ui + 1, nxt);
        const char* nA = has_next ? (const char*)g.A + ((size_t)nxt.z * g.sA) * 2 + (size_t)nxt.pm * tA : cA; const char* nB = has_next ? (const char*)g.Bt + ((size_t)nxt.z * g.sB) * 2 + (size_t)nxt.pn * tB : cB;
        for (int t = 0; t < nt; t += 2) {
            const bool last = (t == nt - 2);
            if constexpr (Epi::MID) { if (t == (nt >> 1)) E.mid(acc, cur, wr, fr); }
            const char* a1 = cA + (size_t)(t + 1) * kstep;
            const char* a2 = last ? nA : cA + (size_t)(t + 2) * kstep; const char* b2 = last ? nB : cB + (size_t)(t + 2) * kstep;
            const char* a3 = a2 + kstep; const char* b3 = b2 + kstep;
            PG8_LDB(B0, 0, 0); PG8_SCHED; PG8_LDA(At, 0, 0); PG8_STAGE(PG8_SA(1, 1), a1 + hA, voffA);
            PG8_WAIT_L(8); PG8_BAR; PG8_WAIT_L(0); PG8_MMA(0, 0, At, B0); PG8_BAR; PG8_SCHED;
            PG8_LDB(B1, 0, 1); PG8_STAGE(PG8_SB(0, 0), b2, voffB);
            PG8_BAR; PG8_WAIT_L(0); PG8_MMA(0, 1, At, B1); PG8_BAR;
            PG8_LDA(At, 0, 1); PG8_STAGE(PG8_SA(0, 0), a2, voffA);
            PG8_BAR; PG8_WAIT_L(0); PG8_MMA(1, 0, At, B0); PG8_BAR; PG8_SCHED;
            PG8_STAGE(PG8_SB(0, 1), b2 + hB, voffB);
            PG8_WAIT_V(6); PG8_BAR; PG8_MMA(1, 1, At, B1); PG8_BAR;
            PG8_LDB(B0, 1, 0); PG8_SCHED; PG8_LDA(At, 1, 0); PG8_STAGE(PG8_SA(0, 1), a2 + hA, voffA);
            PG8_WAIT_L(8); PG8_BAR; PG8_WAIT_L(0); PG8_MMA(0, 0, At, B0); PG8_BAR; PG8_SCHED;
            PG8_LDB(B1, 1, 1); PG8_STAGE(PG8_SB(1, 0), b3, voffB);
            PG8_BAR; PG8_WAIT_L(0); PG8_MMA(0, 1, At, B1); PG8_BAR;
            PG8_LDA(At, 1, 1); PG8_STAGE(PG8_SA(1, 0), a3, voffA);
            PG8_BAR; PG8_WAIT_L(0); PG8_MMA(1, 0, At, B0); PG8_BAR; PG8_SCHED;
            PG8_STAGE(PG8_SB(1, 1), b3 + hB, voffB);
            PG8_WAIT_V(6); PG8_BAR; PG8_MMA(1, 1, At, B1); PG8_BAR;
        }
        E(acc, cur, wr, wc, fr, fq);
        if (!has_next) break;
#pragma unroll
        for (int a = 0; a < 2; ++a)
#pragma unroll
            for (int b = 0; b < 2; ++b)
#pragma unroll
                for (int m = 0; m < 4; ++m)
#pragma unroll
                    for (int n = 0; n < 2; ++n) acc[a][b][m][n] = (f32x4){0.f, 0.f, 0.f, 0.f};
        cur = nxt; cA = nA; cB = nB; ++ui;
    }
    PG8_WAIT_V(0);
    if (wr == 0) PG8_BAR;
    PG8_BAR;
#undef PG8_SA
#undef PG8_SB
#undef PG8_STAGE
#undef PG8_LDA
#undef PG8_LDB
#undef PG8_MMA
#undef PG8_WAIT_V
#undef PG8_WAIT_L
#undef PG8_BAR
#undef PG8_SCHED
}
}

typedef const f32x4 (&AccRef)[2][2][4][2];
__device__ __forceinline__ u32x4 pack8(f32x4 a, f32x4 b) { u32x4 w; w.x = pk2(a[0], a[1]); w.y = pk2(a[2], a[3]); w.z = pk2(b[0], b[1]); w.w = pk2(b[2], b[3]); return w; }

struct EpiIn {
    static constexpr bool PERM = true, MID = false;
    bf16* ZF; bf16* UB; const float* r;
    __device__ __forceinline__ void operator()(AccRef acc, const pg8::Unit& u, int wr, int wc, int fr, int fq) const {
#pragma unroll
        for (int ai = 0; ai < 2; ++ai)
#pragma unroll
            for (int m = 0; m < 4; ++m) {
                const int row = u.pm * 256 + ai * 128 + wr * 64 + m * 16 + fr; const float rs = r[row];
#pragma unroll
                for (int bj = 0; bj < 2; ++bj) {
                    const int col0 = u.pn * 256 + bj * 128 + wc * 32 + 8 * fq;
                    const u32x4 w = pack8(acc[ai][bj][m][0] * rs, acc[ai][bj][m][1] * rs);
                    if (col0 < 512) *(u32x4*)(ZF + (size_t)row * 512 + col0) = w;
                    else { const int c2 = col0 - 512, gg = c2 >> 4, h0 = c2 & 15; *(u32x4*)(UB + ((size_t)(gg * 2048 + (row >> 4)) * 512 + (row & 15) * 16 + h0)) = w; }
                }
            }
    }
};
struct EpiSloc {
    static constexpr bool PERM = false, MID = false;
    float* S;
    __device__ __forceinline__ void operator()(AccRef acc, const pg8::Unit& u, int wr, int wc, int fr, int fq) const {
#pragma unroll
        for (int ai = 0; ai < 2; ++ai)
#pragma unroll
            for (int m = 0; m < 4; ++m) {
                const int row = u.pm * 256 + ai * 128 + wr * 64 + m * 16 + fr;
                float* rp = S + ((size_t)u.z * 2048 + row) * 256 + wc * 32 + 4 * fq;
#pragma unroll
                for (int bj = 0; bj < 2; ++bj)
#pragma unroll
                    for (int n = 0; n < 2; ++n) *(f32x4*)(rp + bj * 128 + n * 16) = acc[ai][bj][m][n];
            }
    }
};
struct EpiSsmOut {
    static constexpr bool PERM = true, MID = false;
    bf16* G;
    __device__ __forceinline__ void operator()(AccRef acc, const pg8::Unit& u, int wr, int wc, int fr, int fq) const {
#pragma unroll
        for (int ai = 0; ai < 2; ++ai)
#pragma unroll
            for (int m = 0; m < 4; ++m) {
                const int row = u.pm * 256 + ai * 128 + wr * 64 + m * 16 + fr;
#pragma unroll
                for (int bj = 0; bj < 2; ++bj) {
                    const int col0 = bj * 128 + wc * 32 + 8 * fq, t = col0 >> 4, i0 = col0 & 15;
                    f32x4 a = acc[ai][bj][m][0], b = acc[ai][bj][m][1];
#pragma unroll
                    for (int j = 0; j < 4; ++j) { a[j] = gelu_t(a[j]); b[j] = gelu_t(b[j]); }
                    *(u32x4*)(G + ((size_t)row * 16 + t) * 512 + u.z * 16 + i0) = pack8(a, b);
                }
            }
    }
};
struct EpiGlu {
    static constexpr bool PERM = true, MID = false;
    const bf16* G; const float* bias; bf16* AO; float* ss;
    __device__ __forceinline__ void operator()(AccRef acc, const pg8::Unit& u, int wr, int wc, int fr, int fq) const {
#pragma unroll
        for (int ai = 0; ai < 2; ++ai)
#pragma unroll
            for (int m = 0; m < 4; ++m) {
                const int row = u.pm * 256 + ai * 128 + wr * 64 + m * 16 + fr; float s2 = 0.f;
#pragma unroll
                for (int bj = 0; bj < 2; ++bj) {
                    const int col0 = u.pn * 256 + bj * 128 + wc * 32 + 8 * fq;
                    const u32x4 gv = *(const u32x4*)(G + (size_t)row * 512 + col0);
                    const f32x4 b0 = *(const f32x4*)(bias + col0), b1 = *(const f32x4*)(bias + col0 + 4);
                    f32x4 a = acc[ai][bj][m][0] + b0, b = acc[ai][bj][m][1] + b1;
                    a[0] = bflo(gv.x) * sigm(a[0]); a[1] = bfhi(gv.x) * sigm(a[1]); a[2] = bflo(gv.y) * sigm(a[2]); a[3] = bfhi(gv.y) * sigm(a[3]);
                    b[0] = bflo(gv.z) * sigm(b[0]); b[1] = bfhi(gv.z) * sigm(b[1]); b[2] = bflo(gv.w) * sigm(b[2]); b[3] = bfhi(gv.w) * sigm(b[3]);
#pragma unroll
                    for (int j = 0; j < 4; ++j) s2 += a[j] * a[j] + b[j] * b[j];
                    *(u32x4*)(AO + (size_t)row * 1024 + 512 + col0) = pack8(a, b);
                }
                s2 += __shfl_xor(s2, 16); s2 += __shfl_xor(s2, 32);
                if (fq == 0) ss[row * 8 + u.pn * 4 + wc] = s2;
            }
    }
};
struct EpiOutSS {
    static constexpr bool PERM = true, MID = false;
    bf16* O; float* ss;
    __device__ __forceinline__ void operator()(AccRef acc, const pg8::Unit& u, int wr, int wc, int fr, int fq) const {
#pragma unroll
        for (int ai = 0; ai < 2; ++ai)
#pragma unroll
            for (int m = 0; m < 4; ++m) {
                const int row = u.pm * 256 + ai * 128 + wr * 64 + m * 16 + fr; float s2 = 0.f;
#pragma unroll
                for (int bj = 0; bj < 2; ++bj) {
                    const int col0 = u.pn * 256 + bj * 128 + wc * 32 + 8 * fq;
                    const f32x4 a = acc[ai][bj][m][0], b = acc[ai][bj][m][1];
#pragma unroll
                    for (int j = 0; j < 4; ++j) s2 += a[j] * a[j] + b[j] * b[j];
                    *(u32x4*)(O + (size_t)row * 1024 + col0) = pack8(a, b);
                }
                s2 += __shfl_xor(s2, 16); s2 += __shfl_xor(s2, 32);
                if (fq == 0) ss[row * 16 + u.pn * 4 + wc] = s2;
            }
    }
};
struct EpiOutMix {
    static constexpr bool PERM = true, MID = true;
    bf16* O; float* ss; const LAS float* qv;
    __device__ __forceinline__ void mid(f32x4 (&acc)[2][2][4][2], const pg8::Unit& u, int wr, int fr) const {
#pragma unroll
        for (int ai = 0; ai < 2; ++ai)
#pragma unroll
            for (int m = 0; m < 4; ++m) { const float q = qv[u.ui * 256 + ai * 128 + wr * 64 + m * 16 + fr];
#pragma unroll
                for (int bj = 0; bj < 2; ++bj)
#pragma unroll
                    for (int n = 0; n < 2; ++n) acc[ai][bj][m][n] *= q; }
    }
    __device__ __forceinline__ void operator()(AccRef acc, const pg8::Unit& u, int wr, int wc, int fr, int fq) const {
#pragma unroll
        for (int ai = 0; ai < 2; ++ai)
#pragma unroll
            for (int m = 0; m < 4; ++m) {
                const int rl = ai * 128 + wr * 64 + m * 16 + fr, row = u.pm * 256 + rl; float s2 = 0.f; const float rs = qv[1024 + u.ui * 256 + rl];
#pragma unroll
                for (int bj = 0; bj < 2; ++bj) {
                    const int col0 = u.pn * 256 + bj * 128 + wc * 32 + 8 * fq;
                    const f32x4 a = acc[ai][bj][m][0] * rs, b = acc[ai][bj][m][1] * rs;
#pragma unroll
                    for (int j = 0; j < 4; ++j) s2 += a[j] * a[j] + b[j] * b[j];
                    *(u32x4*)(O + (size_t)row * 1024 + col0) = pack8(a, b);
                }
                s2 += __shfl_xor(s2, 16); s2 += __shfl_xor(s2, 32);
                if (fq == 0) ss[row * 16 + u.pn * 4 + wc] = s2;
            }
    }
};
struct EpiFF1 {
    static constexpr bool PERM = true, MID = false;
    bf16* H; const float* r;
    __device__ __forceinline__ void operator()(AccRef acc, const pg8::Unit& u, int wr, int wc, int fr, int fq) const {
#pragma unroll
        for (int ai = 0; ai < 2; ++ai)
#pragma unroll
            for (int m = 0; m < 4; ++m) {
                const int row = u.pm * 256 + ai * 128 + wr * 64 + m * 16 + fr; const float rs = r[row];
#pragma unroll
                for (int bj = 0; bj < 2; ++bj) {
                    const int col0 = u.pn * 256 + bj * 128 + wc * 32 + 8 * fq;
                    f32x4 a = acc[ai][bj][m][0] * rs, b = acc[ai][bj][m][1] * rs;
#pragma unroll
                    for (int j = 0; j < 4; ++j) { a[j] = fmaxf(a[j], 0.f); a[j] *= a[j]; b[j] = fmaxf(b[j], 0.f); b[j] *= b[j]; }
                    *(u32x4*)(H + (size_t)row * 4096 + col0) = pack8(a, b);
                }
            }
    }
};

__device__ __forceinline__ void transpose_item(const float* W, int ldw, bf16* WT, int ldt, const float* sc_lo, const float* sc_hi, int split,
                                               LAS float* scr, int item, int nblk, int lane) {
    const int kb = item / nblk, nb = item % nblk, k0 = 64 * kb, n0 = 32 * nb;
#pragma unroll 16
    for (int i = 0; i < 32; ++i) { const int kk = 2 * i + (lane >> 5), k = k0 + kk;
        float s = 1.f; if (sc_lo) s = (k < split) ? sc_lo[k] : sc_hi[k - split];
        scr[kk * 33 + (lane & 31)] = W[(size_t)k * ldw + n0 + (lane & 31)] * s; }
    asm volatile("s_waitcnt lgkmcnt(0)" ::: "memory");
    const int c = lane & 7;
#pragma unroll
    for (int j = 0; j < 4; ++j) { const int n = (lane >> 3) + 8 * j; const LAS float* s = scr + (8 * c) * 33 + n;
        u32x4 o; o.x = pk2(s[0 * 33], s[1 * 33]); o.y = pk2(s[2 * 33], s[3 * 33]); o.z = pk2(s[4 * 33], s[5 * 33]); o.w = pk2(s[6 * 33], s[7 * 33]);
        *(u32x4*)(WT + (size_t)(n0 + n) * ldt + k0 + 8 * c) = o; }
    asm volatile("s_waitcnt lgkmcnt(0)" ::: "memory");
}

__device__ __forceinline__ void ssm_mat_item(const Params& p, int item, LAS unsigned char* lds) {
    int tid = threadIdx.x; asm volatile("" : "+v"(tid)); const int ly = item >> 7, g = (item >> 2) & 31, qt = item & 3;
    LAS float* pwr = (LAS float*)lds;
    LAS float* pwi = pwr + 2 * 64 * 20;
    LAS float* bbr = pwi + 2 * 64 * 20;
    LAS float* bbi = bbr + 2 * 64 * 16;
    LAS float* ccr = bbi + 2 * 64 * 16;
    LAS float* cci = ccr + 2 * 16 * 64;
    LAS float* Gt = cci + 2 * 16 * 64;
    __syncthreads();
    { const int k = (tid >> 6) & 1, pp = tid & 63, tg = tid >> 7; const int idx = (ly * 2 + k) * 32 + g;
      const float dt = expf(p.log_dt[idx]); const float lr = p.lam_re[idx * 64 + pp] * dt, li = p.lam_im[idx * 64 + pp] * dt;
#pragma unroll
      for (int j = 0; j < 5; ++j) { const int tau = tg * 5 + j; if (tau <= 16) { const float e = __expf(lr * tau); float sn, cs; __sincosf(li * tau, &sn, &cs); pwr[(k * 64 + pp) * 20 + tau] = e * cs; pwi[(k * 64 + pp) * 20 + tau] = e * sn; } } }
    for (int i = tid; i < 2048; i += 512) { const int k = i >> 10, r = i & 1023; const int idx = (ly * 2 + k) * 32 + g; ccr[i] = p.c_re[(size_t)idx * 1024 + r]; cci[i] = p.c_im[(size_t)idx * 1024 + r]; }
    __syncthreads();
#pragma unroll
    for (int j = 0; j < 4; ++j) { const int o = tid + 512 * j, k = o >> 10, pp = (o >> 4) & 63, h = o & 15; const int idx = (ly * 2 + k) * 32 + g;
        const float lr = p.lam_re[idx * 64 + pp], li = p.lam_im[idx * 64 + pp], dt = expf(p.log_dt[idx]);
        float sn, cs; sincosf(li * dt, &sn, &cs); const float em1 = expm1f(lr * dt), sh = sinf(0.5f * li * dt);
        const float lbr = em1 * cs - 2.0f * sh * sh, lbi = (em1 + 1.0f) * sn;
        const float den = 1.0f / (lr * lr + li * li); const float cr = (lbr * lr + lbi * li) * den, ci = (lbi * lr - lbr * li) * den;
        const float br = p.b_re[(size_t)idx * 1024 + pp * 16 + h], bi = p.b_im[(size_t)idx * 1024 + pp * 16 + h];
        bbr[o] = cr * br - ci * bi; bbi[o] = cr * bi + ci * br; }
    __syncthreads();
    { const int k = tid >> 8, i = (tid >> 4) & 15, h = tid & 15; float a[16];
#pragma unroll
      for (int tau = 0; tau < 16; ++tau) a[tau] = 0.f;
#pragma nounroll
      for (int pp = 0; pp < 64; ++pp) { const float c_r = ccr[(k * 16 + i) * 64 + pp], c_i = cci[(k * 16 + i) * 64 + pp], b_r = bbr[(k * 64 + pp) * 16 + h], b_i = bbi[(k * 64 + pp) * 16 + h];
          const float xr = c_r * b_r - c_i * b_i, xi = c_r * b_i + c_i * b_r;
          const LAS f32x4* pr4 = (const LAS f32x4*)(pwr + (k * 64 + pp) * 20); const LAS f32x4* pi4 = (const LAS f32x4*)(pwi + (k * 64 + pp) * 20);
#pragma unroll
          for (int t4 = 0; t4 < 4; ++t4) { const f32x4 vr = pr4[t4], vi = pi4[t4];
#pragma unroll
              for (int e = 0; e < 4; ++e) a[t4 * 4 + e] += xr * vr[e] - xi * vi[e]; } }
#pragma unroll
      for (int tau = 0; tau < 16; ++tau) Gt[((k * 16 + tau) * 16 + i) * 16 + h] = a[tau]; }
    __syncthreads();
    bf16* TM = (bf16*)(p.ws + OFF_TM) + (size_t)(ly * 32 + g) * 256 * 512; bf16* MS = (bf16*)(p.ws + OFF_MST) + (size_t)(ly * 32 + g) * 256 * 256;
    const float* dsk = p.d_skip + (ly * 32 + g) * 16;
    for (int o = qt * 64 * 512 + tid; o < (qt + 1) * 64 * 512; o += 512) { const int r = o >> 9, col = o & 511, t = r >> 4, i = r & 15; float v;
        if (col < 256) { const int j = col >> 4, h = col & 15; v = 0.f;
            if (j <= t) v += Gt[((0 * 16 + (t - j)) * 16 + i) * 16 + h];
            if (j >= t) v += Gt[((1 * 16 + (j - t)) * 16 + i) * 16 + h];
            if (j == t && h == i) v += dsk[i]; }
        else { const int k = (col - 256) >> 7, q = (col - 256) & 127, pp = q >> 1, part = q & 1; const int tau = k == 0 ? (t + 1) : (16 - t);
            const float c_r = ccr[(k * 16 + i) * 64 + pp], c_i = cci[(k * 16 + i) * 64 + pp], l_r = pwr[(k * 64 + pp) * 20 + tau], l_i = pwi[(k * 64 + pp) * 20 + tau];
            v = part == 0 ? (c_r * l_r - c_i * l_i) : -(c_r * l_i + c_i * l_r); }
        TM[o] = (bf16)f2bf(v); }
    for (int o = qt * 64 * 256 + tid; o < (qt + 1) * 64 * 256; o += 512) { const int r = o >> 8, col = o & 255, k = r >> 7, q = r & 127, pp = q >> 1, part = q & 1, j = col >> 4, h = col & 15;
        const int tau = k == 0 ? (15 - j) : j;
        const float l_r = pwr[(k * 64 + pp) * 20 + tau], l_i = pwi[(k * 64 + pp) * 20 + tau], b_r = bbr[(k * 64 + pp) * 16 + h], b_i = bbi[(k * 64 + pp) * 16 + h];
        const float v = part == 0 ? (l_r * b_r - l_i * b_i) : (l_r * b_i + l_i * b_r);
        MS[o] = (bf16)f2bf(v); }
}

__device__ __forceinline__ void p0_prologue(const Params& p, LAS unsigned char* lds, int G, int bid) {
    int tid = threadIdx.x; asm volatile("" : "+v"(tid));
    const int lane = tid & 63, wave = __builtin_amdgcn_readfirstlane(tid >> 6);
    for (int rp = 0; rp < P0_REP_A; ++rp)
    for (int it = bid; it < 256; it += G) ssm_mat_item(p, it, lds);
    __syncthreads();
    {
        LAS float* scr = (LAS float*)(lds + wave * 8448);
        const int gw = bid * 8 + wave, NGW = G * 8;
        constexpr int I_IN = 16 * 32, I_OUT = 16 * 32, I_1 = 16 * 128, I_2 = 64 * 32, I_G = 8 * 16, I_L = I_IN + I_OUT + I_1 + I_2 + I_G;
        for (int rp = 0; rp < P0_REP_B; ++rp)
        for (int it = gw; it < 2 * I_L; it += NGW) {
            const int ly = it / I_L; int r = it % I_L; unsigned char* wb = p.ws + OFF_W + (size_t)ly * W_LAYER;
            if (r < I_IN) { transpose_item(p.w_in + (size_t)ly * 1024 * 1024, 1024, (bf16*)(wb + W_IN), 1024, p.pre_mix_g + ly * 1024, nullptr, 1 << 30, scr, r, 32, lane); continue; } r -= I_IN;
            if (r < I_OUT) { transpose_item(p.w_out + (size_t)ly * 1024 * 1024, 1024, (bf16*)(wb + W_OUT), 1024, p.fourier_out_g + ly * 512, p.ssm_out_g + ly * 512, 512, scr, r, 32, lane); continue; } r -= I_OUT;
            if (r < I_1) { transpose_item(p.w_ff1 + (size_t)ly * 1024 * 4096, 4096, (bf16*)(wb + W_1), 1024, p.pre_mlp_g + ly * 1024, nullptr, 1 << 30, scr, r, 128, lane); continue; } r -= I_1;
            if (r < I_2) { transpose_item(p.w_ff2 + (size_t)ly * 4096 * 1024, 1024, (bf16*)(wb + W_2), 4096, nullptr, nullptr, 0, scr, r, 32, lane); continue; } r -= I_2;
            transpose_item(p.w_glu + (size_t)ly * 512 * 512, 512, (bf16*)(wb + W_GLU), 512, nullptr, nullptr, 0, scr, r, 16, lane);
        }
        bf16* XB = (bf16*)(p.ws + OFF_XB); float* rA = (float*)(p.ws + OFF_RA);
        for (int rp = 0; rp < P0_REP_C; ++rp)
        for (int row0 = gw; row0 < MT; row0 += 4 * NGW) {
            f32x4 v[4][4];
#pragma unroll
            for (int rr = 0; rr < 4; ++rr) { const f32x4* xr = (const f32x4*)(p.x + (size_t)(row0 + rr * NGW) * 1024) + lane;
#pragma unroll
                for (int j = 0; j < 4; ++j) v[rr][j] = xr[64 * j]; }
#pragma unroll
            for (int rr = 0; rr < 4; ++rr) { const int row = row0 + rr * NGW; float s2 = 0.f;
                u32x2* o = (u32x2*)(XB + (size_t)row * 1024) + lane;
#pragma unroll
                for (int j = 0; j < 4; ++j) { const f32x4 t = v[rr][j]; s2 += t[0] * t[0] + t[1] * t[1] + t[2] * t[2] + t[3] * t[3]; u32x2 w; w.x = pk2(t[0], t[1]); w.y = pk2(t[2], t[3]); o[64 * j] = w; }
                s2 = wave_sum(s2);
                if (lane == 0) rA[row] = rsqrtf(s2 * (1.0f / 1024.0f) + EPS); }
        }
    }
    {
        bf16* D1 = (bf16*)(p.ws + OFF_D1); bf16* E3 = (bf16*)(p.ws + OFF_E3);
        const int gt = bid * 512 + tid, NT = G * 512;
        for (int idx = gt; idx < 64 * 2 * 128 * 128; idx += NT) { const int n2 = idx >> 15, sel = (idx >> 14) & 1, k1 = (idx >> 7) & 127, n1 = idx & 127;
            const int ph = (k1 * (64 * n1 + n2)) & 8191; float s, c; sincospif((float)ph * (1.0f / 4096.0f), &s, &c); D1[idx] = (bf16)f2bf(sel ? s : c); }
        bf16* E3I = (bf16*)(p.ws + OFF_E3I); bf16* FM = (bf16*)(p.ws + OFF_FMIX);
        for (int idx = gt; idx < 64 * 128; idx += NT) { const int k2 = idx >> 7, col = idx & 127, part = col >> 6, n2 = col & 63;
            const int ph = (n2 * k2) & 63; float s, c; sincospif((float)ph * (1.0f / 32.0f), &s, &c);
            E3[idx] = (bf16)f2bf(part ? s : c);
            E3I[idx] = (bf16)f2bf(part ? c : -s); }
        for (int idx = gt; idx < 2 * 8 * 64 * 128; idx += NT) { const int lh = idx >> 13, e = (idx >> 7) & 63, col = idx & 127, part = col >> 6, c = col & 63;
            const float* wf = p.w_fourier + (size_t)lh * 4096; float a = 0.f;
            for (int d = 0; d < 64; ++d) { const int ph = (c * d) & 63; float sn, cs; sincospif((float)ph * (1.0f / 32.0f), &sn, &cs); a += (part ? sn : cs) * wf[d * 64 + e]; }
            FM[idx] = (bf16)f2bf(a * (1.0f / 724.0773439350247f)); }
    }
}

typedef short v4s16 __attribute__((ext_vector_type(4)));
__device__ __forceinline__ bf16x8 negbf(bf16x8 v) { u32x4 t = __builtin_bit_cast(u32x4, v); t = t ^ 0x80008000u; return __builtin_bit_cast(bf16x8, t); }
__device__ __forceinline__ bf16x8 tr_frag(const LAS unsigned char* a, int hs) {
    const v4s16 lo = __builtin_amdgcn_ds_read_tr16_b64_v4i16((LAS v4s16*)a), hi = __builtin_amdgcn_ds_read_tr16_b64_v4i16((LAS v4s16*)(a + hs));
    return __builtin_shufflevector(lo, hi, 0, 1, 2, 3, 4, 5, 6, 7);
}
constexpr int F1_P = 264, F1_CS = 128 * F1_P;
__device__ __forceinline__ void fft1_phase(const bf16* ZF, const bf16* D1, bf16* T, LAS unsigned char* lds, int G, int bid) {
    int tid = threadIdx.x; asm volatile("" : "+v"(tid));
    const int lane = tid & 63, wave = __builtin_amdgcn_readfirstlane(tid >> 6), wm = wave & 3, wn = wave >> 2, fr = lane & 15, fq = lane >> 4, tq = fr >> 2, tp = fr & 3;
    for (int pr = bid; pr < 256; pr += G) {
        const int n2 = pr & 63, cb = pr >> 6;
        __syncthreads();
        {
            const bf16* src = D1 + (size_t)n2 * 2 * 128 * 128;
#pragma unroll
            for (int j = 0; j < 8; ++j) { const int q = tid + 512 * j, sel = q >> 11, row = (q >> 4) & 127, cc = q & 15;
                *(LAS u32x4*)(lds + F1_CS + sel * 34816 + row * 272 + cc * 16) = *(const u32x4*)(src + sel * 16384 + row * 128 + 8 * cc); }
        }
        for (int b = 0; b < NB; ++b) {
            __syncthreads();
#pragma unroll
            for (int j = 0; j < 4; ++j) { const int q = tid + 512 * j, n1 = q >> 4, cc = q & 15;
                const u32x4 v = *(const u32x4*)(ZF + ((size_t)(b * SEQ + 64 * n1 + n2)) * 512 + cb * 128 + 8 * cc);
                LAS u32x2* d = (LAS u32x2*)(lds + n1 * F1_P + cc * 16); d[0] = (u32x2){v.x, v.y}; d[1] = (u32x2){v.z, v.w}; }
            __syncthreads();
            f32x4 Ar[2][4], Ai[2][4];
#pragma unroll
            for (int mb = 0; mb < 2; ++mb)
#pragma unroll
                for (int nb = 0; nb < 4; ++nb) { Ar[mb][nb] = (f32x4){0.f, 0.f, 0.f, 0.f}; Ai[mb][nb] = (f32x4){0.f, 0.f, 0.f, 0.f}; }
#pragma nounroll
            for (int ks = 0; ks < 4; ++ks) {
                bf16x8 Bf[4];
#pragma unroll
                for (int nb = 0; nb < 4; ++nb) Bf[nb] = tr_frag(lds + (32 * ks + 8 * fq + tq) * F1_P + (64 * wn + 16 * tp + 4 * nb) * 2, 4 * F1_P);
                bf16x8 Cf[2], Sf[2];
#pragma unroll
                for (int mb = 0; mb < 2; ++mb) { const int off = F1_CS + (32 * wm + 16 * mb + fr) * 272 + (32 * ks + 8 * fq) * 2; Cf[mb] = *(const LAS bf16x8*)(lds + off); Sf[mb] = *(const LAS bf16x8*)(lds + off + 34816); }
#pragma unroll
                for (int mb = 0; mb < 2; ++mb)
#pragma unroll
                    for (int nb = 0; nb < 4; ++nb) {
                        Ar[mb][nb] = __builtin_amdgcn_mfma_f32_16x16x32_bf16(Bf[nb], Cf[mb], Ar[mb][nb], 0, 0, 0);
                        Ai[mb][nb] = __builtin_amdgcn_mfma_f32_16x16x32_bf16(Bf[nb], negbf(Sf[mb]), Ai[mb][nb], 0, 0, 0); }
            }
#pragma unroll
            for (int mb = 0; mb < 2; ++mb) { const int k1 = 32 * wm + 16 * mb + fr, c = cb * 128 + 64 * wn + 16 * fq;
                bf16* t0 = T + ((((size_t)(b * 128 + k1) * 2 + 0) * 64 + n2) * 512 + c); bf16* t1 = t0 + 64 * 512;
                *(u32x4*)t0 = pack8(Ar[mb][0], Ar[mb][1]); *(u32x4*)(t0 + 8) = pack8(Ar[mb][2], Ar[mb][3]);
                *(u32x4*)t1 = pack8(Ai[mb][0], Ai[mb][1]); *(u32x4*)(t1 + 8) = pack8(Ai[mb][2], Ai[mb][3]); }
        }
    }
    __syncthreads();
}

constexpr int F3_P = 1088;
__device__ __forceinline__ bf16x8 pack8b(f32x4 a, f32x4 b) { return __builtin_bit_cast(bf16x8, pack8(a, b)); }
__device__ __forceinline__ void fft3_phase(const bf16* T, const bf16* E3, const bf16* E3I, const bf16* FM, bf16* AO, LAS unsigned char* lds, int G, int bid) {
    int tid = threadIdx.x; asm volatile("" : "+v"(tid));
    const int lane = tid & 63, wave = __builtin_amdgcn_readfirstlane(tid >> 6), fr = lane & 15, fq = lane >> 4, tq = fr >> 2, tp = fr & 3;
    LAS float* red = (LAS float*)(lds + 128 * F3_P);
    for (int unit = bid; unit < 512; unit += G) {
        const int b = unit >> 7, k1 = unit & 127;
        __syncthreads();
        const bf16* src = T + (size_t)unit * 65536;
#pragma unroll
        for (int j = 0; j < 16; ++j) { const int q = tid + 512 * j, row = q >> 6, cc = q & 63;
            const u32x4 v = *(const u32x4*)(src + row * 512 + cc * 8);
            LAS u32x2* d = (LAS u32x2*)(lds + row * F3_P + cc * 16); d[0] = (u32x2){v.x, v.y}; d[1] = (u32x2){v.z, v.w}; }
        __syncthreads();
        f32x4 gr[4][4], gi[4][4];
#pragma unroll
        for (int mb = 0; mb < 4; ++mb)
#pragma unroll
            for (int nb = 0; nb < 4; ++nb) { gr[mb][nb] = (f32x4){0.f, 0.f, 0.f, 0.f}; gi[mb][nb] = (f32x4){0.f, 0.f, 0.f, 0.f}; }
#pragma nounroll
        for (int ks = 0; ks < 4; ++ks) {
            bf16x8 Bf[4], Er[4], Ei[4];
#pragma unroll
            for (int mb = 0; mb < 4; ++mb) { const int off = (16 * mb + fr) * 128 + 32 * ks + 8 * fq; Er[mb] = *(const bf16x8*)(E3 + off); Ei[mb] = *(const bf16x8*)(E3I + off); }
#pragma unroll
            for (int nb = 0; nb < 4; ++nb) Bf[nb] = tr_frag(lds + (32 * ks + 8 * fq + tq) * F3_P + (64 * wave + 32 * (nb >> 1) + 8 * tp + 4 * (nb & 1)) * 2, 4 * F3_P);
#pragma unroll
            for (int mb = 0; mb < 4; ++mb)
#pragma unroll
                for (int nb = 0; nb < 4; ++nb) { gr[mb][nb] = __builtin_amdgcn_mfma_f32_16x16x32_bf16(Bf[nb], Er[mb], gr[mb][nb], 0, 0, 0);
                                                 gi[mb][nb] = __builtin_amdgcn_mfma_f32_16x16x32_bf16(Bf[nb], Ei[mb], gi[mb][nb], 0, 0, 0); }
        }
        bf16x8 Af[4][4];
#pragma unroll
        for (int mb = 0; mb < 4; ++mb) { Af[0][mb] = pack8b(gr[mb][0], gr[mb][1]); Af[1][mb] = pack8b(gr[mb][2], gr[mb][3]); Af[2][mb] = pack8b(gi[mb][0], gi[mb][1]); Af[3][mb] = pack8b(gi[mb][2], gi[mb][3]); }
        f32x4 acc[4][4];
#pragma unroll
        for (int mb = 0; mb < 4; ++mb)
#pragma unroll
            for (int nb = 0; nb < 4; ++nb) acc[mb][nb] = (f32x4){0.f, 0.f, 0.f, 0.f};
        const bf16* fm = FM + (size_t)wave * 64 * 128;
#pragma unroll
        for (int kst = 0; kst < 4; ++kst) {
            bf16x8 Ff[4];
#pragma unroll
            for (int nb = 0; nb < 4; ++nb) Ff[nb] = *(const bf16x8*)(fm + (16 * tq + 4 * nb + tp) * 128 + 32 * kst + 8 * fq);
#pragma unroll
            for (int mb = 0; mb < 4; ++mb)
#pragma unroll
                for (int nb = 0; nb < 4; ++nb) acc[mb][nb] = __builtin_amdgcn_mfma_f32_16x16x32_bf16(Ff[nb], Af[kst][mb], acc[mb][nb], 0, 0, 0);
        }
#pragma unroll
        for (int mb = 0; mb < 4; ++mb) { float s = 0.f;
#pragma unroll
            for (int nb = 0; nb < 4; ++nb)
#pragma unroll
                for (int j = 0; j < 4; ++j) s += acc[mb][nb][j] * acc[mb][nb][j];
            s += __shfl_xor(s, 16); s += __shfl_xor(s, 32);
            if (fq == 0) red[wave * 64 + 16 * mb + fr] = s; }
        __syncthreads();
#pragma unroll
        for (int mb = 0; mb < 4; ++mb) { float tot = 0.f;
#pragma unroll
            for (int w = 0; w < 8; ++w) tot += red[w * 64 + 16 * mb + fr];
            const float rinv = rsqrtf(tot * (1.0f / 512.0f) + EPS);
            const size_t token = (size_t)b * SEQ + k1 + 128 * (16 * mb + fr);
            bf16* o = AO + token * 1024 + 64 * wave + 16 * fq;
            *(u32x4*)o = pack8(acc[mb][0] * rinv, acc[mb][1] * rinv); *(u32x4*)(o + 8) = pack8(acc[mb][2] * rinv, acc[mb][3] * rinv); }
    }
    __syncthreads();
}

__device__ __forceinline__ void carry_phase(const Params& p, int ly, const float* Sloc, bf16* UB, LAS unsigned char* lds, int G, int bid) {
    int tid = threadIdx.x; asm volatile("" : "+v"(tid));
    const int lane = tid & 63, wave = __builtin_amdgcn_readfirstlane(tid >> 6);
    LAS f32x2* ex = (LAS f32x2*)lds;
    for (int w = bid; w < 256; w += G) {
        const int dir = w & 1, g = (w >> 1) & 31, b = w >> 6, pp = lane; const int idx = (ly * 2 + dir) * 32 + g;
        const float dt = expf(p.log_dt[idx]); const float lr = p.lam_re[idx * 64 + pp] * dt * 16.0f, li = p.lam_im[idx * 64 + pp] * dt * 16.0f;
        const float e = expf(lr); float sn, cs; sincosf(li, &sn, &cs); const float l_r = e * cs, l_i = e * sn;
        float Lr = l_r, Li = l_i;
#pragma unroll
        for (int k = 0; k < 6; ++k) { const float nr = Lr * Lr - Li * Li, ni = 2.0f * Lr * Li; Lr = nr; Li = ni; }
        const float* src = Sloc + ((size_t)(g * 2048 + b * 512)) * 256 + dir * 128 + 2 * pp;
        bf16* dst = UB + ((size_t)(g * 2048 + b * 512)) * 512 + 256 + dir * 128 + 2 * pp;
        const int ss0 = dir == 0 ? wave * 64 : 511 - wave * 64; const long stp = dir == 0 ? 256 : -256;
        float cr = 0.f, ci = 0.f;
        { const float* ptr = src + (size_t)ss0 * 256;
#pragma nounroll
          for (int hb = 0; hb < 2; ++hb) {
            f32x2 v[32];
#pragma unroll
            for (int j = 0; j < 32; ++j) { v[j] = *(const f32x2*)ptr; ptr += stp; }
#pragma unroll
            for (int j = 0; j < 32; ++j) { const float nr = l_r * cr - l_i * ci + v[j][0], ni = l_r * ci + l_i * cr + v[j][1]; cr = nr; ci = ni; }
          } }
        __syncthreads();
        ex[wave * 64 + lane] = (f32x2){cr, ci};
        __syncthreads();
        cr = 0.f; ci = 0.f;
        for (int u = 0; u < wave; ++u) { const f32x2 eu = ex[u * 64 + lane]; const float nr = Lr * cr - Li * ci + eu[0], ni = Lr * ci + Li * cr + eu[1]; cr = nr; ci = ni; }
        { const float* ptr = src + (size_t)ss0 * 256; bf16* dp = dst + (size_t)ss0 * 512;
#pragma nounroll
          for (int hb = 0; hb < 2; ++hb) {
            f32x2 v[32];
#pragma unroll
            for (int j = 0; j < 32; ++j) { v[j] = *(const f32x2*)ptr; ptr += stp; }
#pragma unroll
            for (int j = 0; j < 32; ++j) {
                *(unsigned*)dp = pk2(cr, ci); dp += 2 * stp;
                const float nr = l_r * cr - l_i * ci + v[j][0], ni = l_r * ci + l_i * cr + v[j][1]; cr = nr; ci = ni; }
          } }
    }
    __syncthreads();
}

__device__ __forceinline__ void norm_phase(float* out, const bf16* MF, const float* ss, const float* gain, bf16* XB, float* rnext, bool last, int G, int bid) {
    int tid = threadIdx.x; asm volatile("" : "+v"(tid));
    const int lane = tid & 63, wave = __builtin_amdgcn_readfirstlane(tid >> 6);
    const int gw = bid * 8 + wave, NGW = G * 8;
    const f32x4* gr = (const f32x4*)gain + lane;
    const f32x4 g0 = gr[0], g1 = gr[64], g2 = gr[128], g3 = gr[192];
    for (int row0 = gw; row0 < MT; row0 += 2 * NGW) {
        u32x2 xv[2][4], mv[2][4]; float tot[2];
#pragma unroll
        for (int rr = 0; rr < 2; ++rr) { const int row = row0 + rr * NGW;
            const u32x2* xr = (const u32x2*)(XB + (size_t)row * 1024) + lane; const u32x2* mr = (const u32x2*)(MF + (size_t)row * 1024) + lane;
#pragma unroll
            for (int j = 0; j < 4; ++j) { xv[rr][j] = xr[64 * j]; mv[rr][j] = mr[64 * j]; }
            const f32x4* sp = (const f32x4*)(ss + (size_t)row * 16); const f32x4 s0 = sp[0], s1 = sp[1], s2 = sp[2], s3 = sp[3];
            tot[rr] = ((((s0[0] + s0[1]) + s0[2]) + s0[3]) + (((s1[0] + s1[1]) + s1[2]) + s1[3])) + ((((s2[0] + s2[1]) + s2[2]) + s2[3]) + (((s3[0] + s3[1]) + s3[2]) + s3[3])); }
#pragma unroll
        for (int rr = 0; rr < 2; ++rr) { const int row = row0 + rr * NGW;
            const float rinv = rsqrtf(tot[rr] * (1.0f / 1024.0f) + EPS); float s2 = 0.f;
#pragma unroll
            for (int j = 0; j < 4; ++j) { const f32x4 gg = j == 0 ? g0 : (j == 1 ? g1 : (j == 2 ? g2 : g3)); const u32x2 xx = xv[rr][j], mm = mv[rr][j]; f32x4 v;
                v[0] = bflo(xx.x) + bflo(mm.x) * rinv * gg[0]; v[1] = bfhi(xx.x) + bfhi(mm.x) * rinv * gg[1]; v[2] = bflo(xx.y) + bflo(mm.y) * rinv * gg[2]; v[3] = bfhi(xx.y) + bfhi(mm.y) * rinv * gg[3];
                if (last) { ((f32x4*)(out + (size_t)row * 1024) + lane)[64 * j] = v; }
                else { u32x2 w; w.x = pk2(v[0], v[1]); w.y = pk2(v[2], v[3]); ((u32x2*)(XB + (size_t)row * 1024) + lane)[64 * j] = w;
                       const float a0 = bflo(w.x), a1 = bfhi(w.x), a2 = bflo(w.y), a3 = bfhi(w.y); s2 += a0 * a0 + a1 * a1 + a2 * a2 + a3 * a3; } }
            if (!last) { s2 = wave_sum(s2); if (lane == 0) rnext[row] = rsqrtf(s2 * (1.0f / 1024.0f) + EPS); } }
    }
}
__device__ __forceinline__ void rescale_phase(bf16* AO, const float* ss, int G, int bid) {
    int tid = threadIdx.x; asm volatile("" : "+v"(tid));
    const int lane = tid & 63, wave = __builtin_amdgcn_readfirstlane(tid >> 6);
    const int gw = bid * 8 + wave, NGW = G * 8;
    for (int row = gw; row < MT; row += NGW) {
        float tot = 0.f;
#pragma unroll
        for (int k = 0; k < 8; ++k) tot += ss[row * 8 + k];
        const float rinv = rsqrtf(tot * (1.0f / 512.0f) + EPS);
        u32x4* ptr = (u32x4*)(AO + (size_t)row * 1024 + 512) + lane; u32x4 v = *ptr;
        v.x = pk2(bflo(v.x) * rinv, bfhi(v.x) * rinv); v.y = pk2(bflo(v.y) * rinv, bfhi(v.y) * rinv); v.z = pk2(bflo(v.z) * rinv, bfhi(v.z) * rinv); v.w = pk2(bflo(v.w) * rinv, bfhi(v.w) * rinv);
        *ptr = v;
    }
}


#define XB_TMO      128
#define XB_XCNT(j)  (256  + 64 * (j))
#define XB_XSUB(j)  (1280 + 64 * (j))
#define XB_XGEN(j)  (2304 + 64 * (j))
#define XB_TOP      3328
#define XB_TOPGEN   3392
#define XCD_BAR_WORDS 3456
#define XB_SPIN_CAP (1u << 18)
__device__ __forceinline__ unsigned xb_ld(unsigned* p)              { return __hip_atomic_load(p, __ATOMIC_RELAXED, __HIP_MEMORY_SCOPE_AGENT); }
__device__ __forceinline__ unsigned xb_add(unsigned* p, unsigned v) { return __hip_atomic_fetch_add(p, v, __ATOMIC_RELAXED, __HIP_MEMORY_SCOPE_AGENT); }
__device__ __forceinline__ unsigned xb_xcc_id() { return (unsigned)__builtin_amdgcn_s_getreg((3 << 11) | 20) & 0xFu; }
#define XB_SPIN(cond, bar) do { unsigned _sp = 0; while (cond) { __builtin_amdgcn_s_sleep(1); \
    if ((++_sp & 255u) == 0u) { if (xb_ld(&(bar)[XB_TMO])) break; if (_sp > XB_SPIN_CAP) { atomicAdd(&(bar)[XB_TMO], 1u); break; } } } } while (0)
struct XcdBarrier { unsigned* bar; unsigned x; volatile LAS unsigned* st; };
__device__ __forceinline__ XcdBarrier xcd_barrier_post(unsigned* bar, volatile LAS unsigned* st) {
    XcdBarrier b; b.bar = bar; b.x = xb_xcc_id(); b.st = st;
    if (threadIdx.x == 0) (void)xb_add(&bar[XB_XCNT(b.x)], 1u);
    return b;
}
__device__ __forceinline__ void xcd_barrier_complete(unsigned* bar, unsigned x, unsigned& nloc, unsigned& nx) {
    const unsigned G = gridDim.x * gridDim.y * gridDim.z;
    unsigned sum, cnt, mine, sp = 0u;
    for (;;) {
        sum = 0u; cnt = 0u; mine = 0u;
#pragma unroll
        for (unsigned j = 0; j < 16; ++j) { const unsigned c = xb_ld(&bar[XB_XCNT(j)]); sum += c; cnt += (c > 0u) ? 1u : 0u; mine = (j == x) ? c : mine; }
        if (sum == G) break;
        __builtin_amdgcn_s_sleep(1);
        if ((++sp & 255u) == 0u) { if (xb_ld(&bar[XB_TMO])) break; if (sp > XB_SPIN_CAP) { atomicAdd(&bar[XB_TMO], 1u); break; } }
    }
    nloc = mine > 0u ? mine : 1u; nx = cnt > 0u ? cnt : 1u;
}
__device__ __forceinline__ void xcd_barrier(const XcdBarrier& b) {
    asm volatile("s_waitcnt vmcnt(0)" ::: "memory");
    __syncthreads();
    if (threadIdx.x == 0) {
        unsigned* bar = b.bar;
        __builtin_amdgcn_s_waitcnt(0);
        unsigned nloc = b.st[0], nx = b.st[1];
        if (nloc == 0u) { xcd_barrier_complete(bar, b.x, nloc, nx); b.st[0] = nloc; b.st[1] = nx; }
        const unsigned old = xb_add(&bar[XB_XSUB(b.x)], 1u);
        const unsigned gen = old / nloc;
        if (old + 1u == (gen + 1u) * nloc) {
            __builtin_amdgcn_fence(__ATOMIC_RELEASE, "agent");
            asm volatile("s_waitcnt vmcnt(0)" ::: "memory");
            const unsigned og = xb_add(&bar[XB_TOP], 1u);
            const unsigned tg = og / nx;
            if (og + 1u == (tg + 1u) * nx) xb_add(&bar[XB_TOPGEN], 1u);
            else XB_SPIN(xb_ld(&bar[XB_TOPGEN]) == tg, bar);
            __builtin_amdgcn_fence(__ATOMIC_ACQUIRE, "agent");
            xb_add(&bar[XB_XGEN(b.x)], 1u);
            asm volatile("s_waitcnt vmcnt(0)" ::: "memory");
        } else {
            XB_SPIN(xb_ld(&bar[XB_XGEN(b.x)]) == gen, bar);
            __builtin_amdgcn_fence(__ATOMIC_ACQUIRE, "agent");
            asm volatile("s_waitcnt vmcnt(0)" ::: "memory");
        }
    }
    __syncthreads();
}

#ifndef REP_P0
#define REP_P0 1
#endif
#ifndef REP_SYNC
#define REP_SYNC 1
#endif
#ifndef REP_MASK_V
#define REP_MASK_V 0u
#endif
constexpr unsigned REP_MASK = REP_MASK_V;
constexpr int PH_PER_LAYER = 10, N_PHASES = 1 + 2 * PH_PER_LAYER;
__global__ void __launch_bounds__(512) hybrid_fwd(Params p) {
    extern __shared__ __attribute__((aligned(16))) unsigned char lds_raw[];
    LAS unsigned char* lds = (LAS unsigned char*)lds_raw;
    cg::grid_group grid = cg::this_grid();
    volatile LAS unsigned* xst = (volatile LAS unsigned*)(lds + LDS_BYTES - 16);
    if (threadIdx.x < 4) xst[threadIdx.x] = 0u;
    __syncthreads();
    const XcdBarrier xbar = xcd_barrier_post((unsigned*)(p.ws + OFF_BAR), xst);
    if (p.ph_hi > 1000) grid.sync();
    const int Gk = gridDim.x, bk = blockIdx.x;
    unsigned char* ws = p.ws;
    float* sss = (float*)(ws + OFF_SSS); float* ssm = (float*)(ws + OFF_SSM); float* ssf = (float*)(ws + OFF_SSF); float* rA = (float*)(ws + OFF_RA); float* rB = (float*)(ws + OFF_RB);
    bf16* XB = (bf16*)(ws + OFF_XB); bf16* MF = (bf16*)(ws + OFF_MF); bf16* GB = (bf16*)(ws + OFF_G); bf16* HB = (bf16*)(ws + OFF_H);
    bf16* PQ = (bf16*)(ws + OFF_PQ); bf16* AO = (bf16*)(ws + OFF_AO); bf16* UB = (bf16*)(ws + OFF_UB); bf16* TB = (bf16*)(ws + OFF_T); float* SL = (float*)(ws + OFF_SLOC);

#pragma nounroll
    for (int ph = p.ph_lo; ph < p.ph_hi; ++ph) {
        int G = Gk, bid = bk; asm volatile("" : "+s"(G), "+s"(bid));
        if (ph == 0) { for (int rep = 0; rep < REP_P0; ++rep) p0_prologue(p, lds, G, bid); }
        else {
            const int ly = (ph - 1) / PH_PER_LAYER, sp = (ph - 1) % PH_PER_LAYER;
            unsigned char* wb = ws + OFF_W + (size_t)ly * W_LAYER;
            pg8::Order S;
            const int nrep = ((REP_MASK >> sp) & 1u) ? 2 : 1;
            for (int rep = 0; rep < nrep; ++rep)
            switch (sp) {
            case 0: {
                pg8::Gemm g{XB, (const bf16*)(wb + W_IN), MT, NIN, 1024, 1024, 1024, 0, 0, 1}; S.init(MT, NIN, 1, G, bid, WGM_IN);
                EpiIn E{PQ, UB, rA}; pg8::gemm_phase<EpiIn>(lds, g, S, E); } break;
            case 1: {
                fft1_phase(PQ, (const bf16*)(ws + OFF_D1), TB, lds, G, bid);
                pg8::Gemm g{UB, (const bf16*)(ws + OFF_MST) + (size_t)ly * 32 * 256 * 256, 2048, 256, 256, 512, 256, (size_t)2048 * 512, (size_t)256 * 256, 32}; S.init(2048, 256, 32, G, bid);
                EpiSloc E{SL}; pg8::gemm_phase<EpiSloc>(lds, g, S, E); } break;
            case 2: {
                carry_phase(p, ly, SL, UB, lds, G, bid);
                fft3_phase(TB, (const bf16*)(ws + OFF_E3), (const bf16*)(ws + OFF_E3I), (const bf16*)(ws + OFF_FMIX) + (size_t)ly * 8 * 64 * 128, AO, lds, G, bid); } break;
            case 3: {
                pg8::Gemm g{UB, (const bf16*)(ws + OFF_TM) + (size_t)ly * 32 * 256 * 512, 2048, 256, 512, 512, 512, (size_t)2048 * 512, (size_t)256 * 512, 32}; S.init(2048, 256, 32, G, bid);
                EpiSsmOut E{GB}; pg8::gemm_phase<EpiSsmOut>(lds, g, S, E); } break;
            case 4: {
                pg8::Gemm g{GB, (const bf16*)(wb + W_GLU), MT, 512, 512, 512, 512, 0, 0, 1}; S.init(MT, 512, 1, G, bid, WGM_GLU);
                EpiGlu E{GB, p.b_glu + ly * 512, AO, sss}; pg8::gemm_phase<EpiGlu>(lds, g, S, E); } break;
            case 5: {
                pg8::Gemm g{AO, (const bf16*)(wb + W_OUT), MT, 1024, 1024, 1024, 1024, 0, 0, 1}; S.init(MT, 1024, 1, G, bid, WGM_OUT);
                LAS float* qv = (LAS float*)(lds + 131072);
                { int tid = threadIdx.x; asm volatile("" : "+v"(tid));
                  for (int i = 0; i < 4; ++i) { pg8::Unit u; if (!S.next(i, u)) break;
                      if (tid < 256) { const f32x4* sp = (const f32x4*)(sss + (size_t)(u.pm * 256 + tid) * 8); const f32x4 a = sp[0], b = sp[1];
                          const float ms = ((((a[0] + a[1]) + a[2]) + a[3]) + (((b[0] + b[1]) + b[2]) + b[3])) * (1.0f / 512.0f) + EPS;
                          qv[i * 256 + tid] = sqrtf(ms); qv[1024 + i * 256 + tid] = rsqrtf(ms); } }
                  __syncthreads(); }
                EpiOutMix E{MF, ssm, qv}; pg8::gemm_phase<EpiOutMix>(lds, g, S, E); } break;
            case 6: norm_phase(p.out, MF, ssm, p.post_mix_g + ly * 1024, XB, rB, false, G, bid); break;
            case 7: {
                pg8::Gemm g{XB, (const bf16*)(wb + W_1), MT, DFF, 1024, 1024, 1024, 0, 0, 1}; S.init(MT, DFF, 1, G, bid, WGM_FF1);
                EpiFF1 E{HB, rB}; pg8::gemm_phase<EpiFF1>(lds, g, S, E); } break;
            case 8: {
                pg8::Gemm g{HB, (const bf16*)(wb + W_2), MT, 1024, DFF, DFF, DFF, 0, 0, 1}; S.init(MT, 1024, 1, G, bid, WGM_FF2);
                EpiOutSS E{MF, ssf}; pg8::gemm_phase<EpiOutSS>(lds, g, S, E); } break;
            case 9: norm_phase(p.out, MF, ssf, p.post_mlp_g + ly * 1024, XB, rA, ly == 1, G, bid); break;
            }
        }
        if (ph + 1 < p.ph_hi) for (int rep = 0; rep < REP_SYNC; ++rep) xcd_barrier(xbar);
    }
}

extern "C" void kernel_launch(void* const* d_in, const int* in_sizes, int n_in, void* d_out, int out_size, void* d_ws, size_t ws_size, hipStream_t stream) {
    static int grid = 0;
    if (grid == 0) {
        if (n_in != 22 || ws_size < WS_END) { fprintf(stderr, "kernel_launch: unexpected n_in %d or ws_size %zu (< %zu)\n", n_in, ws_size, (size_t)WS_END); grid = -1; return; }
        int dev = 0, cus = 0, per_cu = 0;
        hipGetDevice(&dev); hipDeviceGetAttribute(&cus, hipDeviceAttributeMultiprocessorCount, dev);
        if (hipFuncSetAttribute((const void*)hybrid_fwd, hipFuncAttributeMaxDynamicSharedMemorySize, LDS_BYTES) != hipSuccess) { fprintf(stderr, "kernel_launch: hipFuncSetAttribute failed\n"); grid = -1; return; }
        if (hipOccupancyMaxActiveBlocksPerMultiprocessor(&per_cu, (const void*)hybrid_fwd, 512, LDS_BYTES) != hipSuccess || per_cu < 1) { fprintf(stderr, "kernel_launch: occupancy query says %d blocks per CU\n", per_cu); per_cu = 1; }
        (void)hipGetLastError();
        grid = cus;
    }
    if (grid < 0) return;
    if (hipMemsetAsync((char*)d_ws + OFF_BAR, 0, BAR_BYTES, stream) != hipSuccess) { fprintf(stderr, "kernel_launch: memset of the barrier words failed\n"); return; }
    Params p{};
    const float** f = (const float**)&p;
    for (int i = 0; i < 22; ++i) f[i] = (const float*)d_in[i];
    p.out = (float*)d_out; p.ws = (unsigned char*)d_ws; p.ph_lo = 0; p.ph_hi = N_PHASES;
    void* args[] = {&p};
    hipError_t e = hipLaunchCooperativeKernel((const void*)hybrid_fwd, dim3(grid), dim3(512), args, LDS_BYTES, stream);
    if (e != hipSuccess) fprintf(stderr, "kernel_launch: cooperative launch failed: %s (grid %d)\n", hipGetErrorString(e), grid);
}
```

```cpp
#include <hip/hip_runtime.h>
#include <hip/hip_cooperative_groups.h>
#include <cstdio>
namespace cg = cooperative_groups;

#define P0_REP_A 1
#define WGM_FF1 4
#define WGM_IN 2
#define WGM_OUT 4
#define WGM_GLU 4
#define WGM_FF2 4
#define P0_REP_F 1
#define P0_REP_S 1
#define P0_REP_B 1
#define P0_REP_C 1
#define LAS __attribute__((address_space(3)))
typedef unsigned short bf16;
typedef short bf16x8 __attribute__((ext_vector_type(8)));
typedef float f32x4 __attribute__((ext_vector_type(4)));
typedef float f32x2 __attribute__((ext_vector_type(2)));
typedef unsigned u32x4 __attribute__((ext_vector_type(4)));
typedef unsigned u32x2 __attribute__((ext_vector_type(2)));

constexpr int NB = 4, SEQ = 8192, DM = 1024, MT = NB * SEQ, DFO = 512, NHEAD = 8, SG = 32, SP = 64, DFF = 4096, NIN = 1024;
constexpr float EPS = 1e-6f;
constexpr int LDS_BYTES = 147456;
constexpr size_t MiB = 1u << 20;
constexpr size_t OFF_RA = 384 * 1024, OFF_RB = 512 * 1024, OFF_BAR = 640 * 1024, BAR_BYTES = 16384;
constexpr size_t OFF_E3I = 1 * MiB + 16384, OFF_FMIX = 1 * MiB + 65536;
constexpr size_t OFF_E3 = 1 * MiB, OFF_D1 = 2 * MiB, OFF_TM = 6 * MiB, OFF_MST = 22 * MiB, OFF_W = 30 * MiB;
constexpr size_t W_IN = 0, W_OUT = 3 * MiB, W_1 = 5 * MiB, W_2 = 13 * MiB, W_GLU = 21 * MiB, W_LAYER = 22 * MiB;
constexpr size_t OFF_XB = 76 * MiB, OFF_MF = 140 * MiB, OFF_G = 140 * MiB, OFF_H = 204 * MiB;
constexpr size_t OFF_PQ = 204 * MiB, OFF_AO = 204 * MiB, OFF_UB = 268 * MiB, OFF_T = 332 * MiB, OFF_SLOC = 396 * MiB, OFF_SSS = 460 * MiB, OFF_SSM = 461 * MiB, OFF_SSF = 463 * MiB, WS_END = 465 * MiB;

struct Params {
    const float *x, *w_in, *w_out, *pre_mix_g, *post_mix_g, *pre_mlp_g, *post_mlp_g, *fourier_out_g, *ssm_out_g, *w_fourier,
        *lam_re, *lam_im, *log_dt, *b_re, *b_im, *c_re, *c_im, *d_skip, *w_glu, *b_glu, *w_ff1, *w_ff2;
    float* out; unsigned char* ws;
    int ph_lo, ph_hi;
};

__device__ __forceinline__ unsigned f2bf(float f) { unsigned u = __builtin_bit_cast(unsigned, f); return (u + 0x7fffu + ((u >> 16) & 1u)) >> 16; }
typedef __bf16 hwbf2 __attribute__((ext_vector_type(2)));
__device__ __forceinline__ unsigned pk2(float lo, float hi) { const f32x2 v = {lo, hi}; return __builtin_bit_cast(unsigned, __builtin_convertvector(v, hwbf2)); }
__device__ __forceinline__ float bflo(unsigned w) { return __builtin_bit_cast(float, w << 16); }
__device__ __forceinline__ float bfhi(unsigned w) { return __builtin_bit_cast(float, w & 0xffff0000u); }
__device__ __forceinline__ float wave_sum(float v) {
#pragma unroll
    for (int o = 1; o < 64; o <<= 1) v += __shfl_xor(v, o);
    return v;
}
__device__ __forceinline__ float gelu_t(float x) { const float u = 0.7978845608f * (x + 0.044715f * x * x * x); return x * __builtin_amdgcn_rcpf(1.0f + __expf(-2.0f * u)); }
__device__ __forceinline__ float sigm(float v) { return __builtin_amdgcn_rcpf(1.0f + __expf(-v)); }

namespace pg8 {
#define PG8_LAS __attribute__((address_space(3)))
typedef unsigned short bf16_t;
constexpr int BM = 256, BK = 64, HALF = 128, HTB = HALF * BK * 2, STAGE_BYTES = 8 * HTB, NXCD = 8, WGM = 4;
__host__ __device__ __forceinline__ int lds_byte(int r, int c) { const int st = (r >> 4) * 2 + (c >> 5), rr = r & 15, cc = c & 31, ob = rr * 64 + cc * 2; return st * 1024 + (ob ^ (((ob >> 9) & 1) << 5)); }
__host__ __device__ __forceinline__ void stage_rc(int b, int& R, int& C) { const int st = b / 1024, sb = b % 1024, swz = sb ^ (((sb >> 9) & 1) << 5); R = (st >> 1) * 16 + swz / 64; C = (st & 1) * 32 + (swz % 64) / 2; }
__host__ __device__ __forceinline__ int perm32(int rho) { const int n = rho >> 4, i = rho & 15; return 8 * (i >> 2) + 4 * n + (i & 3); }

struct Unit { int pm, pn, z, ui; };
struct Gemm { const bf16_t* A; const bf16_t* Bt; int M, N, K, lda, ldb; size_t sA, sB; int nZ; };

struct Order {
    int nM, nN, nwg, nZ, G, c, wgm;
    __device__ void init(int M, int N, int nZ_, int G_, int c_, int wgm_ = WGM) { nM = M / BM; nN = N / BM; nwg = nM * nN; nZ = nZ_; G = G_; c = c_; wgm = wgm_; }
    __device__ bool next(int i, Unit& u) const {
        const long L = (long)i * G + c; if (L >= (long)nwg * nZ) return false;
        u.ui = i;
        if (nZ > 1 && (nZ % NXCD) == 0) {
            const int xcd = (int)(L % NXCD), idx = (int)(L / NXCD); u.z = xcd * (nZ / NXCD) + idx / nwg; const int wg = idx % nwg; u.pm = wg % nM; u.pn = wg / nM; return true; }
        u.z = (int)(L / nwg);
        int wgid = (int)(L % nwg); { const int q = nwg / NXCD, r = nwg % NXCD, xcd = wgid % NXCD, off = wgid / NXCD; wgid = (xcd < r ? xcd * (q + 1) : r * (q + 1) + (xcd - r) * q) + off; }
        const int nig = wgm * nN, gid = wgid / nig, fm = gid * wgm, gsz = (nM - fm) < wgm ? (nM - fm) : wgm;
        u.pm = fm + ((wgid % nig) % gsz); u.pn = (wgid % nig) / gsz; return true;
    }
};

template <class Epi>
__device__ __forceinline__ void gemm_phase(PG8_LAS unsigned char* lds, const Gemm g, const Order& S, const Epi& E) {
    int tid = threadIdx.x; asm volatile("" : "+v"(tid));
    const int wid = __builtin_amdgcn_readfirstlane(tid >> 6), lane = tid & 63, wr = wid >> 2, wc = wid & 3, fr = lane & 15, fq = lane >> 4;
    const int K = g.K, nt = K / BK;
    unsigned voffA[2], voffB[2];
#pragma unroll
    for (int i = 0; i < 2; ++i) { int R, C; stage_rc(tid * 16 + i * 8192, R, C); const int Rb = Epi::PERM ? ((R & ~31) + perm32(R & 31)) : R;
        voffA[i] = (unsigned)(R * g.lda + C) * 2u; voffB[i] = (unsigned)(Rb * g.ldb + C) * 2u; }
    const size_t kstep = (size_t)(BK * 2);
    const size_t hA = (size_t)HALF * g.lda * 2, hB = (size_t)HALF * g.ldb * 2;
    const size_t tA = 2 * hA, tB = 2 * hB;
    const unsigned ldsw = (unsigned)wid * 1024u;
    const int aoff = lds_byte(wr * 64 + fr, fq * 8), boff = lds_byte(wc * 32 + fr, fq * 8);
#define PG8_SA(b, h) (((b) * 2 + (h)) * HTB)
#define PG8_SB(b, h) ((4 + (b) * 2 + (h)) * HTB)
#define PG8_STAGE(bufoff, gbase, voff) do { _Pragma("unroll") for (int _i = 0; _i < 2; ++_i) \
        __builtin_amdgcn_global_load_lds((const unsigned*)((const char*)(gbase) + (voff)[_i]), (PG8_LAS unsigned*)(lds + (bufoff) + ldsw + _i * 8192), 16, 0, 0); } while (0)
#define PG8_LDA(dst, b, h) do { _Pragma("unroll") for (int m = 0; m < 4; ++m) _Pragma("unroll") for (int k = 0; k < 2; ++k) dst[m][k] = *(const PG8_LAS bf16x8*)(lds + PG8_SA(b, h) + aoff + m * 2048 + k * 1024); } while (0)
#define PG8_LDB(dst, b, h) do { _Pragma("unroll") for (int n = 0; n < 2; ++n) _Pragma("unroll") for (int k = 0; k < 2; ++k) dst[n][k] = *(const PG8_LAS bf16x8*)(lds + PG8_SB(b, h) + boff + n * 2048 + k * 1024); } while (0)
#define PG8_MMA(ai, bj, At, Bt) do { __builtin_amdgcn_s_setprio(1); _Pragma("unroll") for (int m = 0; m < 4; ++m) _Pragma("unroll") for (int n = 0; n < 2; ++n) _Pragma("unroll") for (int k = 0; k < 2; ++k) \
        acc[ai][bj][m][n] = __builtin_amdgcn_mfma_f32_16x16x32_bf16(Bt[n][k], At[m][k], acc[ai][bj][m][n], 0, 0, 0); __builtin_amdgcn_s_setprio(0); } while (0)
#define PG8_WAIT_V(n) asm volatile("s_waitcnt vmcnt(" #n ")" ::: "memory")
#define PG8_WAIT_L(n) asm volatile("s_waitcnt lgkmcnt(" #n ")" ::: "memory")
#define PG8_BAR __builtin_amdgcn_s_barrier()
#define PG8_SCHED __builtin_amdgcn_sched_barrier(0)
    Unit cur, nxt; int ui = 0;
    if (!S.next(0, cur)) return;
    f32x4 acc[2][2][4][2];
#pragma unroll
    for (int a = 0; a < 2; ++a)
#pragma unroll
        for (int b = 0; b < 2; ++b)
#pragma unroll
            for (int m = 0; m < 4; ++m)
#pragma unroll
                for (int n = 0; n < 2; ++n) acc[a][b][m][n] = (f32x4){0.f, 0.f, 0.f, 0.f};
    bf16x8 At[4][2], B0[2][2], B1[2][2];
    const char* cA = (const char*)g.A + ((size_t)cur.z * g.sA) * 2 + (size_t)cur.pm * tA; const char* cB = (const char*)g.Bt + ((size_t)cur.z * g.sB) * 2 + (size_t)cur.pn * tB;
    PG8_STAGE(PG8_SB(0, 0), cB, voffB); PG8_STAGE(PG8_SA(0, 0), cA, voffA); PG8_STAGE(PG8_SB(0, 1), cB + hB, voffB); PG8_STAGE(PG8_SA(0, 1), cA + hA, voffA);
    if (wr == 1) PG8_BAR;
    PG8_WAIT_V(4); PG8_BAR;
    PG8_STAGE(PG8_SB(1, 0), cB + kstep, voffB); PG8_STAGE(PG8_SA(1, 0), cA + kstep, voffA); PG8_STAGE(PG8_SB(1, 1), cB + hB + kstep, voffB);
    PG8_WAIT_V(6); PG8_BAR;
    for (;;) {
        const bool has_next = S.next(ui + 1, nxt);
        const char* nA = has_next ? (const char*)g.A + ((size_t)nxt.z * g.sA) * 2 + (size_t)nxt.pm * tA : cA; const char* nB = has_next ? (const char*)g.Bt + ((size_t)nxt.z * g.sB) * 2 + (size_t)nxt.pn * tB : cB;
        for (int t = 0; t < nt; t += 2) {
            const bool last = (t == nt - 2);
            if constexpr (Epi::MID) { if (t == (nt >> 1)) E.mid(acc, cur, wr, fr); }
            const char* a1 = cA + (size_t)(t + 1) * kstep;
            const char* a2 = last ? nA : cA + (size_t)(t + 2) * kstep; const char* b2 = last ? nB : cB + (size_t)(t + 2) * kstep;
            const char* a3 = a2 + kstep; const char* b3 = b2 + kstep;
            PG8_LDB(B0, 0, 0); PG8_SCHED; PG8_LDA(At, 0, 0); PG8_STAGE(PG8_SA(1, 1), a1 + hA, voffA);
            PG8_WAIT_L(8); PG8_BAR; PG8_WAIT_L(0); PG8_MMA(0, 0, At, B0); PG8_BAR; PG8_SCHED;
            PG8_LDB(B1, 0, 1); PG8_STAGE(PG8_SB(0, 0), b2, voffB);
            PG8_BAR; PG8_WAIT_L(0); PG8_MMA(0, 1, At, B1); PG8_BAR;
            PG8_LDA(At, 0, 1); PG8_STAGE(PG8_SA(0, 0), a2, voffA);
            PG8_BAR; PG8_WAIT_L(0); PG8_MMA(1, 0, At, B0); PG8_BAR; PG8_SCHED;
            PG8_STAGE(PG8_SB(0, 1), b2 + hB, voffB);
            PG8_WAIT_V(6); PG8_BAR; PG8_MMA(1, 1, At, B1); PG8_BAR;
            PG8_LDB(B0, 1, 0); PG8_SCHED; PG8_LDA(At, 1, 0); PG8_STAGE(PG8_SA(0, 1), a2 + hA, voffA);
            PG8_WAIT_L(8); PG8_BAR; PG8_WAIT_L(0); PG8_MMA(0, 0, At, B0); PG8_BAR; PG8_SCHED;
            PG8_LDB(B1, 1, 1); PG8_STAGE(PG8_SB(1, 0), b3, voffB);
            PG8_BAR; PG8_WAIT_L(0); PG8_MMA(0, 1, At, B1); PG8_BAR;
            PG8_LDA(At, 1, 1); PG8_STAGE(PG8_SA(1, 0), a3, voffA);
            PG8_BAR; PG8_WAIT_L(0); PG8_MMA(1, 0, At, B0); PG8_BAR; PG8_SCHED;
            PG8_STAGE(PG8_SB(1, 1), b3 + hB, voffB);
            PG8_WAIT_V(6); PG8_BAR; PG8_MMA(1, 1, At, B1); PG8_BAR;
        }
        E(acc, cur, wr, wc, fr, fq);
        if (!has_next) break;
#pragma unroll
        for (int a = 0; a < 2; ++a)
#pragma unroll
            for (int b = 0; b < 2; ++b)
#pragma unroll
                for (int m = 0; m < 4; ++m)
#pragma unroll
                    for (int n = 0; n < 2; ++n) acc[a][b][m][n] = (f32x4){0.f, 0.f, 0.f, 0.f};
        cur = nxt; cA = nA; cB = nB; ++ui;
    }
    PG8_WAIT_V(0);
    if (wr == 0) PG8_BAR;
    PG8_BAR;
#undef PG8_SA
#undef PG8_SB
#undef PG8_STAGE
#undef PG8_LDA
#undef PG8_LDB
#undef PG8_MMA
#undef PG8_WAIT_V
#undef PG8_WAIT_L
#undef PG8_BAR
#undef PG8_SCHED
}
}

typedef const f32x4 (&AccRef)[2][2][4][2];
__device__ __forceinline__ u32x4 pack8(f32x4 a, f32x4 b) { u32x4 w; w.x = pk2(a[0], a[1]); w.y = pk2(a[2], a[3]); w.z = pk2(b[0], b[1]); w.w = pk2(b[2], b[3]); return w; }

struct EpiIn {
    static constexpr bool PERM = true, MID = false;
    bf16* ZF; bf16* UB; const float* r;
    __device__ __forceinline__ void operator()(AccRef acc, const pg8::Unit& u, int wr, int wc, int fr, int fq) const {
#pragma unroll
        for (int ai = 0; ai < 2; ++ai)
#pragma unroll
            for (int m = 0; m < 4; ++m) {
                const int row = u.pm * 256 + ai * 128 + wr * 64 + m * 16 + fr; const float rs = r[row];
#pragma unroll
                for (int bj = 0; bj < 2; ++bj) {
                    const int col0 = u.pn * 256 + bj * 128 + wc * 32 + 8 * fq;
                    const u32x4 w = pack8(acc[ai][bj][m][0] * rs, acc[ai][bj][m][1] * rs);
                    if (col0 < 512) *(u32x4*)(ZF + (size_t)row * 512 + col0) = w;
                    else { const int c2 = col0 - 512, gg = c2 >> 4, h0 = c2 & 15; *(u32x4*)(UB + ((size_t)(gg * 2048 + (row >> 4)) * 512 + (row & 15) * 16 + h0)) = w; }
                }
            }
    }
};
struct EpiSloc {
    static constexpr bool PERM = false, MID = false;
    float* S;
    __device__ __forceinline__ void operator()(AccRef acc, const pg8::Unit& u, int wr, int wc, int fr, int fq) const {
#pragma unroll
        for (int ai = 0; ai < 2; ++ai)
#pragma unroll
            for (int m = 0; m < 4; ++m) {
                const int row = u.pm * 256 + ai * 128 + wr * 64 + m * 16 + fr;
                float* rp = S + ((size_t)u.z * 2048 + row) * 256 + wc * 32 + 4 * fq;
#pragma unroll
                for (int bj = 0; bj < 2; ++bj)
#pragma unroll
                    for (int n = 0; n < 2; ++n) *(f32x4*)(rp + bj * 128 + n * 16) = acc[ai][bj][m][n];
            }
    }
};
struct EpiSsmOut {
    static constexpr bool PERM = true, MID = false;
    bf16* G;
    __device__ __forceinline__ void operator()(AccRef acc, const pg8::Unit& u, int wr, int wc, int fr, int fq) const {
#pragma unroll
        for (int ai = 0; ai < 2; ++ai)
#pragma unroll
            for (int m = 0; m < 4; ++m) {
                const int row = u.pm * 256 + ai * 128 + wr * 64 + m * 16 + fr;
#pragma unroll
                for (int bj = 0; bj < 2; ++bj) {
                    const int col0 = bj * 128 + wc * 32 + 8 * fq, t = col0 >> 4, i0 = col0 & 15;
                    f32x4 a = acc[ai][bj][m][0], b = acc[ai][bj][m][1];
#pragma unroll
                    for (int j = 0; j < 4; ++j) { a[j] = gelu_t(a[j]); b[j] = gelu_t(b[j]); }
                    *(u32x4*)(G + ((size_t)row * 16 + t) * 512 + u.z * 16 + i0) = pack8(a, b);
                }
            }
    }
};
struct EpiGlu {
    static constexpr bool PERM = true, MID = false;
    const bf16* G; const float* bias; bf16* AO; float* ss;
    __device__ __forceinline__ void operator()(AccRef acc, const pg8::Unit& u, int wr, int wc, int fr, int fq) const {
#pragma unroll
        for (int ai = 0; ai < 2; ++ai)
#pragma unroll
            for (int m = 0; m < 4; ++m) {
                const int row = u.pm * 256 + ai * 128 + wr * 64 + m * 16 + fr; float s2 = 0.f;
#pragma unroll
                for (int bj = 0; bj < 2; ++bj) {
                    const int col0 = u.pn * 256 + bj * 128 + wc * 32 + 8 * fq;
                    const u32x4 gv = *(const u32x4*)(G + (size_t)row * 512 + col0);
                    const f32x4 b0 = *(const f32x4*)(bias + col0), b1 = *(const f32x4*)(bias + col0 + 4);
                    f32x4 a = acc[ai][bj][m][0] + b0, b = acc[ai][bj][m][1] + b1;
                    a[0] = bflo(gv.x) * sigm(a[0]); a[1] = bfhi(gv.x) * sigm(a[1]); a[2] = bflo(gv.y) * sigm(a[2]); a[3] = bfhi(gv.y) * sigm(a[3]);
                    b[0] = bflo(gv.z) * sigm(b[0]); b[1] = bfhi(gv.z) * sigm(b[1]); b[2] = bflo(gv.w) * sigm(b[2]); b[3] = bfhi(gv.w) * sigm(b[3]);
#pragma unroll
                    for (int j = 0; j < 4; ++j) s2 += a[j] * a[j] + b[j] * b[j];
                    *(u32x4*)(AO + (size_t)row * 1024 + 512 + col0) = pack8(a, b);
                }
                s2 += __shfl_xor(s2, 16); s2 += __shfl_xor(s2, 32);
                if (fq == 0) ss[row * 8 + u.pn * 4 + wc] = s2;
            }
    }
};
struct EpiOutSS {
    static constexpr bool PERM = true, MID = false;
    bf16* O; float* ss;
    __device__ __forceinline__ void operator()(AccRef acc, const pg8::Unit& u, int wr, int wc, int fr, int fq) const {
#pragma unroll
        for (int ai = 0; ai < 2; ++ai)
#pragma unroll
            for (int m = 0; m < 4; ++m) {
                const int row = u.pm * 256 + ai * 128 + wr * 64 + m * 16 + fr; float s2 = 0.f;
#pragma unroll
                for (int bj = 0; bj < 2; ++bj) {
                    const int col0 = u.pn * 256 + bj * 128 + wc * 32 + 8 * fq;
                    const f32x4 a = acc[ai][bj][m][0], b = acc[ai][bj][m][1];
#pragma unroll
                    for (int j = 0; j < 4; ++j) s2 += a[j] * a[j] + b[j] * b[j];
                    *(u32x4*)(O + (size_t)row * 1024 + col0) = pack8(a, b);
                }
                s2 += __shfl_xor(s2, 16); s2 += __shfl_xor(s2, 32);
                if (fq == 0) ss[row * 16 + u.pn * 4 + wc] = s2;
            }
    }
};
struct EpiOutMix {
    static constexpr bool PERM = true, MID = true;
    bf16* O; float* ss; const LAS float* qv;
    __device__ __forceinline__ void mid(f32x4 (&acc)[2][2][4][2], const pg8::Unit& u, int wr, int fr) const {
#pragma unroll
        for (int ai = 0; ai < 2; ++ai)
#pragma unroll
            for (int m = 0; m < 4; ++m) { const float q = qv[u.ui * 256 + ai * 128 + wr * 64 + m * 16 + fr];
#pragma unroll
                for (int bj = 0; bj < 2; ++bj)
#pragma unroll
                    for (int n = 0; n < 2; ++n) acc[ai][bj][m][n] *= q; }
    }
    __device__ __forceinline__ void operator()(AccRef acc, const pg8::Unit& u, int wr, int wc, int fr, int fq) const {
#pragma unroll
        for (int ai = 0; ai < 2; ++ai)
#pragma unroll
            for (int m = 0; m < 4; ++m) {
                const int rl = ai * 128 + wr * 64 + m * 16 + fr, row = u.pm * 256 + rl; float s2 = 0.f; const float rs = qv[1024 + u.ui * 256 + rl];
#pragma unroll
                for (int bj = 0; bj < 2; ++bj) {
                    const int col0 = u.pn * 256 + bj * 128 + wc * 32 + 8 * fq;
                    const f32x4 a = acc[ai][bj][m][0] * rs, b = acc[ai][bj][m][1] * rs;
#pragma unroll
                    for (int j = 0; j < 4; ++j) s2 += a[j] * a[j] + b[j] * b[j];
                    *(u32x4*)(O + (size_t)row * 1024 + col0) = pack8(a, b);
                }
                s2 += __shfl_xor(s2, 16); s2 += __shfl_xor(s2, 32);
                if (fq == 0) ss[row * 16 + u.pn * 4 + wc] = s2;
            }
    }
};
struct EpiFF1 {
    static constexpr bool PERM = true, MID = false;
    bf16* H; const float* r;
    __device__ __forceinline__ void operator()(AccRef acc, const pg8::Unit& u, int wr, int wc, int fr, int fq) const {
#pragma unroll
        for (int ai = 0; ai < 2; ++ai)
#pragma unroll
            for (int m = 0; m < 4; ++m) {
                const int row = u.pm * 256 + ai * 128 + wr * 64 + m * 16 + fr; const float rs = r[row];
#pragma unroll
                for (int bj = 0; bj < 2; ++bj) {
                    const int col0 = u.pn * 256 + bj * 128 + wc * 32 + 8 * fq;
                    f32x4 a = acc[ai][bj][m][0] * rs, b = acc[ai][bj][m][1] * rs;
#pragma unroll
                    for (int j = 0; j < 4; ++j) { a[j] = fmaxf(a[j], 0.f); a[j] *= a[j]; b[j] = fmaxf(b[j], 0.f); b[j] *= b[j]; }
                    *(u32x4*)(H + (size_t)row * 4096 + col0) = pack8(a, b);
                }
            }
    }
};

__device__ __forceinline__ void transpose_item(const float* W, int ldw, bf16* WT, int ldt, const float* sc_lo, const float* sc_hi, int split,
                                               LAS float* scr, int item, int nblk, int lane) {
    const int kb = item / nblk, nb = item % nblk, k0 = 64 * kb, n0 = 64 * nb;
#pragma unroll 16
    for (int i = 0; i < 32; ++i) { const int kk = 2 * i + (lane >> 5), k = k0 + kk;
        float s = 1.f; if (sc_lo) s = (k < split) ? sc_lo[k] : sc_hi[k - split];
        const f32x2 w = *(const f32x2*)(W + (size_t)k * ldw + n0 + 2 * (lane & 31));
        scr[kk * 65 + 2 * (lane & 31)] = w[0] * s; scr[kk * 65 + 2 * (lane & 31) + 1] = w[1] * s; }
    asm volatile("s_waitcnt lgkmcnt(0)" ::: "memory");
    const int c = lane & 7;
#pragma unroll
    for (int j = 0; j < 8; ++j) { const int n = (lane >> 3) + 8 * j; const LAS float* s = scr + (8 * c) * 65 + n;
        u32x4 o; o.x = pk2(s[0 * 65], s[1 * 65]); o.y = pk2(s[2 * 65], s[3 * 65]); o.z = pk2(s[4 * 65], s[5 * 65]); o.w = pk2(s[6 * 65], s[7 * 65]);
        *(u32x4*)(WT + (size_t)(n0 + n) * ldt + k0 + 8 * c) = o; }
    asm volatile("s_waitcnt lgkmcnt(0)" ::: "memory");
}

__device__ __forceinline__ void ssm_mat_item(const Params& p, int item, LAS unsigned char* lds) {
    int tid = threadIdx.x; asm volatile("" : "+v"(tid)); const int ly = item >> 7, g = (item >> 2) & 31, qt = item & 3;
    LAS float* pwr = (LAS float*)lds;
    LAS float* pwi = pwr + 2 * 64 * 20;
    LAS float* bbr = pwi + 2 * 64 * 20;
    LAS float* bbi = bbr + 2 * 64 * 16;
    LAS float* ccr = bbi + 2 * 64 * 16;
    LAS float* cci = ccr + 2 * 16 * 64;
    LAS float* Gt = cci + 2 * 16 * 64;
    __syncthreads();
    { const int k = (tid >> 6) & 1, pp = tid & 63, tg = tid >> 7; const int idx = (ly * 2 + k) * 32 + g;
      const float dt = expf(p.log_dt[idx]); const float lr = p.lam_re[idx * 64 + pp] * dt, li = p.lam_im[idx * 64 + pp] * dt;
#pragma unroll
      for (int j = 0; j < 5; ++j) { const int tau = tg * 5 + j; if (tau <= 16) { const float e = __expf(lr * tau); float sn, cs; __sincosf(li * tau, &sn, &cs); pwr[(k * 64 + pp) * 20 + tau] = e * cs; pwi[(k * 64 + pp) * 20 + tau] = e * sn; } } }
    for (int i = tid; i < 2048; i += 512) { const int k = i >> 10, r = i & 1023; const int idx = (ly * 2 + k) * 32 + g; ccr[i] = p.c_re[(size_t)idx * 1024 + r]; cci[i] = p.c_im[(size_t)idx * 1024 + r]; }
    __syncthreads();
#pragma unroll
    for (int j = 0; j < 4; ++j) { const int o = tid + 512 * j, k = o >> 10, pp = (o >> 4) & 63, h = o & 15; const int idx = (ly * 2 + k) * 32 + g;
        const float lr = p.lam_re[idx * 64 + pp], li = p.lam_im[idx * 64 + pp], dt = expf(p.log_dt[idx]);
        float sn, cs; sincosf(li * dt, &sn, &cs); const float em1 = expm1f(lr * dt), sh = sinf(0.5f * li * dt);
        const float lbr = em1 * cs - 2.0f * sh * sh, lbi = (em1 + 1.0f) * sn;
        const float den = 1.0f / (lr * lr + li * li); const float cr = (lbr * lr + lbi * li) * den, ci = (lbi * lr - lbr * li) * den;
        const float br = p.b_re[(size_t)idx * 1024 + pp * 16 + h], bi = p.b_im[(size_t)idx * 1024 + pp * 16 + h];
        bbr[o] = cr * br - ci * bi; bbi[o] = cr * bi + ci * br; }
    __syncthreads();
    { const int k = tid >> 8, i = (tid >> 4) & 15, h = tid & 15; float a[16];
#pragma unroll
      for (int tau = 0; tau < 16; ++tau) a[tau] = 0.f;
#pragma nounroll
      for (int pp = 0; pp < 64; ++pp) { const float c_r = ccr[(k * 16 + i) * 64 + pp], c_i = cci[(k * 16 + i) * 64 + pp], b_r = bbr[(k * 64 + pp) * 16 + h], b_i = bbi[(k * 64 + pp) * 16 + h];
          const float xr = c_r * b_r - c_i * b_i, xi = c_r * b_i + c_i * b_r;
          const LAS f32x4* pr4 = (const LAS f32x4*)(pwr + (k * 64 + pp) * 20); const LAS f32x4* pi4 = (const LAS f32x4*)(pwi + (k * 64 + pp) * 20);
#pragma unroll
          for (int t4 = 0; t4 < 4; ++t4) { const f32x4 vr = pr4[t4], vi = pi4[t4];
#pragma unroll
              for (int e = 0; e < 4; ++e) a[t4 * 4 + e] += xr * vr[e] - xi * vi[e]; } }
#pragma unroll
      for (int tau = 0; tau < 16; ++tau) Gt[((k * 16 + tau) * 16 + i) * 16 + h] = a[tau]; }
    __syncthreads();
    bf16* TM = (bf16*)(p.ws + OFF_TM) + (size_t)(ly * 32 + g) * 256 * 512; bf16* MS = (bf16*)(p.ws + OFF_MST) + (size_t)(ly * 32 + g) * 256 * 256;
    const float* dsk = p.d_skip + (ly * 32 + g) * 16;
    for (int o = qt * 64 * 512 + tid; o < (qt + 1) * 64 * 512; o += 512) { const int r = o >> 9, col = o & 511, t = r >> 4, i = r & 15; float v;
        if (col < 256) { const int j = col >> 4, h = col & 15; v = 0.f;
            if (j <= t) v += Gt[((0 * 16 + (t - j)) * 16 + i) * 16 + h];
            if (j >= t) v += Gt[((1 * 16 + (j - t)) * 16 + i) * 16 + h];
            if (j == t && h == i) v += dsk[i]; }
        else { const int k = (col - 256) >> 7, q = (col - 256) & 127, pp = q >> 1, part = q & 1; const int tau = k == 0 ? (t + 1) : (16 - t);
            const float c_r = ccr[(k * 16 + i) * 64 + pp], c_i = cci[(k * 16 + i) * 64 + pp], l_r = pwr[(k * 64 + pp) * 20 + tau], l_i = pwi[(k * 64 + pp) * 20 + tau];
            v = part == 0 ? (c_r * l_r - c_i * l_i) : -(c_r * l_i + c_i * l_r); }
        TM[o] = (bf16)f2bf(v); }
    for (int o = qt * 64 * 256 + tid; o < (qt + 1) * 64 * 256; o += 512) { const int r = o >> 8, col = o & 255, k = r >> 7, q = r & 127, pp = q >> 1, part = q & 1, j = col >> 4, h = col & 15;
        const int tau = k == 0 ? (15 - j) : j;
        const float l_r = pwr[(k * 64 + pp) * 20 + tau], l_i = pwi[(k * 64 + pp) * 20 + tau], b_r = bbr[(k * 64 + pp) * 16 + h], b_i = bbi[(k * 64 + pp) * 16 + h];
        const float v = part == 0 ? (l_r * b_r - l_i * b_i) : (l_r * b_i + l_i * b_r);
        MS[o] = (bf16)f2bf(v); }
}

__device__ __forceinline__ void p0_prologue(const Params& p, LAS unsigned char* lds, int G, int bid) {
    int tid = threadIdx.x; asm volatile("" : "+v"(tid));
    const int lane = tid & 63, wave = __builtin_amdgcn_readfirstlane(tid >> 6);
    for (int rp = 0; rp < P0_REP_A; ++rp)
    for (int it = bid; it < 256; it += G) ssm_mat_item(p, it, lds);
    __syncthreads();
    {
        LAS float* scr = (LAS float*)(lds + wave * 16640);
        const int gw = bid * 8 + wave, NGW = G * 8;
        constexpr int I_IN = 16 * 16, I_OUT = 16 * 16, I_1 = 16 * 64, I_2 = 64 * 16, I_G = 8 * 8, I_L = I_IN + I_OUT + I_1 + I_2 + I_G;
        for (int rp = 0; rp < P0_REP_B; ++rp)
        for (int it = gw; it < 2 * I_L; it += NGW) {
            const int ly = it / I_L; int r = it % I_L; unsigned char* wb = p.ws + OFF_W + (size_t)ly * W_LAYER;
            if (r < I_IN) { transpose_item(p.w_in + (size_t)ly * 1024 * 1024, 1024, (bf16*)(wb + W_IN), 1024, p.pre_mix_g + ly * 1024, nullptr, 1 << 30, scr, r, 16, lane); continue; } r -= I_IN;
            if (r < I_OUT) { transpose_item(p.w_out + (size_t)ly * 1024 * 1024, 1024, (bf16*)(wb + W_OUT), 1024, p.fourier_out_g + ly * 512, p.ssm_out_g + ly * 512, 512, scr, r, 16, lane); continue; } r -= I_OUT;
            if (r < I_1) { transpose_item(p.w_ff1 + (size_t)ly * 1024 * 4096, 4096, (bf16*)(wb + W_1), 1024, p.pre_mlp_g + ly * 1024, nullptr, 1 << 30, scr, r, 64, lane); continue; } r -= I_1;
            if (r < I_2) { transpose_item(p.w_ff2 + (size_t)ly * 4096 * 1024, 1024, (bf16*)(wb + W_2), 4096, nullptr, nullptr, 0, scr, r, 16, lane); continue; } r -= I_2;
            transpose_item(p.w_glu + (size_t)ly * 512 * 512, 512, (bf16*)(wb + W_GLU), 512, nullptr, nullptr, 0, scr, r, 8, lane);
        }
        bf16* XB = (bf16*)(p.ws + OFF_XB); float* rA = (float*)(p.ws + OFF_RA);
        for (int rp = 0; rp < P0_REP_C; ++rp)
        for (int row0 = gw; row0 < MT; row0 += 4 * NGW) {
            f32x4 v[4][4];
#pragma unroll
            for (int rr = 0; rr < 4; ++rr) { const f32x4* xr = (const f32x4*)(p.x + (size_t)(row0 + rr * NGW) * 1024) + lane;
#pragma unroll
                for (int j = 0; j < 4; ++j) v[rr][j] = xr[64 * j]; }
#pragma unroll
            for (int rr = 0; rr < 4; ++rr) { const int row = row0 + rr * NGW; float s2 = 0.f;
                u32x2* o = (u32x2*)(XB + (size_t)row * 1024) + lane;
#pragma unroll
                for (int j = 0; j < 4; ++j) { const f32x4 t = v[rr][j]; s2 += t[0] * t[0] + t[1] * t[1] + t[2] * t[2] + t[3] * t[3]; u32x2 w; w.x = pk2(t[0], t[1]); w.y = pk2(t[2], t[3]); o[64 * j] = w; }
                s2 = wave_sum(s2);
                if (lane == 0) rA[row] = rsqrtf(s2 * (1.0f / 1024.0f) + EPS); }
        }
    }
    {
        bf16* D1 = (bf16*)(p.ws + OFF_D1); bf16* E3 = (bf16*)(p.ws + OFF_E3);
        const int gt = bid * 512 + tid, NT = G * 512;
        for (int idx = gt; idx < 64 * 2 * 128 * 128; idx += NT) { const int n2 = idx >> 15, sel = (idx >> 14) & 1, k1 = (idx >> 7) & 127, n1 = idx & 127;
            const int ph = (k1 * (64 * n1 + n2)) & 8191; float s, c; sincospif((float)ph * (1.0f / 4096.0f), &s, &c); D1[idx] = (bf16)f2bf(sel ? s : c); }
        bf16* E3I = (bf16*)(p.ws + OFF_E3I); bf16* FM = (bf16*)(p.ws + OFF_FMIX);
        for (int idx = gt; idx < 64 * 128; idx += NT) { const int k2 = idx >> 7, col = idx & 127, part = col >> 6, n2 = col & 63;
            const int ph = (n2 * k2) & 63; float s, c; sincospif((float)ph * (1.0f / 32.0f), &s, &c);
            E3[idx] = (bf16)f2bf(part ? s : c);
            E3I[idx] = (bf16)f2bf(part ? c : -s); }
        LAS float* cst = (LAS float*)lds;
        __syncthreads();
        if (tid < 64) { float sn, cs; sincospif((float)tid * (1.0f / 32.0f), &sn, &cs); cst[tid] = cs; cst[64 + tid] = sn; }
        __syncthreads();
        for (int idx = gt; idx < 2 * 8 * 64 * 128; idx += NT) { const int lh = idx >> 13, e = (idx >> 7) & 63, col = idx & 127, part = col >> 6, c = col & 63;
            const float* wf = p.w_fourier + (size_t)lh * 4096; float a = 0.f;
#pragma unroll 8
            for (int d = 0; d < 64; ++d) a += cst[64 * part + ((c * d) & 63)] * wf[d * 64 + e];
            FM[idx] = (bf16)f2bf(a * (1.0f / 724.0773439350247f)); }
    }
}

typedef short v4s16 __attribute__((ext_vector_type(4)));
__device__ __forceinline__ bf16x8 negbf(bf16x8 v) { u32x4 t = __builtin_bit_cast(u32x4, v); t = t ^ 0x80008000u; return __builtin_bit_cast(bf16x8, t); }
__device__ __forceinline__ bf16x8 tr_frag(const LAS unsigned char* a, int hs) {
    const v4s16 lo = __builtin_amdgcn_ds_read_tr16_b64_v4i16((LAS v4s16*)a), hi = __builtin_amdgcn_ds_read_tr16_b64_v4i16((LAS v4s16*)(a + hs));
    return __builtin_shufflevector(lo, hi, 0, 1, 2, 3, 4, 5, 6, 7);
}
constexpr int F1_P = 264, F1_CS = 128 * F1_P;
__device__ __forceinline__ void fft1_phase(const bf16* ZF, const bf16* D1, bf16* T, LAS unsigned char* lds, int G, int bid) {
    int tid = threadIdx.x; asm volatile("" : "+v"(tid));
    const int lane = tid & 63, wave = __builtin_amdgcn_readfirstlane(tid >> 6), wm = wave & 3, wn = wave >> 2, fr = lane & 15, fq = lane >> 4, tq = fr >> 2, tp = fr & 3;
    for (int pr = bid; pr < 256; pr += G) {
        const int n2 = pr & 63, cb = pr >> 6;
        __syncthreads();
        {
            const bf16* src = D1 + (size_t)n2 * 2 * 128 * 128;
#pragma unroll
            for (int j = 0; j < 8; ++j) { const int q = tid + 512 * j, sel = q >> 11, row = (q >> 4) & 127, cc = q & 15;
                *(LAS u32x4*)(lds + F1_CS + sel * 34816 + row * 272 + cc * 16) = *(const u32x4*)(src + sel * 16384 + row * 128 + 8 * cc); }
        }
        for (int b = 0; b < NB; ++b) {
            __syncthreads();
#pragma unroll
            for (int j = 0; j < 4; ++j) { const int q = tid + 512 * j, n1 = q >> 4, cc = q & 15;
                const u32x4 v = *(const u32x4*)(ZF + ((size_t)(b * SEQ + 64 * n1 + n2)) * 512 + cb * 128 + 8 * cc);
                LAS u32x2* d = (LAS u32x2*)(lds + n1 * F1_P + cc * 16); d[0] = (u32x2){v.x, v.y}; d[1] = (u32x2){v.z, v.w}; }
            __syncthreads();
            f32x4 Ar[2][4], Ai[2][4];
#pragma unroll
            for (int mb = 0; mb < 2; ++mb)
#pragma unroll
                for (int nb = 0; nb < 4; ++nb) { Ar[mb][nb] = (f32x4){0.f, 0.f, 0.f, 0.f}; Ai[mb][nb] = (f32x4){0.f, 0.f, 0.f, 0.f}; }
#pragma nounroll
            for (int ks = 0; ks < 4; ++ks) {
                bf16x8 Bf[4];
#pragma unroll
                for (int nb = 0; nb < 4; ++nb) Bf[nb] = tr_frag(lds + (32 * ks + 8 * fq + tq) * F1_P + (64 * wn + 16 * tp + 4 * nb) * 2, 4 * F1_P);
                bf16x8 Cf[2], Sf[2];
#pragma unroll
                for (int mb = 0; mb < 2; ++mb) { const int off = F1_CS + (32 * wm + 16 * mb + fr) * 272 + (32 * ks + 8 * fq) * 2; Cf[mb] = *(const LAS bf16x8*)(lds + off); Sf[mb] = *(const LAS bf16x8*)(lds + off + 34816); }
#pragma unroll
                for (int mb = 0; mb < 2; ++mb)
#pragma unroll
                    for (int nb = 0; nb < 4; ++nb) {
                        Ar[mb][nb] = __builtin_amdgcn_mfma_f32_16x16x32_bf16(Bf[nb], Cf[mb], Ar[mb][nb], 0, 0, 0);
                        Ai[mb][nb] = __builtin_amdgcn_mfma_f32_16x16x32_bf16(Bf[nb], negbf(Sf[mb]), Ai[mb][nb], 0, 0, 0); }
            }
#pragma unroll
            for (int mb = 0; mb < 2; ++mb) { const int k1 = 32 * wm + 16 * mb + fr, c = cb * 128 + 64 * wn + 16 * fq;
                bf16* t0 = T + ((((size_t)(b * 128 + k1) * 2 + 0) * 64 + n2) * 512 + c); bf16* t1 = t0 + 64 * 512;
                *(u32x4*)t0 = pack8(Ar[mb][0], Ar[mb][1]); *(u32x4*)(t0 + 8) = pack8(Ar[mb][2], Ar[mb][3]);
                *(u32x4*)t1 = pack8(Ai[mb][0], Ai[mb][1]); *(u32x4*)(t1 + 8) = pack8(Ai[mb][2], Ai[mb][3]); }
        }
    }
    __syncthreads();
}

constexpr int F3_P = 1088;
__device__ __forceinline__ bf16x8 pack8b(f32x4 a, f32x4 b) { return __builtin_bit_cast(bf16x8, pack8(a, b)); }
__device__ __forceinline__ void fft3_phase(const bf16* T, const bf16* E3, const bf16* E3I, const bf16* FM, bf16* AO, LAS unsigned char* lds, int G, int bid) {
    int tid = threadIdx.x; asm volatile("" : "+v"(tid));
    const int lane = tid & 63, wave = __builtin_amdgcn_readfirstlane(tid >> 6), fr = lane & 15, fq = lane >> 4, tq = fr >> 2, tp = fr & 3;
    LAS float* red = (LAS float*)(lds + 128 * F3_P);
#define F3_ISSUE(u_) do { const bf16* src_ = T + (size_t)(u_) * 65536; _Pragma("unroll") for (int j_ = 0; j_ < 16; ++j_) { const int row_ = wave * 16 + j_; \
        __builtin_amdgcn_global_load_lds((const unsigned*)(src_ + row_ * 512 + lane * 8), (LAS unsigned*)(lds + row_ * F3_P), 16, 0, 0); } } while (0)
    if (bid < 512) F3_ISSUE(bid);
    for (int unit = bid; unit < 512; unit += G) {
        const int b = unit >> 7, k1 = unit & 127;
        asm volatile("s_waitcnt vmcnt(0)" ::: "memory");
        __syncthreads();
        f32x4 gr[4][4], gi[4][4];
#pragma unroll
        for (int mb = 0; mb < 4; ++mb)
#pragma unroll
            for (int nb = 0; nb < 4; ++nb) { gr[mb][nb] = (f32x4){0.f, 0.f, 0.f, 0.f}; gi[mb][nb] = (f32x4){0.f, 0.f, 0.f, 0.f}; }
#pragma nounroll
        for (int ks = 0; ks < 4; ++ks) {
            bf16x8 Bf[4], Er[4], Ei[4];
#pragma unroll
            for (int mb = 0; mb < 4; ++mb) { const int off = (16 * mb + fr) * 128 + 32 * ks + 8 * fq; Er[mb] = *(const bf16x8*)(E3 + off); Ei[mb] = *(const bf16x8*)(E3I + off); }
#pragma unroll
            for (int nb = 0; nb < 4; ++nb) Bf[nb] = tr_frag(lds + (32 * ks + 8 * fq + tq) * F3_P + (64 * wave + 32 * (nb >> 1) + 8 * tp + 4 * (nb & 1)) * 2, 4 * F3_P);
#pragma unroll
            for (int mb = 0; mb < 4; ++mb)
#pragma unroll
                for (int nb = 0; nb < 4; ++nb) { gr[mb][nb] = __builtin_amdgcn_mfma_f32_16x16x32_bf16(Bf[nb], Er[mb], gr[mb][nb], 0, 0, 0);
                                                 gi[mb][nb] = __builtin_amdgcn_mfma_f32_16x16x32_bf16(Bf[nb], Ei[mb], gi[mb][nb], 0, 0, 0); }
        }
        __syncthreads();
        if (unit + G < 512) F3_ISSUE(unit + G);
        bf16x8 Af[4][4];
#pragma unroll
        for (int mb = 0; mb < 4; ++mb) { Af[0][mb] = pack8b(gr[mb][0], gr[mb][1]); Af[1][mb] = pack8b(gr[mb][2], gr[mb][3]); Af[2][mb] = pack8b(gi[mb][0], gi[mb][1]); Af[3][mb] = pack8b(gi[mb][2], gi[mb][3]); }
        f32x4 acc[4][4];
#pragma unroll
        for (int mb = 0; mb < 4; ++mb)
#pragma unroll
            for (int nb = 0; nb < 4; ++nb) acc[mb][nb] = (f32x4){0.f, 0.f, 0.f, 0.f};
        const bf16* fm = FM + (size_t)wave * 64 * 128;
#pragma unroll
        for (int kst = 0; kst < 4; ++kst) {
            bf16x8 Ff[4];
#pragma unroll
            for (int nb = 0; nb < 4; ++nb) Ff[nb] = *(const bf16x8*)(fm + (16 * tq + 4 * nb + tp) * 128 + 32 * kst + 8 * fq);
#pragma unroll
            for (int mb = 0; mb < 4; ++mb)
#pragma unroll
                for (int nb = 0; nb < 4; ++nb) acc[mb][nb] = __builtin_amdgcn_mfma_f32_16x16x32_bf16(Ff[nb], Af[kst][mb], acc[mb][nb], 0, 0, 0);
        }
#pragma unroll
        for (int mb = 0; mb < 4; ++mb) { float s = 0.f;
#pragma unroll
            for (int nb = 0; nb < 4; ++nb)
#pragma unroll
                for (int j = 0; j < 4; ++j) s += acc[mb][nb][j] * acc[mb][nb][j];
            s += __shfl_xor(s, 16); s += __shfl_xor(s, 32);
            if (fq == 0) red[wave * 64 + 16 * mb + fr] = s; }
        __syncthreads();
#pragma unroll
        for (int mb = 0; mb < 4; ++mb) { float tot = 0.f;
#pragma unroll
            for (int w = 0; w < 8; ++w) tot += red[w * 64 + 16 * mb + fr];
            const float rinv = rsqrtf(tot * (1.0f / 512.0f) + EPS);
            const size_t token = (size_t)b * SEQ + k1 + 128 * (16 * mb + fr);
            bf16* o = AO + token * 1024 + 64 * wave + 16 * fq;
            *(u32x4*)o = pack8(acc[mb][0] * rinv, acc[mb][1] * rinv); *(u32x4*)(o + 8) = pack8(acc[mb][2] * rinv, acc[mb][3] * rinv); }
    }
    __syncthreads();
}

__device__ __forceinline__ void carry_phase(const Params& p, int ly, const float* Sloc, bf16* UB, LAS unsigned char* lds, int G, int bid) {
    int tid = threadIdx.x; asm volatile("" : "+v"(tid));
    const int lane = tid & 63, wave = __builtin_amdgcn_readfirstlane(tid >> 6);
    LAS f32x2* ex = (LAS f32x2*)lds;
    for (int w = bid; w < 256; w += G) {
        const int dir = w & 1, g = (w >> 1) & 31, b = w >> 6, pp = lane; const int idx = (ly * 2 + dir) * 32 + g;
        const float dt = expf(p.log_dt[idx]); const float lr = p.lam_re[idx * 64 + pp] * dt * 16.0f, li = p.lam_im[idx * 64 + pp] * dt * 16.0f;
        const float e = expf(lr); float sn, cs; sincosf(li, &sn, &cs); const float l_r = e * cs, l_i = e * sn;
        float Lr = l_r, Li = l_i;
#pragma unroll
        for (int k = 0; k < 6; ++k) { const float nr = Lr * Lr - Li * Li, ni = 2.0f * Lr * Li; Lr = nr; Li = ni; }
        const float* src = Sloc + ((size_t)(g * 2048 + b * 512)) * 256 + dir * 128 + 2 * pp;
        bf16* dst = UB + ((size_t)(g * 2048 + b * 512)) * 512 + 256 + dir * 128 + 2 * pp;
        const int ss0 = dir == 0 ? wave * 64 : 511 - wave * 64; const long stp = dir == 0 ? 256 : -256;
        float cr = 0.f, ci = 0.f;
        { const float* ptr = src + (size_t)ss0 * 256;
#pragma nounroll
          for (int hb = 0; hb < 2; ++hb) {
            f32x2 v[32];
#pragma unroll
            for (int j = 0; j < 32; ++j) { v[j] = *(const f32x2*)ptr; ptr += stp; }
#pragma unroll
            for (int j = 0; j < 32; ++j) { const float nr = l_r * cr - l_i * ci + v[j][0], ni = l_r * ci + l_i * cr + v[j][1]; cr = nr; ci = ni; }
          } }
        __syncthreads();
        ex[wave * 64 + lane] = (f32x2){cr, ci};
        __syncthreads();
        cr = 0.f; ci = 0.f;
        for (int u = 0; u < wave; ++u) { const f32x2 eu = ex[u * 64 + lane]; const float nr = Lr * cr - Li * ci + eu[0], ni = Lr * ci + Li * cr + eu[1]; cr = nr; ci = ni; }
        { const float* ptr = src + (size_t)ss0 * 256; bf16* dp = dst + (size_t)ss0 * 512;
#pragma nounroll
          for (int hb = 0; hb < 2; ++hb) {
            f32x2 v[32];
#pragma unroll
            for (int j = 0; j < 32; ++j) { v[j] = *(const f32x2*)ptr; ptr += stp; }
#pragma unroll
            for (int j = 0; j < 32; ++j) {
                *(unsigned*)dp = pk2(cr, ci); dp += 2 * stp;
                const float nr = l_r * cr - l_i * ci + v[j][0], ni = l_r * ci + l_i * cr + v[j][1]; cr = nr; ci = ni; }
          } }
    }
    __syncthreads();
}

__device__ __forceinline__ void norm_phase(float* out, const bf16* MF, const float* ss, const float* gain, bf16* XB, float* rnext, bool last, int G, int bid) {
    int tid = threadIdx.x; asm volatile("" : "+v"(tid));
    const int lane = tid & 63, wave = __builtin_amdgcn_readfirstlane(tid >> 6);
    const int gw = bid * 8 + wave, NGW = G * 8;
    const f32x4* gr = (const f32x4*)gain + lane;
    const f32x4 g0 = gr[0], g1 = gr[64], g2 = gr[128], g3 = gr[192];
    for (int row0 = gw; row0 < MT; row0 += 2 * NGW) {
        u32x2 xv[2][4], mv[2][4]; float tot[2];
#pragma unroll
        for (int rr = 0; rr < 2; ++rr) { const int row = row0 + rr * NGW;
            const u32x2* xr = (const u32x2*)(XB + (size_t)row * 1024) + lane; const u32x2* mr = (const u32x2*)(MF + (size_t)row * 1024) + lane;
#pragma unroll
            for (int j = 0; j < 4; ++j) { xv[rr][j] = xr[64 * j]; mv[rr][j] = mr[64 * j]; }
            const f32x4* sp = (const f32x4*)(ss + (size_t)row * 16); const f32x4 s0 = sp[0], s1 = sp[1], s2 = sp[2], s3 = sp[3];
            tot[rr] = ((((s0[0] + s0[1]) + s0[2]) + s0[3]) + (((s1[0] + s1[1]) + s1[2]) + s1[3])) + ((((s2[0] + s2[1]) + s2[2]) + s2[3]) + (((s3[0] + s3[1]) + s3[2]) + s3[3])); }
#pragma unroll
        for (int rr = 0; rr < 2; ++rr) { const int row = row0 + rr * NGW;
            const float rinv = rsqrtf(tot[rr] * (1.0f / 1024.0f) + EPS); float s2 = 0.f;
#pragma unroll
            for (int j = 0; j < 4; ++j) { const f32x4 gg = j == 0 ? g0 : (j == 1 ? g1 : (j == 2 ? g2 : g3)); const u32x2 xx = xv[rr][j], mm = mv[rr][j]; f32x4 v;
                v[0] = bflo(xx.x) + bflo(mm.x) * rinv * gg[0]; v[1] = bfhi(xx.x) + bfhi(mm.x) * rinv * gg[1]; v[2] = bflo(xx.y) + bflo(mm.y) * rinv * gg[2]; v[3] = bfhi(xx.y) + bfhi(mm.y) * rinv * gg[3];
                if (last) { ((f32x4*)(out + (size_t)row * 1024) + lane)[64 * j] = v; }
                else { u32x2 w; w.x = pk2(v[0], v[1]); w.y = pk2(v[2], v[3]); ((u32x2*)(XB + (size_t)row * 1024) + lane)[64 * j] = w;
                       const float a0 = bflo(w.x), a1 = bfhi(w.x), a2 = bflo(w.y), a3 = bfhi(w.y); s2 += a0 * a0 + a1 * a1 + a2 * a2 + a3 * a3; } }
            if (!last) { s2 = wave_sum(s2); if (lane == 0) rnext[row] = rsqrtf(s2 * (1.0f / 1024.0f) + EPS); } }
    }
}
__device__ __forceinline__ void rescale_phase(bf16* AO, const float* ss, int G, int bid) {
    int tid = threadIdx.x; asm volatile("" : "+v"(tid));
    const int lane = tid & 63, wave = __builtin_amdgcn_readfirstlane(tid >> 6);
    const int gw = bid * 8 + wave, NGW = G * 8;
    for (int row = gw; row < MT; row += NGW) {
        float tot = 0.f;
#pragma unroll
        for (int k = 0; k < 8; ++k) tot += ss[row * 8 + k];
        const float rinv = rsqrtf(tot * (1.0f / 512.0f) + EPS);
        u32x4* ptr = (u32x4*)(AO + (size_t)row * 1024 + 512) + lane; u32x4 v = *ptr;
        v.x = pk2(bflo(v.x) * rinv, bfhi(v.x) * rinv); v.y = pk2(bflo(v.y) * rinv, bfhi(v.y) * rinv); v.z = pk2(bflo(v.z) * rinv, bfhi(v.z) * rinv); v.w = pk2(bflo(v.w) * rinv, bfhi(v.w) * rinv);
        *ptr = v;
    }
}


#define XB_TMO      128
#define XB_XCNT(j)  (256  + 64 * (j))
#define XB_XSUB(j)  (1280 + 64 * (j))
#define XB_XGEN(j)  (2304 + 64 * (j))
#define XB_TOP      3328
#define XB_TOPGEN   3392
#define XCD_BAR_WORDS 3456
#define XB_SPIN_CAP (1u << 18)
__device__ __forceinline__ unsigned xb_ld(unsigned* p)              { return __hip_atomic_load(p, __ATOMIC_RELAXED, __HIP_MEMORY_SCOPE_AGENT); }
__device__ __forceinline__ unsigned xb_add(unsigned* p, unsigned v) { return __hip_atomic_fetch_add(p, v, __ATOMIC_RELAXED, __HIP_MEMORY_SCOPE_AGENT); }
__device__ __forceinline__ unsigned xb_xcc_id() { return (unsigned)__builtin_amdgcn_s_getreg((3 << 11) | 20) & 0xFu; }
#define XB_SPIN(cond, bar) do { unsigned _sp = 0; while (cond) { __builtin_amdgcn_s_sleep(1); \
    if ((++_sp & 255u) == 0u) { if (xb_ld(&(bar)[XB_TMO])) break; if (_sp > XB_SPIN_CAP) { atomicAdd(&(bar)[XB_TMO], 1u); break; } } } } while (0)
struct XcdBarrier { unsigned* bar; unsigned x; volatile LAS unsigned* st; };
__device__ __forceinline__ XcdBarrier xcd_barrier_post(unsigned* bar, volatile LAS unsigned* st) {
    XcdBarrier b; b.bar = bar; b.x = xb_xcc_id(); b.st = st;
    if (threadIdx.x == 0) (void)xb_add(&bar[XB_XCNT(b.x)], 1u);
    return b;
}
__device__ __forceinline__ void xcd_barrier_complete(unsigned* bar, unsigned x, unsigned& nloc, unsigned& nx) {
    const unsigned G = gridDim.x * gridDim.y * gridDim.z;
    unsigned sum, cnt, mine, sp = 0u;
    for (;;) {
        sum = 0u; cnt = 0u; mine = 0u;
#pragma unroll
        for (unsigned j = 0; j < 16; ++j) { const unsigned c = xb_ld(&bar[XB_XCNT(j)]); sum += c; cnt += (c > 0u) ? 1u : 0u; mine = (j == x) ? c : mine; }
        if (sum == G) break;
        __builtin_amdgcn_s_sleep(1);
        if ((++sp & 255u) == 0u) { if (xb_ld(&bar[XB_TMO])) break; if (sp > XB_SPIN_CAP) { atomicAdd(&bar[XB_TMO], 1u); break; } }
    }
    nloc = mine > 0u ? mine : 1u; nx = cnt > 0u ? cnt : 1u;
}
__device__ __forceinline__ void xcd_barrier(const XcdBarrier& b) {
    asm volatile("s_waitcnt vmcnt(0)" ::: "memory");
    __syncthreads();
    if (threadIdx.x == 0) {
        unsigned* bar = b.bar;
        __builtin_amdgcn_s_waitcnt(0);
        unsigned nloc = b.st[0], nx = b.st[1];
        if (nloc == 0u) { xcd_barrier_complete(bar, b.x, nloc, nx); b.st[0] = nloc; b.st[1] = nx; }
        const unsigned old = xb_add(&bar[XB_XSUB(b.x)], 1u);
        const unsigned gen = old / nloc;
        if (old + 1u == (gen + 1u) * nloc) {
            __builtin_amdgcn_fence(__ATOMIC_RELEASE, "agent");
            asm volatile("s_waitcnt vmcnt(0)" ::: "memory");
            const unsigned og = xb_add(&bar[XB_TOP], 1u);
            const unsigned tg = og / nx;
            if (og + 1u == (tg + 1u) * nx) xb_add(&bar[XB_TOPGEN], 1u);
            else XB_SPIN(xb_ld(&bar[XB_TOPGEN]) == tg, bar);
            __builtin_amdgcn_fence(__ATOMIC_ACQUIRE, "agent");
            xb_add(&bar[XB_XGEN(b.x)], 1u);
            asm volatile("s_waitcnt vmcnt(0)" ::: "memory");
        } else {
            XB_SPIN(xb_ld(&bar[XB_XGEN(b.x)]) == gen, bar);
            __builtin_amdgcn_fence(__ATOMIC_ACQUIRE, "agent");
            asm volatile("s_waitcnt vmcnt(0)" ::: "memory");
        }
    }
    __syncthreads();
}

#ifndef REP_P0
#define REP_P0 1
#endif
#ifndef REP_SYNC
#define REP_SYNC 1
#endif
#ifndef REP_MASK_V
#define REP_MASK_V 0u
#endif
constexpr unsigned REP_MASK = REP_MASK_V;
constexpr int PH_PER_LAYER = 10, N_PHASES = 1 + 2 * PH_PER_LAYER;
__global__ void __launch_bounds__(512) hybrid_fwd(Params p) {
    extern __shared__ __attribute__((aligned(16))) unsigned char lds_raw[];
    LAS unsigned char* lds = (LAS unsigned char*)lds_raw;
    cg::grid_group grid = cg::this_grid();
    volatile LAS unsigned* xst = (volatile LAS unsigned*)(lds + LDS_BYTES - 16);
    if (threadIdx.x < 4) xst[threadIdx.x] = 0u;
    __syncthreads();
    const XcdBarrier xbar = xcd_barrier_post((unsigned*)(p.ws + OFF_BAR), xst);
    if (p.ph_hi > 1000) grid.sync();
    const int Gk = gridDim.x, bk = blockIdx.x;
    unsigned char* ws = p.ws;
    float* sss = (float*)(ws + OFF_SSS); float* ssm = (float*)(ws + OFF_SSM); float* ssf = (float*)(ws + OFF_SSF); float* rA = (float*)(ws + OFF_RA); float* rB = (float*)(ws + OFF_RB);
    bf16* XB = (bf16*)(ws + OFF_XB); bf16* MF = (bf16*)(ws + OFF_MF); bf16* GB = (bf16*)(ws + OFF_G); bf16* HB = (bf16*)(ws + OFF_H);
    bf16* PQ = (bf16*)(ws + OFF_PQ); bf16* AO = (bf16*)(ws + OFF_AO); bf16* UB = (bf16*)(ws + OFF_UB); bf16* TB = (bf16*)(ws + OFF_T); float* SL = (float*)(ws + OFF_SLOC);

#pragma nounroll
    for (int ph = p.ph_lo; ph < p.ph_hi; ++ph) {
        int G = Gk, bid = bk; asm volatile("" : "+s"(G), "+s"(bid));
        if (ph == 0) { for (int rep = 0; rep < REP_P0; ++rep) p0_prologue(p, lds, G, bid); }
        else {
            const int ly = (ph - 1) / PH_PER_LAYER, sp = (ph - 1) % PH_PER_LAYER;
            unsigned char* wb = ws + OFF_W + (size_t)ly * W_LAYER;
            pg8::Order S;
            const int nrep = ((REP_MASK >> sp) & 1u) ? 2 : 1;
            for (int rep = 0; rep < nrep; ++rep)
            switch (sp) {
            case 0: {
                pg8::Gemm g{XB, (const bf16*)(wb + W_IN), MT, NIN, 1024, 1024, 1024, 0, 0, 1}; S.init(MT, NIN, 1, G, bid, WGM_IN);
                EpiIn E{PQ, UB, rA}; pg8::gemm_phase<EpiIn>(lds, g, S, E); } break;
            case 1: {
                fft1_phase(PQ, (const bf16*)(ws + OFF_D1), TB, lds, G, bid);
                pg8::Gemm g{UB, (const bf16*)(ws + OFF_MST) + (size_t)ly * 32 * 256 * 256, 2048, 256, 256, 512, 256, (size_t)2048 * 512, (size_t)256 * 256, 32}; S.init(2048, 256, 32, G, bid);
                EpiSloc E{SL}; pg8::gemm_phase<EpiSloc>(lds, g, S, E); } break;
            case 2: {
                carry_phase(p, ly, SL, UB, lds, G, bid);
                fft3_phase(TB, (const bf16*)(ws + OFF_E3), (const bf16*)(ws + OFF_E3I), (const bf16*)(ws + OFF_FMIX) + (size_t)ly * 8 * 64 * 128, AO, lds, G, bid); } break;
            case 3: {
                pg8::Gemm g{UB, (const bf16*)(ws + OFF_TM) + (size_t)ly * 32 * 256 * 512, 2048, 256, 512, 512, 512, (size_t)2048 * 512, (size_t)256 * 512, 32}; S.init(2048, 256, 32, G, bid);
                EpiSsmOut E{GB}; pg8::gemm_phase<EpiSsmOut>(lds, g, S, E); } break;
            case 4: {
                pg8::Gemm g{GB, (const bf16*)(wb + W_GLU), MT, 512, 512, 512, 512, 0, 0, 1}; S.init(MT, 512, 1, G, bid, WGM_GLU);
                EpiGlu E{GB, p.b_glu + ly * 512, AO, sss}; pg8::gemm_phase<EpiGlu>(lds, g, S, E); } break;
            case 5: {
                pg8::Gemm g{AO, (const bf16*)(wb + W_OUT), MT, 1024, 1024, 1024, 1024, 0, 0, 1}; S.init(MT, 1024, 1, G, bid, WGM_OUT);
                LAS float* qv = (LAS float*)(lds + 131072);
                { int tid = threadIdx.x; asm volatile("" : "+v"(tid));
                  for (int i = 0; i < 4; ++i) { pg8::Unit u; if (!S.next(i, u)) break;
                      if (tid < 256) { const f32x4* sp = (const f32x4*)(sss + (size_t)(u.pm * 256 + tid) * 8); const f32x4 a = sp[0], b = sp[1];
                          const float ms = ((((a[0] + a[1]) + a[2]) + a[3]) + (((b[0] + b[1]) + b[2]) + b[3])) * (1.0f / 512.0f) + EPS;
                          qv[i * 256 + tid] = sqrtf(ms); qv[1024 + i * 256 + tid] = rsqrtf(ms); } }
                  __syncthreads(); }
                EpiOutMix E{MF, ssm, qv}; pg8::gemm_phase<EpiOutMix>(lds, g, S, E); } break;
            case 6: norm_phase(p.out, MF, ssm, p.post_mix_g + ly * 1024, XB, rB, false, G, bid); break;
            case 7: {
                pg8::Gemm g{XB, (const bf16*)(wb + W_1), MT, DFF, 1024, 1024, 1024, 0, 0, 1}; S.init(MT, DFF, 1, G, bid, WGM_FF1);
                EpiFF1 E{HB, rB}; pg8::gemm_phase<EpiFF1>(lds, g, S, E); } break;
            case 8: {
                pg8::Gemm g{HB, (const bf16*)(wb + W_2), MT, 1024, DFF, DFF, DFF, 0, 0, 1}; S.init(MT, 1024, 1, G, bid, WGM_FF2);
                EpiOutSS E{MF, ssf}; pg8::gemm_phase<EpiOutSS>(lds, g, S, E); } break;
            case 9: norm_phase(p.out, MF, ssf, p.post_mlp_g + ly * 1024, XB, rA, ly == 1, G, bid); break;
            }
        }
        if (ph + 1 < p.ph_hi) for (int rep = 0; rep < REP_SYNC; ++rep) xcd_barrier(xbar);
    }
}

extern "C" void kernel_launch(void* const* d_in, const int* in_sizes, int n_in, void* d_out, int out_size, void* d_ws, size_t ws_size, hipStream_t stream) {
    static int grid = 0;
    if (grid == 0) {
        if (n_in != 22 || ws_size < WS_END) { fprintf(stderr, "kernel_launch: unexpected n_in %d or ws_size %zu (< %zu)\n", n_in, ws_size, (size_t)WS_END); grid = -1; return; }
        int dev = 0, cus = 0, per_cu = 0;
        hipGetDevice(&dev); hipDeviceGetAttribute(&cus, hipDeviceAttributeMultiprocessorCount, dev);
        if (hipFuncSetAttribute((const void*)hybrid_fwd, hipFuncAttributeMaxDynamicSharedMemorySize, LDS_BYTES) != hipSuccess) { fprintf(stderr, "kernel_launch: hipFuncSetAttribute failed\n"); grid = -1; return; }
        if (hipOccupancyMaxActiveBlocksPerMultiprocessor(&per_cu, (const void*)hybrid_fwd, 512, LDS_BYTES) != hipSuccess || per_cu < 1) { fprintf(stderr, "kernel_launch: occupancy query says %d blocks per CU\n", per_cu); per_cu = 1; }
        (void)hipGetLastError();
        grid = cus;
    }
    if (grid < 0) return;
    if (hipMemsetAsync((char*)d_ws + OFF_BAR, 0, BAR_BYTES, stream) != hipSuccess) { fprintf(stderr, "kernel_launch: memset of the barrier words failed\n"); return; }
    Params p{};
    const float** f = (const float**)&p;
    for (int i = 0; i < 22; ++i) f[i] = (const float*)d_in[i];
    p.out = (float*)d_out; p.ws = (unsigned char*)d_ws; p.ph_lo = 0; p.ph_hi = N_PHASES;
    void* args[] = {&p};
    hipError_t e = hipLaunchCooperativeKernel((const void*)hybrid_fwd, dim3(grid), dim3(512), args, LDS_BYTES, stream);
    if (e != hipSuccess) fprintf(stderr, "kernel_launch: cooperative launch failed: %s (grid %d)\n", hipGetErrorString(e), grid);
}
```

```cpp
#include <hip/hip_runtime.h>
#include <hip/hip_cooperative_groups.h>
#include <cstdio>
namespace cg = cooperative_groups;

#define P0_REP_A 1
#define WGM_FF1 4
#define WGM_IN 2
#define WGM_OUT 4
#define WGM_GLU 4
#define WGM_FF2 4
#define P0_REP_F 1
#define P0_REP_S 1
#define P0_REP_B 1
#define P0_REP_C 1
#define LAS __attribute__((address_space(3)))
typedef unsigned short bf16;
typedef short bf16x8 __attribute__((ext_vector_type(8)));
typedef float f32x4 __attribute__((ext_vector_type(4)));
typedef float f32x2 __attribute__((ext_vector_type(2)));
typedef unsigned u32x4 __attribute__((ext_vector_type(4)));
typedef unsigned u32x2 __attribute__((ext_vector_type(2)));

constexpr int NB = 4, SEQ = 8192, DM = 1024, MT = NB * SEQ, DFO = 512, NHEAD = 8, SG = 32, SP = 64, DFF = 4096, NIN = 1024;
constexpr float EPS = 1e-6f;
constexpr int LDS_BYTES = 147456;
constexpr size_t MiB = 1u << 20;
constexpr size_t OFF_RA = 384 * 1024, OFF_RB = 512 * 1024, OFF_BAR = 640 * 1024, BAR_BYTES = 16384;
constexpr size_t OFF_E3I = 1 * MiB + 16384, OFF_FMIX = 1 * MiB + 65536;
constexpr size_t OFF_E3 = 1 * MiB, OFF_D1 = 2 * MiB, OFF_TM = 6 * MiB, OFF_MST = 22 * MiB, OFF_W = 30 * MiB;
constexpr size_t W_IN = 0, W_OUT = 3 * MiB, W_1 = 5 * MiB, W_2 = 13 * MiB, W_GLU = 21 * MiB, W_LAYER = 22 * MiB;
constexpr size_t OFF_XB = 76 * MiB, OFF_MF = 140 * MiB, OFF_G = 140 * MiB, OFF_H = 204 * MiB;
constexpr size_t OFF_PQ = 204 * MiB, OFF_AO = 204 * MiB, OFF_UB = 268 * MiB, OFF_T = 332 * MiB, OFF_SLOC = 396 * MiB, OFF_SSS = 460 * MiB, OFF_SSM = 461 * MiB, OFF_SSF = 463 * MiB, WS_END = 465 * MiB;

struct Params {
    const float *x, *w_in, *w_out, *pre_mix_g, *post_mix_g, *pre_mlp_g, *post_mlp_g, *fourier_out_g, *ssm_out_g, *w_fourier,
        *lam_re, *lam_im, *log_dt, *b_re, *b_im, *c_re, *c_im, *d_skip, *w_glu, *b_glu, *w_ff1, *w_ff2;
    float* out; unsigned char* ws;
    int ph_lo, ph_hi;
};

__device__ __forceinline__ unsigned f2bf(float f) { unsigned u = __builtin_bit_cast(unsigned, f); return (u + 0x7fffu + ((u >> 16) & 1u)) >> 16; }
typedef __bf16 hwbf2 __attribute__((ext_vector_type(2)));
__device__ __forceinline__ unsigned pk2(float lo, float hi) { const f32x2 v = {lo, hi}; return __builtin_bit_cast(unsigned, __builtin_convertvector(v, hwbf2)); }
__device__ __forceinline__ float bflo(unsigned w) { return __builtin_bit_cast(float, w << 16); }
__device__ __forceinline__ float bfhi(unsigned w) { return __builtin_bit_cast(float, w & 0xffff0000u); }
__device__ __forceinline__ float wave_sum(float v) {
#pragma unroll
    for (int o = 1; o < 64; o <<= 1) v += __shfl_xor(v, o);
    return v;
}
__device__ __forceinline__ float gelu_t(float x) { const float u = 0.7978845608f * (x + 0.044715f * x * x * x); return x * __builtin_amdgcn_rcpf(1.0f + __expf(-2.0f * u)); }
__device__ __forceinline__ float sigm(float v) { return __builtin_amdgcn_rcpf(1.0f + __expf(-v)); }

namespace pg8 {
#define PG8_LAS __attribute__((address_space(3)))
typedef unsigned short bf16_t;
constexpr int BM = 256, BK = 64, HALF = 128, HTB = HALF * BK * 2, STAGE_BYTES = 8 * HTB, NXCD = 8, WGM = 4;
__host__ __device__ __forceinline__ int lds_byte(int r, int c) { const int st = (r >> 4) * 2 + (c >> 5), rr = r & 15, cc = c & 31, ob = rr * 64 + cc * 2; return st * 1024 + (ob ^ (((ob >> 9) & 1) << 5)); }
__host__ __device__ __forceinline__ void stage_rc(int b, int& R, int& C) { const int st = b / 1024, sb = b % 1024, swz = sb ^ (((sb >> 9) & 1) << 5); R = (st >> 1) * 16 + swz / 64; C = (st & 1) * 32 + (swz % 64) / 2; }
__host__ __device__ __forceinline__ int perm32(int rho) { const int n = rho >> 4, i = rho & 15; return 8 * (i >> 2) + 4 * n + (i & 3); }

struct Unit { int pm, pn, z, ui; };
struct Gemm { const bf16_t* A; const bf16_t* Bt; int M, N, K, lda, ldb; size_t sA, sB; int nZ; };

struct Order {
    int nM, nN, nwg, nZ, G, c, wgm;
    __device__ void init(int M, int N, int nZ_, int G_, int c_, int wgm_ = WGM) { nM = M / BM; nN = N / BM; nwg = nM * nN; nZ = nZ_; G = G_; c = c_; wgm = wgm_; }
    __device__ bool next(int i, Unit& u) const {
        const long L = (long)i * G + c; if (L >= (long)nwg * nZ) return false;
        u.ui = i;
        if (nZ > 1 && (nZ % NXCD) == 0) {
            const int xcd = (int)(L % NXCD), idx = (int)(L / NXCD); u.z = xcd * (nZ / NXCD) + idx / nwg; const int wg = idx % nwg; u.pm = wg % nM; u.pn = wg / nM; return true; }
        u.z = (int)(L / nwg);
        int wgid = (int)(L % nwg); { const int q = nwg / NXCD, r = nwg % NXCD, xcd = wgid % NXCD, off = wgid / NXCD; wgid = (xcd < r ? xcd * (q + 1) : r * (q + 1) + (xcd - r) * q) + off; }
        const int nig = wgm * nN, gid = wgid / nig, fm = gid * wgm, gsz = (nM - fm) < wgm ? (nM - fm) : wgm;
        u.pm = fm + ((wgid % nig) % gsz); u.pn = (wgid % nig) / gsz; return true;
    }
};

template <class Epi>
__device__ __forceinline__ void gemm_phase(PG8_LAS unsigned char* lds, const Gemm g, const Order& S, const Epi& E) {
    int tid = threadIdx.x; asm volatile("" : "+v"(tid));
    const int wid = __builtin_amdgcn_readfirstlane(tid >> 6), lane = tid & 63, wr = wid >> 2, wc = wid & 3, fr = lane & 15, fq = lane >> 4;
    const int K = g.K, nt = K / BK;
    unsigned voffA[2], voffB[2];
#pragma unroll
    for (int i = 0; i < 2; ++i) { int R, C; stage_rc(tid * 16 + i * 8192, R, C); const int Rb = Epi::PERM ? ((R & ~31) + perm32(R & 31)) : R;
        voffA[i] = (unsigned)(R * g.lda + C) * 2u; voffB[i] = (unsigned)(Rb * g.ldb + C) * 2u; }
    const size_t kstep = (size_t)(BK * 2);
    const size_t hA = (size_t)HALF * g.lda * 2, hB = (size_t)HALF * g.ldb * 2;
    const size_t tA = 2 * hA, tB = 2 * hB;
    const unsigned ldsw = (unsigned)wid * 1024u;
    const int aoff = lds_byte(wr * 64 + fr, fq * 8), boff = lds_byte(wc * 32 + fr, fq * 8);
#define PG8_SA(b, h) (((b) * 2 + (h)) * HTB)
#define PG8_SB(b, h) ((4 + (b) * 2 + (h)) * HTB)
#define PG8_STAGE(bufoff, gbase, voff) do { _Pragma("unroll") for (int _i = 0; _i < 2; ++_i) \
        __builtin_amdgcn_global_load_lds((const unsigned*)((const char*)(gbase) + (voff)[_i]), (PG8_LAS unsigned*)(lds + (bufoff) + ldsw + _i * 8192), 16, 0, 0); } while (0)
#define PG8_LDA(dst, b, h) do { _Pragma("unroll") for (int m = 0; m < 4; ++m) _Pragma("unroll") for (int k = 0; k < 2; ++k) dst[m][k] = *(const PG8_LAS bf16x8*)(lds + PG8_SA(b, h) + aoff + m * 2048 + k * 1024); } while (0)
#define PG8_LDB(dst, b, h) do { _Pragma("unroll") for (int n = 0; n < 2; ++n) _Pragma("unroll") for (int k = 0; k < 2; ++k) dst[n][k] = *(const PG8_LAS bf16x8*)(lds + PG8_SB(b, h) + boff + n * 2048 + k * 1024); } while (0)
#define PG8_MMA(ai, bj, At, Bt) do { __builtin_amdgcn_s_setprio(1); _Pragma("unroll") for (int m = 0; m < 4; ++m) _Pragma("unroll") for (int n = 0; n < 2; ++n) _Pragma("unroll") for (int k = 0; k < 2; ++k) \
        acc[ai][bj][m][n] = __builtin_amdgcn_mfma_f32_16x16x32_bf16(Bt[n][k], At[m][k], acc[ai][bj][m][n], 0, 0, 0); __builtin_amdgcn_s_setprio(0); } while (0)
#define PG8_WAIT_V(n) asm volatile("s_waitcnt vmcnt(" #n ")" ::: "memory")
#define PG8_WAIT_L(n) asm volatile("s_waitcnt lgkmcnt(" #n ")" ::: "memory")
#define PG8_BAR __builtin_amdgcn_s_barrier()
#define PG8_SCHED __builtin_amdgcn_sched_barrier(0)
    Unit cur, nxt; int ui = 0;
    if (!S.next(0, cur)) return;
    f32x4 acc[2][2][4][2];
#pragma unroll
    for (int a = 0; a < 2; ++a)
#pragma unroll
        for (int b = 0; b < 2; ++b)
#pragma unroll
            for (int m = 0; m < 4; ++m)
#pragma unroll
                for (int n = 0; n < 2; ++n) acc[a][b][m][n] = (f32x4){0.f, 0.f, 0.f, 0.f};
    bf16x8 At[4][2], B0[2][2], B1[2][2];
    const char* cA = (const char*)g.A + ((size_t)cur.z * g.sA) * 2 + (size_t)cur.pm * tA; const char* cB = (const char*)g.Bt + ((size_t)cur.z * g.sB) * 2 + (size_t)cur.pn * tB;
    PG8_STAGE(PG8_SB(0, 0), cB, voffB); PG8_STAGE(PG8_SA(0, 0), cA, voffA); PG8_STAGE(PG8_SB(0, 1), cB + hB, voffB); PG8_STAGE(PG8_SA(0, 1), cA + hA, voffA);
    if (wr == 1) PG8_BAR;
    PG8_WAIT_V(4); PG8_BAR;
    PG8_STAGE(PG8_SB(1, 0), cB + kstep, voffB); PG8_STAGE(PG8_SA(1, 0), cA + kstep, voffA); PG8_STAGE(PG8_SB(1, 1), cB + hB + kstep, voffB);
    PG8_WAIT_V(6); PG8_BAR;
    for (;;) {
        const bool has_next = S.next(ui + 1, nxt);
        const char* nA = has_next ? (const char*)g.A + ((size_t)nxt.z * g.sA) * 2 + (size_t)nxt.pm * tA : cA; const char* nB = has_next ? (const char*)g.Bt + ((size_t)nxt.z * g.sB) * 2 + (size_t)nxt.pn * tB : cB;
        for (int t = 0; t < nt; t += 2) {
            const bool last = (t == nt - 2);
            if constexpr (Epi::MID) { if (t == (nt >> 1)) E.mid(acc, cur, wr, fr); }
            const char* a1 = cA + (size_t)(t + 1) * kstep;
            const char* a2 = last ? nA : cA + (size_t)(t + 2) * kstep; const char* b2 = last ? nB : cB + (size_t)(t + 2) * kstep;
            const char* a3 = a2 + kstep; const char* b3 = b2 + kstep;
            PG8_LDB(B0, 0, 0); PG8_SCHED; PG8_LDA(At, 0, 0); PG8_STAGE(PG8_SA(1, 1), a1 + hA, voffA);
            PG8_WAIT_L(8); PG8_BAR; PG8_WAIT_L(0); PG8_MMA(0, 0, At, B0); PG8_BAR; PG8_SCHED;
            PG8_LDB(B1, 0, 1); PG8_STAGE(PG8_SB(0, 0), b2, voffB);
            PG8_BAR; PG8_WAIT_L(0); PG8_MMA(0, 1, At, B1); PG8_BAR;
            PG8_LDA(At, 0, 1); PG8_STAGE(PG8_SA(0, 0), a2, voffA);
            PG8_BAR; PG8_WAIT_L(0); PG8_MMA(1, 0, At, B0); PG8_BAR; PG8_SCHED;
            PG8_STAGE(PG8_SB(0, 1), b2 + hB, voffB);
            PG8_WAIT_V(6); PG8_BAR; PG8_MMA(1, 1, At, B1); PG8_BAR;
            PG8_LDB(B0, 1, 0); PG8_SCHED; PG8_LDA(At, 1, 0); PG8_STAGE(PG8_SA(0, 1), a2 + hA, voffA);
            PG8_WAIT_L(8); PG8_BAR; PG8_WAIT_L(0); PG8_MMA(0, 0, At, B0); PG8_BAR; PG8_SCHED;
            PG8_LDB(B1, 1, 1); PG8_STAGE(PG8_SB(1, 0), b3, voffB);
            PG8_BAR; PG8_WAIT_L(0); PG8_MMA(0, 1, At, B1); PG8_BAR;
            PG8_LDA(At, 1, 1); PG8_STAGE(PG8_SA(1, 0), a3, voffA);
            PG8_BAR; PG8_WAIT_L(0); PG8_MMA(1, 0, At, B0); PG8_BAR; PG8_SCHED;
            PG8_STAGE(PG8_SB(1, 1), b3 + hB, voffB);
            PG8_WAIT_V(6); PG8_BAR; PG8_MMA(1, 1, At, B1); PG8_BAR;
        }
        E(acc, cur, wr, wc, fr, fq);
        if (!has_next) break;
#pragma unroll
        for (int a = 0; a < 2; ++a)
#pragma unroll
            for (int b = 0; b < 2; ++b)
#pragma unroll
                for (int m = 0; m < 4; ++m)
#pragma unroll
                    for (int n = 0; n < 2; ++n) acc[a][b][m][n] = (f32x4){0.f, 0.f, 0.f, 0.f};
        cur = nxt; cA = nA; cB = nB; ++ui;
    }
    PG8_WAIT_V(0);
    if (wr == 0) PG8_BAR;
    PG8_BAR;
#undef PG8_SA
#undef PG8_SB
#undef PG8_STAGE
#undef PG8_LDA
#undef PG8_LDB
#undef PG8_MMA
#undef PG8_WAIT_V
#undef PG8_WAIT_L
#undef PG8_BAR
#undef PG8_SCHED
}
}

typedef const f32x4 (&AccRef)[2][2][4][2];
__device__ __forceinline__ u32x4 pack8(f32x4 a, f32x4 b) { u32x4 w; w.x = pk2(a[0], a[1]); w.y = pk2(a[2], a[3]); w.z = pk2(b[0], b[1]); w.w = pk2(b[2], b[3]); return w; }

struct EpiIn {
    static constexpr bool PERM = true, MID = false;
    bf16* ZF; bf16* UB; const float* r;
    __device__ __forceinline__ void operator()(AccRef acc, const pg8::Unit& u, int wr, int wc, int fr, int fq) const {
#pragma unroll
        for (int ai = 0; ai < 2; ++ai)
#pragma unroll
            for (int m = 0; m < 4; ++m) {
                const int row = u.pm * 256 + ai * 128 + wr * 64 + m * 16 + fr; const float rs = r[row];
#pragma unroll
                for (int bj = 0; bj < 2; ++bj) {
                    const int col0 = u.pn * 256 + bj * 128 + wc * 32 + 8 * fq;
                    const u32x4 w = pack8(acc[ai][bj][m][0] * rs, acc[ai][bj][m][1] * rs);
                    if (col0 < 512) *(u32x4*)(ZF + (size_t)row * 512 + col0) = w;
                    else { const int c2 = col0 - 512, gg = c2 >> 4, h0 = c2 & 15; *(u32x4*)(UB + ((size_t)(gg * 2048 + (row >> 4)) * 512 + (row & 15) * 16 + h0)) = w; }
                }
            }
    }
};
struct EpiSloc {
    static constexpr bool PERM = false, MID = false;
    float* S;
    __device__ __forceinline__ void operator()(AccRef acc, const pg8::Unit& u, int wr, int wc, int fr, int fq) const {
#pragma unroll
        for (int ai = 0; ai < 2; ++ai)
#pragma unroll
            for (int m = 0; m < 4; ++m) {
                const int row = u.pm * 256 + ai * 128 + wr * 64 + m * 16 + fr;
                float* rp = S + ((size_t)u.z * 2048 + row) * 256 + wc * 32 + 4 * fq;
#pragma unroll
                for (int bj = 0; bj < 2; ++bj)
#pragma unroll
                    for (int n = 0; n < 2; ++n) *(f32x4*)(rp + bj * 128 + n * 16) = acc[ai][bj][m][n];
            }
    }
};
struct EpiSsmOut {
    static constexpr bool PERM = true, MID = false;
    bf16* G;
    __device__ __forceinline__ void operator()(AccRef acc, const pg8::Unit& u, int wr, int wc, int fr, int fq) const {
#pragma unroll
        for (int ai = 0; ai < 2; ++ai)
#pragma unroll
            for (int m = 0; m < 4; ++m) {
                const int row = u.pm * 256 + ai * 128 + wr * 64 + m * 16 + fr;
#pragma unroll
                for (int bj = 0; bj < 2; ++bj) {
                    const int col0 = bj * 128 + wc * 32 + 8 * fq, t = col0 >> 4, i0 = col0 & 15;
                    f32x4 a = acc[ai][bj][m][0], b = acc[ai][bj][m][1];
#pragma unroll
                    for (int j = 0; j < 4; ++j) { a[j] = gelu_t(a[j]); b[j] = gelu_t(b[j]); }
                    *(u32x4*)(G + ((size_t)row * 16 + t) * 512 + u.z * 16 + i0) = pack8(a, b);
                }
            }
    }
};
struct EpiGlu {
    static constexpr bool PERM = true, MID = false;
    const bf16* G; const float* bias; bf16* AO; float* ss;
    __device__ __forceinline__ void operator()(AccRef acc, const pg8::Unit& u, int wr, int wc, int fr, int fq) const {
#pragma unroll
        for (int ai = 0; ai < 2; ++ai)
#pragma unroll
            for (int m = 0; m < 4; ++m) {
                const int row = u.pm * 256 + ai * 128 + wr * 64 + m * 16 + fr; float s2 = 0.f;
#pragma unroll
                for (int bj = 0; bj < 2; ++bj) {
                    const int col0 = u.pn * 256 + bj * 128 + wc * 32 + 8 * fq;
                    const u32x4 gv = *(const u32x4*)(G + (size_t)row * 512 + col0);
                    const f32x4 b0 = *(const f32x4*)(bias + col0), b1 = *(const f32x4*)(bias + col0 + 4);
                    f32x4 a = acc[ai][bj][m][0] + b0, b = acc[ai][bj][m][1] + b1;
                    a[0] = bflo(gv.x) * sigm(a[0]); a[1] = bfhi(gv.x) * sigm(a[1]); a[2] = bflo(gv.y) * sigm(a[2]); a[3] = bfhi(gv.y) * sigm(a[3]);
                    b[0] = bflo(gv.z) * sigm(b[0]); b[1] = bfhi(gv.z) * sigm(b[1]); b[2] = bflo(gv.w) * sigm(b[2]); b[3] = bfhi(gv.w) * sigm(b[3]);
#pragma unroll
                    for (int j = 0; j < 4; ++j) s2 += a[j] * a[j] + b[j] * b[j];
                    *(u32x4*)(AO + (size_t)row * 1024 + 512 + col0) = pack8(a, b);
                }
                s2 += __shfl_xor(s2, 16); s2 += __shfl_xor(s2, 32);
                if (fq == 0) ss[row * 8 + u.pn * 4 + wc] = s2;
            }
    }
};
struct EpiOutSS {
    static constexpr bool PERM = true, MID = false;
    bf16* O; float* ss;
    __device__ __forceinline__ void operator()(AccRef acc, const pg8::Unit& u, int wr, int wc, int fr, int fq) const {
#pragma unroll
        for (int ai = 0; ai < 2; ++ai)
#pragma unroll
            for (int m = 0; m < 4; ++m) {
                const int row = u.pm * 256 + ai * 128 + wr * 64 + m * 16 + fr; float s2 = 0.f;
#pragma unroll
                for (int bj = 0; bj < 2; ++bj) {
                    const int col0 = u.pn * 256 + bj * 128 + wc * 32 + 8 * fq;
                    const f32x4 a = acc[ai][bj][m][0], b = acc[ai][bj][m][1];
#pragma unroll
                    for (int j = 0; j < 4; ++j) s2 += a[j] * a[j] + b[j] * b[j];
                    *(u32x4*)(O + (size_t)row * 1024 + col0) = pack8(a, b);
                }
                s2 += __shfl_xor(s2, 16); s2 += __shfl_xor(s2, 32);
                if (fq == 0) ss[row * 16 + u.pn * 4 + wc] = s2;
            }
    }
};
struct EpiOutMix {
    static constexpr bool PERM = true, MID = true;
    bf16* O; float* ss; const LAS float* qv;
    __device__ __forceinline__ void mid(f32x4 (&acc)[2][2][4][2], const pg8::Unit& u, int wr, int fr) const {
#pragma unroll
        for (int ai = 0; ai < 2; ++ai)
#pragma unroll
            for (int m = 0; m < 4; ++m) { const float q = qv[u.ui * 256 + ai * 128 + wr * 64 + m * 16 + fr];
#pragma unroll
                for (int bj = 0; bj < 2; ++bj)
#pragma unroll
                    for (int n = 0; n < 2; ++n) acc[ai][bj][m][n] *= q; }
    }
    __device__ __forceinline__ void operator()(AccRef acc, const pg8::Unit& u, int wr, int wc, int fr, int fq) const {
#pragma unroll
        for (int ai = 0; ai < 2; ++ai)
#pragma unroll
            for (int m = 0; m < 4; ++m) {
                const int rl = ai * 128 + wr * 64 + m * 16 + fr, row = u.pm * 256 + rl; float s2 = 0.f; const float rs = qv[1024 + u.ui * 256 + rl];
#pragma unroll
                for (int bj = 0; bj < 2; ++bj) {
                    const int col0 = u.pn * 256 + bj * 128 + wc * 32 + 8 * fq;
                    const f32x4 a = acc[ai][bj][m][0] * rs, b = acc[ai][bj][m][1] * rs;
#pragma unroll
                    for (int j = 0; j < 4; ++j) s2 += a[j] * a[j] + b[j] * b[j];
                    *(u32x4*)(O + (size_t)row * 1024 + col0) = pack8(a, b);
                }
                s2 += __shfl_xor(s2, 16); s2 += __shfl_xor(s2, 32);
                if (fq == 0) ss[row * 16 + u.pn * 4 + wc] = s2;
            }
    }
};
struct EpiFF1 {
    static constexpr bool PERM = true, MID = false;
    bf16* H; const float* r;
    __device__ __forceinline__ void operator()(AccRef acc, const pg8::Unit& u, int wr, int wc, int fr, int fq) const {
#pragma unroll
        for (int ai = 0; ai < 2; ++ai)
#pragma unroll
            for (int m = 0; m < 4; ++m) {
                const int row = u.pm * 256 + ai * 128 + wr * 64 + m * 16 + fr; const float rs = r[row];
#pragma unroll
                for (int bj = 0; bj < 2; ++bj) {
                    const int col0 = u.pn * 256 + bj * 128 + wc * 32 + 8 * fq;
                    f32x4 a = acc[ai][bj][m][0] * rs, b = acc[ai][bj][m][1] * rs;
#pragma unroll
                    for (int j = 0; j < 4; ++j) { a[j] = fmaxf(a[j], 0.f); a[j] *= a[j]; b[j] = fmaxf(b[j], 0.f); b[j] *= b[j]; }
                    __builtin_nontemporal_store(pack8(a, b), (u32x4*)(H + (size_t)row * 4096 + col0));
                }
            }
    }
};

__device__ __forceinline__ void transpose_item(const float* W, int ldw, bf16* WT, int ldt, const float* sc_lo, const float* sc_hi, int split,
                                               LAS float* scr, int item, int nblk, int lane) {
    const int kb = item / nblk, nb = item % nblk, k0 = 64 * kb, n0 = 64 * nb;
#pragma unroll 16
    for (int i = 0; i < 32; ++i) { const int kk = 2 * i + (lane >> 5), k = k0 + kk;
        float s = 1.f; if (sc_lo) s = (k < split) ? sc_lo[k] : sc_hi[k - split];
        const f32x2 w = __builtin_nontemporal_load((const f32x2*)(W + (size_t)k * ldw + n0 + 2 * (lane & 31)));
        scr[kk * 65 + 2 * (lane & 31)] = w[0] * s; scr[kk * 65 + 2 * (lane & 31) + 1] = w[1] * s; }
    asm volatile("s_waitcnt lgkmcnt(0)" ::: "memory");
    const int c = lane & 7;
#pragma unroll
    for (int j = 0; j < 8; ++j) { const int n = (lane >> 3) + 8 * j; const LAS float* s = scr + (8 * c) * 65 + n;
        u32x4 o; o.x = pk2(s[0 * 65], s[1 * 65]); o.y = pk2(s[2 * 65], s[3 * 65]); o.z = pk2(s[4 * 65], s[5 * 65]); o.w = pk2(s[6 * 65], s[7 * 65]);
        *(u32x4*)(WT + (size_t)(n0 + n) * ldt + k0 + 8 * c) = o; }
    asm volatile("s_waitcnt lgkmcnt(0)" ::: "memory");
}

__device__ __forceinline__ void ssm_mat_item(const Params& p, int item, LAS unsigned char* lds) {
    int tid = threadIdx.x; asm volatile("" : "+v"(tid)); const int ly = item >> 7, g = (item >> 2) & 31, qt = item & 3;
    LAS float* pwr = (LAS float*)lds;
    LAS float* pwi = pwr + 2 * 64 * 20;
    LAS float* bbr = pwi + 2 * 64 * 20;
    LAS float* bbi = bbr + 2 * 64 * 16;
    LAS float* ccr = bbi + 2 * 64 * 16;
    LAS float* cci = ccr + 2 * 16 * 64;
    LAS float* Gt = cci + 2 * 16 * 64;
    __syncthreads();
    { const int k = (tid >> 6) & 1, pp = tid & 63, tg = tid >> 7; const int idx = (ly * 2 + k) * 32 + g;
      const float dt = expf(p.log_dt[idx]); const float lr = p.lam_re[idx * 64 + pp] * dt, li = p.lam_im[idx * 64 + pp] * dt;
#pragma unroll
      for (int j = 0; j < 5; ++j) { const int tau = tg * 5 + j; if (tau <= 16) { const float e = __expf(lr * tau); float sn, cs; __sincosf(li * tau, &sn, &cs); pwr[(k * 64 + pp) * 20 + tau] = e * cs; pwi[(k * 64 + pp) * 20 + tau] = e * sn; } } }
    for (int i = tid; i < 2048; i += 512) { const int k = i >> 10, r = i & 1023; const int idx = (ly * 2 + k) * 32 + g; ccr[i] = p.c_re[(size_t)idx * 1024 + r]; cci[i] = p.c_im[(size_t)idx * 1024 + r]; }
    __syncthreads();
#pragma unroll
    for (int j = 0; j < 4; ++j) { const int o = tid + 512 * j, k = o >> 10, pp = (o >> 4) & 63, h = o & 15; const int idx = (ly * 2 + k) * 32 + g;
        const float lr = p.lam_re[idx * 64 + pp], li = p.lam_im[idx * 64 + pp], dt = expf(p.log_dt[idx]);
        float sn, cs; sincosf(li * dt, &sn, &cs); const float em1 = expm1f(lr * dt), sh = sinf(0.5f * li * dt);
        const float lbr = em1 * cs - 2.0f * sh * sh, lbi = (em1 + 1.0f) * sn;
        const float den = 1.0f / (lr * lr + li * li); const float cr = (lbr * lr + lbi * li) * den, ci = (lbi * lr - lbr * li) * den;
        const float br = p.b_re[(size_t)idx * 1024 + pp * 16 + h], bi = p.b_im[(size_t)idx * 1024 + pp * 16 + h];
        bbr[o] = cr * br - ci * bi; bbi[o] = cr * bi + ci * br; }
    __syncthreads();
    { const int k = tid >> 8, i = (tid >> 4) & 15, h = tid & 15; float a[16];
#pragma unroll
      for (int tau = 0; tau < 16; ++tau) a[tau] = 0.f;
#pragma nounroll
      for (int pp = 0; pp < 64; ++pp) { const float c_r = ccr[(k * 16 + i) * 64 + pp], c_i = cci[(k * 16 + i) * 64 + pp], b_r = bbr[(k * 64 + pp) * 16 + h], b_i = bbi[(k * 64 + pp) * 16 + h];
          const float xr = c_r * b_r - c_i * b_i, xi = c_r * b_i + c_i * b_r;
          const LAS f32x4* pr4 = (const LAS f32x4*)(pwr + (k * 64 + pp) * 20); const LAS f32x4* pi4 = (const LAS f32x4*)(pwi + (k * 64 + pp) * 20);
#pragma unroll
          for (int t4 = 0; t4 < 4; ++t4) { const f32x4 vr = pr4[t4], vi = pi4[t4];
#pragma unroll
              for (int e = 0; e < 4; ++e) a[t4 * 4 + e] += xr * vr[e] - xi * vi[e]; } }
#pragma unroll
      for (int tau = 0; tau < 16; ++tau) Gt[((k * 16 + tau) * 16 + i) * 16 + h] = a[tau]; }
    __syncthreads();
    bf16* TM = (bf16*)(p.ws + OFF_TM) + (size_t)(ly * 32 + g) * 256 * 512; bf16* MS = (bf16*)(p.ws + OFF_MST) + (size_t)(ly * 32 + g) * 256 * 256;
    const float* dsk = p.d_skip + (ly * 32 + g) * 16;
    for (int o = qt * 64 * 512 + tid; o < (qt + 1) * 64 * 512; o += 512) { const int r = o >> 9, col = o & 511, t = r >> 4, i = r & 15; float v;
        if (col < 256) { const int j = col >> 4, h = col & 15; v = 0.f;
            if (j <= t) v += Gt[((0 * 16 + (t - j)) * 16 + i) * 16 + h];
            if (j >= t) v += Gt[((1 * 16 + (j - t)) * 16 + i) * 16 + h];
            if (j == t && h == i) v += dsk[i]; }
        else { const int k = (col - 256) >> 7, q = (col - 256) & 127, pp = q >> 1, part = q & 1; const int tau = k == 0 ? (t + 1) : (16 - t);
            const float c_r = ccr[(k * 16 + i) * 64 + pp], c_i = cci[(k * 16 + i) * 64 + pp], l_r = pwr[(k * 64 + pp) * 20 + tau], l_i = pwi[(k * 64 + pp) * 20 + tau];
            v = part == 0 ? (c_r * l_r - c_i * l_i) : -(c_r * l_i + c_i * l_r); }
        TM[o] = (bf16)f2bf(v); }
    for (int o = qt * 64 * 256 + tid; o < (qt + 1) * 64 * 256; o += 512) { const int r = o >> 8, col = o & 255, k = r >> 7, q = r & 127, pp = q >> 1, part = q & 1, j = col >> 4, h = col & 15;
        const int tau = k == 0 ? (15 - j) : j;
        const float l_r = pwr[(k * 64 + pp) * 20 + tau], l_i = pwi[(k * 64 + pp) * 20 + tau], b_r = bbr[(k * 64 + pp) * 16 + h], b_i = bbi[(k * 64 + pp) * 16 + h];
        const float v = part == 0 ? (l_r * b_r - l_i * b_i) : (l_r * b_i + l_i * b_r);
        MS[o] = (bf16)f2bf(v); }
}

__device__ __forceinline__ void p0_prologue(const Params& p, LAS unsigned char* lds, int G, int bid) {
    int tid = threadIdx.x; asm volatile("" : "+v"(tid));
    const int lane = tid & 63, wave = __builtin_amdgcn_readfirstlane(tid >> 6);
    for (int rp = 0; rp < P0_REP_A; ++rp)
    for (int it = bid; it < 256; it += G) ssm_mat_item(p, it, lds);
    __syncthreads();
    {
        LAS float* scr = (LAS float*)(lds + wave * 16640);
        const int gw = bid * 8 + wave, NGW = G * 8;
        constexpr int I_IN = 16 * 16, I_OUT = 16 * 16, I_1 = 16 * 64, I_2 = 64 * 16, I_G = 8 * 8, I_L = I_IN + I_OUT + I_1 + I_2 + I_G;
        for (int rp = 0; rp < P0_REP_B; ++rp)
        for (int it = gw; it < 2 * I_L; it += NGW) {
            const int ly = it / I_L; int r = it % I_L; unsigned char* wb = p.ws + OFF_W + (size_t)ly * W_LAYER;
            if (r < I_IN) { transpose_item(p.w_in + (size_t)ly * 1024 * 1024, 1024, (bf16*)(wb + W_IN), 1024, p.pre_mix_g + ly * 1024, nullptr, 1 << 30, scr, r, 16, lane); continue; } r -= I_IN;
            if (r < I_OUT) { transpose_item(p.w_out + (size_t)ly * 1024 * 1024, 1024, (bf16*)(wb + W_OUT), 1024, p.fourier_out_g + ly * 512, p.ssm_out_g + ly * 512, 512, scr, r, 16, lane); continue; } r -= I_OUT;
            if (r < I_1) { transpose_item(p.w_ff1 + (size_t)ly * 1024 * 4096, 4096, (bf16*)(wb + W_1), 1024, p.pre_mlp_g + ly * 1024, nullptr, 1 << 30, scr, r, 64, lane); continue; } r -= I_1;
            if (r < I_2) { transpose_item(p.w_ff2 + (size_t)ly * 4096 * 1024, 1024, (bf16*)(wb + W_2), 4096, nullptr, nullptr, 0, scr, r, 16, lane); continue; } r -= I_2;
            transpose_item(p.w_glu + (size_t)ly * 512 * 512, 512, (bf16*)(wb + W_GLU), 512, nullptr, nullptr, 0, scr, r, 8, lane);
        }
        bf16* XB = (bf16*)(p.ws + OFF_XB); float* rA = (float*)(p.ws + OFF_RA);
        for (int rp = 0; rp < P0_REP_C; ++rp)
        for (int row0 = gw; row0 < MT; row0 += 4 * NGW) {
            f32x4 v[4][4];
#pragma unroll
            for (int rr = 0; rr < 4; ++rr) { const f32x4* xr = (const f32x4*)(p.x + (size_t)(row0 + rr * NGW) * 1024) + lane;
#pragma unroll
                for (int j = 0; j < 4; ++j) v[rr][j] = __builtin_nontemporal_load(xr + 64 * j); }
#pragma unroll
            for (int rr = 0; rr < 4; ++rr) { const int row = row0 + rr * NGW; float s2 = 0.f;
                u32x2* o = (u32x2*)(XB + (size_t)row * 1024) + lane;
#pragma unroll
                for (int j = 0; j < 4; ++j) { const f32x4 t = v[rr][j]; s2 += t[0] * t[0] + t[1] * t[1] + t[2] * t[2] + t[3] * t[3]; u32x2 w; w.x = pk2(t[0], t[1]); w.y = pk2(t[2], t[3]); o[64 * j] = w; }
                s2 = wave_sum(s2);
                if (lane == 0) rA[row] = rsqrtf(s2 * (1.0f / 1024.0f) + EPS); }
        }
    }
    {
        bf16* D1 = (bf16*)(p.ws + OFF_D1); bf16* E3 = (bf16*)(p.ws + OFF_E3);
        const int gt = bid * 512 + tid, NT = G * 512;
        for (int idx = gt; idx < 64 * 2 * 128 * 128; idx += NT) { const int n2 = idx >> 15, sel = (idx >> 14) & 1, k1 = (idx >> 7) & 127, n1 = idx & 127;
            const int ph = (k1 * (64 * n1 + n2)) & 8191; float s, c; sincospif((float)ph * (1.0f / 4096.0f), &s, &c); D1[idx] = (bf16)f2bf(sel ? s : c); }
        bf16* E3I = (bf16*)(p.ws + OFF_E3I); bf16* FM = (bf16*)(p.ws + OFF_FMIX);
        for (int idx = gt; idx < 64 * 128; idx += NT) { const int k2 = idx >> 7, col = idx & 127, part = col >> 6, n2 = col & 63;
            const int ph = (n2 * k2) & 63; float s, c; sincospif((float)ph * (1.0f / 32.0f), &s, &c);
            E3[idx] = (bf16)f2bf(part ? s : c);
            E3I[idx] = (bf16)f2bf(part ? c : -s); }
        LAS float* cst = (LAS float*)lds;
        __syncthreads();
        if (tid < 64) { float sn, cs; sincospif((float)tid * (1.0f / 32.0f), &sn, &cs); cst[tid] = cs; cst[64 + tid] = sn; }
        __syncthreads();
        for (int idx = gt; idx < 2 * 8 * 64 * 128; idx += NT) { const int lh = idx >> 13, e = (idx >> 7) & 63, col = idx & 127, part = col >> 6, c = col & 63;
            const float* wf = p.w_fourier + (size_t)lh * 4096; float a = 0.f;
#pragma unroll 8
            for (int d = 0; d < 64; ++d) a += cst[64 * part + ((c * d) & 63)] * wf[d * 64 + e];
            FM[idx] = (bf16)f2bf(a * (1.0f / 724.0773439350247f)); }
    }
}

typedef short v4s16 __attribute__((ext_vector_type(4)));
__device__ __forceinline__ bf16x8 negbf(bf16x8 v) { u32x4 t = __builtin_bit_cast(u32x4, v); t = t ^ 0x80008000u; return __builtin_bit_cast(bf16x8, t); }
__device__ __forceinline__ bf16x8 tr_frag(const LAS unsigned char* a, int hs) {
    const v4s16 lo = __builtin_amdgcn_ds_read_tr16_b64_v4i16((LAS v4s16*)a), hi = __builtin_amdgcn_ds_read_tr16_b64_v4i16((LAS v4s16*)(a + hs));
    return __builtin_shufflevector(lo, hi, 0, 1, 2, 3, 4, 5, 6, 7);
}
constexpr int F1_P = 264, F1_CS = 128 * F1_P;
__device__ __forceinline__ void fft1_phase(const bf16* ZF, const bf16* D1, bf16* T, LAS unsigned char* lds, int G, int bid) {
    int tid = threadIdx.x; asm volatile("" : "+v"(tid));
    const int lane = tid & 63, wave = __builtin_amdgcn_readfirstlane(tid >> 6), wm = wave & 3, wn = wave >> 2, fr = lane & 15, fq = lane >> 4, tq = fr >> 2, tp = fr & 3;
    for (int pr = bid; pr < 256; pr += G) {
        const int n2 = pr & 63, cb = pr >> 6;
        __syncthreads();
        {
            const bf16* src = D1 + (size_t)n2 * 2 * 128 * 128;
#pragma unroll
            for (int j = 0; j < 8; ++j) { const int q = tid + 512 * j, sel = q >> 11, row = (q >> 4) & 127, cc = q & 15;
                *(LAS u32x4*)(lds + F1_CS + sel * 34816 + row * 272 + cc * 16) = *(const u32x4*)(src + sel * 16384 + row * 128 + 8 * cc); }
        }
        for (int b = 0; b < NB; ++b) {
            __syncthreads();
#pragma unroll
            for (int j = 0; j < 4; ++j) { const int q = tid + 512 * j, n1 = q >> 4, cc = q & 15;
                const u32x4 v = *(const u32x4*)(ZF + ((size_t)(b * SEQ + 64 * n1 + n2)) * 512 + cb * 128 + 8 * cc);
                LAS u32x2* d = (LAS u32x2*)(lds + n1 * F1_P + cc * 16); d[0] = (u32x2){v.x, v.y}; d[1] = (u32x2){v.z, v.w}; }
            __syncthreads();
            f32x4 Ar[2][4], Ai[2][4];
#pragma unroll
            for (int mb = 0; mb < 2; ++mb)
#pragma unroll
                for (int nb = 0; nb < 4; ++nb) { Ar[mb][nb] = (f32x4){0.f, 0.f, 0.f, 0.f}; Ai[mb][nb] = (f32x4){0.f, 0.f, 0.f, 0.f}; }
#pragma nounroll
            for (int ks = 0; ks < 4; ++ks) {
                bf16x8 Bf[4];
#pragma unroll
                for (int nb = 0; nb < 4; ++nb) Bf[nb] = tr_frag(lds + (32 * ks + 8 * fq + tq) * F1_P + (64 * wn + 16 * tp + 4 * nb) * 2, 4 * F1_P);
                bf16x8 Cf[2], Sf[2];
#pragma unroll
                for (int mb = 0; mb < 2; ++mb) { const int off = F1_CS + (32 * wm + 16 * mb + fr) * 272 + (32 * ks + 8 * fq) * 2; Cf[mb] = *(const LAS bf16x8*)(lds + off); Sf[mb] = *(const LAS bf16x8*)(lds + off + 34816); }
#pragma unroll
                for (int mb = 0; mb < 2; ++mb)
#pragma unroll
                    for (int nb = 0; nb < 4; ++nb) {
                        Ar[mb][nb] = __builtin_amdgcn_mfma_f32_16x16x32_bf16(Bf[nb], Cf[mb], Ar[mb][nb], 0, 0, 0);
                        Ai[mb][nb] = __builtin_amdgcn_mfma_f32_16x16x32_bf16(Bf[nb], negbf(Sf[mb]), Ai[mb][nb], 0, 0, 0); }
            }
#pragma unroll
            for (int mb = 0; mb < 2; ++mb) { const int k1 = 32 * wm + 16 * mb + fr, c = cb * 128 + 64 * wn + 16 * fq;
                bf16* t0 = T + ((((size_t)(b * 128 + k1) * 2 + 0) * 64 + n2) * 512 + c); bf16* t1 = t0 + 64 * 512;
                *(u32x4*)t0 = pack8(Ar[mb][0], Ar[mb][1]); *(u32x4*)(t0 + 8) = pack8(Ar[mb][2], Ar[mb][3]);
                *(u32x4*)t1 = pack8(Ai[mb][0], Ai[mb][1]); *(u32x4*)(t1 + 8) = pack8(Ai[mb][2], Ai[mb][3]); }
        }
    }
    __syncthreads();
}

constexpr int F3_P = 1088;
__device__ __forceinline__ bf16x8 pack8b(f32x4 a, f32x4 b) { return __builtin_bit_cast(bf16x8, pack8(a, b)); }
__device__ __forceinline__ void fft3_phase(const bf16* T, const bf16* E3, const bf16* E3I, const bf16* FM, bf16* AO, LAS unsigned char* lds, int G, int bid) {
    int tid = threadIdx.x; asm volatile("" : "+v"(tid));
    const int lane = tid & 63, wave = __builtin_amdgcn_readfirstlane(tid >> 6), fr = lane & 15, fq = lane >> 4, tq = fr >> 2, tp = fr & 3;
    LAS float* red = (LAS float*)(lds + 128 * F3_P);
#define F3_ISSUE(u_) do { const bf16* src_ = T + (size_t)(u_) * 65536; _Pragma("unroll") for (int j_ = 0; j_ < 16; ++j_) { const int row_ = wave * 16 + j_; \
        __builtin_amdgcn_global_load_lds((const unsigned*)(src_ + row_ * 512 + lane * 8), (LAS unsigned*)(lds + row_ * F3_P), 16, 0, 0); } } while (0)
    if (bid < 512) F3_ISSUE(bid);
    for (int unit = bid; unit < 512; unit += G) {
        const int b = unit >> 7, k1 = unit & 127;
        asm volatile("s_waitcnt vmcnt(0)" ::: "memory");
        __syncthreads();
        f32x4 gr[4][4], gi[4][4];
#pragma unroll
        for (int mb = 0; mb < 4; ++mb)
#pragma unroll
            for (int nb = 0; nb < 4; ++nb) { gr[mb][nb] = (f32x4){0.f, 0.f, 0.f, 0.f}; gi[mb][nb] = (f32x4){0.f, 0.f, 0.f, 0.f}; }
#pragma nounroll
        for (int ks = 0; ks < 4; ++ks) {
            bf16x8 Bf[4], Er[4], Ei[4];
#pragma unroll
            for (int mb = 0; mb < 4; ++mb) { const int off = (16 * mb + fr) * 128 + 32 * ks + 8 * fq; Er[mb] = *(const bf16x8*)(E3 + off); Ei[mb] = *(const bf16x8*)(E3I + off); }
#pragma unroll
            for (int nb = 0; nb < 4; ++nb) Bf[nb] = tr_frag(lds + (32 * ks + 8 * fq + tq) * F3_P + (64 * wave + 32 * (nb >> 1) + 8 * tp + 4 * (nb & 1)) * 2, 4 * F3_P);
#pragma unroll
            for (int mb = 0; mb < 4; ++mb)
#pragma unroll
                for (int nb = 0; nb < 4; ++nb) { gr[mb][nb] = __builtin_amdgcn_mfma_f32_16x16x32_bf16(Bf[nb], Er[mb], gr[mb][nb], 0, 0, 0);
                                                 gi[mb][nb] = __builtin_amdgcn_mfma_f32_16x16x32_bf16(Bf[nb], Ei[mb], gi[mb][nb], 0, 0, 0); }
        }
        __syncthreads();
        if (unit + G < 512) F3_ISSUE(unit + G);
        bf16x8 Af[4][4];
#pragma unroll
        for (int mb = 0; mb < 4; ++mb) { Af[0][mb] = pack8b(gr[mb][0], gr[mb][1]); Af[1][mb] = pack8b(gr[mb][2], gr[mb][3]); Af[2][mb] = pack8b(gi[mb][0], gi[mb][1]); Af[3][mb] = pack8b(gi[mb][2], gi[mb][3]); }
        f32x4 acc[4][4];
#pragma unroll
        for (int mb = 0; mb < 4; ++mb)
#pragma unroll
            for (int nb = 0; nb < 4; ++nb) acc[mb][nb] = (f32x4){0.f, 0.f, 0.f, 0.f};
        const bf16* fm = FM + (size_t)wave * 64 * 128;
#pragma unroll
        for (int kst = 0; kst < 4; ++kst) {
            bf16x8 Ff[4];
#pragma unroll
            for (int nb = 0; nb < 4; ++nb) Ff[nb] = *(const bf16x8*)(fm + (16 * tq + 4 * nb + tp) * 128 + 32 * kst + 8 * fq);
#pragma unroll
            for (int mb = 0; mb < 4; ++mb)
#pragma unroll
                for (int nb = 0; nb < 4; ++nb) acc[mb][nb] = __builtin_amdgcn_mfma_f32_16x16x32_bf16(Ff[nb], Af[kst][mb], acc[mb][nb], 0, 0, 0);
        }
#pragma unroll
        for (int mb = 0; mb < 4; ++mb) { float s = 0.f;
#pragma unroll
            for (int nb = 0; nb < 4; ++nb)
#pragma unroll
                for (int j = 0; j < 4; ++j) s += acc[mb][nb][j] * acc[mb][nb][j];
            s += __shfl_xor(s, 16); s += __shfl_xor(s, 32);
            if (fq == 0) red[wave * 64 + 16 * mb + fr] = s; }
        __syncthreads();
#pragma unroll
        for (int mb = 0; mb < 4; ++mb) { float tot = 0.f;
#pragma unroll
            for (int w = 0; w < 8; ++w) tot += red[w * 64 + 16 * mb + fr];
            const float rinv = rsqrtf(tot * (1.0f / 512.0f) + EPS);
            const size_t token = (size_t)b * SEQ + k1 + 128 * (16 * mb + fr);
            bf16* o = AO + token * 1024 + 64 * wave + 16 * fq;
            *(u32x4*)o = pack8(acc[mb][0] * rinv, acc[mb][1] * rinv); *(u32x4*)(o + 8) = pack8(acc[mb][2] * rinv, acc[mb][3] * rinv); }
    }
    __syncthreads();
}

__device__ __forceinline__ void carry_phase(const Params& p, int ly, const float* Sloc, bf16* UB, LAS unsigned char* lds, int G, int bid) {
    int tid = threadIdx.x; asm volatile("" : "+v"(tid));
    const int lane = tid & 63, wave = __builtin_amdgcn_readfirstlane(tid >> 6);
    LAS f32x2* ex = (LAS f32x2*)lds;
    for (int w = bid; w < 256; w += G) {
        const int dir = w & 1, g = (w >> 1) & 31, b = w >> 6, pp = lane; const int idx = (ly * 2 + dir) * 32 + g;
        const float dt = expf(p.log_dt[idx]); const float lr = p.lam_re[idx * 64 + pp] * dt * 16.0f, li = p.lam_im[idx * 64 + pp] * dt * 16.0f;
        const float e = expf(lr); float sn, cs; sincosf(li, &sn, &cs); const float l_r = e * cs, l_i = e * sn;
        float Lr = l_r, Li = l_i;
#pragma unroll
        for (int k = 0; k < 6; ++k) { const float nr = Lr * Lr - Li * Li, ni = 2.0f * Lr * Li; Lr = nr; Li = ni; }
        const float* src = Sloc + ((size_t)(g * 2048 + b * 512)) * 256 + dir * 128 + 2 * pp;
        bf16* dst = UB + ((size_t)(g * 2048 + b * 512)) * 512 + 256 + dir * 128 + 2 * pp;
        const int ss0 = dir == 0 ? wave * 64 : 511 - wave * 64; const long stp = dir == 0 ? 256 : -256;
        float cr = 0.f, ci = 0.f;
        { const float* ptr = src + (size_t)ss0 * 256;
#pragma nounroll
          for (int hb = 0; hb < 2; ++hb) {
            f32x2 v[32];
#pragma unroll
            for (int j = 0; j < 32; ++j) { v[j] = *(const f32x2*)ptr; ptr += stp; }
#pragma unroll
            for (int j = 0; j < 32; ++j) { const float nr = l_r * cr - l_i * ci + v[j][0], ni = l_r * ci + l_i * cr + v[j][1]; cr = nr; ci = ni; }
          } }
        __syncthreads();
        ex[wave * 64 + lane] = (f32x2){cr, ci};
        __syncthreads();
        cr = 0.f; ci = 0.f;
        for (int u = 0; u < wave; ++u) { const f32x2 eu = ex[u * 64 + lane]; const float nr = Lr * cr - Li * ci + eu[0], ni = Lr * ci + Li * cr + eu[1]; cr = nr; ci = ni; }
        { const float* ptr = src + (size_t)ss0 * 256; bf16* dp = dst + (size_t)ss0 * 512;
#pragma nounroll
          for (int hb = 0; hb < 2; ++hb) {
            f32x2 v[32];
#pragma unroll
            for (int j = 0; j < 32; ++j) { v[j] = *(const f32x2*)ptr; ptr += stp; }
#pragma unroll
            for (int j = 0; j < 32; ++j) {
                *(unsigned*)dp = pk2(cr, ci); dp += 2 * stp;
                const float nr = l_r * cr - l_i * ci + v[j][0], ni = l_r * ci + l_i * cr + v[j][1]; cr = nr; ci = ni; }
          } }
    }
    __syncthreads();
}

__device__ __forceinline__ void norm_phase(float* out, const bf16* MF, const float* ss, const float* gain, bf16* XB, float* rnext, bool last, int G, int bid) {
    int tid = threadIdx.x; asm volatile("" : "+v"(tid));
    const int lane = tid & 63, wave = __builtin_amdgcn_readfirstlane(tid >> 6);
    const int gw = bid * 8 + wave, NGW = G * 8;
    const f32x4* gr = (const f32x4*)gain + lane;
    const f32x4 g0 = gr[0], g1 = gr[64], g2 = gr[128], g3 = gr[192];
    for (int row0 = gw; row0 < MT; row0 += 2 * NGW) {
        u32x2 xv[2][4], mv[2][4]; float tot[2];
#pragma unroll
        for (int rr = 0; rr < 2; ++rr) { const int row = row0 + rr * NGW;
            const u32x2* xr = (const u32x2*)(XB + (size_t)row * 1024) + lane; const u32x2* mr = (const u32x2*)(MF + (size_t)row * 1024) + lane;
#pragma unroll
            for (int j = 0; j < 4; ++j) { xv[rr][j] = xr[64 * j]; mv[rr][j] = mr[64 * j]; }
            const f32x4* sp = (const f32x4*)(ss + (size_t)row * 16); const f32x4 s0 = sp[0], s1 = sp[1], s2 = sp[2], s3 = sp[3];
            tot[rr] = ((((s0[0] + s0[1]) + s0[2]) + s0[3]) + (((s1[0] + s1[1]) + s1[2]) + s1[3])) + ((((s2[0] + s2[1]) + s2[2]) + s2[3]) + (((s3[0] + s3[1]) + s3[2]) + s3[3])); }
#pragma unroll
        for (int rr = 0; rr < 2; ++rr) { const int row = row0 + rr * NGW;
            const float rinv = rsqrtf(tot[rr] * (1.0f / 1024.0f) + EPS); float s2 = 0.f;
#pragma unroll
            for (int j = 0; j < 4; ++j) { const f32x4 gg = j == 0 ? g0 : (j == 1 ? g1 : (j == 2 ? g2 : g3)); const u32x2 xx = xv[rr][j], mm = mv[rr][j]; f32x4 v;
                v[0] = bflo(xx.x) + bflo(mm.x) * rinv * gg[0]; v[1] = bfhi(xx.x) + bfhi(mm.x) * rinv * gg[1]; v[2] = bflo(xx.y) + bflo(mm.y) * rinv * gg[2]; v[3] = bfhi(xx.y) + bfhi(mm.y) * rinv * gg[3];
                if (last) { ((f32x4*)(out + (size_t)row * 1024) + lane)[64 * j] = v; }
                else { u32x2 w; w.x = pk2(v[0], v[1]); w.y = pk2(v[2], v[3]); ((u32x2*)(XB + (size_t)row * 1024) + lane)[64 * j] = w;
                       const float a0 = bflo(w.x), a1 = bfhi(w.x), a2 = bflo(w.y), a3 = bfhi(w.y); s2 += a0 * a0 + a1 * a1 + a2 * a2 + a3 * a3; } }
            if (!last) { s2 = wave_sum(s2); if (lane == 0) rnext[row] = rsqrtf(s2 * (1.0f / 1024.0f) + EPS); } }
    }
}
__device__ __forceinline__ void rescale_phase(bf16* AO, const float* ss, int G, int bid) {
    int tid = threadIdx.x; asm volatile("" : "+v"(tid));
    const int lane = tid & 63, wave = __builtin_amdgcn_readfirstlane(tid >> 6);
    const int gw = bid * 8 + wave, NGW = G * 8;
    for (int row = gw; row < MT; row += NGW) {
        float tot = 0.f;
#pragma unroll
        for (int k = 0; k < 8; ++k) tot += ss[row * 8 + k];
        const float rinv = rsqrtf(tot * (1.0f / 512.0f) + EPS);
        u32x4* ptr = (u32x4*)(AO + (size_t)row * 1024 + 512) + lane; u32x4 v = *ptr;
        v.x = pk2(bflo(v.x) * rinv, bfhi(v.x) * rinv); v.y = pk2(bflo(v.y) * rinv, bfhi(v.y) * rinv); v.z = pk2(bflo(v.z) * rinv, bfhi(v.z) * rinv); v.w = pk2(bflo(v.w) * rinv, bfhi(v.w) * rinv);
        *ptr = v;
    }
}


#define XB_TMO      128
#define XB_XCNT(j)  (256  + 64 * (j))
#define XB_XSUB(j)  (1280 + 64 * (j))
#define XB_XGEN(j)  (2304 + 64 * (j))
#define XB_TOP      3328
#define XB_TOPGEN   3392
#define XCD_BAR_WORDS 3456
#define XB_SPIN_CAP (1u << 18)
__device__ __forceinline__ unsigned xb_ld(unsigned* p)              { return __hip_atomic_load(p, __ATOMIC_RELAXED, __HIP_MEMORY_SCOPE_AGENT); }
__device__ __forceinline__ unsigned xb_add(unsigned* p, unsigned v) { return __hip_atomic_fetch_add(p, v, __ATOMIC_RELAXED, __HIP_MEMORY_SCOPE_AGENT); }
__device__ __forceinline__ unsigned xb_xcc_id() { return (unsigned)__builtin_amdgcn_s_getreg((3 << 11) | 20) & 0xFu; }
#define XB_SPIN(cond, bar) do { unsigned _sp = 0; while (cond) { __builtin_amdgcn_s_sleep(1); \
    if ((++_sp & 255u) == 0u) { if (xb_ld(&(bar)[XB_TMO])) break; if (_sp > XB_SPIN_CAP) { atomicAdd(&(bar)[XB_TMO], 1u); break; } } } } while (0)
struct XcdBarrier { unsigned* bar; unsigned x; volatile LAS unsigned* st; };
__device__ __forceinline__ XcdBarrier xcd_barrier_post(unsigned* bar, volatile LAS unsigned* st) {
    XcdBarrier b; b.bar = bar; b.x = xb_xcc_id(); b.st = st;
    if (threadIdx.x == 0) (void)xb_add(&bar[XB_XCNT(b.x)], 1u);
    return b;
}
__device__ __forceinline__ void xcd_barrier_complete(unsigned* bar, unsigned x, unsigned& nloc, unsigned& nx) {
    const unsigned G = gridDim.x * gridDim.y * gridDim.z;
    unsigned sum, cnt, mine, sp = 0u;
    for (;;) {
        sum = 0u; cnt = 0u; mine = 0u;
#pragma unroll
        for (unsigned j = 0; j < 16; ++j) { const unsigned c = xb_ld(&bar[XB_XCNT(j)]); sum += c; cnt += (c > 0u) ? 1u : 0u; mine = (j == x) ? c : mine; }
        if (sum == G) break;
        __builtin_amdgcn_s_sleep(1);
        if ((++sp & 255u) == 0u) { if (xb_ld(&bar[XB_TMO])) break; if (sp > XB_SPIN_CAP) { atomicAdd(&bar[XB_TMO], 1u); break; } }
    }
    nloc = mine > 0u ? mine : 1u; nx = cnt > 0u ? cnt : 1u;
}
__device__ __forceinline__ void xcd_barrier(const XcdBarrier& b) {
    asm volatile("s_waitcnt vmcnt(0)" ::: "memory");
    __syncthreads();
    if (threadIdx.x == 0) {
        unsigned* bar = b.bar;
        __builtin_amdgcn_s_waitcnt(0);
        unsigned nloc = b.st[0], nx = b.st[1];
        if (nloc == 0u) { xcd_barrier_complete(bar, b.x, nloc, nx); b.st[0] = nloc; b.st[1] = nx; }
        const unsigned old = xb_add(&bar[XB_XSUB(b.x)], 1u);
        const unsigned gen = old / nloc;
        if (old + 1u == (gen + 1u) * nloc) {
            __builtin_amdgcn_fence(__ATOMIC_RELEASE, "agent");
            asm volatile("s_waitcnt vmcnt(0)" ::: "memory");
            const unsigned og = xb_add(&bar[XB_TOP], 1u);
            const unsigned tg = og / nx;
            if (og + 1u == (tg + 1u) * nx) xb_add(&bar[XB_TOPGEN], 1u);
            else XB_SPIN(xb_ld(&bar[XB_TOPGEN]) == tg, bar);
            __builtin_amdgcn_fence(__ATOMIC_ACQUIRE, "agent");
            xb_add(&bar[XB_XGEN(b.x)], 1u);
            asm volatile("s_waitcnt vmcnt(0)" ::: "memory");
        } else {
            XB_SPIN(xb_ld(&bar[XB_XGEN(b.x)]) == gen, bar);
            __builtin_amdgcn_fence(__ATOMIC_ACQUIRE, "agent");
            asm volatile("s_waitcnt vmcnt(0)" ::: "memory");
        }
    }
    __syncthreads();
}

#ifndef REP_P0
#define REP_P0 1
#endif
#ifndef REP_SYNC
#define REP_SYNC 1
#endif
#ifndef REP_MASK_V
#define REP_MASK_V 0u
#endif
constexpr unsigned REP_MASK = REP_MASK_V;
constexpr int PH_PER_LAYER = 10, N_PHASES = 1 + 2 * PH_PER_LAYER;
__global__ void __launch_bounds__(512) hybrid_fwd(Params p) {
    extern __shared__ __attribute__((aligned(16))) unsigned char lds_raw[];
    LAS unsigned char* lds = (LAS unsigned char*)lds_raw;
    cg::grid_group grid = cg::this_grid();
    volatile LAS unsigned* xst = (volatile LAS unsigned*)(lds + LDS_BYTES - 16);
    if (threadIdx.x < 4) xst[threadIdx.x] = 0u;
    __syncthreads();
    const XcdBarrier xbar = xcd_barrier_post((unsigned*)(p.ws + OFF_BAR), xst);
    if (p.ph_hi > 1000) grid.sync();
    const int Gk = gridDim.x, bk = blockIdx.x;
    unsigned char* ws = p.ws;
    float* sss = (float*)(ws + OFF_SSS); float* ssm = (float*)(ws + OFF_SSM); float* ssf = (float*)(ws + OFF_SSF); float* rA = (float*)(ws + OFF_RA); float* rB = (float*)(ws + OFF_RB);
    bf16* XB = (bf16*)(ws + OFF_XB); bf16* MF = (bf16*)(ws + OFF_MF); bf16* GB = (bf16*)(ws + OFF_G); bf16* HB = (bf16*)(ws + OFF_H);
    bf16* PQ = (bf16*)(ws + OFF_PQ); bf16* AO = (bf16*)(ws + OFF_AO); bf16* UB = (bf16*)(ws + OFF_UB); bf16* TB = (bf16*)(ws + OFF_T); float* SL = (float*)(ws + OFF_SLOC);

#pragma nounroll
    for (int ph = p.ph_lo; ph < p.ph_hi; ++ph) {
        int G = Gk, bid = bk; asm volatile("" : "+s"(G), "+s"(bid));
        if (ph == 0) { for (int rep = 0; rep < REP_P0; ++rep) p0_prologue(p, lds, G, bid); }
        else {
            const int ly = (ph - 1) / PH_PER_LAYER, sp = (ph - 1) % PH_PER_LAYER;
            unsigned char* wb = ws + OFF_W + (size_t)ly * W_LAYER;
            pg8::Order S;
            const int nrep = ((REP_MASK >> sp) & 1u) ? 2 : 1;
            for (int rep = 0; rep < nrep; ++rep)
            switch (sp) {
            case 0: {
                pg8::Gemm g{XB, (const bf16*)(wb + W_IN), MT, NIN, 1024, 1024, 1024, 0, 0, 1}; S.init(MT, NIN, 1, G, bid, WGM_IN);
                EpiIn E{PQ, UB, rA}; pg8::gemm_phase<EpiIn>(lds, g, S, E); } break;
            case 1: {
                fft1_phase(PQ, (const bf16*)(ws + OFF_D1), TB, lds, G, bid);
                pg8::Gemm g{UB, (const bf16*)(ws + OFF_MST) + (size_t)ly * 32 * 256 * 256, 2048, 256, 256, 512, 256, (size_t)2048 * 512, (size_t)256 * 256, 32}; S.init(2048, 256, 32, G, bid);
                EpiSloc E{SL}; pg8::gemm_phase<EpiSloc>(lds, g, S, E); } break;
            case 2: {
                carry_phase(p, ly, SL, UB, lds, G, bid);
                fft3_phase(TB, (const bf16*)(ws + OFF_E3), (const bf16*)(ws + OFF_E3I), (const bf16*)(ws + OFF_FMIX) + (size_t)ly * 8 * 64 * 128, AO, lds, G, bid); } break;
            case 3: {
                pg8::Gemm g{UB, (const bf16*)(ws + OFF_TM) + (size_t)ly * 32 * 256 * 512, 2048, 256, 512, 512, 512, (size_t)2048 * 512, (size_t)256 * 512, 32}; S.init(2048, 256, 32, G, bid);
                EpiSsmOut E{GB}; pg8::gemm_phase<EpiSsmOut>(lds, g, S, E); } break;
            case 4: {
                pg8::Gemm g{GB, (const bf16*)(wb + W_GLU), MT, 512, 512, 512, 512, 0, 0, 1}; S.init(MT, 512, 1, G, bid, WGM_GLU);
                EpiGlu E{GB, p.b_glu + ly * 512, AO, sss}; pg8::gemm_phase<EpiGlu>(lds, g, S, E); } break;
            case 5: {
                pg8::Gemm g{AO, (const bf16*)(wb + W_OUT), MT, 1024, 1024, 1024, 1024, 0, 0, 1}; S.init(MT, 1024, 1, G, bid, WGM_OUT);
                LAS float* qv = (LAS float*)(lds + 131072);
                { int tid = threadIdx.x; asm volatile("" : "+v"(tid));
                  for (int i = 0; i < 4; ++i) { pg8::Unit u; if (!S.next(i, u)) break;
                      if (tid < 256) { const f32x4* sp = (const f32x4*)(sss + (size_t)(u.pm * 256 + tid) * 8); const f32x4 a = sp[0], b = sp[1];
                          const float ms = ((((a[0] + a[1]) + a[2]) + a[3]) + (((b[0] + b[1]) + b[2]) + b[3])) * (1.0f / 512.0f) + EPS;
                          qv[i * 256 + tid] = sqrtf(ms); qv[1024 + i * 256 + tid] = rsqrtf(ms); } }
                  __syncthreads(); }
                EpiOutMix E{MF, ssm, qv}; pg8::gemm_phase<EpiOutMix>(lds, g, S, E); } break;
            case 6: norm_phase(p.out, MF, ssm, p.post_mix_g + ly * 1024, XB, rB, false, G, bid); break;
            case 7: {
                pg8::Gemm g{XB, (const bf16*)(wb + W_1), MT, DFF, 1024, 1024, 1024, 0, 0, 1}; S.init(MT, DFF, 1, G, bid, WGM_FF1);
                EpiFF1 E{HB, rB}; pg8::gemm_phase<EpiFF1>(lds, g, S, E); } break;
            case 8: {
                pg8::Gemm g{HB, (const bf16*)(wb + W_2), MT, 1024, DFF, DFF, DFF, 0, 0, 1}; S.init(MT, 1024, 1, G, bid, WGM_FF2);
                EpiOutSS E{MF, ssf}; pg8::gemm_phase<EpiOutSS>(lds, g, S, E); } break;
            case 9: norm_phase(p.out, MF, ssf, p.post_mlp_g + ly * 1024, XB, rA, ly == 1, G, bid); break;
            }
        }
        if (ph + 1 < p.ph_hi) for (int rep = 0; rep < REP_SYNC; ++rep) xcd_barrier(xbar);
    }
}

extern "C" void kernel_launch(void* const* d_in, const int* in_sizes, int n_in, void* d_out, int out_size, void* d_ws, size_t ws_size, hipStream_t stream) {
    static int grid = 0;
    if (grid == 0) {
        if (n_in != 22 || ws_size < WS_END) { fprintf(stderr, "kernel_launch: unexpected n_in %d or ws_size %zu (< %zu)\n", n_in, ws_size, (size_t)WS_END); grid = -1; return; }
        int dev = 0, cus = 0, per_cu = 0;
        hipGetDevice(&dev); hipDeviceGetAttribute(&cus, hipDeviceAttributeMultiprocessorCount, dev);
        if (hipFuncSetAttribute((const void*)hybrid_fwd, hipFuncAttributeMaxDynamicSharedMemorySize, LDS_BYTES) != hipSuccess) { fprintf(stderr, "kernel_launch: hipFuncSetAttribute failed\n"); grid = -1; return; }
        if (hipOccupancyMaxActiveBlocksPerMultiprocessor(&per_cu, (const void*)hybrid_fwd, 512, LDS_BYTES) != hipSuccess || per_cu < 1) { fprintf(stderr, "kernel_launch: occupancy query says %d blocks per CU\n", per_cu); per_cu = 1; }
        (void)hipGetLastError();
        grid = cus;
    }
    if (grid < 0) return;
    if (hipMemsetAsync((char*)d_ws + OFF_BAR, 0, BAR_BYTES, stream) != hipSuccess) { fprintf(stderr, "kernel_launch: memset of the barrier words failed\n"); return; }
    Params p{};
    const float** f = (const float**)&p;
    for (int i = 0; i < 22; ++i) f[i] = (const float*)d_in[i];
    p.out = (float*)d_out; p.ws = (unsigned char*)d_ws; p.ph_lo = 0; p.ph_hi = N_PHASES;
    void* args[] = {&p};
    hipError_t e = hipLaunchCooperativeKernel((const void*)hybrid_fwd, dim3(grid), dim3(512), args, LDS_BYTES, stream);
    if (e != hipSuccess) fprintf(stderr, "kernel_launch: cooperative launch failed: %s (grid %d)\n", hipGetErrorString(e), grid);
}
```

```cpp
#include <hip/hip_runtime.h>
#include <hip/hip_cooperative_groups.h>
#include <cstdio>
namespace cg = cooperative_groups;

#define P0_REP_A 1
#define WGM_FF1 4
#define WGM_IN 2
#define WGM_OUT 4
#define WGM_GLU 4
#define WGM_FF2 4
#define P0_REP_F 1
#define P0_REP_S 1
#define P0_REP_B 1
#define P0_REP_C 1
#define LAS __attribute__((address_space(3)))
typedef unsigned short bf16;
typedef short bf16x8 __attribute__((ext_vector_type(8)));
typedef float f32x4 __attribute__((ext_vector_type(4)));
typedef float f32x2 __attribute__((ext_vector_type(2)));
typedef unsigned u32x4 __attribute__((ext_vector_type(4)));
typedef unsigned u32x2 __attribute__((ext_vector_type(2)));

constexpr int NB = 4, SEQ = 8192, DM = 1024, MT = NB * SEQ, DFO = 512, NHEAD = 8, SG = 32, SP = 64, DFF = 4096, NIN = 1024;
constexpr float EPS = 1e-6f;
constexpr int LDS_BYTES = 147456;
constexpr size_t MiB = 1u << 20;
constexpr size_t OFF_RA = 384 * 1024, OFF_RB = 512 * 1024, OFF_BAR = 640 * 1024, BAR_BYTES = 16384;
constexpr size_t OFF_E3I = 1 * MiB + 16384, OFF_FMIX = 1 * MiB + 65536;
constexpr size_t OFF_E3 = 1 * MiB, OFF_D1 = 2 * MiB, OFF_TM = 6 * MiB, OFF_MST = 22 * MiB, OFF_W = 30 * MiB;
constexpr size_t W_IN = 0, W_OUT = 3 * MiB, W_1 = 5 * MiB, W_2 = 13 * MiB, W_GLU = 21 * MiB, W_LAYER = 22 * MiB;
constexpr size_t OFF_XB = 76 * MiB, OFF_MF = 140 * MiB, OFF_G = 140 * MiB, OFF_H = 204 * MiB;
constexpr size_t OFF_PQ = 204 * MiB, OFF_AO = 204 * MiB, OFF_UB = 268 * MiB, OFF_T = 332 * MiB, OFF_SLOC = 396 * MiB, OFF_SSS = 460 * MiB, OFF_SSM = 461 * MiB, OFF_SSF = 463 * MiB, WS_END = 465 * MiB;

struct Params {
    const float *x, *w_in, *w_out, *pre_mix_g, *post_mix_g, *pre_mlp_g, *post_mlp_g, *fourier_out_g, *ssm_out_g, *w_fourier,
        *lam_re, *lam_im, *log_dt, *b_re, *b_im, *c_re, *c_im, *d_skip, *w_glu, *b_glu, *w_ff1, *w_ff2;
    float* out; unsigned char* ws;
    int ph_lo, ph_hi;
};

__device__ __forceinline__ unsigned f2bf(float f) { unsigned u = __builtin_bit_cast(unsigned, f); return (u + 0x7fffu + ((u >> 16) & 1u)) >> 16; }
typedef __bf16 hwbf2 __attribute__((ext_vector_type(2)));
__device__ __forceinline__ unsigned pk2(float lo, float hi) { const f32x2 v = {lo, hi}; return __builtin_bit_cast(unsigned, __builtin_convertvector(v, hwbf2)); }
__device__ __forceinline__ float bflo(unsigned w) { return __builtin_bit_cast(float, w << 16); }
__device__ __forceinline__ float bfhi(unsigned w) { return __builtin_bit_cast(float, w & 0xffff0000u); }
__device__ __forceinline__ float wave_sum(float v) {
#pragma unroll
    for (int o = 1; o < 64; o <<= 1) v += __shfl_xor(v, o);
    return v;
}
__device__ __forceinline__ float gelu_t(float x) { const float u = 0.7978845608f * (x + 0.044715f * x * x * x); return x * __builtin_amdgcn_rcpf(1.0f + __expf(-2.0f * u)); }
__device__ __forceinline__ float sigm(float v) { return __builtin_amdgcn_rcpf(1.0f + __expf(-v)); }

namespace pg8 {
#define PG8_LAS __attribute__((address_space(3)))
typedef unsigned short bf16_t;
constexpr int BM = 256, BK = 64, HALF = 128, HTB = HALF * BK * 2, STAGE_BYTES = 8 * HTB, NXCD = 8, WGM = 4;
__host__ __device__ __forceinline__ int lds_byte(int r, int c) { const int st = (r >> 4) * 2 + (c >> 5), rr = r & 15, cc = c & 31, ob = rr * 64 + cc * 2; return st * 1024 + (ob ^ (((ob >> 9) & 1) << 5)); }
__host__ __device__ __forceinline__ void stage_rc(int b, int& R, int& C) { const int st = b / 1024, sb = b % 1024, swz = sb ^ (((sb >> 9) & 1) << 5); R = (st >> 1) * 16 + swz / 64; C = (st & 1) * 32 + (swz % 64) / 2; }
__host__ __device__ __forceinline__ int perm32(int rho) { const int n = rho >> 4, i = rho & 15; return 8 * (i >> 2) + 4 * n + (i & 3); }

struct Unit { int pm, pn, z, ui; };
struct Gemm { const bf16_t* A; const bf16_t* Bt; int M, N, K, lda, ldb; size_t sA, sB; int nZ; };

struct Order {
    int nM, nN, nwg, nZ, G, c, wgm;
    __device__ void init(int M, int N, int nZ_, int G_, int c_, int wgm_ = WGM) { nM = M / BM; nN = N / BM; nwg = nM * nN; nZ = nZ_; G = G_; c = c_; wgm = wgm_; }
    __device__ bool next(int i, Unit& u) const {
        const long L = (long)i * G + c; if (L >= (long)nwg * nZ) return false;
        u.ui = i;
        if (nZ > 1 && (nZ % NXCD) == 0) {
            const int xcd = (int)(L % NXCD), idx = (int)(L / NXCD); u.z = xcd * (nZ / NXCD) + idx / nwg; const int wg = idx % nwg; u.pm = wg % nM; u.pn = wg / nM; return true; }
        u.z = (int)(L / nwg);
        int wgid = (int)(L % nwg); { const int q = nwg / NXCD, r = nwg % NXCD, xcd = wgid % NXCD, off = wgid / NXCD; wgid = (xcd < r ? xcd * (q + 1) : r * (q + 1) + (xcd - r) * q) + off; }
        const int nig = wgm * nN, gid = wgid / nig, fm = gid * wgm, gsz = (nM - fm) < wgm ? (nM - fm) : wgm;
        u.pm = fm + ((wgid % nig) % gsz); u.pn = (wgid % nig) / gsz; return true;
    }
};

template <class Epi>
__device__ __forceinline__ void gemm_phase(PG8_LAS unsigned char* lds, const Gemm g, const Order& S, const Epi& E) {
    int tid = threadIdx.x; asm volatile("" : "+v"(tid));
    const int wid = __builtin_amdgcn_readfirstlane(tid >> 6), lane = tid & 63, wr = wid >> 2, wc = wid & 3, fr = lane & 15, fq = lane >> 4;
    const int K = g.K, nt = K / BK;
    unsigned voffA[2], voffB[2];
#pragma unroll
    for (int i = 0; i < 2; ++i) { int R, C; stage_rc(tid * 16 + i * 8192, R, C); const int Rb = Epi::PERM ? ((R & ~31) + perm32(R & 31)) : R;
        voffA[i] = (unsigned)(R * g.lda + C) * 2u; voffB[i] = (unsigned)(Rb * g.ldb + C) * 2u; }
    const size_t kstep = (size_t)(BK * 2);
    const size_t hA = (size_t)HALF * g.lda * 2, hB = (size_t)HALF * g.ldb * 2;
    const size_t tA = 2 * hA, tB = 2 * hB;
    const unsigned ldsw = (unsigned)wid * 1024u;
    const int aoff = lds_byte(wr * 64 + fr, fq * 8), boff = lds_byte(wc * 32 + fr, fq * 8);
#define PG8_SA(b, h) (((b) * 2 + (h)) * HTB)
#define PG8_SB(b, h) ((4 + (b) * 2 + (h)) * HTB)
#define PG8_STAGE(bufoff, gbase, voff) do { _Pragma("unroll") for (int _i = 0; _i < 2; ++_i) \
        __builtin_amdgcn_global_load_lds((const unsigned*)((const char*)(gbase) + (voff)[_i]), (PG8_LAS unsigned*)(lds + (bufoff) + ldsw + _i * 8192), 16, 0, 0); } while (0)
#define PG8_LDA(dst, b, h) do { _Pragma("unroll") for (int m = 0; m < 4; ++m) _Pragma("unroll") for (int k = 0; k < 2; ++k) dst[m][k] = *(const PG8_LAS bf16x8*)(lds + PG8_SA(b, h) + aoff + m * 2048 + k * 1024); } while (0)
#define PG8_LDB(dst, b, h) do { _Pragma("unroll") for (int n = 0; n < 2; ++n) _Pragma("unroll") for (int k = 0; k < 2; ++k) dst[n][k] = *(const PG8_LAS bf16x8*)(lds + PG8_SB(b, h) + boff + n * 2048 + k * 1024); } while (0)
#define PG8_MMA(ai, bj, At, Bt) do { __builtin_amdgcn_s_setprio(1); _Pragma("unroll") for (int m = 0; m < 4; ++m) _Pragma("unroll") for (int n = 0; n < 2; ++n) _Pragma("unroll") for (int k = 0; k < 2; ++k) \
        acc[ai][bj][m][n] = __builtin_amdgcn_mfma_f32_16x16x32_bf16(Bt[n][k], At[m][k], acc[ai][bj][m][n], 0, 0, 0); __builtin_amdgcn_s_setprio(0); } while (0)
#define PG8_WAIT_V(n) asm volatile("s_waitcnt vmcnt(" #n ")" ::: "memory")
#define PG8_WAIT_L(n) asm volatile("s_waitcnt lgkmcnt(" #n ")" ::: "memory")
#define PG8_BAR __builtin_amdgcn_s_barrier()
#define PG8_SCHED __builtin_amdgcn_sched_barrier(0)
    Unit cur, nxt; int ui = 0;
    if (!S.next(0, cur)) return;
    f32x4 acc[2][2][4][2];
#pragma unroll
    for (int a = 0; a < 2; ++a)
#pragma unroll
        for (int b = 0; b < 2; ++b)
#pragma unroll
            for (int m = 0; m < 4; ++m)
#pragma unroll
                for (int n = 0; n < 2; ++n) acc[a][b][m][n] = (f32x4){0.f, 0.f, 0.f, 0.f};
    bf16x8 At[4][2], B0[2][2], B1[2][2];
    const char* cA = (const char*)g.A + ((size_t)cur.z * g.sA) * 2 + (size_t)cur.pm * tA; const char* cB = (const char*)g.Bt + ((size_t)cur.z * g.sB) * 2 + (size_t)cur.pn * tB;
    PG8_STAGE(PG8_SB(0, 0), cB, voffB); PG8_STAGE(PG8_SA(0, 0), cA, voffA); PG8_STAGE(PG8_SB(0, 1), cB + hB, voffB); PG8_STAGE(PG8_SA(0, 1), cA + hA, voffA);
    if (wr == 1) PG8_BAR;
    PG8_WAIT_V(4); PG8_BAR;
    PG8_STAGE(PG8_SB(1, 0), cB + kstep, voffB); PG8_STAGE(PG8_SA(1, 0), cA + kstep, voffA); PG8_STAGE(PG8_SB(1, 1), cB + hB + kstep, voffB);
    PG8_WAIT_V(6); PG8_BAR;
    for (;;) {
        const bool has_next = S.next(ui + 1, nxt);
        const char* nA = has_next ? (const char*)g.A + ((size_t)nxt.z * g.sA) * 2 + (size_t)nxt.pm * tA : cA; const char* nB = has_next ? (const char*)g.Bt + ((size_t)nxt.z * g.sB) * 2 + (size_t)nxt.pn * tB : cB;
        for (int t = 0; t < nt; t += 2) {
            const bool last = (t == nt - 2);
            if constexpr (Epi::MID) { if (t == (nt >> 1)) E.mid(acc, cur, wr, fr); }
            const char* a1 = cA + (size_t)(t + 1) * kstep;
            const char* a2 = last ? nA : cA + (size_t)(t + 2) * kstep; const char* b2 = last ? nB : cB + (size_t)(t + 2) * kstep;
            const char* a3 = a2 + kstep; const char* b3 = b2 + kstep;
            PG8_LDB(B0, 0, 0); PG8_SCHED; PG8_LDA(At, 0, 0); PG8_STAGE(PG8_SA(1, 1), a1 + hA, voffA);
            PG8_WAIT_L(8); PG8_BAR; PG8_WAIT_L(0); PG8_MMA(0, 0, At, B0); PG8_BAR; PG8_SCHED;
            PG8_LDB(B1, 0, 1); PG8_STAGE(PG8_SB(0, 0), b2, voffB);
            PG8_BAR; PG8_WAIT_L(0); PG8_MMA(0, 1, At, B1); PG8_BAR;
            PG8_LDA(At, 0, 1); PG8_STAGE(PG8_SA(0, 0), a2, voffA);
            PG8_BAR; PG8_WAIT_L(0); PG8_MMA(1, 0, At, B0); PG8_BAR; PG8_SCHED;
            PG8_STAGE(PG8_SB(0, 1), b2 + hB, voffB);
            PG8_WAIT_V(6); PG8_BAR; PG8_MMA(1, 1, At, B1); PG8_BAR;
            PG8_LDB(B0, 1, 0); PG8_SCHED; PG8_LDA(At, 1, 0); PG8_STAGE(PG8_SA(0, 1), a2 + hA, voffA);
            PG8_WAIT_L(8); PG8_BAR; PG8_WAIT_L(0); PG8_MMA(0, 0, At, B0); PG8_BAR; PG8_SCHED;
            PG8_LDB(B1, 1, 1); PG8_STAGE(PG8_SB(1, 0), b3, voffB);
            PG8_BAR; PG8_WAIT_L(0); PG8_MMA(0, 1, At, B1); PG8_BAR;
            PG8_LDA(At, 1, 1); PG8_STAGE(PG8_SA(1, 0), a3, voffA);
            PG8_BAR; PG8_WAIT_L(0); PG8_MMA(1, 0, At, B0); PG8_BAR; PG8_SCHED;
            PG8_STAGE(PG8_SB(1, 1), b3 + hB, voffB);
            PG8_WAIT_V(6); PG8_BAR; PG8_MMA(1, 1, At, B1); PG8_BAR;
        }
        E(acc, cur, wr, wc, fr, fq);
        if (!has_next) break;
#pragma unroll
        for (int a = 0; a < 2; ++a)
#pragma unroll
            for (int b = 0; b < 2; ++b)
#pragma unroll
                for (int m = 0; m < 4; ++m)
#pragma unroll
                    for (int n = 0; n < 2; ++n) acc[a][b][m][n] = (f32x4){0.f, 0.f, 0.f, 0.f};
        cur = nxt; cA = nA; cB = nB; ++ui;
    }
    PG8_WAIT_V(0);
    if (wr == 0) PG8_BAR;
    PG8_BAR;
#undef PG8_SA
#undef PG8_SB
#undef PG8_STAGE
#undef PG8_LDA
#undef PG8_LDB
#undef PG8_MMA
#undef PG8_WAIT_V
#undef PG8_WAIT_L
#undef PG8_BAR
#undef PG8_SCHED
}
}

typedef const f32x4 (&AccRef)[2][2][4][2];
__device__ __forceinline__ u32x4 pack8(f32x4 a, f32x4 b) { u32x4 w; w.x = pk2(a[0], a[1]); w.y = pk2(a[2], a[3]); w.z = pk2(b[0], b[1]); w.w = pk2(b[2], b[3]); return w; }

struct EpiIn {
    static constexpr bool PERM = true, MID = false;
    bf16* ZF; bf16* UB; const float* r;
    __device__ __forceinline__ void operator()(AccRef acc, const pg8::Unit& u, int wr, int wc, int fr, int fq) const {
#pragma unroll
        for (int ai = 0; ai < 2; ++ai)
#pragma unroll
            for (int m = 0; m < 4; ++m) {
                const int row = u.pm * 256 + ai * 128 + wr * 64 + m * 16 + fr; const float rs = r[row];
#pragma unroll
                for (int bj = 0; bj < 2; ++bj) {
                    const int col0 = u.pn * 256 + bj * 128 + wc * 32 + 8 * fq;
                    const u32x4 w = pack8(acc[ai][bj][m][0] * rs, acc[ai][bj][m][1] * rs);
                    if (col0 < 512) *(u32x4*)(ZF + (size_t)row * 512 + col0) = w;
                    else { const int c2 = col0 - 512, gg = c2 >> 4, h0 = c2 & 15; *(u32x4*)(UB + ((size_t)(gg * 2048 + (row >> 4)) * 512 + (row & 15) * 16 + h0)) = w; }
                }
            }
    }
};
struct EpiSloc {
    static constexpr bool PERM = false, MID = false;
    float* S;
    __device__ __forceinline__ void operator()(AccRef acc, const pg8::Unit& u, int wr, int wc, int fr, int fq) const {
#pragma unroll
        for (int ai = 0; ai < 2; ++ai)
#pragma unroll
            for (int m = 0; m < 4; ++m) {
                const int row = u.pm * 256 + ai * 128 + wr * 64 + m * 16 + fr;
                float* rp = S + ((size_t)u.z * 2048 + row) * 256 + wc * 32 + 4 * fq;
#pragma unroll
                for (int bj = 0; bj < 2; ++bj)
#pragma unroll
                    for (int n = 0; n < 2; ++n) *(f32x4*)(rp + bj * 128 + n * 16) = acc[ai][bj][m][n];
            }
    }
};
struct EpiSsmOut {
    static constexpr bool PERM = true, MID = false;
    bf16* G;
    __device__ __forceinline__ void operator()(AccRef acc, const pg8::Unit& u, int wr, int wc, int fr, int fq) const {
#pragma unroll
        for (int ai = 0; ai < 2; ++ai)
#pragma unroll
            for (int m = 0; m < 4; ++m) {
                const int row = u.pm * 256 + ai * 128 + wr * 64 + m * 16 + fr;
#pragma unroll
                for (int bj = 0; bj < 2; ++bj) {
                    const int col0 = bj * 128 + wc * 32 + 8 * fq, t = col0 >> 4, i0 = col0 & 15;
                    f32x4 a = acc[ai][bj][m][0], b = acc[ai][bj][m][1];
#pragma unroll
                    for (int j = 0; j < 4; ++j) { a[j] = gelu_t(a[j]); b[j] = gelu_t(b[j]); }
                    *(u32x4*)(G + ((size_t)row * 16 + t) * 512 + u.z * 16 + i0) = pack8(a, b);
                }
            }
    }
};
struct EpiGlu {
    static constexpr bool PERM = true, MID = false;
    const bf16* G; const float* bias; bf16* AO; float* ss;
    __device__ __forceinline__ void operator()(AccRef acc, const pg8::Unit& u, int wr, int wc, int fr, int fq) const {
#pragma unroll
        for (int ai = 0; ai < 2; ++ai)
#pragma unroll
            for (int m = 0; m < 4; ++m) {
                const int row = u.pm * 256 + ai * 128 + wr * 64 + m * 16 + fr; float s2 = 0.f;
#pragma unroll
                for (int bj = 0; bj < 2; ++bj) {
                    const int col0 = u.pn * 256 + bj * 128 + wc * 32 + 8 * fq;
                    const u32x4 gv = *(const u32x4*)(G + (size_t)row * 512 + col0);
                    const f32x4 b0 = *(const f32x4*)(bias + col0), b1 = *(const f32x4*)(bias + col0 + 4);
                    f32x4 a = acc[ai][bj][m][0] + b0, b = acc[ai][bj][m][1] + b1;
                    a[0] = bflo(gv.x) * sigm(a[0]); a[1] = bfhi(gv.x) * sigm(a[1]); a[2] = bflo(gv.y) * sigm(a[2]); a[3] = bfhi(gv.y) * sigm(a[3]);
                    b[0] = bflo(gv.z) * sigm(b[0]); b[1] = bfhi(gv.z) * sigm(b[1]); b[2] = bflo(gv.w) * sigm(b[2]); b[3] = bfhi(gv.w) * sigm(b[3]);
#pragma unroll
                    for (int j = 0; j < 4; ++j) s2 += a[j] * a[j] + b[j] * b[j];
                    *(u32x4*)(AO + (size_t)row * 1024 + 512 + col0) = pack8(a, b);
                }
                s2 += __shfl_xor(s2, 16); s2 += __shfl_xor(s2, 32);
                if (fq == 0) ss[row * 8 + u.pn * 4 + wc] = s2;
            }
    }
};
struct EpiOutSS {
    static constexpr bool PERM = true, MID = false;
    bf16* O; float* ss;
    __device__ __forceinline__ void operator()(AccRef acc, const pg8::Unit& u, int wr, int wc, int fr, int fq) const {
#pragma unroll
        for (int ai = 0; ai < 2; ++ai)
#pragma unroll
            for (int m = 0; m < 4; ++m) {
                const int row = u.pm * 256 + ai * 128 + wr * 64 + m * 16 + fr; float s2 = 0.f;
#pragma unroll
                for (int bj = 0; bj < 2; ++bj) {
                    const int col0 = u.pn * 256 + bj * 128 + wc * 32 + 8 * fq;
                    const f32x4 a = acc[ai][bj][m][0], b = acc[ai][bj][m][1];
#pragma unroll
                    for (int j = 0; j < 4; ++j) s2 += a[j] * a[j] + b[j] * b[j];
                    *(u32x4*)(O + (size_t)row * 1024 + col0) = pack8(a, b);
                }
                s2 += __shfl_xor(s2, 16); s2 += __shfl_xor(s2, 32);
                if (fq == 0) ss[row * 16 + u.pn * 4 + wc] = s2;
            }
    }
};
struct EpiOutMix {
    static constexpr bool PERM = true, MID = true;
    bf16* O; float* ss; const LAS float* qv;
    __device__ __forceinline__ void mid(f32x4 (&acc)[2][2][4][2], const pg8::Unit& u, int wr, int fr) const {
#pragma unroll
        for (int ai = 0; ai < 2; ++ai)
#pragma unroll
            for (int m = 0; m < 4; ++m) { const float q = qv[u.ui * 256 + ai * 128 + wr * 64 + m * 16 + fr];
#pragma unroll
                for (int bj = 0; bj < 2; ++bj)
#pragma unroll
                    for (int n = 0; n < 2; ++n) acc[ai][bj][m][n] *= q; }
    }
    __device__ __forceinline__ void operator()(AccRef acc, const pg8::Unit& u, int wr, int wc, int fr, int fq) const {
#pragma unroll
        for (int ai = 0; ai < 2; ++ai)
#pragma unroll
            for (int m = 0; m < 4; ++m) {
                const int rl = ai * 128 + wr * 64 + m * 16 + fr, row = u.pm * 256 + rl; float s2 = 0.f; const float rs = qv[1024 + u.ui * 256 + rl];
#pragma unroll
                for (int bj = 0; bj < 2; ++bj) {
                    const int col0 = u.pn * 256 + bj * 128 + wc * 32 + 8 * fq;
                    const f32x4 a = acc[ai][bj][m][0] * rs, b = acc[ai][bj][m][1] * rs;
#pragma unroll
                    for (int j = 0; j < 4; ++j) s2 += a[j] * a[j] + b[j] * b[j];
                    *(u32x4*)(O + (size_t)row * 1024 + col0) = pack8(a, b);
                }
                s2 += __shfl_xor(s2, 16); s2 += __shfl_xor(s2, 32);
                if (fq == 0) ss[row * 16 + u.pn * 4 + wc] = s2;
            }
    }
};
struct EpiFF1 {
    static constexpr bool PERM = true, MID = false;
    bf16* H; const float* r;
    __device__ __forceinline__ void operator()(AccRef acc, const pg8::Unit& u, int wr, int wc, int fr, int fq) const {
#pragma unroll
        for (int ai = 0; ai < 2; ++ai)
#pragma unroll
            for (int m = 0; m < 4; ++m) {
                const int row = u.pm * 256 + ai * 128 + wr * 64 + m * 16 + fr; const float rs = r[row];
#pragma unroll
                for (int bj = 0; bj < 2; ++bj) {
                    const int col0 = u.pn * 256 + bj * 128 + wc * 32 + 8 * fq;
                    f32x4 a = acc[ai][bj][m][0] * rs, b = acc[ai][bj][m][1] * rs;
#pragma unroll
                    for (int j = 0; j < 4; ++j) { a[j] = fmaxf(a[j], 0.f); a[j] *= a[j]; b[j] = fmaxf(b[j], 0.f); b[j] *= b[j]; }
                    __builtin_nontemporal_store(pack8(a, b), (u32x4*)(H + (size_t)row * 4096 + col0));
                }
            }
    }
};

__device__ __forceinline__ void transpose_item(const float* W, int ldw, bf16* WT, int ldt, const float* sc_lo, const float* sc_hi, int split,
                                               LAS float* scr, int item, int nblk, int lane) {
    const int kb = item / nblk, nb = item % nblk, k0 = 64 * kb, n0 = 64 * nb;
#pragma unroll 16
    for (int i = 0; i < 32; ++i) { const int kk = 2 * i + (lane >> 5), k = k0 + kk;
        float s = 1.f; if (sc_lo) s = (k < split) ? sc_lo[k] : sc_hi[k - split];
        const f32x2 w = __builtin_nontemporal_load((const f32x2*)(W + (size_t)k * ldw + n0 + 2 * (lane & 31)));
        scr[kk * 65 + 2 * (lane & 31)] = w[0] * s; scr[kk * 65 + 2 * (lane & 31) + 1] = w[1] * s; }
    asm volatile("s_waitcnt lgkmcnt(0)" ::: "memory");
    const int c = lane & 7;
#pragma unroll
    for (int j = 0; j < 8; ++j) { const int n = (lane >> 3) + 8 * j; const LAS float* s = scr + (8 * c) * 65 + n;
        u32x4 o; o.x = pk2(s[0 * 65], s[1 * 65]); o.y = pk2(s[2 * 65], s[3 * 65]); o.z = pk2(s[4 * 65], s[5 * 65]); o.w = pk2(s[6 * 65], s[7 * 65]);
        *(u32x4*)(WT + (size_t)(n0 + n) * ldt + k0 + 8 * c) = o; }
    asm volatile("s_waitcnt lgkmcnt(0)" ::: "memory");
}

__device__ __forceinline__ void ssm_mat_item(const Params& p, int item, LAS unsigned char* lds) {
    int tid = threadIdx.x; asm volatile("" : "+v"(tid)); const int ly = item >> 7, g = (item >> 2) & 31, qt = item & 3;
    LAS float* pwr = (LAS float*)lds;
    LAS float* pwi = pwr + 2 * 64 * 20;
    LAS float* bbr = pwi + 2 * 64 * 20;
    LAS float* bbi = bbr + 2 * 64 * 16;
    LAS float* ccr = bbi + 2 * 64 * 16;
    LAS float* cci = ccr + 2 * 16 * 64;
    LAS float* Gt = cci + 2 * 16 * 64;
    __syncthreads();
    { const int k = (tid >> 6) & 1, pp = tid & 63, tg = tid >> 7; const int idx = (ly * 2 + k) * 32 + g;
      const float dt = expf(p.log_dt[idx]); const float lr = p.lam_re[idx * 64 + pp] * dt, li = p.lam_im[idx * 64 + pp] * dt;
#pragma unroll
      for (int j = 0; j < 5; ++j) { const int tau = tg * 5 + j; if (tau <= 16) { const float e = __expf(lr * tau); float sn, cs; __sincosf(li * tau, &sn, &cs); pwr[(k * 64 + pp) * 20 + tau] = e * cs; pwi[(k * 64 + pp) * 20 + tau] = e * sn; } } }
    for (int i = tid; i < 2048; i += 512) { const int k = i >> 10, r = i & 1023; const int idx = (ly * 2 + k) * 32 + g; ccr[i] = p.c_re[(size_t)idx * 1024 + r]; cci[i] = p.c_im[(size_t)idx * 1024 + r]; }
    __syncthreads();
#pragma unroll
    for (int j = 0; j < 4; ++j) { const int o = tid + 512 * j, k = o >> 10, pp = (o >> 4) & 63, h = o & 15; const int idx = (ly * 2 + k) * 32 + g;
        const float lr = p.lam_re[idx * 64 + pp], li = p.lam_im[idx * 64 + pp], dt = expf(p.log_dt[idx]);
        float sn, cs; sincosf(li * dt, &sn, &cs); const float em1 = expm1f(lr * dt), sh = sinf(0.5f * li * dt);
        const float lbr = em1 * cs - 2.0f * sh * sh, lbi = (em1 + 1.0f) * sn;
        const float den = 1.0f / (lr * lr + li * li); const float cr = (lbr * lr + lbi * li) * den, ci = (lbi * lr - lbr * li) * den;
        const float br = p.b_re[(size_t)idx * 1024 + pp * 16 + h], bi = p.b_im[(size_t)idx * 1024 + pp * 16 + h];
        bbr[o] = cr * br - ci * bi; bbi[o] = cr * bi + ci * br; }
    __syncthreads();
    { const int k = tid >> 8, i = (tid >> 4) & 15, h = tid & 15; float a[16];
#pragma unroll
      for (int tau = 0; tau < 16; ++tau) a[tau] = 0.f;
#pragma nounroll
      for (int pp = 0; pp < 64; ++pp) { const float c_r = ccr[(k * 16 + i) * 64 + pp], c_i = cci[(k * 16 + i) * 64 + pp], b_r = bbr[(k * 64 + pp) * 16 + h], b_i = bbi[(k * 64 + pp) * 16 + h];
          const float xr = c_r * b_r - c_i * b_i, xi = c_r * b_i + c_i * b_r;
          const LAS f32x4* pr4 = (const LAS f32x4*)(pwr + (k * 64 + pp) * 20); const LAS f32x4* pi4 = (const LAS f32x4*)(pwi + (k * 64 + pp) * 20);
#pragma unroll
          for (int t4 = 0; t4 < 4; ++t4) { const f32x4 vr = pr4[t4], vi = pi4[t4];
#pragma unroll
              for (int e = 0; e < 4; ++e) a[t4 * 4 + e] += xr * vr[e] - xi * vi[e]; } }
#pragma unroll
      for (int tau = 0; tau < 16; ++tau) Gt[((k * 16 + tau) * 16 + i) * 16 + h] = a[tau]; }
    __syncthreads();
    bf16* TM = (bf16*)(p.ws + OFF_TM) + (size_t)(ly * 32 + g) * 256 * 512; bf16* MS = (bf16*)(p.ws + OFF_MST) + (size_t)(ly * 32 + g) * 256 * 256;
    const float* dsk = p.d_skip + (ly * 32 + g) * 16;
    for (int o = qt * 64 * 512 + tid; o < (qt + 1) * 64 * 512; o += 512) { const int r = o >> 9, col = o & 511, t = r >> 4, i = r & 15; float v;
        if (col < 256) { const int j = col >> 4, h = col & 15; v = 0.f;
            if (j <= t) v += Gt[((0 * 16 + (t - j)) * 16 + i) * 16 + h];
            if (j >= t) v += Gt[((1 * 16 + (j - t)) * 16 + i) * 16 + h];
            if (j == t && h == i) v += dsk[i]; }
        else { const int k = (col - 256) >> 7, q = (col - 256) & 127, pp = q >> 1, part = q & 1; const int tau = k == 0 ? (t + 1) : (16 - t);
            const float c_r = ccr[(k * 16 + i) * 64 + pp], c_i = cci[(k * 16 + i) * 64 + pp], l_r = pwr[(k * 64 + pp) * 20 + tau], l_i = pwi[(k * 64 + pp) * 20 + tau];
            v = part == 0 ? (c_r * l_r - c_i * l_i) : -(c_r * l_i + c_i * l_r); }
        TM[o] = (bf16)f2bf(v); }
    for (int o = qt * 64 * 256 + tid; o < (qt + 1) * 64 * 256; o += 512) { const int r = o >> 8, col = o & 255, k = r >> 7, q = r & 127, pp = q >> 1, part = q & 1, j = col >> 4, h = col & 15;
        const int tau = k == 0 ? (15 - j) : j;
        const float l_r = pwr[(k * 64 + pp) * 20 + tau], l_i = pwi[(k * 64 + pp) * 20 + tau], b_r = bbr[(k * 64 + pp) * 16 + h], b_i = bbi[(k * 64 + pp) * 16 + h];
        const float v = part == 0 ? (l_r * b_r - l_i * b_i) : (l_r * b_i + l_i * b_r);
        MS[o] = (bf16)f2bf(v); }
}

__device__ __forceinline__ void p0_prologue(const Params& p, LAS unsigned char* lds, int G, int bid) {
    int tid = threadIdx.x; asm volatile("" : "+v"(tid));
    const int lane = tid & 63, wave = __builtin_amdgcn_readfirstlane(tid >> 6);
    for (int rp = 0; rp < P0_REP_A; ++rp)
    for (int it = bid; it < 256; it += G) ssm_mat_item(p, it, lds);
    __syncthreads();
    {
        LAS float* scr = (LAS float*)(lds + wave * 16640);
        const int gw = bid * 8 + wave, NGW = G * 8;
        constexpr int I_IN = 16 * 16, I_OUT = 16 * 16, I_1 = 16 * 64, I_2 = 64 * 16, I_G = 8 * 8, I_L = I_IN + I_OUT + I_1 + I_2 + I_G;
        for (int rp = 0; rp < P0_REP_B; ++rp)
        for (int it = gw; it < 2 * I_L; it += NGW) {
            const int ly = it / I_L; int r = it % I_L; unsigned char* wb = p.ws + OFF_W + (size_t)ly * W_LAYER;
            if (r < I_IN) { transpose_item(p.w_in + (size_t)ly * 1024 * 1024, 1024, (bf16*)(wb + W_IN), 1024, p.pre_mix_g + ly * 1024, nullptr, 1 << 30, scr, r, 16, lane); continue; } r -= I_IN;
            if (r < I_OUT) { transpose_item(p.w_out + (size_t)ly * 1024 * 1024, 1024, (bf16*)(wb + W_OUT), 1024, p.fourier_out_g + ly * 512, p.ssm_out_g + ly * 512, 512, scr, r, 16, lane); continue; } r -= I_OUT;
            if (r < I_1) { transpose_item(p.w_ff1 + (size_t)ly * 1024 * 4096, 4096, (bf16*)(wb + W_1), 1024, p.pre_mlp_g + ly * 1024, nullptr, 1 << 30, scr, r, 64, lane); continue; } r -= I_1;
            if (r < I_2) { transpose_item(p.w_ff2 + (size_t)ly * 4096 * 1024, 1024, (bf16*)(wb + W_2), 4096, nullptr, nullptr, 0, scr, r, 16, lane); continue; } r -= I_2;
            transpose_item(p.w_glu + (size_t)ly * 512 * 512, 512, (bf16*)(wb + W_GLU), 512, nullptr, nullptr, 0, scr, r, 8, lane);
        }
        bf16* XB = (bf16*)(p.ws + OFF_XB); float* rA = (float*)(p.ws + OFF_RA);
        for (int rp = 0; rp < P0_REP_C; ++rp)
        for (int row0 = gw; row0 < MT; row0 += 4 * NGW) {
            f32x4 v[4][4];
#pragma unroll
            for (int rr = 0; rr < 4; ++rr) { const f32x4* xr = (const f32x4*)(p.x + (size_t)(row0 + rr * NGW) * 1024) + lane;
#pragma unroll
                for (int j = 0; j < 4; ++j) v[rr][j] = __builtin_nontemporal_load(xr + 64 * j); }
#pragma unroll
            for (int rr = 0; rr < 4; ++rr) { const int row = row0 + rr * NGW; float s2 = 0.f;
                u32x2* o = (u32x2*)(XB + (size_t)row * 1024) + lane;
#pragma unroll
                for (int j = 0; j < 4; ++j) { const f32x4 t = v[rr][j]; s2 += t[0] * t[0] + t[1] * t[1] + t[2] * t[2] + t[3] * t[3]; u32x2 w; w.x = pk2(t[0], t[1]); w.y = pk2(t[2], t[3]); o[64 * j] = w; }
                s2 = wave_sum(s2);
                if (lane == 0) rA[row] = rsqrtf(s2 * (1.0f / 1024.0f) + EPS); }
        }
    }
    {
        bf16* D1 = (bf16*)(p.ws + OFF_D1); bf16* E3 = (bf16*)(p.ws + OFF_E3);
        const int gt = bid * 512 + tid, NT = G * 512;
        for (int idx = gt; idx < 64 * 2 * 128 * 128; idx += NT) { const int n2 = idx >> 15, sel = (idx >> 14) & 1, k1 = (idx >> 7) & 127, n1 = idx & 127;
            const int ph = (k1 * (64 * n1 + n2)) & 8191; float s, c; sincospif((float)ph * (1.0f / 4096.0f), &s, &c); D1[idx] = (bf16)f2bf(sel ? s : c); }
        bf16* E3I = (bf16*)(p.ws + OFF_E3I); bf16* FM = (bf16*)(p.ws + OFF_FMIX);
        for (int idx = gt; idx < 64 * 128; idx += NT) { const int k2 = idx >> 7, col = idx & 127, part = col >> 6, n2 = col & 63;
            const int ph = (n2 * k2) & 63; float s, c; sincospif((float)ph * (1.0f / 32.0f), &s, &c);
            E3[idx] = (bf16)f2bf(part ? s : c);
            E3I[idx] = (bf16)f2bf(part ? c : -s); }
        LAS float* cst = (LAS float*)lds;
        __syncthreads();
        if (tid < 64) { float sn, cs; sincospif((float)tid * (1.0f / 32.0f), &sn, &cs); cst[tid] = cs; cst[64 + tid] = sn; }
        __syncthreads();
        for (int idx = gt; idx < 2 * 8 * 64 * 128; idx += NT) { const int lh = idx >> 13, e = (idx >> 7) & 63, col = idx & 127, part = col >> 6, c = col & 63;
            const float* wf = p.w_fourier + (size_t)lh * 4096; float a = 0.f;
#pragma unroll 8
            for (int d = 0; d < 64; ++d) a += cst[64 * part + ((c * d) & 63)] * wf[d * 64 + e];
            FM[idx] = (bf16)f2bf(a * (1.0f / 724.0773439350247f)); }
    }
}

typedef short v4s16 __attribute__((ext_vector_type(4)));
__device__ __forceinline__ bf16x8 negbf(bf16x8 v) { u32x4 t = __builtin_bit_cast(u32x4, v); t = t ^ 0x80008000u; return __builtin_bit_cast(bf16x8, t); }
__device__ __forceinline__ bf16x8 tr_frag(const LAS unsigned char* a, int hs) {
    const v4s16 lo = __builtin_amdgcn_ds_read_tr16_b64_v4i16((LAS v4s16*)a), hi = __builtin_amdgcn_ds_read_tr16_b64_v4i16((LAS v4s16*)(a + hs));
    return __builtin_shufflevector(lo, hi, 0, 1, 2, 3, 4, 5, 6, 7);
}
constexpr int F1_P = 264, F1_CS = 128 * F1_P;
__device__ __forceinline__ void fft1_phase(const bf16* ZF, const bf16* D1, bf16* T, LAS unsigned char* lds, int G, int bid) {
    int tid = threadIdx.x; asm volatile("" : "+v"(tid));
    const int lane = tid & 63, wave = __builtin_amdgcn_readfirstlane(tid >> 6), wm = wave & 3, wn = wave >> 2, fr = lane & 15, fq = lane >> 4, tq = fr >> 2, tp = fr & 3;
    for (int pr = bid; pr < 256; pr += G) {
        const int n2 = pr & 63, cb = pr >> 6;
        __syncthreads();
        {
            const bf16* src = D1 + (size_t)n2 * 2 * 128 * 128;
#pragma unroll
            for (int j = 0; j < 8; ++j) { const int q = tid + 512 * j, sel = q >> 11, row = (q >> 4) & 127, cc = q & 15;
                *(LAS u32x4*)(lds + F1_CS + sel * 34816 + row * 272 + cc * 16) = *(const u32x4*)(src + sel * 16384 + row * 128 + 8 * cc); }
        }
        u32x4 pre[4];
#pragma unroll
        for (int j = 0; j < 4; ++j) { const int q = tid + 512 * j, n1 = q >> 4, cc = q & 15; pre[j] = *(const u32x4*)(ZF + ((size_t)(64 * n1 + n2)) * 512 + cb * 128 + 8 * cc); }
        for (int b = 0; b < NB; ++b) {
            __syncthreads();
#pragma unroll
            for (int j = 0; j < 4; ++j) { const int q = tid + 512 * j, n1 = q >> 4, cc = q & 15; const u32x4 v = pre[j];
                LAS u32x2* d = (LAS u32x2*)(lds + n1 * F1_P + cc * 16); d[0] = (u32x2){v.x, v.y}; d[1] = (u32x2){v.z, v.w}; }
            __syncthreads();
            if (b + 1 < NB) {
#pragma unroll
                for (int j = 0; j < 4; ++j) { const int q = tid + 512 * j, n1 = q >> 4, cc = q & 15; pre[j] = *(const u32x4*)(ZF + ((size_t)((b + 1) * SEQ + 64 * n1 + n2)) * 512 + cb * 128 + 8 * cc); } }
            f32x4 Ar[2][4], Ai[2][4];
#pragma unroll
            for (int mb = 0; mb < 2; ++mb)
#pragma unroll
                for (int nb = 0; nb < 4; ++nb) { Ar[mb][nb] = (f32x4){0.f, 0.f, 0.f, 0.f}; Ai[mb][nb] = (f32x4){0.f, 0.f, 0.f, 0.f}; }
#pragma nounroll
            for (int ks = 0; ks < 4; ++ks) {
                bf16x8 Bf[4];
#pragma unroll
                for (int nb = 0; nb < 4; ++nb) Bf[nb] = tr_frag(lds + (32 * ks + 8 * fq + tq) * F1_P + (64 * wn + 16 * tp + 4 * nb) * 2, 4 * F1_P);
                bf16x8 Cf[2], Sf[2];
#pragma unroll
                for (int mb = 0; mb < 2; ++mb) { const int off = F1_CS + (32 * wm + 16 * mb + fr) * 272 + (32 * ks + 8 * fq) * 2; Cf[mb] = *(const LAS bf16x8*)(lds + off); Sf[mb] = *(const LAS bf16x8*)(lds + off + 34816); }
#pragma unroll
                for (int mb = 0; mb < 2; ++mb)
#pragma unroll
                    for (int nb = 0; nb < 4; ++nb) {
                        Ar[mb][nb] = __builtin_amdgcn_mfma_f32_16x16x32_bf16(Bf[nb], Cf[mb], Ar[mb][nb], 0, 0, 0);
                        Ai[mb][nb] = __builtin_amdgcn_mfma_f32_16x16x32_bf16(Bf[nb], negbf(Sf[mb]), Ai[mb][nb], 0, 0, 0); }
            }
#pragma unroll
            for (int mb = 0; mb < 2; ++mb) { const int k1 = 32 * wm + 16 * mb + fr, c = cb * 128 + 64 * wn + 16 * fq;
                bf16* t0 = T + ((((size_t)(b * 128 + k1) * 2 + 0) * 64 + n2) * 512 + c); bf16* t1 = t0 + 64 * 512;
                *(u32x4*)t0 = pack8(Ar[mb][0], Ar[mb][1]); *(u32x4*)(t0 + 8) = pack8(Ar[mb][2], Ar[mb][3]);
                *(u32x4*)t1 = pack8(Ai[mb][0], Ai[mb][1]); *(u32x4*)(t1 + 8) = pack8(Ai[mb][2], Ai[mb][3]); }
        }
    }
    __syncthreads();
}

constexpr int F3_P = 1088;
__device__ __forceinline__ bf16x8 pack8b(f32x4 a, f32x4 b) { return __builtin_bit_cast(bf16x8, pack8(a, b)); }
__device__ __forceinline__ void fft3_phase(const bf16* T, const bf16* E3, const bf16* E3I, const bf16* FM, bf16* AO, LAS unsigned char* lds, int G, int bid) {
    int tid = threadIdx.x; asm volatile("" : "+v"(tid));
    const int lane = tid & 63, wave = __builtin_amdgcn_readfirstlane(tid >> 6), fr = lane & 15, fq = lane >> 4, tq = fr >> 2, tp = fr & 3;
    LAS float* red = (LAS float*)(lds + 128 * F3_P);
#define F3_ISSUE(u_) do { const bf16* src_ = T + (size_t)(u_) * 65536; _Pragma("unroll") for (int j_ = 0; j_ < 16; ++j_) { const int row_ = wave * 16 + j_; \
        __builtin_amdgcn_global_load_lds((const unsigned*)(src_ + row_ * 512 + lane * 8), (LAS unsigned*)(lds + row_ * F3_P), 16, 0, 0); } } while (0)
    if (bid < 512) F3_ISSUE(bid);
    for (int unit = bid; unit < 512; unit += G) {
        const int b = unit >> 7, k1 = unit & 127;
        asm volatile("s_waitcnt vmcnt(0)" ::: "memory");
        __syncthreads();
        f32x4 gr[4][4], gi[4][4];
#pragma unroll
        for (int mb = 0; mb < 4; ++mb)
#pragma unroll
            for (int nb = 0; nb < 4; ++nb) { gr[mb][nb] = (f32x4){0.f, 0.f, 0.f, 0.f}; gi[mb][nb] = (f32x4){0.f, 0.f, 0.f, 0.f}; }
#pragma nounroll
        for (int ks = 0; ks < 4; ++ks) {
            bf16x8 Bf[4], Er[4], Ei[4];
#pragma unroll
            for (int mb = 0; mb < 4; ++mb) { const int off = (16 * mb + fr) * 128 + 32 * ks + 8 * fq; Er[mb] = *(const bf16x8*)(E3 + off); Ei[mb] = *(const bf16x8*)(E3I + off); }
#pragma unroll
            for (int nb = 0; nb < 4; ++nb) Bf[nb] = tr_frag(lds + (32 * ks + 8 * fq + tq) * F3_P + (64 * wave + 32 * (nb >> 1) + 8 * tp + 4 * (nb & 1)) * 2, 4 * F3_P);
#pragma unroll
            for (int mb = 0; mb < 4; ++mb)
#pragma unroll
                for (int nb = 0; nb < 4; ++nb) { gr[mb][nb] = __builtin_amdgcn_mfma_f32_16x16x32_bf16(Bf[nb], Er[mb], gr[mb][nb], 0, 0, 0);
                                                 gi[mb][nb] = __builtin_amdgcn_mfma_f32_16x16x32_bf16(Bf[nb], Ei[mb], gi[mb][nb], 0, 0, 0); }
        }
        __syncthreads();
        if (unit + G < 512) F3_ISSUE(unit + G);
        bf16x8 Af[4][4];
#pragma unroll
        for (int mb = 0; mb < 4; ++mb) { Af[0][mb] = pack8b(gr[mb][0], gr[mb][1]); Af[1][mb] = pack8b(gr[mb][2], gr[mb][3]); Af[2][mb] = pack8b(gi[mb][0], gi[mb][1]); Af[3][mb] = pack8b(gi[mb][2], gi[mb][3]); }
        f32x4 acc[4][4];
#pragma unroll
        for (int mb = 0; mb < 4; ++mb)
#pragma unroll
            for (int nb = 0; nb < 4; ++nb) acc[mb][nb] = (f32x4){0.f, 0.f, 0.f, 0.f};
        const bf16* fm = FM + (size_t)wave * 64 * 128;
#pragma unroll
        for (int kst = 0; kst < 4; ++kst) {
            bf16x8 Ff[4];
#pragma unroll
            for (int nb = 0; nb < 4; ++nb) Ff[nb] = *(const bf16x8*)(fm + (16 * tq + 4 * nb + tp) * 128 + 32 * kst + 8 * fq);
#pragma unroll
            for (int mb = 0; mb < 4; ++mb)
#pragma unroll
                for (int nb = 0; nb < 4; ++nb) acc[mb][nb] = __builtin_amdgcn_mfma_f32_16x16x32_bf16(Ff[nb], Af[kst][mb], acc[mb][nb], 0, 0, 0);
        }
#pragma unroll
        for (int mb = 0; mb < 4; ++mb) { float s = 0.f;
#pragma unroll
            for (int nb = 0; nb < 4; ++nb)
#pragma unroll
                for (int j = 0; j < 4; ++j) s += acc[mb][nb][j] * acc[mb][nb][j];
            s += __shfl_xor(s, 16); s += __shfl_xor(s, 32);
            if (fq == 0) red[wave * 64 + 16 * mb + fr] = s; }
        __syncthreads();
#pragma unroll
        for (int mb = 0; mb < 4; ++mb) { float tot = 0.f;
#pragma unroll
            for (int w = 0; w < 8; ++w) tot += red[w * 64 + 16 * mb + fr];
            const float rinv = rsqrtf(tot * (1.0f / 512.0f) + EPS);
            const size_t token = (size_t)b * SEQ + k1 + 128 * (16 * mb + fr);
            bf16* o = AO + token * 1024 + 64 * wave + 16 * fq;
            *(u32x4*)o = pack8(acc[mb][0] * rinv, acc[mb][1] * rinv); *(u32x4*)(o + 8) = pack8(acc[mb][2] * rinv, acc[mb][3] * rinv); }
    }
    __syncthreads();
}

__device__ __forceinline__ void carry_phase(const Params& p, int ly, const float* Sloc, bf16* UB, LAS unsigned char* lds, int G, int bid) {
    int tid = threadIdx.x; asm volatile("" : "+v"(tid));
    const int lane = tid & 63, wave = __builtin_amdgcn_readfirstlane(tid >> 6);
    LAS f32x2* ex = (LAS f32x2*)lds;
    for (int w = bid; w < 256; w += G) {
        const int dir = w & 1, g = (w >> 1) & 31, b = w >> 6, pp = lane; const int idx = (ly * 2 + dir) * 32 + g;
        const float dt = expf(p.log_dt[idx]); const float lr = p.lam_re[idx * 64 + pp] * dt * 16.0f, li = p.lam_im[idx * 64 + pp] * dt * 16.0f;
        const float e = expf(lr); float sn, cs; sincosf(li, &sn, &cs); const float l_r = e * cs, l_i = e * sn;
        float Lr = l_r, Li = l_i;
#pragma unroll
        for (int k = 0; k < 6; ++k) { const float nr = Lr * Lr - Li * Li, ni = 2.0f * Lr * Li; Lr = nr; Li = ni; }
        const float* src = Sloc + ((size_t)(g * 2048 + b * 512)) * 256 + dir * 128 + 2 * pp;
        bf16* dst = UB + ((size_t)(g * 2048 + b * 512)) * 512 + 256 + dir * 128 + 2 * pp;
        const int ss0 = dir == 0 ? wave * 64 : 511 - wave * 64; const long stp = dir == 0 ? 256 : -256;
        float cr = 0.f, ci = 0.f;
        { const float* ptr = src + (size_t)ss0 * 256;
#pragma nounroll
          for (int hb = 0; hb < 2; ++hb) {
            f32x2 v[32];
#pragma unroll
            for (int j = 0; j < 32; ++j) { v[j] = *(const f32x2*)ptr; ptr += stp; }
#pragma unroll
            for (int j = 0; j < 32; ++j) { const float nr = l_r * cr - l_i * ci + v[j][0], ni = l_r * ci + l_i * cr + v[j][1]; cr = nr; ci = ni; }
          } }
        __syncthreads();
        ex[wave * 64 + lane] = (f32x2){cr, ci};
        __syncthreads();
        cr = 0.f; ci = 0.f;
        for (int u = 0; u < wave; ++u) { const f32x2 eu = ex[u * 64 + lane]; const float nr = Lr * cr - Li * ci + eu[0], ni = Lr * ci + Li * cr + eu[1]; cr = nr; ci = ni; }
        { const float* ptr = src + (size_t)ss0 * 256; bf16* dp = dst + (size_t)ss0 * 512;
#pragma nounroll
          for (int hb = 0; hb < 2; ++hb) {
            f32x2 v[32];
#pragma unroll
            for (int j = 0; j < 32; ++j) { v[j] = *(const f32x2*)ptr; ptr += stp; }
#pragma unroll
            for (int j = 0; j < 32; ++j) {
                *(unsigned*)dp = pk2(cr, ci); dp += 2 * stp;
                const float nr = l_r * cr - l_i * ci + v[j][0], ni = l_r * ci + l_i * cr + v[j][1]; cr = nr; ci = ni; }
          } }
    }
    __syncthreads();
}

__device__ __forceinline__ void norm_phase(float* out, const bf16* MF, const float* ss, const float* gain, bf16* XB, float* rnext, bool last, int G, int bid) {
    int tid = threadIdx.x; asm volatile("" : "+v"(tid));
    const int lane = tid & 63, wave = __builtin_amdgcn_readfirstlane(tid >> 6);
    const int gw = bid * 8 + wave, NGW = G * 8;
    const f32x4* gr = (const f32x4*)gain + lane;
    const f32x4 g0 = gr[0], g1 = gr[64], g2 = gr[128], g3 = gr[192];
    for (int row0 = gw; row0 < MT; row0 += 2 * NGW) {
        u32x2 xv[2][4], mv[2][4]; float tot[2];
#pragma unroll
        for (int rr = 0; rr < 2; ++rr) { const int row = row0 + rr * NGW;
            const u32x2* xr = (const u32x2*)(XB + (size_t)row * 1024) + lane; const u32x2* mr = (const u32x2*)(MF + (size_t)row * 1024) + lane;
#pragma unroll
            for (int j = 0; j < 4; ++j) { xv[rr][j] = xr[64 * j]; mv[rr][j] = mr[64 * j]; }
            const f32x4* sp = (const f32x4*)(ss + (size_t)row * 16); const f32x4 s0 = sp[0], s1 = sp[1], s2 = sp[2], s3 = sp[3];
            tot[rr] = ((((s0[0] + s0[1]) + s0[2]) + s0[3]) + (((s1[0] + s1[1]) + s1[2]) + s1[3])) + ((((s2[0] + s2[1]) + s2[2]) + s2[3]) + (((s3[0] + s3[1]) + s3[2]) + s3[3])); }
#pragma unroll
        for (int rr = 0; rr < 2; ++rr) { const int row = row0 + rr * NGW;
            const float rinv = rsqrtf(tot[rr] * (1.0f / 1024.0f) + EPS); float s2 = 0.f;
#pragma unroll
            for (int j = 0; j < 4; ++j) { const f32x4 gg = j == 0 ? g0 : (j == 1 ? g1 : (j == 2 ? g2 : g3)); const u32x2 xx = xv[rr][j], mm = mv[rr][j]; f32x4 v;
                v[0] = bflo(xx.x) + bflo(mm.x) * rinv * gg[0]; v[1] = bfhi(xx.x) + bfhi(mm.x) * rinv * gg[1]; v[2] = bflo(xx.y) + bflo(mm.y) * rinv * gg[2]; v[3] = bfhi(xx.y) + bfhi(mm.y) * rinv * gg[3];
                if (last) { ((f32x4*)(out + (size_t)row * 1024) + lane)[64 * j] = v; }
                else { u32x2 w; w.x = pk2(v[0], v[1]); w.y = pk2(v[2], v[3]); ((u32x2*)(XB + (size_t)row * 1024) + lane)[64 * j] = w;
                       const float a0 = bflo(w.x), a1 = bfhi(w.x), a2 = bflo(w.y), a3 = bfhi(w.y); s2 += a0 * a0 + a1 * a1 + a2 * a2 + a3 * a3; } }
            if (!last) { s2 = wave_sum(s2); if (lane == 0) rnext[row] = rsqrtf(s2 * (1.0f / 1024.0f) + EPS); } }
    }
}
__device__ __forceinline__ void rescale_phase(bf16* AO, const float* ss, int G, int bid) {
    int tid = threadIdx.x; asm volatile("" : "+v"(tid));
    const int lane = tid & 63, wave = __builtin_amdgcn_readfirstlane(tid >> 6);
    const int gw = bid * 8 + wave, NGW = G * 8;
    for (int row = gw; row < MT; row += NGW) {
        float tot = 0.f;
#pragma unroll
        for (int k = 0; k < 8; ++k) tot += ss[row * 8 + k];
        const float rinv = rsqrtf(tot * (1.0f / 512.0f) + EPS);
        u32x4* ptr = (u32x4*)(AO + (size_t)row * 1024 + 512) + lane; u32x4 v = *ptr;
        v.x = pk2(bflo(v.x) * rinv, bfhi(v.x) * rinv); v.y = pk2(bflo(v.y) * rinv, bfhi(v.y) * rinv); v.z = pk2(bflo(v.z) * rinv, bfhi(v.z) * rinv); v.w = pk2(bflo(v.w) * rinv, bfhi(v.w) * rinv);
        *ptr = v;
    }
}


#define XB_TMO      128
#define XB_XCNT(j)  (256  + 64 * (j))
#define XB_XSUB(j)  (1280 + 64 * (j))
#define XB_XGEN(j)  (2304 + 64 * (j))
#define XB_TOP      3328
#define XB_TOPGEN   3392
#define XCD_BAR_WORDS 3456
#define XB_SPIN_CAP (1u << 18)
__device__ __forceinline__ unsigned xb_ld(unsigned* p)              { return __hip_atomic_load(p, __ATOMIC_RELAXED, __HIP_MEMORY_SCOPE_AGENT); }
__device__ __forceinline__ unsigned xb_add(unsigned* p, unsigned v) { return __hip_atomic_fetch_add(p, v, __ATOMIC_RELAXED, __HIP_MEMORY_SCOPE_AGENT); }
__device__ __forceinline__ unsigned xb_xcc_id() { return (unsigned)__builtin_amdgcn_s_getreg((3 << 11) | 20) & 0xFu; }
#define XB_SPIN(cond, bar) do { unsigned _sp = 0; while (cond) { __builtin_amdgcn_s_sleep(1); \
    if ((++_sp & 255u) == 0u) { if (xb_ld(&(bar)[XB_TMO])) break; if (_sp > XB_SPIN_CAP) { atomicAdd(&(bar)[XB_TMO], 1u); break; } } } } while (0)
struct XcdBarrier { unsigned* bar; unsigned x; volatile LAS unsigned* st; };
__device__ __forceinline__ XcdBarrier xcd_barrier_post(unsigned* bar, volatile LAS unsigned* st) {
    XcdBarrier b; b.bar = bar; b.x = xb_xcc_id(); b.st = st;
    if (threadIdx.x == 0) (void)xb_add(&bar[XB_XCNT(b.x)], 1u);
    return b;
}
__device__ __forceinline__ void xcd_barrier_complete(unsigned* bar, unsigned x, unsigned& nloc, unsigned& nx) {
    const unsigned G = gridDim.x * gridDim.y * gridDim.z;
    unsigned sum, cnt, mine, sp = 0u;
    for (;;) {
        sum = 0u; cnt = 0u; mine = 0u;
#pragma unroll
        for (unsigned j = 0; j < 16; ++j) { const unsigned c = xb_ld(&bar[XB_XCNT(j)]); sum += c; cnt += (c > 0u) ? 1u : 0u; mine = (j == x) ? c : mine; }
        if (sum == G) break;
        __builtin_amdgcn_s_sleep(1);
        if ((++sp & 255u) == 0u) { if (xb_ld(&bar[XB_TMO])) break; if (sp > XB_SPIN_CAP) { atomicAdd(&bar[XB_TMO], 1u); break; } }
    }
    nloc = mine > 0u ? mine : 1u; nx = cnt > 0u ? cnt : 1u;
}
__device__ __forceinline__ void xcd_barrier(const XcdBarrier& b) {
    asm volatile("s_waitcnt vmcnt(0)" ::: "memory");
    __syncthreads();
    if (threadIdx.x == 0) {
        unsigned* bar = b.bar;
        __builtin_amdgcn_s_waitcnt(0);
        unsigned nloc = b.st[0], nx = b.st[1];
        if (nloc == 0u) { xcd_barrier_complete(bar, b.x, nloc, nx); b.st[0] = nloc; b.st[1] = nx; }
        const unsigned old = xb_add(&bar[XB_XSUB(b.x)], 1u);
        const unsigned gen = old / nloc;
        if (old + 1u == (gen + 1u) * nloc) {
            __builtin_amdgcn_fence(__ATOMIC_RELEASE, "agent");
            asm volatile("s_waitcnt vmcnt(0)" ::: "memory");
            const unsigned og = xb_add(&bar[XB_TOP], 1u);
            const unsigned tg = og / nx;
            if (og + 1u == (tg + 1u) * nx) xb_add(&bar[XB_TOPGEN], 1u);
            else XB_SPIN(xb_ld(&bar[XB_TOPGEN]) == tg, bar);
            __builtin_amdgcn_fence(__ATOMIC_ACQUIRE, "agent");
            xb_add(&bar[XB_XGEN(b.x)], 1u);
            asm volatile("s_waitcnt vmcnt(0)" ::: "memory");
        } else {
            XB_SPIN(xb_ld(&bar[XB_XGEN(b.x)]) == gen, bar);
            __builtin_amdgcn_fence(__ATOMIC_ACQUIRE, "agent");
            asm volatile("s_waitcnt vmcnt(0)" ::: "memory");
        }
    }
    __syncthreads();
}

#ifndef REP_P0
#define REP_P0 1
#endif
#ifndef REP_SYNC
#define REP_SYNC 1
#endif
#ifndef REP_MASK_V
#define REP_MASK_V 0u
#endif
constexpr unsigned REP_MASK = REP_MASK_V;
constexpr int PH_PER_LAYER = 10, N_PHASES = 1 + 2 * PH_PER_LAYER;
__global__ void __launch_bounds__(512) hybrid_fwd(Params p) {
    extern __shared__ __attribute__((aligned(16))) unsigned char lds_raw[];
    LAS unsigned char* lds = (LAS unsigned char*)lds_raw;
    cg::grid_group grid = cg::this_grid();
    volatile LAS unsigned* xst = (volatile LAS unsigned*)(lds + LDS_BYTES - 16);
    if (threadIdx.x < 4) xst[threadIdx.x] = 0u;
    __syncthreads();
    const XcdBarrier xbar = xcd_barrier_post((unsigned*)(p.ws + OFF_BAR), xst);
    if (p.ph_hi > 1000) grid.sync();
    const int Gk = gridDim.x, bk = blockIdx.x;
    unsigned char* ws = p.ws;
    float* sss = (float*)(ws + OFF_SSS); float* ssm = (float*)(ws + OFF_SSM); float* ssf = (float*)(ws + OFF_SSF); float* rA = (float*)(ws + OFF_RA); float* rB = (float*)(ws + OFF_RB);
    bf16* XB = (bf16*)(ws + OFF_XB); bf16* MF = (bf16*)(ws + OFF_MF); bf16* GB = (bf16*)(ws + OFF_G); bf16* HB = (bf16*)(ws + OFF_H);
    bf16* PQ = (bf16*)(ws + OFF_PQ); bf16* AO = (bf16*)(ws + OFF_AO); bf16* UB = (bf16*)(ws + OFF_UB); bf16* TB = (bf16*)(ws + OFF_T); float* SL = (float*)(ws + OFF_SLOC);

#pragma nounroll
    for (int ph = p.ph_lo; ph < p.ph_hi; ++ph) {
        int G = Gk, bid = bk; asm volatile("" : "+s"(G), "+s"(bid));
        if (ph == 0) { for (int rep = 0; rep < REP_P0; ++rep) p0_prologue(p, lds, G, bid); }
        else {
            const int ly = (ph - 1) / PH_PER_LAYER, sp = (ph - 1) % PH_PER_LAYER;
            unsigned char* wb = ws + OFF_W + (size_t)ly * W_LAYER;
            pg8::Order S;
            const int nrep = ((REP_MASK >> sp) & 1u) ? 2 : 1;
            for (int rep = 0; rep < nrep; ++rep)
            switch (sp) {
            case 0: {
                pg8::Gemm g{XB, (const bf16*)(wb + W_IN), MT, NIN, 1024, 1024, 1024, 0, 0, 1}; S.init(MT, NIN, 1, G, bid, WGM_IN);
                EpiIn E{PQ, UB, rA}; pg8::gemm_phase<EpiIn>(lds, g, S, E); } break;
            case 1: {
                fft1_phase(PQ, (const bf16*)(ws + OFF_D1), TB, lds, G, bid);
                pg8::Gemm g{UB, (const bf16*)(ws + OFF_MST) + (size_t)ly * 32 * 256 * 256, 2048, 256, 256, 512, 256, (size_t)2048 * 512, (size_t)256 * 256, 32}; S.init(2048, 256, 32, G, bid);
                EpiSloc E{SL}; pg8::gemm_phase<EpiSloc>(lds, g, S, E); } break;
            case 2: {
                carry_phase(p, ly, SL, UB, lds, G, bid);
                fft3_phase(TB, (const bf16*)(ws + OFF_E3), (const bf16*)(ws + OFF_E3I), (const bf16*)(ws + OFF_FMIX) + (size_t)ly * 8 * 64 * 128, AO, lds, G, bid); } break;
            case 3: {
                pg8::Gemm g{UB, (const bf16*)(ws + OFF_TM) + (size_t)ly * 32 * 256 * 512, 2048, 256, 512, 512, 512, (size_t)2048 * 512, (size_t)256 * 512, 32}; S.init(2048, 256, 32, G, bid);
                EpiSsmOut E{GB}; pg8::gemm_phase<EpiSsmOut>(lds, g, S, E); } break;
            case 4: {
                pg8::Gemm g{GB, (const bf16*)(wb + W_GLU), MT, 512, 512, 512, 512, 0, 0, 1}; S.init(MT, 512, 1, G, bid, WGM_GLU);
                EpiGlu E{GB, p.b_glu + ly * 512, AO, sss}; pg8::gemm_phase<EpiGlu>(lds, g, S, E); } break;
            case 5: {
                pg8::Gemm g{AO, (const bf16*)(wb + W_OUT), MT, 1024, 1024, 1024, 1024, 0, 0, 1}; S.init(MT, 1024, 1, G, bid, WGM_OUT);
                LAS float* qv = (LAS float*)(lds + 131072);
                { int tid = threadIdx.x; asm volatile("" : "+v"(tid));
                  for (int i = 0; i < 4; ++i) { pg8::Unit u; if (!S.next(i, u)) break;
                      if (tid < 256) { const f32x4* sp = (const f32x4*)(sss + (size_t)(u.pm * 256 + tid) * 8); const f32x4 a = sp[0], b = sp[1];
                          const float ms = ((((a[0] + a[1]) + a[2]) + a[3]) + (((b[0] + b[1]) + b[2]) + b[3])) * (1.0f / 512.0f) + EPS;
                          qv[i * 256 + tid] = sqrtf(ms); qv[1024 + i * 256 + tid] = rsqrtf(ms); } }
                  __syncthreads(); }
                EpiOutMix E{MF, ssm, qv}; pg8::gemm_phase<EpiOutMix>(lds, g, S, E); } break;
            case 6: norm_phase(p.out, MF, ssm, p.post_mix_g + ly * 1024, XB, rB, false, G, bid); break;
            case 7: {
                pg8::Gemm g{XB, (const bf16*)(wb + W_1), MT, DFF, 1024, 1024, 1024, 0, 0, 1}; S.init(MT, DFF, 1, G, bid, WGM_FF1);
                EpiFF1 E{HB, rB}; pg8::gemm_phase<EpiFF1>(lds, g, S, E); } break;
            case 8: {
                pg8::Gemm g{HB, (const bf16*)(wb + W_2), MT, 1024, DFF, DFF, DFF, 0, 0, 1}; S.init(MT, 1024, 1, G, bid, WGM_FF2);
                EpiOutSS E{MF, ssf}; pg8::gemm_phase<EpiOutSS>(lds, g, S, E); } break;
            case 9: norm_phase(p.out, MF, ssf, p.post_mlp_g + ly * 1024, XB, rA, ly == 1, G, bid); break;
            }
        }
        if (ph + 1 < p.ph_hi) for (int rep = 0; rep < REP_SYNC; ++rep) xcd_barrier(xbar);
    }
}

extern "C" void kernel_launch(void* const* d_in, const int* in_sizes, int n_in, void* d_out, int out_size, void* d_ws, size_t ws_size, hipStream_t stream) {
    static int grid = 0;
    if (grid == 0) {
        if (n_in != 22 || ws_size < WS_END) { fprintf(stderr, "kernel_launch: unexpected n_in %d or ws_size %zu (< %zu)\n", n_in, ws_size, (size_t)WS_END); grid = -1; return; }
        int dev = 0, cus = 0, per_cu = 0;
        hipGetDevice(&dev); hipDeviceGetAttribute(&cus, hipDeviceAttributeMultiprocessorCount, dev);
        if (hipFuncSetAttribute((const void*)hybrid_fwd, hipFuncAttributeMaxDynamicSharedMemorySize, LDS_BYTES) != hipSuccess) { fprintf(stderr, "kernel_launch: hipFuncSetAttribute failed\n"); grid = -1; return; }
        if (hipOccupancyMaxActiveBlocksPerMultiprocessor(&per_cu, (const void*)hybrid_fwd, 512, LDS_BYTES) != hipSuccess || per_cu < 1) { fprintf(stderr, "kernel_launch: occupancy query says %d blocks per CU\n", per_cu); per_cu = 1; }
        (void)hipGetLastError();
        grid = cus;
    }
    if (grid < 0) return;
    if (hipMemsetAsync((char*)d_ws + OFF_BAR, 0, BAR_BYTES, stream) != hipSuccess) { fprintf(stderr, "kernel_launch: memset of the barrier words failed\n"); return; }
    Params p{};
    const float** f = (const float**)&p;
    for (int i = 0; i < 22; ++i) f[i] = (const float*)d_in[i];
    p.out = (float*)d_out; p.ws = (unsigned char*)d_ws; p.ph_lo = 0; p.ph_hi = N_PHASES;
    void* args[] = {&p};
    hipError_t e = hipLaunchCooperativeKernel((const void*)hybrid_fwd, dim3(grid), dim3(512), args, LDS_BYTES, stream);
    if (e != hipSuccess) fprintf(stderr, "kernel_launch: cooperative launch failed: %s (grid %d)\n", hipGetErrorString(e), grid);
}
```

```cpp
#include <hip/hip_runtime.h>
#include <hip/hip_cooperative_groups.h>
#include <cstdio>
namespace cg = cooperative_groups;

#define P0_REP_A 1
#define WGM_FF1 4
#define WGM_IN 2
#define WGM_OUT 4
#define WGM_GLU 4
#define WGM_FF2 4
#define P0_REP_F 1
#define P0_REP_S 1
#define P0_REP_B 1
#define P0_REP_C 1
#define LAS __attribute__((address_space(3)))
typedef unsigned short bf16;
typedef short bf16x8 __attribute__((ext_vector_type(8)));
typedef float f32x4 __attribute__((ext_vector_type(4)));
typedef float f32x2 __attribute__((ext_vector_type(2)));
typedef unsigned u32x4 __attribute__((ext_vector_type(4)));
typedef unsigned u32x2 __attribute__((ext_vector_type(2)));

constexpr int NB = 4, SEQ = 8192, DM = 1024, MT = NB * SEQ, DFO = 512, NHEAD = 8, SG = 32, SP = 64, DFF = 4096, NIN = 1024;
constexpr float EPS = 1e-6f;
constexpr int LDS_BYTES = 147456;
constexpr size_t MiB = 1u << 20;
constexpr size_t OFF_RA = 384 * 1024, OFF_RB = 512 * 1024, OFF_BAR = 640 * 1024, BAR_BYTES = 16384;
constexpr size_t OFF_E3I = 1 * MiB + 16384, OFF_FMIX = 1 * MiB + 65536;
constexpr size_t OFF_E3 = 1 * MiB, OFF_D1 = 2 * MiB, OFF_TM = 6 * MiB, OFF_MST = 22 * MiB, OFF_W = 30 * MiB;
constexpr size_t W_IN = 0, W_OUT = 3 * MiB, W_1 = 5 * MiB, W_2 = 13 * MiB, W_GLU = 21 * MiB, W_LAYER = 22 * MiB;
constexpr size_t OFF_XB = 76 * MiB, OFF_MF = 140 * MiB, OFF_G = 140 * MiB, OFF_H = 204 * MiB;
constexpr size_t OFF_PQ = 204 * MiB, OFF_AO = 204 * MiB, OFF_UB = 268 * MiB, OFF_T = 332 * MiB, OFF_SLOC = 396 * MiB, OFF_SSS = 460 * MiB, OFF_SSM = 461 * MiB, OFF_SSF = 463 * MiB, WS_END = 465 * MiB;

struct Params {
    const float *x, *w_in, *w_out, *pre_mix_g, *post_mix_g, *pre_mlp_g, *post_mlp_g, *fourier_out_g, *ssm_out_g, *w_fourier,
        *lam_re, *lam_im, *log_dt, *b_re, *b_im, *c_re, *c_im, *d_skip, *w_glu, *b_glu, *w_ff1, *w_ff2;
    float* out; unsigned char* ws;
    int ph_lo, ph_hi;
};

__device__ __forceinline__ unsigned f2bf(float f) { unsigned u = __builtin_bit_cast(unsigned, f); return (u + 0x7fffu + ((u >> 16) & 1u)) >> 16; }
typedef __bf16 hwbf2 __attribute__((ext_vector_type(2)));
__device__ __forceinline__ unsigned pk2(float lo, float hi) { const f32x2 v = {lo, hi}; return __builtin_bit_cast(unsigned, __builtin_convertvector(v, hwbf2)); }
__device__ __forceinline__ float bflo(unsigned w) { return __builtin_bit_cast(float, w << 16); }
__device__ __forceinline__ float bfhi(unsigned w) { return __builtin_bit_cast(float, w & 0xffff0000u); }
__device__ __forceinline__ float wave_sum(float v) {
#pragma unroll
    for (int o = 1; o < 64; o <<= 1) v += __shfl_xor(v, o);
    return v;
}
__device__ __forceinline__ float gelu_t(float x) { const float u = 0.7978845608f * (x + 0.044715f * x * x * x); return x * __builtin_amdgcn_rcpf(1.0f + __expf(-2.0f * u)); }
__device__ __forceinline__ float sigm(float v) { return __builtin_amdgcn_rcpf(1.0f + __expf(-v)); }

namespace pg8 {
#define PG8_LAS __attribute__((address_space(3)))
typedef unsigned short bf16_t;
constexpr int BM = 256, BK = 64, HALF = 128, HTB = HALF * BK * 2, STAGE_BYTES = 8 * HTB, NXCD = 8, WGM = 4;
__host__ __device__ __forceinline__ int lds_byte(int r, int c) { const int st = (r >> 4) * 2 + (c >> 5), rr = r & 15, cc = c & 31, ob = rr * 64 + cc * 2; return st * 1024 + (ob ^ (((ob >> 9) & 1) << 5)); }
__host__ __device__ __forceinline__ void stage_rc(int b, int& R, int& C) { const int st = b / 1024, sb = b % 1024, swz = sb ^ (((sb >> 9) & 1) << 5); R = (st >> 1) * 16 + swz / 64; C = (st & 1) * 32 + (swz % 64) / 2; }
__host__ __device__ __forceinline__ int perm32(int rho) { const int n = rho >> 4, i = rho & 15; return 8 * (i >> 2) + 4 * n + (i & 3); }

struct Unit { int pm, pn, z, ui; };
struct Gemm { const bf16_t* A; const bf16_t* Bt; int M, N, K, lda, ldb; size_t sA, sB; int nZ; };

struct Order {
    int nM, nN, nwg, nZ, G, c, wgm;
    __device__ void init(int M, int N, int nZ_, int G_, int c_, int wgm_ = WGM) { nM = M / BM; nN = N / BM; nwg = nM * nN; nZ = nZ_; G = G_; c = c_; wgm = wgm_; }
    __device__ bool next(int i, Unit& u) const {
        const long L = (long)i * G + c; if (L >= (long)nwg * nZ) return false;
        u.ui = i;
        if (nZ > 1 && (nZ % NXCD) == 0) {
            const int xcd = (int)(L % NXCD), idx = (int)(L / NXCD); u.z = xcd * (nZ / NXCD) + idx / nwg; const int wg = idx % nwg; u.pm = wg % nM; u.pn = wg / nM; return true; }
        u.z = (int)(L / nwg);
        int wgid = (int)(L % nwg); { const int q = nwg / NXCD, r = nwg % NXCD, xcd = wgid % NXCD, off = wgid / NXCD; wgid = (xcd < r ? xcd * (q + 1) : r * (q + 1) + (xcd - r) * q) + off; }
        const int nig = wgm * nN, gid = wgid / nig, fm = gid * wgm, gsz = (nM - fm) < wgm ? (nM - fm) : wgm;
        u.pm = fm + ((wgid % nig) % gsz); u.pn = (wgid % nig) / gsz; return true;
    }
};

template <class Epi>
__device__ __forceinline__ void gemm_phase(PG8_LAS unsigned char* lds, const Gemm g, const Order& S, const Epi& E) {
    int tid = threadIdx.x; asm volatile("" : "+v"(tid));
    const int wid = __builtin_amdgcn_readfirstlane(tid >> 6), lane = tid & 63, wr = wid >> 2, wc = wid & 3, fr = lane & 15, fq = lane >> 4;
    const int K = g.K, nt = K / BK;
    unsigned voffA[2], voffB[2];
#pragma unroll
    for (int i = 0; i < 2; ++i) { int R, C; stage_rc(tid * 16 + i * 8192, R, C); const int Rb = Epi::PERM ? ((R & ~31) + perm32(R & 31)) : R;
        voffA[i] = (unsigned)(R * g.lda + C) * 2u; voffB[i] = (unsigned)(Rb * g.ldb + C) * 2u; }
    const size_t kstep = (size_t)(BK * 2);
    const size_t hA = (size_t)HALF * g.lda * 2, hB = (size_t)HALF * g.ldb * 2;
    const size_t tA = 2 * hA, tB = 2 * hB;
    const unsigned ldsw = (unsigned)wid * 1024u;
    const int aoff = lds_byte(wr * 64 + fr, fq * 8), boff = lds_byte(wc * 32 + fr, fq * 8);
#define PG8_SA(b, h) (((b) * 2 + (h)) * HTB)
#define PG8_SB(b, h) ((4 + (b) * 2 + (h)) * HTB)
#define PG8_STAGE(bufoff, gbase, voff) do { _Pragma("unroll") for (int _i = 0; _i < 2; ++_i) \
        __builtin_amdgcn_global_load_lds((const unsigned*)((const char*)(gbase) + (voff)[_i]), (PG8_LAS unsigned*)(lds + (bufoff) + ldsw + _i * 8192), 16, 0, 0); } while (0)
#define PG8_LDA(dst, b, h) do { _Pragma("unroll") for (int m = 0; m < 4; ++m) _Pragma("unroll") for (int k = 0; k < 2; ++k) dst[m][k] = *(const PG8_LAS bf16x8*)(lds + PG8_SA(b, h) + aoff + m * 2048 + k * 1024); } while (0)
#define PG8_LDB(dst, b, h) do { _Pragma("unroll") for (int n = 0; n < 2; ++n) _Pragma("unroll") for (int k = 0; k < 2; ++k) dst[n][k] = *(const PG8_LAS bf16x8*)(lds + PG8_SB(b, h) + boff + n * 2048 + k * 1024); } while (0)
#define PG8_MMA(ai, bj, At, Bt) do { __builtin_amdgcn_s_setprio(1); _Pragma("unroll") for (int m = 0; m < 4; ++m) _Pragma("unroll") for (int n = 0; n < 2; ++n) _Pragma("unroll") for (int k = 0; k < 2; ++k) \
        acc[ai][bj][m][n] = __builtin_amdgcn_mfma_f32_16x16x32_bf16(Bt[n][k], At[m][k], acc[ai][bj][m][n], 0, 0, 0); __builtin_amdgcn_s_setprio(0); } while (0)
#define PG8_WAIT_V(n) asm volatile("s_waitcnt vmcnt(" #n ")" ::: "memory")
#define PG8_WAIT_L(n) asm volatile("s_waitcnt lgkmcnt(" #n ")" ::: "memory")
#define PG8_BAR __builtin_amdgcn_s_barrier()
#define PG8_SCHED __builtin_amdgcn_sched_barrier(0)
    Unit cur, nxt; int ui = 0;
    if (!S.next(0, cur)) return;
    f32x4 acc[2][2][4][2];
#pragma unroll
    for (int a = 0; a < 2; ++a)
#pragma unroll
        for (int b = 0; b < 2; ++b)
#pragma unroll
            for (int m = 0; m < 4; ++m)
#pragma unroll
                for (int n = 0; n < 2; ++n) acc[a][b][m][n] = (f32x4){0.f, 0.f, 0.f, 0.f};
    bf16x8 At[4][2], B0[2][2], B1[2][2];
    const char* cA = (const char*)g.A + ((size_t)cur.z * g.sA) * 2 + (size_t)cur.pm * tA; const char* cB = (const char*)g.Bt + ((size_t)cur.z * g.sB) * 2 + (size_t)cur.pn * tB;
    PG8_STAGE(PG8_SB(0, 0), cB, voffB); PG8_STAGE(PG8_SA(0, 0), cA, voffA); PG8_STAGE(PG8_SB(0, 1), cB + hB, voffB); PG8_STAGE(PG8_SA(0, 1), cA + hA, voffA);
    if (wr == 1) PG8_BAR;
    PG8_WAIT_V(4); PG8_BAR;
    PG8_STAGE(PG8_SB(1, 0), cB + kstep, voffB); PG8_STAGE(PG8_SA(1, 0), cA + kstep, voffA); PG8_STAGE(PG8_SB(1, 1), cB + hB + kstep, voffB);
    PG8_WAIT_V(6); PG8_BAR;
    for (;;) {
        const bool has_next = S.next(ui + 1, nxt);
        const char* nA = has_next ? (const char*)g.A + ((size_t)nxt.z * g.sA) * 2 + (size_t)nxt.pm * tA : cA; const char* nB = has_next ? (const char*)g.Bt + ((size_t)nxt.z * g.sB) * 2 + (size_t)nxt.pn * tB : cB;
        for (int t = 0; t < nt; t += 2) {
            const bool last = (t == nt - 2);
            if constexpr (Epi::MID) { if (t == (nt >> 1)) E.mid(acc, cur, wr, fr); }
            const char* a1 = cA + (size_t)(t + 1) * kstep;
            const char* a2 = last ? nA : cA + (size_t)(t + 2) * kstep; const char* b2 = last ? nB : cB + (size_t)(t + 2) * kstep;
            const char* a3 = a2 + kstep; const char* b3 = b2 + kstep;
            PG8_LDB(B0, 0, 0); PG8_SCHED; PG8_LDA(At, 0, 0); PG8_STAGE(PG8_SA(1, 1), a1 + hA, voffA);
            PG8_WAIT_L(8); PG8_BAR; PG8_WAIT_L(0); PG8_MMA(0, 0, At, B0); PG8_BAR; PG8_SCHED;
            PG8_LDB(B1, 0, 1); PG8_STAGE(PG8_SB(0, 0), b2, voffB);
            PG8_BAR; PG8_WAIT_L(0); PG8_MMA(0, 1, At, B1); PG8_BAR;
            PG8_LDA(At, 0, 1); PG8_STAGE(PG8_SA(0, 0), a2, voffA);
            PG8_BAR; PG8_WAIT_L(0); PG8_MMA(1, 0, At, B0); PG8_BAR; PG8_SCHED;
            PG8_STAGE(PG8_SB(0, 1), b2 + hB, voffB);
            PG8_WAIT_V(6); PG8_BAR; PG8_MMA(1, 1, At, B1); PG8_BAR;
            PG8_LDB(B0, 1, 0); PG8_SCHED; PG8_LDA(At, 1, 0); PG8_STAGE(PG8_SA(0, 1), a2 + hA, voffA);
            PG8_WAIT_L(8); PG8_BAR; PG8_WAIT_L(0); PG8_MMA(0, 0, At, B0); PG8_BAR; PG8_SCHED;
            PG8_LDB(B1, 1, 1); PG8_STAGE(PG8_SB(1, 0), b3, voffB);
            PG8_BAR; PG8_WAIT_L(0); PG8_MMA(0, 1, At, B1); PG8_BAR;
            PG8_LDA(At, 1, 1); PG8_STAGE(PG8_SA(1, 0), a3, voffA);
            PG8_BAR; PG8_WAIT_L(0); PG8_MMA(1, 0, At, B0); PG8_BAR; PG8_SCHED;
            PG8_STAGE(PG8_SB(1, 1), b3 + hB, voffB);
            PG8_WAIT_V(6); PG8_BAR; PG8_MMA(1, 1, At, B1); PG8_BAR;
        }
        E(acc, cur, wr, wc, fr, fq);
        if (!has_next) break;
#pragma unroll
        for (int a = 0; a < 2; ++a)
#pragma unroll
            for (int b = 0; b < 2; ++b)
#pragma unroll
                for (int m = 0; m < 4; ++m)
#pragma unroll
                    for (int n = 0; n < 2; ++n) acc[a][b][m][n] = (f32x4){0.f, 0.f, 0.f, 0.f};
        cur = nxt; cA = nA; cB = nB; ++ui;
    }
    PG8_WAIT_V(0);
    if (wr == 0) PG8_BAR;
    PG8_BAR;
#undef PG8_SA
#undef PG8_SB
#undef PG8_STAGE
#undef PG8_LDA
#undef PG8_LDB
#undef PG8_MMA
#undef PG8_WAIT_V
#undef PG8_WAIT_L
#undef PG8_BAR
#undef PG8_SCHED
}
}

typedef const f32x4 (&AccRef)[2][2][4][2];
__device__ __forceinline__ u32x4 pack8(f32x4 a, f32x4 b) { u32x4 w; w.x = pk2(a[0], a[1]); w.y = pk2(a[2], a[3]); w.z = pk2(b[0], b[1]); w.w = pk2(b[2], b[3]); return w; }

struct EpiIn {
    static constexpr bool PERM = true, MID = false;
    bf16* ZF; bf16* UB; const float* r;
    __device__ __forceinline__ void operator()(AccRef acc, const pg8::Unit& u, int wr, int wc, int fr, int fq) const {
#pragma unroll
        for (int ai = 0; ai < 2; ++ai)
#pragma unroll
            for (int m = 0; m < 4; ++m) {
                const int row = u.pm * 256 + ai * 128 + wr * 64 + m * 16 + fr; const float rs = r[row];
#pragma unroll
                for (int bj = 0; bj < 2; ++bj) {
                    const int col0 = u.pn * 256 + bj * 128 + wc * 32 + 8 * fq;
                    const u32x4 w = pack8(acc[ai][bj][m][0] * rs, acc[ai][bj][m][1] * rs);
                    if (col0 < 512) *(u32x4*)(ZF + (size_t)row * 512 + col0) = w;
                    else { const int c2 = col0 - 512, gg = c2 >> 4, h0 = c2 & 15; *(u32x4*)(UB + ((size_t)(gg * 2048 + (row >> 4)) * 512 + (row & 15) * 16 + h0)) = w; }
                }
            }
    }
};
struct EpiSloc {
    static constexpr bool PERM = false, MID = false;
    float* S;
    __device__ __forceinline__ void operator()(AccRef acc, const pg8::Unit& u, int wr, int wc, int fr, int fq) const {
#pragma unroll
        for (int ai = 0; ai < 2; ++ai)
#pragma unroll
            for (int m = 0; m < 4; ++m) {
                const int row = u.pm * 256 + ai * 128 + wr * 64 + m * 16 + fr;
                float* rp = S + ((size_t)u.z * 2048 + row) * 256 + wc * 32 + 4 * fq;
#pragma unroll
                for (int bj = 0; bj < 2; ++bj)
#pragma unroll
                    for (int n = 0; n < 2; ++n) *(f32x4*)(rp + bj * 128 + n * 16) = acc[ai][bj][m][n];
            }
    }
};
struct EpiSsmOut {
    static constexpr bool PERM = true, MID = false;
    bf16* G;
    __device__ __forceinline__ void operator()(AccRef acc, const pg8::Unit& u, int wr, int wc, int fr, int fq) const {
#pragma unroll
        for (int ai = 0; ai < 2; ++ai)
#pragma unroll
            for (int m = 0; m < 4; ++m) {
                const int row = u.pm * 256 + ai * 128 + wr * 64 + m * 16 + fr;
#pragma unroll
                for (int bj = 0; bj < 2; ++bj) {
                    const int col0 = bj * 128 + wc * 32 + 8 * fq, t = col0 >> 4, i0 = col0 & 15;
                    f32x4 a = acc[ai][bj][m][0], b = acc[ai][bj][m][1];
#pragma unroll
                    for (int j = 0; j < 4; ++j) { a[j] = gelu_t(a[j]); b[j] = gelu_t(b[j]); }
                    *(u32x4*)(G + ((size_t)row * 16 + t) * 512 + u.z * 16 + i0) = pack8(a, b);
                }
            }
    }
};
struct EpiGlu {
    static constexpr bool PERM = true, MID = false;
    const bf16* G; const float* bias; bf16* AO; float* ss;
    __device__ __forceinline__ void operator()(AccRef acc, const pg8::Unit& u, int wr, int wc, int fr, int fq) const {
#pragma unroll
        for (int ai = 0; ai < 2; ++ai)
#pragma unroll
            for (int m = 0; m < 4; ++m) {
                const int row = u.pm * 256 + ai * 128 + wr * 64 + m * 16 + fr; float s2 = 0.f;
#pragma unroll
                for (int bj = 0; bj < 2; ++bj) {
                    const int col0 = u.pn * 256 + bj * 128 + wc * 32 + 8 * fq;
                    const u32x4 gv = *(const u32x4*)(G + (size_t)row * 512 + col0);
                    const f32x4 b0 = *(const f32x4*)(bias + col0), b1 = *(const f32x4*)(bias + col0 + 4);
                    f32x4 a = acc[ai][bj][m][0] + b0, b = acc[ai][bj][m][1] + b1;
                    a[0] = bflo(gv.x) * sigm(a[0]); a[1] = bfhi(gv.x) * sigm(a[1]); a[2] = bflo(gv.y) * sigm(a[2]); a[3] = bfhi(gv.y) * sigm(a[3]);
                    b[0] = bflo(gv.z) * sigm(b[0]); b[1] = bfhi(gv.z) * sigm(b[1]); b[2] = bflo(gv.w) * sigm(b[2]); b[3] = bfhi(gv.w) * sigm(b[3]);
#pragma unroll
                    for (int j = 0; j < 4; ++j) s2 += a[j] * a[j] + b[j] * b[j];
                    *(u32x4*)(AO + (size_t)row * 1024 + 512 + col0) = pack8(a, b);
                }
                s2 += __shfl_xor(s2, 16); s2 += __shfl_xor(s2, 32);
                if (fq == 0) ss[row * 8 + u.pn * 4 + wc] = s2;
            }
    }
};
struct EpiOutSS {
    static constexpr bool PERM = true, MID = false;
    bf16* O; float* ss;
    __device__ __forceinline__ void operator()(AccRef acc, const pg8::Unit& u, int wr, int wc, int fr, int fq) const {
#pragma unroll
        for (int ai = 0; ai < 2; ++ai)
#pragma unroll
            for (int m = 0; m < 4; ++m) {
                const int row = u.pm * 256 + ai * 128 + wr * 64 + m * 16 + fr; float s2 = 0.f;
#pragma unroll
                for (int bj = 0; bj < 2; ++bj) {
                    const int col0 = u.pn * 256 + bj * 128 + wc * 32 + 8 * fq;
                    const f32x4 a = acc[ai][bj][m][0], b = acc[ai][bj][m][1];
#pragma unroll
                    for (int j = 0; j < 4; ++j) s2 += a[j] * a[j] + b[j] * b[j];
                    *(u32x4*)(O + (size_t)row * 1024 + col0) = pack8(a, b);
                }
                s2 += __shfl_xor(s2, 16); s2 += __shfl_xor(s2, 32);
                if (fq == 0) ss[row * 16 + u.pn * 4 + wc] = s2;
            }
    }
};
struct EpiOutMix {
    static constexpr bool PERM = true, MID = true;
    bf16* O; float* ss; const LAS float* qv;
    __device__ __forceinline__ void mid(f32x4 (&acc)[2][2][4][2], const pg8::Unit& u, int wr, int fr) const {
#pragma unroll
        for (int ai = 0; ai < 2; ++ai)
#pragma unroll
            for (int m = 0; m < 4; ++m) { const float q = qv[u.ui * 256 + ai * 128 + wr * 64 + m * 16 + fr];
#pragma unroll
                for (int bj = 0; bj < 2; ++bj)
#pragma unroll
                    for (int n = 0; n < 2; ++n) acc[ai][bj][m][n] *= q; }
    }
    __device__ __forceinline__ void operator()(AccRef acc, const pg8::Unit& u, int wr, int wc, int fr, int fq) const {
#pragma unroll
        for (int ai = 0; ai < 2; ++ai)
#pragma unroll
            for (int m = 0; m < 4; ++m) {
                const int rl = ai * 128 + wr * 64 + m * 16 + fr, row = u.pm * 256 + rl; float s2 = 0.f; const float rs = qv[1024 + u.ui * 256 + rl];
#pragma unroll
                for (int bj = 0; bj < 2; ++bj) {
                    const int col0 = u.pn * 256 + bj * 128 + wc * 32 + 8 * fq;
                    const f32x4 a = acc[ai][bj][m][0] * rs, b = acc[ai][bj][m][1] * rs;
#pragma unroll
                    for (int j = 0; j < 4; ++j) s2 += a[j] * a[j] + b[j] * b[j];
                    *(u32x4*)(O + (size_t)row * 1024 + col0) = pack8(a, b);
                }
                s2 += __shfl_xor(s2, 16); s2 += __shfl_xor(s2, 32);
                if (fq == 0) ss[row * 16 + u.pn * 4 + wc] = s2;
            }
    }
};
struct EpiFF1 {
    static constexpr bool PERM = true, MID = false;
    bf16* H; const float* r;
    __device__ __forceinline__ void operator()(AccRef acc, const pg8::Unit& u, int wr, int wc, int fr, int fq) const {
#pragma unroll
        for (int ai = 0; ai < 2; ++ai)
#pragma unroll
            for (int m = 0; m < 4; ++m) {
                const int row = u.pm * 256 + ai * 128 + wr * 64 + m * 16 + fr; const float rs = r[row];
#pragma unroll
                for (int bj = 0; bj < 2; ++bj) {
                    const int col0 = u.pn * 256 + bj * 128 + wc * 32 + 8 * fq;
                    f32x4 a = acc[ai][bj][m][0] * rs, b = acc[ai][bj][m][1] * rs;
#pragma unroll
                    for (int j = 0; j < 4; ++j) { a[j] = fmaxf(a[j], 0.f); a[j] *= a[j]; b[j] = fmaxf(b[j], 0.f); b[j] *= b[j]; }
                    __builtin_nontemporal_store(pack8(a, b), (u32x4*)(H + (size_t)row * 4096 + col0));
                }
            }
    }
};

__device__ __forceinline__ void transpose_item(const float* W, int ldw, bf16* WT, int ldt, const float* sc_lo, const float* sc_hi, int split,
                                               LAS float* scr, int item, int nblk, int lane) {
    const int kb = item / nblk, nb = item % nblk, k0 = 64 * kb, n0 = 64 * nb;
#pragma unroll 16
    for (int i = 0; i < 32; ++i) { const int kk = 2 * i + (lane >> 5), k = k0 + kk;
        float s = 1.f; if (sc_lo) s = (k < split) ? sc_lo[k] : sc_hi[k - split];
        const f32x2 w = __builtin_nontemporal_load((const f32x2*)(W + (size_t)k * ldw + n0 + 2 * (lane & 31)));
        scr[kk * 65 + 2 * (lane & 31)] = w[0] * s; scr[kk * 65 + 2 * (lane & 31) + 1] = w[1] * s; }
    asm volatile("s_waitcnt lgkmcnt(0)" ::: "memory");
    const int c = lane & 7;
#pragma unroll
    for (int j = 0; j < 8; ++j) { const int n = (lane >> 3) + 8 * j; const LAS float* s = scr + (8 * c) * 65 + n;
        u32x4 o; o.x = pk2(s[0 * 65], s[1 * 65]); o.y = pk2(s[2 * 65], s[3 * 65]); o.z = pk2(s[4 * 65], s[5 * 65]); o.w = pk2(s[6 * 65], s[7 * 65]);
        *(u32x4*)(WT + (size_t)(n0 + n) * ldt + k0 + 8 * c) = o; }
    asm volatile("s_waitcnt lgkmcnt(0)" ::: "memory");
}

__device__ __forceinline__ void ssm_mat_item(const Params& p, int item, LAS unsigned char* lds) {
    int tid = threadIdx.x; asm volatile("" : "+v"(tid)); const int ly = item >> 7, g = (item >> 2) & 31, qt = item & 3;
    LAS float* pwr = (LAS float*)lds;
    LAS float* pwi = pwr + 2 * 64 * 20;
    LAS float* bbr = pwi + 2 * 64 * 20;
    LAS float* bbi = bbr + 2 * 64 * 16;
    LAS float* ccr = bbi + 2 * 64 * 16;
    LAS float* cci = ccr + 2 * 16 * 64;
    LAS float* Gt = cci + 2 * 16 * 64;
    __syncthreads();
    { const int k = (tid >> 6) & 1, pp = tid & 63, tg = tid >> 7; const int idx = (ly * 2 + k) * 32 + g;
      const float dt = expf(p.log_dt[idx]); const float lr = p.lam_re[idx * 64 + pp] * dt, li = p.lam_im[idx * 64 + pp] * dt;
#pragma unroll
      for (int j = 0; j < 5; ++j) { const int tau = tg * 5 + j; if (tau <= 16) { const float e = __expf(lr * tau); float sn, cs; __sincosf(li * tau, &sn, &cs); pwr[(k * 64 + pp) * 20 + tau] = e * cs; pwi[(k * 64 + pp) * 20 + tau] = e * sn; } } }
    for (int i = tid; i < 2048; i += 512) { const int k = i >> 10, r = i & 1023; const int idx = (ly * 2 + k) * 32 + g; ccr[i] = p.c_re[(size_t)idx * 1024 + r]; cci[i] = p.c_im[(size_t)idx * 1024 + r]; }
    __syncthreads();
#pragma unroll
    for (int j = 0; j < 4; ++j) { const int o = tid + 512 * j, k = o >> 10, pp = (o >> 4) & 63, h = o & 15; const int idx = (ly * 2 + k) * 32 + g;
        const float lr = p.lam_re[idx * 64 + pp], li = p.lam_im[idx * 64 + pp], dt = expf(p.log_dt[idx]);
        float sn, cs; sincosf(li * dt, &sn, &cs); const float em1 = expm1f(lr * dt), sh = sinf(0.5f * li * dt);
        const float lbr = em1 * cs - 2.0f * sh * sh, lbi = (em1 + 1.0f) * sn;
        const float den = 1.0f / (lr * lr + li * li); const float cr = (lbr * lr + lbi * li) * den, ci = (lbi * lr - lbr * li) * den;
        const float br = p.b_re[(size_t)idx * 1024 + pp * 16 + h], bi = p.b_im[(size_t)idx * 1024 + pp * 16 + h];
        bbr[o] = cr * br - ci * bi; bbi[o] = cr * bi + ci * br; }
    __syncthreads();
    { const int k = tid >> 8, i = (tid >> 4) & 15, h = tid & 15; float a[16];
#pragma unroll
      for (int tau = 0; tau < 16; ++tau) a[tau] = 0.f;
#pragma nounroll
      for (int pp = 0; pp < 64; ++pp) { const float c_r = ccr[(k * 16 + i) * 64 + pp], c_i = cci[(k * 16 + i) * 64 + pp], b_r = bbr[(k * 64 + pp) * 16 + h], b_i = bbi[(k * 64 + pp) * 16 + h];
          const float xr = c_r * b_r - c_i * b_i, xi = c_r * b_i + c_i * b_r;
          const LAS f32x4* pr4 = (const LAS f32x4*)(pwr + (k * 64 + pp) * 20); const LAS f32x4* pi4 = (const LAS f32x4*)(pwi + (k * 64 + pp) * 20);
#pragma unroll
          for (int t4 = 0; t4 < 4; ++t4) { const f32x4 vr = pr4[t4], vi = pi4[t4];
#pragma unroll
              for (int e = 0; e < 4; ++e) a[t4 * 4 + e] += xr * vr[e] - xi * vi[e]; } }
#pragma unroll
      for (int tau = 0; tau < 16; ++tau) Gt[((k * 16 + tau) * 16 + i) * 16 + h] = a[tau]; }
    __syncthreads();
    bf16* TM = (bf16*)(p.ws + OFF_TM) + (size_t)(ly * 32 + g) * 256 * 512; bf16* MS = (bf16*)(p.ws + OFF_MST) + (size_t)(ly * 32 + g) * 256 * 256;
    const float* dsk = p.d_skip + (ly * 32 + g) * 16;
    for (int o = qt * 64 * 512 + tid; o < (qt + 1) * 64 * 512; o += 512) { const int r = o >> 9, col = o & 511, t = r >> 4, i = r & 15; float v;
        if (col < 256) { const int j = col >> 4, h = col & 15; v = 0.f;
            if (j <= t) v += Gt[((0 * 16 + (t - j)) * 16 + i) * 16 + h];
            if (j >= t) v += Gt[((1 * 16 + (j - t)) * 16 + i) * 16 + h];
            if (j == t && h == i) v += dsk[i]; }
        else { const int k = (col - 256) >> 7, q = (col - 256) & 127, pp = q >> 1, part = q & 1; const int tau = k == 0 ? (t + 1) : (16 - t);
            const float c_r = ccr[(k * 16 + i) * 64 + pp], c_i = cci[(k * 16 + i) * 64 + pp], l_r = pwr[(k * 64 + pp) * 20 + tau], l_i = pwi[(k * 64 + pp) * 20 + tau];
            v = part == 0 ? (c_r * l_r - c_i * l_i) : -(c_r * l_i + c_i * l_r); }
        TM[o] = (bf16)f2bf(v); }
    for (int o = qt * 64 * 256 + tid; o < (qt + 1) * 64 * 256; o += 512) { const int r = o >> 8, col = o & 255, k = r >> 7, q = r & 127, pp = q >> 1, part = q & 1, j = col >> 4, h = col & 15;
        const int tau = k == 0 ? (15 - j) : j;
        const float l_r = pwr[(k * 64 + pp) * 20 + tau], l_i = pwi[(k * 64 + pp) * 20 + tau], b_r = bbr[(k * 64 + pp) * 16 + h], b_i = bbi[(k * 64 + pp) * 16 + h];
        const float v = part == 0 ? (l_r * b_r - l_i * b_i) : (l_r * b_i + l_i * b_r);
        MS[o] = (bf16)f2bf(v); }
}

__device__ __forceinline__ void p0_prologue(const Params& p, LAS unsigned char* lds, int G, int bid) {
    int tid = threadIdx.x; asm volatile("" : "+v"(tid));
    const int lane = tid & 63, wave = __builtin_amdgcn_readfirstlane(tid >> 6);
    for (int rp = 0; rp < P0_REP_A; ++rp)
    for (int it = bid; it < 256; it += G) ssm_mat_item(p, it, lds);
    __syncthreads();
    {
        LAS float* scr = (LAS float*)(lds + wave * 16640);
        const int gw = bid * 8 + wave, NGW = G * 8;
        constexpr int I_IN = 16 * 16, I_OUT = 16 * 16, I_1 = 16 * 64, I_2 = 64 * 16, I_G = 8 * 8, I_L = I_IN + I_OUT + I_1 + I_2 + I_G;
        for (int rp = 0; rp < P0_REP_B; ++rp)
        for (int it = gw; it < 2 * I_L; it += NGW) {
            const int ly = it / I_L; int r = it % I_L; unsigned char* wb = p.ws + OFF_W + (size_t)ly * W_LAYER;
            if (r < I_IN) { transpose_item(p.w_in + (size_t)ly * 1024 * 1024, 1024, (bf16*)(wb + W_IN), 1024, p.pre_mix_g + ly * 1024, nullptr, 1 << 30, scr, r, 16, lane); continue; } r -= I_IN;
            if (r < I_OUT) { transpose_item(p.w_out + (size_t)ly * 1024 * 1024, 1024, (bf16*)(wb + W_OUT), 1024, p.fourier_out_g + ly * 512, p.ssm_out_g + ly * 512, 512, scr, r, 16, lane); continue; } r -= I_OUT;
            if (r < I_1) { transpose_item(p.w_ff1 + (size_t)ly * 1024 * 4096, 4096, (bf16*)(wb + W_1), 1024, p.pre_mlp_g + ly * 1024, nullptr, 1 << 30, scr, r, 64, lane); continue; } r -= I_1;
            if (r < I_2) { transpose_item(p.w_ff2 + (size_t)ly * 4096 * 1024, 1024, (bf16*)(wb + W_2), 4096, nullptr, nullptr, 0, scr, r, 16, lane); continue; } r -= I_2;
            transpose_item(p.w_glu + (size_t)ly * 512 * 512, 512, (bf16*)(wb + W_GLU), 512, nullptr, nullptr, 0, scr, r, 8, lane);
        }
        bf16* XB = (bf16*)(p.ws + OFF_XB); float* rA = (float*)(p.ws + OFF_RA);
        for (int rp = 0; rp < P0_REP_C; ++rp)
        for (int row0 = gw; row0 < MT; row0 += 4 * NGW) {
            f32x4 v[4][4];
#pragma unroll
            for (int rr = 0; rr < 4; ++rr) { const f32x4* xr = (const f32x4*)(p.x + (size_t)(row0 + rr * NGW) * 1024) + lane;
#pragma unroll
                for (int j = 0; j < 4; ++j) v[rr][j] = __builtin_nontemporal_load(xr + 64 * j); }
#pragma unroll
            for (int rr = 0; rr < 4; ++rr) { const int row = row0 + rr * NGW; float s2 = 0.f;
                u32x2* o = (u32x2*)(XB + (size_t)row * 1024) + lane;
#pragma unroll
                for (int j = 0; j < 4; ++j) { const f32x4 t = v[rr][j]; s2 += t[0] * t[0] + t[1] * t[1] + t[2] * t[2] + t[3] * t[3]; u32x2 w; w.x = pk2(t[0], t[1]); w.y = pk2(t[2], t[3]); o[64 * j] = w; }
                s2 = wave_sum(s2);
                if (lane == 0) rA[row] = rsqrtf(s2 * (1.0f / 1024.0f) + EPS); }
        }
    }
    {
        bf16* D1 = (bf16*)(p.ws + OFF_D1); bf16* E3 = (bf16*)(p.ws + OFF_E3);
        const int gt = bid * 512 + tid, NT = G * 512;
        for (int idx = gt; idx < 64 * 2 * 128 * 128; idx += NT) { const int n2 = idx >> 15, sel = (idx >> 14) & 1, k1 = (idx >> 7) & 127, n1 = idx & 127;
            const int ph = (k1 * (64 * n1 + n2)) & 8191; float s, c; sincospif((float)ph * (1.0f / 4096.0f), &s, &c); D1[idx] = (bf16)f2bf(sel ? s : c); }
        bf16* E3I = (bf16*)(p.ws + OFF_E3I); bf16* FM = (bf16*)(p.ws + OFF_FMIX);
        for (int idx = gt; idx < 64 * 128; idx += NT) { const int k2 = idx >> 7, col = idx & 127, part = col >> 6, n2 = col & 63;
            const int ph = (n2 * k2) & 63; float s, c; sincospif((float)ph * (1.0f / 32.0f), &s, &c);
            E3[idx] = (bf16)f2bf(part ? s : c);
            E3I[idx] = (bf16)f2bf(part ? c : -s); }
        LAS float* cst = (LAS float*)lds;
        __syncthreads();
        if (tid < 64) { float sn, cs; sincospif((float)tid * (1.0f / 32.0f), &sn, &cs); cst[tid] = cs; cst[64 + tid] = sn; }
        __syncthreads();
        for (int idx = gt; idx < 2 * 8 * 64 * 128; idx += NT) { const int lh = idx >> 13, e = (idx >> 7) & 63, col = idx & 127, part = col >> 6, c = col & 63;
            const float* wf = p.w_fourier + (size_t)lh * 4096; float a = 0.f;
#pragma unroll 8
            for (int d = 0; d < 64; ++d) a += cst[64 * part + ((c * d) & 63)] * wf[d * 64 + e];
            FM[idx] = (bf16)f2bf(a * (1.0f / 724.0773439350247f)); }
    }
}

typedef short v4s16 __attribute__((ext_vector_type(4)));
__device__ __forceinline__ bf16x8 negbf(bf16x8 v) { u32x4 t = __builtin_bit_cast(u32x4, v); t = t ^ 0x80008000u; return __builtin_bit_cast(bf16x8, t); }
__device__ __forceinline__ bf16x8 tr_frag(const LAS unsigned char* a, int hs) {
    const v4s16 lo = __builtin_amdgcn_ds_read_tr16_b64_v4i16((LAS v4s16*)a), hi = __builtin_amdgcn_ds_read_tr16_b64_v4i16((LAS v4s16*)(a + hs));
    return __builtin_shufflevector(lo, hi, 0, 1, 2, 3, 4, 5, 6, 7);
}
constexpr int F1_P = 264, F1_CS = 128 * F1_P;
__device__ __forceinline__ void fft1_phase(const bf16* ZF, const bf16* D1, bf16* T, LAS unsigned char* lds, int G, int bid) {
    int tid = threadIdx.x; asm volatile("" : "+v"(tid));
    const int lane = tid & 63, wave = __builtin_amdgcn_readfirstlane(tid >> 6), wm = wave & 3, wn = wave >> 2, fr = lane & 15, fq = lane >> 4, tq = fr >> 2, tp = fr & 3;
    for (int pr = bid; pr < 256; pr += G) {
        const int n2 = pr & 63, cb = pr >> 6;
        __syncthreads();
        {
            const bf16* src = D1 + (size_t)n2 * 2 * 128 * 128;
#pragma unroll
            for (int j = 0; j < 8; ++j) { const int q = tid + 512 * j, sel = q >> 11, row = (q >> 4) & 127, cc = q & 15;
                *(LAS u32x4*)(lds + F1_CS + sel * 34816 + row * 272 + cc * 16) = *(const u32x4*)(src + sel * 16384 + row * 128 + 8 * cc); }
        }
        u32x4 pre[4];
#pragma unroll
        for (int j = 0; j < 4; ++j) { const int q = tid + 512 * j, n1 = q >> 4, cc = q & 15; pre[j] = *(const u32x4*)(ZF + ((size_t)(64 * n1 + n2)) * 512 + cb * 128 + 8 * cc); }
        for (int b = 0; b < NB; ++b) {
            __syncthreads();
#pragma unroll
            for (int j = 0; j < 4; ++j) { const int q = tid + 512 * j, n1 = q >> 4, cc = q & 15; const u32x4 v = pre[j];
                LAS u32x2* d = (LAS u32x2*)(lds + n1 * F1_P + cc * 16); d[0] = (u32x2){v.x, v.y}; d[1] = (u32x2){v.z, v.w}; }
            __syncthreads();
            if (b + 1 < NB) {
#pragma unroll
                for (int j = 0; j < 4; ++j) { const int q = tid + 512 * j, n1 = q >> 4, cc = q & 15; pre[j] = *(const u32x4*)(ZF + ((size_t)((b + 1) * SEQ + 64 * n1 + n2)) * 512 + cb * 128 + 8 * cc); } }
            f32x4 Ar[2][4], Ai[2][4];
#pragma unroll
            for (int mb = 0; mb < 2; ++mb)
#pragma unroll
                for (int nb = 0; nb < 4; ++nb) { Ar[mb][nb] = (f32x4){0.f, 0.f, 0.f, 0.f}; Ai[mb][nb] = (f32x4){0.f, 0.f, 0.f, 0.f}; }
#pragma nounroll
            for (int ks = 0; ks < 4; ++ks) {
                bf16x8 Bf[4];
#pragma unroll
                for (int nb = 0; nb < 4; ++nb) Bf[nb] = tr_frag(lds + (32 * ks + 8 * fq + tq) * F1_P + (64 * wn + 16 * tp + 4 * nb) * 2, 4 * F1_P);
                bf16x8 Cf[2], Sf[2];
#pragma unroll
                for (int mb = 0; mb < 2; ++mb) { const int off = F1_CS + (32 * wm + 16 * mb + fr) * 272 + (32 * ks + 8 * fq) * 2; Cf[mb] = *(const LAS bf16x8*)(lds + off); Sf[mb] = *(const LAS bf16x8*)(lds + off + 34816); }
#pragma unroll
                for (int mb = 0; mb < 2; ++mb)
#pragma unroll
                    for (int nb = 0; nb < 4; ++nb) {
                        Ar[mb][nb] = __builtin_amdgcn_mfma_f32_16x16x32_bf16(Bf[nb], Cf[mb], Ar[mb][nb], 0, 0, 0);
                        Ai[mb][nb] = __builtin_amdgcn_mfma_f32_16x16x32_bf16(Bf[nb], negbf(Sf[mb]), Ai[mb][nb], 0, 0, 0); }
            }
#pragma unroll
            for (int mb = 0; mb < 2; ++mb) { const int k1 = 32 * wm + 16 * mb + fr, c = cb * 128 + 64 * wn + 16 * fq;
                bf16* t0 = T + ((((size_t)(b * 128 + k1) * 2 + 0) * 64 + n2) * 512 + c); bf16* t1 = t0 + 64 * 512;
                *(u32x4*)t0 = pack8(Ar[mb][0], Ar[mb][1]); *(u32x4*)(t0 + 8) = pack8(Ar[mb][2], Ar[mb][3]);
                *(u32x4*)t1 = pack8(Ai[mb][0], Ai[mb][1]); *(u32x4*)(t1 + 8) = pack8(Ai[mb][2], Ai[mb][3]); }
        }
    }
    __syncthreads();
}

constexpr int F3_P = 1088;
__device__ __forceinline__ bf16x8 pack8b(f32x4 a, f32x4 b) { return __builtin_bit_cast(bf16x8, pack8(a, b)); }
__device__ __forceinline__ void fft3_phase(const bf16* T, const bf16* E3, const bf16* E3I, const bf16* FM, bf16* AO, LAS unsigned char* lds, int G, int bid) {
    int tid = threadIdx.x; asm volatile("" : "+v"(tid));
    const int lane = tid & 63, wave = __builtin_amdgcn_readfirstlane(tid >> 6), fr = lane & 15, fq = lane >> 4, tq = fr >> 2, tp = fr & 3;
    LAS float* red = (LAS float*)(lds + 128 * F3_P);
#define F3_ISSUE(u_) do { const bf16* src_ = T + (size_t)(u_) * 65536; _Pragma("unroll") for (int j_ = 0; j_ < 16; ++j_) { const int row_ = wave * 16 + j_; \
        __builtin_amdgcn_global_load_lds((const unsigned*)(src_ + row_ * 512 + lane * 8), (LAS unsigned*)(lds + row_ * F3_P), 16, 0, 0); } } while (0)
    if (bid < 512) F3_ISSUE(bid);
    for (int unit = bid; unit < 512; unit += G) {
        const int b = unit >> 7, k1 = unit & 127;
        asm volatile("s_waitcnt vmcnt(0)" ::: "memory");
        __syncthreads();
        f32x4 gr[4][4], gi[4][4];
#pragma unroll
        for (int mb = 0; mb < 4; ++mb)
#pragma unroll
            for (int nb = 0; nb < 4; ++nb) { gr[mb][nb] = (f32x4){0.f, 0.f, 0.f, 0.f}; gi[mb][nb] = (f32x4){0.f, 0.f, 0.f, 0.f}; }
#pragma nounroll
        for (int ks = 0; ks < 4; ++ks) {
            bf16x8 Bf[4], Er[4], Ei[4];
#pragma unroll
            for (int mb = 0; mb < 4; ++mb) { const int off = (16 * mb + fr) * 128 + 32 * ks + 8 * fq; Er[mb] = *(const bf16x8*)(E3 + off); Ei[mb] = *(const bf16x8*)(E3I + off); }
#pragma unroll
            for (int nb = 0; nb < 4; ++nb) Bf[nb] = tr_frag(lds + (32 * ks + 8 * fq + tq) * F3_P + (64 * wave + 32 * (nb >> 1) + 8 * tp + 4 * (nb & 1)) * 2, 4 * F3_P);
#pragma unroll
            for (int mb = 0; mb < 4; ++mb)
#pragma unroll
                for (int nb = 0; nb < 4; ++nb) { gr[mb][nb] = __builtin_amdgcn_mfma_f32_16x16x32_bf16(Bf[nb], Er[mb], gr[mb][nb], 0, 0, 0);
                                                 gi[mb][nb] = __builtin_amdgcn_mfma_f32_16x16x32_bf16(Bf[nb], Ei[mb], gi[mb][nb], 0, 0, 0); }
        }
        __syncthreads();
        if (unit + G < 512) F3_ISSUE(unit + G);
        bf16x8 Af[4][4];
#pragma unroll
        for (int mb = 0; mb < 4; ++mb) { Af[0][mb] = pack8b(gr[mb][0], gr[mb][1]); Af[1][mb] = pack8b(gr[mb][2], gr[mb][3]); Af[2][mb] = pack8b(gi[mb][0], gi[mb][1]); Af[3][mb] = pack8b(gi[mb][2], gi[mb][3]); }
        f32x4 acc[4][4];
#pragma unroll
        for (int mb = 0; mb < 4; ++mb)
#pragma unroll
            for (int nb = 0; nb < 4; ++nb) acc[mb][nb] = (f32x4){0.f, 0.f, 0.f, 0.f};
        const bf16* fm = FM + (size_t)wave * 64 * 128;
#pragma unroll
        for (int kst = 0; kst < 4; ++kst) {
            bf16x8 Ff[4];
#pragma unroll
            for (int nb = 0; nb < 4; ++nb) Ff[nb] = *(const bf16x8*)(fm + (16 * tq + 4 * nb + tp) * 128 + 32 * kst + 8 * fq);
#pragma unroll
            for (int mb = 0; mb < 4; ++mb)
#pragma unroll
                for (int nb = 0; nb < 4; ++nb) acc[mb][nb] = __builtin_amdgcn_mfma_f32_16x16x32_bf16(Ff[nb], Af[kst][mb], acc[mb][nb], 0, 0, 0);
        }
#pragma unroll
        for (int mb = 0; mb < 4; ++mb) { float s = 0.f;
#pragma unroll
            for (int nb = 0; nb < 4; ++nb)
#pragma unroll
                for (int j = 0; j < 4; ++j) s += acc[mb][nb][j] * acc[mb][nb][j];
            s += __shfl_xor(s, 16); s += __shfl_xor(s, 32);
            if (fq == 0) red[wave * 64 + 16 * mb + fr] = s; }
        __syncthreads();
#pragma unroll
        for (int mb = 0; mb < 4; ++mb) { float tot = 0.f;
#pragma unroll
            for (int w = 0; w < 8; ++w) tot += red[w * 64 + 16 * mb + fr];
            const float rinv = rsqrtf(tot * (1.0f / 512.0f) + EPS);
            const size_t token = (size_t)b * SEQ + k1 + 128 * (16 * mb + fr);
            bf16* o = AO + token * 1024 + 64 * wave + 16 * fq;
            *(u32x4*)o = pack8(acc[mb][0] * rinv, acc[mb][1] * rinv); *(u32x4*)(o + 8) = pack8(acc[mb][2] * rinv, acc[mb][3] * rinv); }
    }
    __syncthreads();
}

__device__ __forceinline__ void carry_phase(const Params& p, int ly, const float* Sloc, bf16* UB, LAS unsigned char* lds, int G, int bid) {
    int tid = threadIdx.x; asm volatile("" : "+v"(tid));
    const int lane = tid & 63, wave = __builtin_amdgcn_readfirstlane(tid >> 6);
    LAS f32x2* ex = (LAS f32x2*)lds;
    for (int w = bid; w < 256; w += G) {
        const int dir = w & 1, g = (w >> 1) & 31, b = w >> 6, pp = lane; const int idx = (ly * 2 + dir) * 32 + g;
        const float dt = expf(p.log_dt[idx]); const float lr = p.lam_re[idx * 64 + pp] * dt * 16.0f, li = p.lam_im[idx * 64 + pp] * dt * 16.0f;
        const float e = expf(lr); float sn, cs; sincosf(li, &sn, &cs); const float l_r = e * cs, l_i = e * sn;
        float Lr = l_r, Li = l_i;
#pragma unroll
        for (int k = 0; k < 6; ++k) { const float nr = Lr * Lr - Li * Li, ni = 2.0f * Lr * Li; Lr = nr; Li = ni; }
        const float* src = Sloc + ((size_t)(g * 2048 + b * 512)) * 256 + dir * 128 + 2 * pp;
        bf16* dst = UB + ((size_t)(g * 2048 + b * 512)) * 512 + 256 + dir * 128 + 2 * pp;
        const int ss0 = dir == 0 ? wave * 64 : 511 - wave * 64; const long stp = dir == 0 ? 256 : -256;
        float cr = 0.f, ci = 0.f;
        { const float* ptr = src + (size_t)ss0 * 256;
#pragma nounroll
          for (int hb = 0; hb < 2; ++hb) {
            f32x2 v[32];
#pragma unroll
            for (int j = 0; j < 32; ++j) { v[j] = *(const f32x2*)ptr; ptr += stp; }
#pragma unroll
            for (int j = 0; j < 32; ++j) { const float nr = l_r * cr - l_i * ci + v[j][0], ni = l_r * ci + l_i * cr + v[j][1]; cr = nr; ci = ni; }
          } }
        __syncthreads();
        ex[wave * 64 + lane] = (f32x2){cr, ci};
        __syncthreads();
        cr = 0.f; ci = 0.f;
        for (int u = 0; u < wave; ++u) { const f32x2 eu = ex[u * 64 + lane]; const float nr = Lr * cr - Li * ci + eu[0], ni = Lr * ci + Li * cr + eu[1]; cr = nr; ci = ni; }
        { const float* ptr = src + (size_t)ss0 * 256; bf16* dp = dst + (size_t)ss0 * 512;
#pragma nounroll
          for (int hb = 0; hb < 2; ++hb) {
            f32x2 v[32];
#pragma unroll
            for (int j = 0; j < 32; ++j) { v[j] = *(const f32x2*)ptr; ptr += stp; }
#pragma unroll
            for (int j = 0; j < 32; ++j) {
                *(unsigned*)dp = pk2(cr, ci); dp += 2 * stp;
                const float nr = l_r * cr - l_i * ci + v[j][0], ni = l_r * ci + l_i * cr + v[j][1]; cr = nr; ci = ni; }
          } }
    }
    __syncthreads();
}

__device__ __forceinline__ void norm_phase(float* out, const bf16* MF, const float* ss, const float* gain, bf16* XB, float* rnext, bool last, int G, int bid) {
    int tid = threadIdx.x; asm volatile("" : "+v"(tid));
    const int lane = tid & 63, wave = __builtin_amdgcn_readfirstlane(tid >> 6);
    const int gw = bid * 8 + wave, NGW = G * 8;
    f32x4 gq[2][2];
#pragma unroll
    for (int j = 0; j < 2; ++j) { gq[j][0] = *(const f32x4*)(gain + 8 * lane + 512 * j); gq[j][1] = *(const f32x4*)(gain + 8 * lane + 512 * j + 4); }
    for (int row0 = gw; row0 < MT; row0 += 2 * NGW) {
        u32x4 xv[2][2], mv[2][2]; float tot[2];
#pragma unroll
        for (int rr = 0; rr < 2; ++rr) { const int row = row0 + rr * NGW;
            const u32x4* xr = (const u32x4*)(XB + (size_t)row * 1024) + lane; const u32x4* mr = (const u32x4*)(MF + (size_t)row * 1024) + lane;
#pragma unroll
            for (int j = 0; j < 2; ++j) { xv[rr][j] = xr[64 * j]; mv[rr][j] = mr[64 * j]; }
            const f32x4* sp = (const f32x4*)(ss + (size_t)row * 16); const f32x4 s0 = sp[0], s1 = sp[1], s2 = sp[2], s3 = sp[3];
            tot[rr] = ((((s0[0] + s0[1]) + s0[2]) + s0[3]) + (((s1[0] + s1[1]) + s1[2]) + s1[3])) + ((((s2[0] + s2[1]) + s2[2]) + s2[3]) + (((s3[0] + s3[1]) + s3[2]) + s3[3])); }
#pragma unroll
        for (int rr = 0; rr < 2; ++rr) { const int row = row0 + rr * NGW;
            const float rinv = rsqrtf(tot[rr] * (1.0f / 1024.0f) + EPS); float s2 = 0.f;
#pragma unroll
            for (int j = 0; j < 2; ++j) { const u32x4 xx = xv[rr][j], mm = mv[rr][j]; const f32x4 ga = gq[j][0] * rinv, gb = gq[j][1] * rinv; f32x4 a, b;
                a[0] = bflo(xx.x) + bflo(mm.x) * ga[0]; a[1] = bfhi(xx.x) + bfhi(mm.x) * ga[1]; a[2] = bflo(xx.y) + bflo(mm.y) * ga[2]; a[3] = bfhi(xx.y) + bfhi(mm.y) * ga[3];
                b[0] = bflo(xx.z) + bflo(mm.z) * gb[0]; b[1] = bfhi(xx.z) + bfhi(mm.z) * gb[1]; b[2] = bflo(xx.w) + bflo(mm.w) * gb[2]; b[3] = bfhi(xx.w) + bfhi(mm.w) * gb[3];
                if (last) { float* op = out + (size_t)row * 1024 + 8 * lane + 512 * j; *(f32x4*)op = a; *(f32x4*)(op + 4) = b; }
                else { const u32x4 w = pack8(a, b); ((u32x4*)(XB + (size_t)row * 1024) + lane)[64 * j] = w;
                       const float e0 = bflo(w.x), e1 = bfhi(w.x), e2 = bflo(w.y), e3 = bfhi(w.y), e4 = bflo(w.z), e5 = bfhi(w.z), e6 = bflo(w.w), e7 = bfhi(w.w);
                       s2 += ((e0 * e0 + e1 * e1) + (e2 * e2 + e3 * e3)) + ((e4 * e4 + e5 * e5) + (e6 * e6 + e7 * e7)); } }
            if (!last) { s2 = wave_sum(s2); if (lane == 0) rnext[row] = rsqrtf(s2 * (1.0f / 1024.0f) + EPS); } }
    }
}
__device__ __forceinline__ void rescale_phase(bf16* AO, const float* ss, int G, int bid) {
    int tid = threadIdx.x; asm volatile("" : "+v"(tid));
    const int lane = tid & 63, wave = __builtin_amdgcn_readfirstlane(tid >> 6);
    const int gw = bid * 8 + wave, NGW = G * 8;
    for (int row = gw; row < MT; row += NGW) {
        float tot = 0.f;
#pragma unroll
        for (int k = 0; k < 8; ++k) tot += ss[row * 8 + k];
        const float rinv = rsqrtf(tot * (1.0f / 512.0f) + EPS);
        u32x4* ptr = (u32x4*)(AO + (size_t)row * 1024 + 512) + lane; u32x4 v = *ptr;
        v.x = pk2(bflo(v.x) * rinv, bfhi(v.x) * rinv); v.y = pk2(bflo(v.y) * rinv, bfhi(v.y) * rinv); v.z = pk2(bflo(v.z) * rinv, bfhi(v.z) * rinv); v.w = pk2(bflo(v.w) * rinv, bfhi(v.w) * rinv);
        *ptr = v;
    }
}


#define XB_TMO      128
#define XB_XCNT(j)  (256  + 64 * (j))
#define XB_XSUB(j)  (1280 + 64 * (j))
#define XB_XGEN(j)  (2304 + 64 * (j))
#define XB_TOP      3328
#define XB_TOPGEN   3392
#define XCD_BAR_WORDS 3456
#define XB_SPIN_CAP (1u << 18)
__device__ __forceinline__ unsigned xb_ld(unsigned* p)              { return __hip_atomic_load(p, __ATOMIC_RELAXED, __HIP_MEMORY_SCOPE_AGENT); }
__device__ __forceinline__ unsigned xb_add(unsigned* p, unsigned v) { return __hip_atomic_fetch_add(p, v, __ATOMIC_RELAXED, __HIP_MEMORY_SCOPE_AGENT); }
__device__ __forceinline__ unsigned xb_xcc_id() { return (unsigned)__builtin_amdgcn_s_getreg((3 << 11) | 20) & 0xFu; }
#define XB_SPIN(cond, bar) do { unsigned _sp = 0; while (cond) { __builtin_amdgcn_s_sleep(1); \
    if ((++_sp & 255u) == 0u) { if (xb_ld(&(bar)[XB_TMO])) break; if (_sp > XB_SPIN_CAP) { atomicAdd(&(bar)[XB_TMO], 1u); break; } } } } while (0)
struct XcdBarrier { unsigned* bar; unsigned x; volatile LAS unsigned* st; };
__device__ __forceinline__ XcdBarrier xcd_barrier_post(unsigned* bar, volatile LAS unsigned* st) {
    XcdBarrier b; b.bar = bar; b.x = xb_xcc_id(); b.st = st;
    if (threadIdx.x == 0) (void)xb_add(&bar[XB_XCNT(b.x)], 1u);
    return b;
}
__device__ __forceinline__ void xcd_barrier_complete(unsigned* bar, unsigned x, unsigned& nloc, unsigned& nx) {
    const unsigned G = gridDim.x * gridDim.y * gridDim.z;
    unsigned sum, cnt, mine, sp = 0u;
    for (;;) {
        sum = 0u; cnt = 0u; mine = 0u;
#pragma unroll
        for (unsigned j = 0; j < 16; ++j) { const unsigned c = xb_ld(&bar[XB_XCNT(j)]); sum += c; cnt += (c > 0u) ? 1u : 0u; mine = (j == x) ? c : mine; }
        if (sum == G) break;
        __builtin_amdgcn_s_sleep(1);
        if ((++sp & 255u) == 0u) { if (xb_ld(&bar[XB_TMO])) break; if (sp > XB_SPIN_CAP) { atomicAdd(&bar[XB_TMO], 1u); break; } }
    }
    nloc = mine > 0u ? mine : 1u; nx = cnt > 0u ? cnt : 1u;
}
__device__ __forceinline__ void xcd_barrier(const XcdBarrier& b) {
    asm volatile("s_waitcnt vmcnt(0)" ::: "memory");
    __syncthreads();
    if (threadIdx.x == 0) {
        unsigned* bar = b.bar;
        __builtin_amdgcn_s_waitcnt(0);
        unsigned nloc = b.st[0], nx = b.st[1];
        if (nloc == 0u) { xcd_barrier_complete(bar, b.x, nloc, nx); b.st[0] = nloc; b.st[1] = nx; }
        const unsigned old = xb_add(&bar[XB_XSUB(b.x)], 1u);
        const unsigned gen = old / nloc;
        if (old + 1u == (gen + 1u) * nloc) {
            __builtin_amdgcn_fence(__ATOMIC_RELEASE, "agent");
            asm volatile("s_waitcnt vmcnt(0)" ::: "memory");
            const unsigned og = xb_add(&bar[XB_TOP], 1u);
            const unsigned tg = og / nx;
            if (og + 1u == (tg + 1u) * nx) xb_add(&bar[XB_TOPGEN], 1u);
            else XB_SPIN(xb_ld(&bar[XB_TOPGEN]) == tg, bar);
            __builtin_amdgcn_fence(__ATOMIC_ACQUIRE, "agent");
            xb_add(&bar[XB_XGEN(b.x)], 1u);
            asm volatile("s_waitcnt vmcnt(0)" ::: "memory");
        } else {
            XB_SPIN(xb_ld(&bar[XB_XGEN(b.x)]) == gen, bar);
            __builtin_amdgcn_fence(__ATOMIC_ACQUIRE, "agent");
            asm volatile("s_waitcnt vmcnt(0)" ::: "memory");
        }
    }
    __syncthreads();
}

#ifndef REP_P0
#define REP_P0 1
#endif
#ifndef REP_SYNC
#define REP_SYNC 1
#endif
#ifndef REP_MASK_V
#define REP_MASK_V 0u
#endif
constexpr unsigned REP_MASK = REP_MASK_V;
constexpr int PH_PER_LAYER = 10, N_PHASES = 1 + 2 * PH_PER_LAYER;
__global__ void __launch_bounds__(512) hybrid_fwd(Params p) {
    extern __shared__ __attribute__((aligned(16))) unsigned char lds_raw[];
    LAS unsigned char* lds = (LAS unsigned char*)lds_raw;
    cg::grid_group grid = cg::this_grid();
    volatile LAS unsigned* xst = (volatile LAS unsigned*)(lds + LDS_BYTES - 16);
    if (threadIdx.x < 4) xst[threadIdx.x] = 0u;
    __syncthreads();
    const XcdBarrier xbar = xcd_barrier_post((unsigned*)(p.ws + OFF_BAR), xst);
    if (p.ph_hi > 1000) grid.sync();
    const int Gk = gridDim.x, bk = blockIdx.x;
    unsigned char* ws = p.ws;
    float* sss = (float*)(ws + OFF_SSS); float* ssm = (float*)(ws + OFF_SSM); float* ssf = (float*)(ws + OFF_SSF); float* rA = (float*)(ws + OFF_RA); float* rB = (float*)(ws + OFF_RB);
    bf16* XB = (bf16*)(ws + OFF_XB); bf16* MF = (bf16*)(ws + OFF_MF); bf16* GB = (bf16*)(ws + OFF_G); bf16* HB = (bf16*)(ws + OFF_H);
    bf16* PQ = (bf16*)(ws + OFF_PQ); bf16* AO = (bf16*)(ws + OFF_AO); bf16* UB = (bf16*)(ws + OFF_UB); bf16* TB = (bf16*)(ws + OFF_T); float* SL = (float*)(ws + OFF_SLOC);

#pragma nounroll
    for (int ph = p.ph_lo; ph < p.ph_hi; ++ph) {
        int G = Gk, bid = bk; asm volatile("" : "+s"(G), "+s"(bid));
        if (ph == 0) { for (int rep = 0; rep < REP_P0; ++rep) p0_prologue(p, lds, G, bid); }
        else {
            const int ly = (ph - 1) / PH_PER_LAYER, sp = (ph - 1) % PH_PER_LAYER;
            unsigned char* wb = ws + OFF_W + (size_t)ly * W_LAYER;
            pg8::Order S;
            const int nrep = ((REP_MASK >> sp) & 1u) ? 2 : 1;
            for (int rep = 0; rep < nrep; ++rep)
            switch (sp) {
            case 0: {
                pg8::Gemm g{XB, (const bf16*)(wb + W_IN), MT, NIN, 1024, 1024, 1024, 0, 0, 1}; S.init(MT, NIN, 1, G, bid, WGM_IN);
                EpiIn E{PQ, UB, rA}; pg8::gemm_phase<EpiIn>(lds, g, S, E); } break;
            case 1: {
                fft1_phase(PQ, (const bf16*)(ws + OFF_D1), TB, lds, G, bid);
                pg8::Gemm g{UB, (const bf16*)(ws + OFF_MST) + (size_t)ly * 32 * 256 * 256, 2048, 256, 256, 512, 256, (size_t)2048 * 512, (size_t)256 * 256, 32}; S.init(2048, 256, 32, G, bid);
                EpiSloc E{SL}; pg8::gemm_phase<EpiSloc>(lds, g, S, E); } break;
            case 2: {
                carry_phase(p, ly, SL, UB, lds, G, bid);
                fft3_phase(TB, (const bf16*)(ws + OFF_E3), (const bf16*)(ws + OFF_E3I), (const bf16*)(ws + OFF_FMIX) + (size_t)ly * 8 * 64 * 128, AO, lds, G, bid); } break;
            case 3: {
                pg8::Gemm g{UB, (const bf16*)(ws + OFF_TM) + (size_t)ly * 32 * 256 * 512, 2048, 256, 512, 512, 512, (size_t)2048 * 512, (size_t)256 * 512, 32}; S.init(2048, 256, 32, G, bid);
                EpiSsmOut E{GB}; pg8::gemm_phase<EpiSsmOut>(lds, g, S, E); } break;
            case 4: {
                pg8::Gemm g{GB, (const bf16*)(wb + W_GLU), MT, 512, 512, 512, 512, 0, 0, 1}; S.init(MT, 512, 1, G, bid, WGM_GLU);
                EpiGlu E{GB, p.b_glu + ly * 512, AO, sss}; pg8::gemm_phase<EpiGlu>(lds, g, S, E); } break;
            case 5: {
                pg8::Gemm g{AO, (const bf16*)(wb + W_OUT), MT, 1024, 1024, 1024, 1024, 0, 0, 1}; S.init(MT, 1024, 1, G, bid, WGM_OUT);
                LAS float* qv = (LAS float*)(lds + 131072);
                { int tid = threadIdx.x; asm volatile("" : "+v"(tid));
                  for (int i = 0; i < 4; ++i) { pg8::Unit u; if (!S.next(i, u)) break;
                      if (tid < 256) { const f32x4* sp = (const f32x4*)(sss + (size_t)(u.pm * 256 + tid) * 8); const f32x4 a = sp[0], b = sp[1];
                          const float ms = ((((a[0] + a[1]) + a[2]) + a[3]) + (((b[0] + b[1]) + b[2]) + b[3])) * (1.0f / 512.0f) + EPS;
                          qv[i * 256 + tid] = sqrtf(ms); qv[1024 + i * 256 + tid] = rsqrtf(ms); } }
                  __syncthreads(); }
                EpiOutMix E{MF, ssm, qv}; pg8::gemm_phase<EpiOutMix>(lds, g, S, E); } break;
            case 6: norm_phase(p.out, MF, ssm, p.post_mix_g + ly * 1024, XB, rB, false, G, bid); break;
            case 7: {
                pg8::Gemm g{XB, (const bf16*)(wb + W_1), MT, DFF, 1024, 1024, 1024, 0, 0, 1}; S.init(MT, DFF, 1, G, bid, WGM_FF1);
                EpiFF1 E{HB, rB}; pg8::gemm_phase<EpiFF1>(lds, g, S, E); } break;
            case 8: {
                pg8::Gemm g{HB, (const bf16*)(wb + W_2), MT, 1024, DFF, DFF, DFF, 0, 0, 1}; S.init(MT, 1024, 1, G, bid, WGM_FF2);
                EpiOutSS E{MF, ssf}; pg8::gemm_phase<EpiOutSS>(lds, g, S, E); } break;
            case 9: norm_phase(p.out, MF, ssf, p.post_mlp_g + ly * 1024, XB, rA, ly == 1, G, bid); break;
            }
        }
        if (ph + 1 < p.ph_hi) for (int rep = 0; rep < REP_SYNC; ++rep) xcd_barrier(xbar);
    }
}

extern "C" void kernel_launch(void* const* d_in, const int* in_sizes, int n_in, void* d_out, int out_size, void* d_ws, size_t ws_size, hipStream_t stream) {
    static int grid = 0;
    if (grid == 0) {
        if (n_in != 22 || ws_size < WS_END) { fprintf(stderr, "kernel_launch: unexpected n_in %d or ws_size %zu (< %zu)\n", n_in, ws_size, (size_t)WS_END); grid = -1; return; }
        int dev = 0, cus = 0, per_cu = 0;
        hipGetDevice(&dev); hipDeviceGetAttribute(&cus, hipDeviceAttributeMultiprocessorCount, dev);
        if (hipFuncSetAttribute((const void*)hybrid_fwd, hipFuncAttributeMaxDynamicSharedMemorySize, LDS_BYTES) != hipSuccess) { fprintf(stderr, "kernel_launch: hipFuncSetAttribute failed\n"); grid = -1; return; }
        if (hipOccupancyMaxActiveBlocksPerMultiprocessor(&per_cu, (const void*)hybrid_fwd, 512, LDS_BYTES) != hipSuccess || per_cu < 1) { fprintf(stderr, "kernel_launch: occupancy query says %d blocks per CU\n", per_cu); per_cu = 1; }
        (void)hipGetLastError();
        grid = cus;
    }
    if (grid < 0) return;
    if (hipMemsetAsync((char*)d_ws + OFF_BAR, 0, BAR_BYTES, stream) != hipSuccess) { fprintf(stderr, "kernel_launch: memset of the barrier words failed\n"); return; }
    Params p{};
    const float** f = (const float**)&p;
    for (int i = 0; i < 22; ++i) f[i] = (const float*)d_in[i];
    p.out = (float*)d_out; p.ws = (unsigned char*)d_ws; p.ph_lo = 0; p.ph_hi = N_PHASES;
    void* args[] = {&p};
    hipError_t e = hipLaunchCooperativeKernel((const void*)hybrid_fwd, dim3(grid), dim3(512), args, LDS_BYTES, stream);
    if (e != hipSuccess) fprintf(stderr, "kernel_launch: cooperative launch failed: %s (grid %d)\n", hipGetErrorString(e), grid);
}
```
